# Optimizing an MI355X kernel written in HIP

```python
import jax, jax.numpy as jnp
from jax import lax
import numpy as np

D_MODEL = 1024
BATCH = 8
SEQ = 2048
DEPTH = 4

N_META = 16
EPS = 1e-6
RNN_WIDTH = D_MODEL
RNN_BLOCKS = 8
RNN_BLOCK = RNN_WIDTH // RNN_BLOCKS
CONV_WIDTH = 4
RGLRU_C = 8.0
GLA_HEADS = 4
GLA_DK = D_MODEL // 2 // GLA_HEADS
GLA_DV = D_MODEL // GLA_HEADS
GLA_GATE_RANK = 16
GLA_TAU = 16.0
GLA_CHUNK = 64
MLA_HEADS = 16
MLA_NOPE = 64
MLA_ROPE = 32
MLA_V = 64
MLA_Q_RANK = D_MODEL // 2
MLA_KV_RANK = D_MODEL // 4
ROPE_BASE = 10000.0
Q_BLOCK = 128

N_AB = (DEPTH + 1) // 2
N_C = DEPTH // 2

EVEN_SPLITS = (RNN_WIDTH, RNN_WIDTH, GLA_HEADS * GLA_DK, GLA_HEADS * GLA_DK,
               GLA_HEADS * GLA_DV, GLA_GATE_RANK, GLA_HEADS * GLA_DV)
EVEN_IN = sum(EVEN_SPLITS)
EVEN_MIX = RNN_WIDTH + GLA_HEADS * GLA_DV
ODD_SPLITS = (MLA_Q_RANK, MLA_KV_RANK, MLA_ROPE, MLA_HEADS * MLA_V)
ODD_IN = sum(ODD_SPLITS)
ODD_MIX = MLA_HEADS * MLA_V

kernel_name = "hybrid_rglru_gla_mla_meta"


def _split(t, sizes):
    idx = np.cumsum(sizes)[:-1].tolist()
    return jnp.split(t, idx, axis=-1)


def rmsnorm(x, g):
    xf = x.astype(jnp.float32)
    y = xf * lax.rsqrt(jnp.mean(xf * xf, axis=-1, keepdims=True) + EPS)
    return (y * g.astype(jnp.float32)).astype(x.dtype)


def apply_rope(x, cos, sin):
    xf = x.astype(jnp.float32)
    x1, x2 = jnp.split(xf, 2, axis=-1)
    return jnp.concatenate([x1 * cos - x2 * sin, x2 * cos + x1 * sin], axis=-1).astype(x.dtype)


def causal_conv(x, w, b):
    T = x.shape[1]
    xp = jnp.pad(x, ((0, 0), (CONV_WIDTH - 1, 0), (0, 0)))
    y = xp[:, 0:T] * w[0]
    for k in range(1, CONV_WIDTH):
        y = y + xp[:, k:k + T] * w[k]
    return y + b


def rglru(x, gate_a_w, gate_a_b, gate_x_w, gate_x_b, lam):
    B, T, _ = x.shape
    xf = x.astype(jnp.float32)
    xb = xf.reshape(B, T, RNN_BLOCKS, RNN_BLOCK)
    r = jax.nn.sigmoid(jnp.einsum('btgi,gij->btgj', xb, gate_a_w.astype(jnp.float32)).reshape(B, T, RNN_WIDTH)
                       + gate_a_b.astype(jnp.float32))
    i = jax.nn.sigmoid(jnp.einsum('btgi,gij->btgj', xb, gate_x_w.astype(jnp.float32)).reshape(B, T, RNN_WIDTH)
                       + gate_x_b.astype(jnp.float32))
    log_a = -RGLRU_C * r * jax.nn.softplus(-lam.astype(jnp.float32))
    a = jnp.exp(log_a)
    u = jnp.sqrt(-jnp.expm1(2.0 * log_a)) * (i * xf)

    def combine(e1, e2):
        a1, b1 = e1
        a2, b2 = e2
        return a1 * a2, a2 * b1 + b2

    _, h = lax.associative_scan(combine, (a, u), axis=1)
    return h.astype(x.dtype)


def gla_chunked(q, k, v, log_alpha):
    B, T, H, DK = q.shape
    DV = v.shape[-1]
    dtype = v.dtype
    pad = (-N_META) % GLA_CHUNK
    padf = lambda t: jnp.pad(t.astype(jnp.float32), ((0, 0), (pad, 0), (0, 0), (0, 0)))
    q, k, v, la = padf(q), padf(k), padf(v), padf(log_alpha)
    Tp = T + pad
    N = Tp // GLA_CHUNK

    def chunks(t):
        return t.reshape(B, N, GLA_CHUNK, H, t.shape[-1]).transpose(1, 0, 3, 2, 4)

    q, k, v, la = chunks(q), chunks(k), chunks(v), chunks(la)
    b = jnp.cumsum(la, axis=3)
    b_last = b[:, :, :, -1:, :]
    q_dec = q * jnp.exp(b)
    k_inv = k * jnp.exp(-b)
    k_end = k * jnp.exp(b_last - b)
    causal = jnp.tril(jnp.ones((GLA_CHUNK, GLA_CHUNK), dtype=bool))
    s = jnp.where(causal, jnp.einsum('nbhcd,nbhsd->nbhcs', q_dec, k_inv), 0.0)
    o_intra = jnp.einsum('nbhcs,nbhse->nbhce', s, v)

    def step(S, inp):
        qd, ke, vv, bl = inp
        o = jnp.einsum('bhcd,bhde->bhce', qd, S)
        S = jnp.exp(bl)[:, :, 0, :, None] * S + jnp.einsum('bhcd,bhce->bhde', ke, vv)
        return S, o

    S0 = jnp.zeros((B, H, DK, DV), jnp.float32)
    _, o_inter = lax.scan(step, S0, (q_dec, k_end, v, b_last))
    o = (o_intra + o_inter).transpose(1, 0, 3, 2, 4).reshape(B, Tp, H, DV)[:, pad:]
    return o.astype(dtype)


def ab_mixer(h, w_in, conv_w, conv_b, gate_a_w, gate_a_b, gate_x_w, gate_x_b, lam,
             alpha_w, alpha_b, gla_norm, w_out):
    B, T, _ = h.shape
    xa, ga, q, k, v, ad, gb = _split(h @ w_in, EVEN_SPLITS)
    ya = rglru(causal_conv(xa, conv_w, conv_b), gate_a_w, gate_a_b, gate_x_w, gate_x_b, lam)
    ya = ya * jax.nn.silu(ga)
    q = q.reshape(B, T, GLA_HEADS, GLA_DK) * (GLA_DK ** -0.5)
    k = k.reshape(B, T, GLA_HEADS, GLA_DK)
    v = v.reshape(B, T, GLA_HEADS, GLA_DV)
    log_alpha = jax.nn.log_sigmoid((ad @ alpha_w + alpha_b).astype(jnp.float32)) / GLA_TAU
    log_alpha = log_alpha.reshape(B, T, GLA_HEADS, GLA_DK)
    ob = rmsnorm(gla_chunked(q, k, v, log_alpha), gla_norm).reshape(B, T, GLA_HEADS * GLA_DV)
    ob = ob * jax.nn.silu(gb)
    return jnp.concatenate([ya, ob], axis=-1) @ w_out


def causal_mla_attention(q_nope, q_rope, k_nope, k_rope, v):
    T = q_nope.shape[1]
    Tp = -(-T // Q_BLOCK) * Q_BLOCK
    padt = lambda t: jnp.pad(t, ((0, 0), (0, Tp - T)) + ((0, 0),) * (t.ndim - 2))
    q_nope, q_rope, k_nope, k_rope, v = map(padt, (q_nope, q_rope, k_nope, k_rope, v))
    scale = (MLA_NOPE + MLA_ROPE) ** -0.5
    outs = []
    for n in range(Tp // Q_BLOCK):
        q0, q1 = n * Q_BLOCK, (n + 1) * Q_BLOCK
        s = (jnp.einsum('bqhd,bkhd->bhqk', q_nope[:, q0:q1], k_nope[:, :q1])
             + jnp.einsum('bqhr,bkr->bhqk', q_rope[:, q0:q1], k_rope[:, :q1]))
        s = s.astype(jnp.float32) * scale
        qi = jnp.arange(q0, q1)[:, None]
        ki = jnp.arange(q1)[None, :]
        s = jnp.where(ki <= qi, s, -jnp.inf)
        p = jax.nn.softmax(s, axis=-1).astype(v.dtype)
        outs.append(jnp.einsum('bhqk,bkhd->bqhd', p, v[:, :q1]))
    return jnp.concatenate(outs, axis=1)[:, :T]


def mla_mixer(h, w_in, q_norm, w_q_up, kv_norm, w_kv_up, w_out, cos, sin):
    B, T, _ = h.shape
    cq, ckv, k_rope, gate = _split(h @ w_in, ODD_SPLITS)
    q = (rmsnorm(cq, q_norm) @ w_q_up).reshape(B, T, MLA_HEADS, MLA_NOPE + MLA_ROPE)
    q_nope, q_rope = q[..., :MLA_NOPE], q[..., MLA_NOPE:]
    kv = (rmsnorm(ckv, kv_norm) @ w_kv_up).reshape(B, T, MLA_HEADS, MLA_NOPE + MLA_V)
    k_nope, v = kv[..., :MLA_NOPE], kv[..., MLA_NOPE:]
    q_rope = apply_rope(q_rope, cos[:, :, None, :], sin[:, :, None, :])
    k_rope = apply_rope(k_rope, cos, sin)
    o = causal_mla_attention(q_nope, q_rope, k_nope, k_rope, v).reshape(B, T, ODD_MIX)
    return (o * jax.nn.silu(gate)) @ w_out


def setup_inputs(seed: int = 0) -> dict:
    key = jax.random.key(seed)
    ks = iter(jax.random.split(key, 32))
    nrm = lambda shape, scale: jax.random.normal(next(ks), shape, jnp.float32) * scale
    u = jax.random.uniform(next(ks), (N_AB, RNN_WIDTH), jnp.float32, 0.9, 0.999)
    s = u ** (1.0 / RGLRU_C)
    lam = jnp.log(s) - jnp.log1p(-s)
    return {
        "x": nrm((BATCH, SEQ, D_MODEL), 1.0),
        "positions": jnp.broadcast_to(jnp.arange(SEQ, dtype=jnp.int32)[None], (BATCH, SEQ)),
        "meta_tokens": nrm((N_META, D_MODEL), 1.0),
        "ab_norm": 1.0 + nrm((N_AB, D_MODEL), 0.1),
        "ab_w_in": nrm((N_AB, D_MODEL, EVEN_IN), D_MODEL ** -0.5),
        "ab_conv_w": nrm((N_AB, CONV_WIDTH, RNN_WIDTH), CONV_WIDTH ** -0.5),
        "ab_conv_b": nrm((N_AB, RNN_WIDTH), 0.01),
        "ab_gate_a_w": nrm((N_AB, RNN_BLOCKS, RNN_BLOCK, RNN_BLOCK), RNN_BLOCK ** -0.5),
        "ab_gate_a_b": nrm((N_AB, RNN_WIDTH), 0.01),
        "ab_gate_x_w": nrm((N_AB, RNN_BLOCKS, RNN_BLOCK, RNN_BLOCK), RNN_BLOCK ** -0.5),
        "ab_gate_x_b": nrm((N_AB, RNN_WIDTH), 0.01),
        "ab_lru_lambda": lam,
        "ab_alpha_w": nrm((N_AB, GLA_GATE_RANK, GLA_HEADS * GLA_DK), GLA_GATE_RANK ** -0.5),
        "ab_alpha_b": nrm((N_AB, GLA_HEADS * GLA_DK), 0.1),
        "ab_gla_norm": 1.0 + nrm((N_AB, GLA_DV), 0.1),
        "ab_w_out": nrm((N_AB, EVEN_MIX, D_MODEL), EVEN_MIX ** -0.5),
        "c_norm": 1.0 + nrm((N_C, D_MODEL), 0.1),
        "c_w_in": nrm((N_C, D_MODEL, ODD_IN), D_MODEL ** -0.5),
        "c_q_norm": 1.0 + nrm((N_C, MLA_Q_RANK), 0.1),
        "c_w_q_up": nrm((N_C, MLA_Q_RANK, MLA_HEADS * (MLA_NOPE + MLA_ROPE)), MLA_Q_RANK ** -0.5),
        "c_kv_norm": 1.0 + nrm((N_C, MLA_KV_RANK), 0.1),
        "c_w_kv_up": nrm((N_C, MLA_KV_RANK, MLA_HEADS * (MLA_NOPE + MLA_V)), MLA_KV_RANK ** -0.5),
        "c_w_out": nrm((N_C, ODD_MIX, D_MODEL), ODD_MIX ** -0.5),
        "final_norm": 1.0 + nrm((D_MODEL,), 0.1),
    }


def reference(x, positions, meta_tokens, ab_norm, ab_w_in, ab_conv_w, ab_conv_b, ab_gate_a_w,
              ab_gate_a_b, ab_gate_x_w, ab_gate_x_b, ab_lru_lambda, ab_alpha_w, ab_alpha_b,
              ab_gla_norm, ab_w_out, c_norm, c_w_in, c_q_norm, c_w_q_up, c_kv_norm, c_w_kv_up,
              c_w_out, final_norm):
    B = x.shape[0]
    meta = jnp.broadcast_to(meta_tokens.astype(x.dtype)[None], (B, N_META, D_MODEL))
    h = jnp.concatenate([meta, x], axis=1)
    meta_pos = jnp.broadcast_to(jnp.arange(N_META, dtype=positions.dtype)[None], (B, N_META))
    pos = jnp.concatenate([meta_pos, positions + N_META], axis=1)
    inv_freq = ROPE_BASE ** (-jnp.arange(0, MLA_ROPE, 2, dtype=jnp.float32) / MLA_ROPE)
    ang = pos.astype(jnp.float32)[..., None] * inv_freq
    cos, sin = jnp.cos(ang), jnp.sin(ang)
    for layer in range(DEPTH):
        j = layer // 2
        if layer % 2 == 0:
            h = h + ab_mixer(rmsnorm(h, ab_norm[j]), ab_w_in[j], ab_conv_w[j], ab_conv_b[j],
                             ab_gate_a_w[j], ab_gate_a_b[j], ab_gate_x_w[j], ab_gate_x_b[j],
                             ab_lru_lambda[j], ab_alpha_w[j], ab_alpha_b[j], ab_gla_norm[j],
                             ab_w_out[j])
        else:
            h = h + mla_mixer(rmsnorm(h, c_norm[j]), c_w_in[j], c_q_norm[j], c_w_q_up[j],
                              c_kv_norm[j], c_w_kv_up[j], c_w_out[j], cos, sin)
    h = rmsnorm(h, final_norm)
    return h[:, N_META:]
```

```cpp
#include <hip/hip_runtime.h>
#include <hip/hip_cooperative_groups.h>
#include <cstdio>
#include <cmath>
namespace cg = cooperative_groups;

typedef unsigned short bf16_t;
typedef short bf16x8 __attribute__((ext_vector_type(8)));
typedef float f32x4 __attribute__((ext_vector_type(4)));
typedef unsigned u32x4 __attribute__((ext_vector_type(4)));
typedef unsigned u32x2 __attribute__((ext_vector_type(2)));

constexpr int T_ = 2064;
constexpr int M_ = 8 * T_;
constexpr int TP_ = 2112;
constexpr float EPS_ = 1e-6f;
constexpr int SMEM_BYTES = 75776;
constexpr float QSCALE_MLA = 0.10206207261596575f * 1.4426950408889634f;

constexpr size_t W_PER_J = 11796480;
constexpr size_t W_IN_E = 0, W_OUT_E = 5373952, W_IN_O = 7471104, W_Q = 9437184, W_KV = 10223616, W_O = 10747904;

struct Params {
  const float* x; const int* positions; const float* meta;
  const float *ab_norm, *ab_w_in, *ab_conv_w, *ab_conv_b, *ab_gate_a_w, *ab_gate_a_b, *ab_gate_x_w, *ab_gate_x_b,
      *ab_lam, *ab_alpha_w, *ab_alpha_b, *ab_gla_norm, *ab_w_out;
  const float *c_norm, *c_w_in, *c_q_norm, *c_w_q_up, *c_kv_norm, *c_w_kv_up, *c_w_out, *final_norm;
  float* out;
  unsigned char* ws;
  float inv_freq[16];
};

struct WS {
  bf16_t *HHI, *HLO; float2* ROPE;
  bf16_t *XA, *GA, *Q, *K, *V, *GB, *AD; float* SSQ; float* BL;
  bf16_t *CQ, *CKV, *GATE, *KR, *QB, *KN, *VT;
  bf16_t* W;
};

__device__ __forceinline__ unsigned char* opaque_ptr(unsigned char* q) {
  unsigned lo = (unsigned)(unsigned long long)q, hi = (unsigned)((unsigned long long)q >> 32);
  asm volatile("" : "+v"(lo), "+v"(hi));
  lo = __builtin_amdgcn_readfirstlane(lo); hi = __builtin_amdgcn_readfirstlane(hi);
  typedef __attribute__((address_space(1))) unsigned char gu8;
  return (unsigned char*)(gu8*)(((unsigned long long)hi << 32) | lo);
}
__device__ __forceinline__ WS make_ws(const Params& p) {
  WS w;
  unsigned char* b = opaque_ptr(p.ws);
  w.HHI = (bf16_t*)b; b += (size_t)M_ * 2048;
  w.HLO = (bf16_t*)b; b += (size_t)M_ * 2048;
  w.ROPE = (float2*)b; b += (size_t)M_ * 128;
  unsigned char* r = b;
  w.XA = (bf16_t*)r; r += (size_t)M_ * 2048;
  w.GA = (bf16_t*)r; r += (size_t)M_ * 2048;
  w.Q = (bf16_t*)r; r += (size_t)M_ * 1024;
  w.K = (bf16_t*)r; r += (size_t)M_ * 1024;
  w.V = (bf16_t*)r; r += (size_t)M_ * 2048;
  w.GB = (bf16_t*)r; r += (size_t)M_ * 2048;
  w.AD = (bf16_t*)r; r += (size_t)M_ * 32;
  w.SSQ = (float*)r; r += (size_t)M_ * 128;
  w.BL = (float*)r; r += (size_t)8 * 4 * 33 * 128 * 4;
  r = b;
  w.CQ = (bf16_t*)r; r += (size_t)M_ * 1024;
  w.CKV = (bf16_t*)r; r += (size_t)M_ * 512;
  w.GATE = (bf16_t*)r; r += (size_t)M_ * 2048;
  w.KR = (bf16_t*)r; r += (size_t)M_ * 64;
  w.QB = (bf16_t*)r; r += (size_t)M_ * 3072;
  w.KN = (bf16_t*)r; r += (size_t)M_ * 2048;
  w.VT = (bf16_t*)r; r += (size_t)128 * 64 * TP_ * 2;
  w.W = (bf16_t*)opaque_ptr((unsigned char*)p.out);
  return w;
}

__device__ __forceinline__ unsigned cvt_pk_bf16(float lo, float hi) {
  unsigned r; asm("v_cvt_pk_bf16_f32 %0, %1, %2" : "=v"(r) : "v"(lo), "v"(hi)); return r;
}
__device__ __forceinline__ float bf2f(bf16_t v) { return __uint_as_float(((unsigned)v) << 16); }
__device__ __forceinline__ float bflo(unsigned v) { return __uint_as_float(v << 16); }
__device__ __forceinline__ float bfhi(unsigned v) { return __uint_as_float(v & 0xffff0000u); }
__device__ __forceinline__ bf16_t f2bf(float f) { return (bf16_t)(cvt_pk_bf16(f, 0.f) & 0xffffu); }
__device__ __forceinline__ float sigmoidf_(float x) { return 1.f / (1.f + __expf(-x)); }
__device__ __forceinline__ float siluf_(float x) { return x / (1.f + __expf(-x)); }
__device__ __forceinline__ bf16x8 as_bf16x8(u32x4 v) { return __builtin_bit_cast(bf16x8, v); }
__device__ __forceinline__ int opaque_tid() { int t = threadIdx.x; asm volatile("" : "+v"(t)); return t; }
__device__ __forceinline__ int opaque_bid() { int t = blockIdx.x; asm volatile("" : "+s"(t)); return t; }
#define MFMA16(a, b, c) __builtin_amdgcn_mfma_f32_16x16x32_bf16((a), (b), (c), 0, 0, 0)

__shared__ __attribute__((aligned(16))) unsigned char smem[SMEM_BYTES + 16];

#define XB_TMO      128
#define XB_XCNT(j)  (256  + 64 * (j))
#define XB_XSUB(j)  (1280 + 64 * (j))
#define XB_XGEN(j)  (2304 + 64 * (j))
#define XB_TOP      3328
#define XB_TOPGEN   3392
#define XCD_BAR_WORDS 3456
#define XB_SPIN_CAP (1u << 18)
#define LAS __attribute__((address_space(3)))
constexpr size_t BAR_OFF = 260046848;

__device__ __forceinline__ unsigned xb_ld(unsigned* p)              { return __hip_atomic_load(p, __ATOMIC_RELAXED, __HIP_MEMORY_SCOPE_AGENT); }
__device__ __forceinline__ unsigned xb_add(unsigned* p, unsigned v) { return __hip_atomic_fetch_add(p, v, __ATOMIC_RELAXED, __HIP_MEMORY_SCOPE_AGENT); }
__device__ __forceinline__ unsigned xb_xcc_id() { return (unsigned)__builtin_amdgcn_s_getreg((3 << 11) | 20) & 0xFu; }
#define XB_SPIN(cond, bar) do { unsigned _sp = 0; while (cond) { __builtin_amdgcn_s_sleep(1); \
    if ((++_sp & 255u) == 0u) { if (xb_ld(&(bar)[XB_TMO])) break; if (_sp > XB_SPIN_CAP) { atomicAdd(&(bar)[XB_TMO], 1u); break; } } } } while (0)

struct XcdBarrier { unsigned* bar; unsigned x; volatile LAS unsigned* st; };

__device__ __forceinline__ XcdBarrier xcd_barrier_post(unsigned* bar, volatile LAS unsigned* st) {
    XcdBarrier b; b.bar = bar; b.x = xb_xcc_id(); b.st = st;
    if (threadIdx.x == 0) (void)xb_add(&bar[XB_XCNT(b.x)], 1u);
    return b;
}
__device__ __forceinline__ void xcd_barrier_complete(unsigned* bar, unsigned x, unsigned& nloc, unsigned& nx) {
    const unsigned G = gridDim.x * gridDim.y * gridDim.z;
    unsigned sum, cnt, mine, sp = 0u;
    for (;;) {
        sum = 0u; cnt = 0u; mine = 0u;
#pragma unroll
        for (unsigned j = 0; j < 16; ++j) { const unsigned c = xb_ld(&bar[XB_XCNT(j)]); sum += c; cnt += (c > 0u) ? 1u : 0u; mine = (j == x) ? c : mine; }
        if (sum == G) break;
        __builtin_amdgcn_s_sleep(1);
        if ((++sp & 255u) == 0u) { if (xb_ld(&bar[XB_TMO])) break; if (sp > XB_SPIN_CAP) { atomicAdd(&bar[XB_TMO], 1u); break; } }
    }
    nloc = mine > 0u ? mine : 1u; nx = cnt > 0u ? cnt : 1u;
}
__device__ __forceinline__ void xcd_barrier(const XcdBarrier& b) {
    asm volatile("s_waitcnt vmcnt(0)" ::: "memory");
    __syncthreads();
    if (threadIdx.x == 0) {
        unsigned* bar = b.bar;
        __builtin_amdgcn_s_waitcnt(0);
        unsigned nloc = b.st[0], nx = b.st[1];
        if (nloc == 0u) { xcd_barrier_complete(bar, b.x, nloc, nx); b.st[0] = nloc; b.st[1] = nx; }
        const unsigned old = xb_add(&bar[XB_XSUB(b.x)], 1u);
        const unsigned gen = old / nloc;
        if (old + 1u == (gen + 1u) * nloc) {
            __builtin_amdgcn_fence(__ATOMIC_RELEASE, "agent");
            asm volatile("s_waitcnt vmcnt(0)" ::: "memory");
            const unsigned og = xb_add(&bar[XB_TOP], 1u);
            const unsigned tg = og / nx;
            if (og + 1u == (tg + 1u) * nx) xb_add(&bar[XB_TOPGEN], 1u);
            else XB_SPIN(xb_ld(&bar[XB_TOPGEN]) == tg, bar);
            __builtin_amdgcn_fence(__ATOMIC_ACQUIRE, "agent");
            xb_add(&bar[XB_XGEN(b.x)], 1u);
            asm volatile("s_waitcnt vmcnt(0)" ::: "memory");
        } else {
            XB_SPIN(xb_ld(&bar[XB_XGEN(b.x)]) == gen, bar);
            __builtin_amdgcn_fence(__ATOMIC_ACQUIRE, "agent");
            asm volatile("s_waitcnt vmcnt(0)" ::: "memory");
        }
    }
    __syncthreads();
}


__device__ __forceinline__ int map_even_in(int n) { return n < 4096 ? n : (n < 5120 ? n + 16 : (n < 5136 ? n - 1024 : -1)); }
__device__ __forceinline__ int map_odd_in(int n) { return n < 768 ? n : (n < 1792 ? n + 32 : (n < 1824 ? n - 1024 : -1)); }

__device__ __forceinline__ void convert_tile(const float* __restrict__ src, int K, int Nsrc, bf16_t* __restrict__ dst,
                                             int kind, const float* __restrict__ g, int tile) {
  float* tl = (float*)smem;
  const int nkt = K >> 6;
  const int ntile = tile / nkt, ktile = tile - ntile * nkt;
  const int n0 = ntile * 64, k0 = ktile * 64;
  const int tid = opaque_tid();
  const int nl = tid & 63, kq = tid >> 6;
  const int n = n0 + nl;
  const int sc = kind == 0 ? map_even_in(n) : (kind == 1 ? map_odd_in(n) : n);
  float cs = 1.f;
  if (kind == 0 && n >= 2048 && n < 2560) cs = 0.08838834764831845f;
  if (kind == 2) cs = QSCALE_MLA;
#pragma unroll
  for (int i = 0; i < 16; ++i) {
    const int kl = kq + 4 * i;
    float v = 0.f;
    if (sc >= 0) {
      v = src[(size_t)(k0 + kl) * Nsrc + sc] * cs;
      if (g) v *= g[k0 + kl];
    }
    tl[kl * 65 + nl] = v;
  }
  __syncthreads();
#pragma unroll
  for (int i = 0; i < 2; ++i) {
    const int c = tid + 256 * i;
    const int nl2 = c >> 3, kc = c & 7;
    float v[8];
#pragma unroll
    for (int jj = 0; jj < 8; ++jj) v[jj] = tl[(kc * 8 + jj) * 65 + nl2];
    u32x4 pk;
    pk.x = cvt_pk_bf16(v[0], v[1]); pk.y = cvt_pk_bf16(v[2], v[3]); pk.z = cvt_pk_bf16(v[4], v[5]); pk.w = cvt_pk_bf16(v[6], v[7]);
    *(u32x4*)(dst + (size_t)(n0 + nl2) * K + k0 + kc * 8) = pk;
  }
  __syncthreads();
}

__device__ __forceinline__ void phase_prologue(const Params& p, const WS& ws) {
  for (int id = opaque_bid(); id < 5760; id += gridDim.x) {
    const int j = id / 2880; int r = id - j * 2880;
    bf16_t* wb = ws.W + (size_t)j * W_PER_J;
    if (r < 1312) convert_tile(p.ab_w_in + (size_t)j * 1024 * 5136, 1024, 5136, wb + W_IN_E, 0, p.ab_norm + j * 1024, r);
    else if ((r -= 1312) < 512) convert_tile(p.ab_w_out + (size_t)j * 2048 * 1024, 2048, 1024, wb + W_OUT_E, 3, nullptr, r);
    else if ((r -= 512) < 480) convert_tile(p.c_w_in + (size_t)j * 1024 * 1824, 1024, 1824, wb + W_IN_O, 1, p.c_norm + j * 1024, r);
    else if ((r -= 480) < 192) convert_tile(p.c_w_q_up + (size_t)j * 512 * 1536, 512, 1536, wb + W_Q, 2, p.c_q_norm + j * 512, r);
    else if ((r -= 192) < 128) convert_tile(p.c_w_kv_up + (size_t)j * 256 * 2048, 256, 2048, wb + W_KV, 3, p.c_kv_norm + j * 256, r);
    else { r -= 128; convert_tile(p.c_w_out + (size_t)j * 1024 * 1024, 1024, 1024, wb + W_O, 3, nullptr, r); }
  }
  const size_t gtid = (size_t)opaque_bid() * 256 + opaque_tid(), gsz = (size_t)gridDim.x * 256;
  for (size_t idx = gtid; idx < (size_t)M_ * 256; idx += gsz) {
    const int row = (int)(idx >> 8), c4 = (int)(idx & 255);
    const int b = row / T_, t = row - b * T_;
    const float* src = t < 16 ? p.meta + (size_t)t * 1024 : p.x + ((size_t)b * 2048 + (t - 16)) * 1024;
    const float4 v = *(const float4*)(src + c4 * 4);
    u32x2 hi; hi.x = cvt_pk_bf16(v.x, v.y); hi.y = cvt_pk_bf16(v.z, v.w);
    u32x2 lo; lo.x = cvt_pk_bf16(v.x - bflo(hi.x), v.y - bfhi(hi.x)); lo.y = cvt_pk_bf16(v.z - bflo(hi.y), v.w - bfhi(hi.y));
    *(u32x2*)(ws.HHI + (size_t)row * 1024 + c4 * 4) = hi;
    *(u32x2*)(ws.HLO + (size_t)row * 1024 + c4 * 4) = lo;
  }
  for (size_t idx = gtid; idx < (size_t)M_ * 16; idx += gsz) {
    const int row = (int)(idx >> 4), i = (int)(idx & 15);
    const int b = row / T_, t = row - b * T_;
    const int pos = t < 16 ? t : p.positions[b * 2048 + (t - 16)] + 16;
    const float angf = (float)pos * p.inv_freq[i];
    const double rev = (double)angf * 0.15915494309189533577;
    const float fr = (float)(rev - rint(rev));
    ws.ROPE[idx] = make_float2(__builtin_amdgcn_cosf(fr), __builtin_amdgcn_sinf(fr));
  }
}

#ifndef REP_GEMM
#define REP_GEMM 1
#endif
#ifndef REP_ATTN
#define REP_ATTN 1
#endif
#ifndef REP_E2
#define REP_E2 1
#endif
enum { EPI_E1 = 0, EPI_O1 = 1, EPI_Q = 2, EPI_KV = 3, EPI_RES = 4 };

template <int EPI>
__device__ __forceinline__ void gemm_epilogue(const WS& ws, const f32x4 (&acc)[4][4], const float (&rs)[4], int tok0, int n0,
                                              int wm, int wn, int lr, int lq, bool dry) {
  const int tokw = tok0 + wn * 64 + lr;
  const int nw = n0 + wm * 64;
  if (EPI == EPI_E1) {
    bf16_t* dst; int ld, c;
    if (n0 < 1024) { dst = ws.XA; ld = 1024; c = n0; }
    else if (n0 < 2048) { dst = ws.GA; ld = 1024; c = n0 - 1024; }
    else if (n0 < 2560) { dst = ws.Q; ld = 512; c = n0 - 2048; }
    else if (n0 < 3072) { dst = ws.K; ld = 512; c = n0 - 2560; }
    else if (n0 < 4096) { dst = ws.V; ld = 1024; c = n0 - 3072; }
    else if (n0 < 5120) { dst = ws.GB; ld = 1024; c = n0 - 4096; }
    else { dst = ws.AD; ld = 16; c = 0; }
    const bool isad = n0 >= 5120;
#pragma unroll
    for (int ni = 0; ni < 4; ++ni) {
      if (isad && (wm != 0 || ni != 0)) continue;
#pragma unroll
      for (int ti = 0; ti < 4; ++ti) {
        const f32x4 v = acc[ni][ti] * rs[ti];
        u32x2 pk; pk.x = cvt_pk_bf16(v[0], v[1]); pk.y = cvt_pk_bf16(v[2], v[3]);
        *(u32x2*)(dst + (size_t)(tokw + ti * 16) * ld + c + wm * 64 + ni * 16 + 4 * lq) = pk;
      }
    }
  } else if (EPI == EPI_O1) {
    if (n0 < 1792) {
      bf16_t* dst; int ld, c;
      if (n0 < 512) { dst = ws.CQ; ld = 512; c = n0; }
      else if (n0 < 768) { dst = ws.CKV; ld = 256; c = n0 - 512; }
      else { dst = ws.GATE; ld = 1024; c = n0 - 768; }
#pragma unroll
      for (int ni = 0; ni < 4; ++ni)
#pragma unroll
        for (int ti = 0; ti < 4; ++ti) {
          const f32x4 v = acc[ni][ti] * rs[ti];
          u32x2 pk; pk.x = cvt_pk_bf16(v[0], v[1]); pk.y = cvt_pk_bf16(v[2], v[3]);
          *(u32x2*)(dst + (size_t)(tokw + ti * 16) * ld + c + wm * 64 + ni * 16 + 4 * lq) = pk;
        }
    } else if (wm == 0) {
#pragma unroll
      for (int ti = 0; ti < 4; ++ti) {
        const int tok = tokw + ti * 16;
        const f32x4 x1 = acc[0][ti] * rs[ti], x2 = acc[1][ti] * rs[ti];
        float o1[4], o2[4];
#pragma unroll
        for (int jj = 0; jj < 4; ++jj) {
          const float2 cs = ws.ROPE[(size_t)tok * 16 + 4 * lq + jj];
          o1[jj] = x1[jj] * cs.x - x2[jj] * cs.y;
          o2[jj] = x2[jj] * cs.x + x1[jj] * cs.y;
        }
        u32x2 pk; pk.x = cvt_pk_bf16(o1[0], o1[1]); pk.y = cvt_pk_bf16(o1[2], o1[3]);
        *(u32x2*)(ws.KR + (size_t)tok * 32 + 4 * lq) = pk;
        pk.x = cvt_pk_bf16(o2[0], o2[1]); pk.y = cvt_pk_bf16(o2[2], o2[3]);
        *(u32x2*)(ws.KR + (size_t)tok * 32 + 16 + 4 * lq) = pk;
      }
    }
  } else if (EPI == EPI_Q) {
#pragma unroll
    for (int ni = 0; ni < 4; ++ni)
#pragma unroll
      for (int ti = 0; ti < 4; ++ti) {
        const f32x4 v = acc[ni][ti] * rs[ti];
        u32x2 pk; pk.x = cvt_pk_bf16(v[0], v[1]); pk.y = cvt_pk_bf16(v[2], v[3]);
        *(u32x2*)(ws.QB + (size_t)(tokw + ti * 16) * 1536 + nw + ni * 16 + 4 * lq) = pk;
      }
  } else if (EPI == EPI_KV) {
    const int hd = nw >> 7;
    const bool isv = (nw & 127) >= 64;
    if (!isv) {
#pragma unroll
      for (int ni = 0; ni < 4; ++ni)
#pragma unroll
        for (int ti = 0; ti < 4; ++ti) {
          const f32x4 v = acc[ni][ti] * rs[ti];
          u32x2 pk; pk.x = cvt_pk_bf16(v[0], v[1]); pk.y = cvt_pk_bf16(v[2], v[3]);
          *(u32x2*)(ws.KN + (size_t)(tokw + ti * 16) * 1024 + hd * 64 + ni * 16 + 4 * lq) = pk;
        }
    } else {
#pragma unroll
      for (int ti = 0; ti < 4; ++ti) {
        const int tok = tokw + ti * 16;
        const int b = tok / T_, t = tok - b * T_;
        bf16_t* vb = ws.VT + ((size_t)(b * 16 + hd) * 64) * TP_ + t;
#pragma unroll
        for (int ni = 0; ni < 4; ++ni) {
          const f32x4 v = acc[ni][ti] * rs[ti];
#pragma unroll
          for (int jj = 0; jj < 4; ++jj) vb[(size_t)(ni * 16 + 4 * lq + jj) * TP_] = f2bf(v[jj]);
        }
      }
    }
  } else {
#pragma unroll
    for (int ni = 0; ni < 4; ++ni)
#pragma unroll
      for (int ti = 0; ti < 4; ++ti) {
        const size_t off = (size_t)(tokw + ti * 16) * 1024 + nw + ni * 16 + 4 * lq;
        const u32x2 hi = *(const u32x2*)(ws.HHI + off), lo = *(const u32x2*)(ws.HLO + off);
        const float h0 = bflo(hi.x) + bflo(lo.x) + acc[ni][ti][0], h1 = bfhi(hi.x) + bfhi(lo.x) + acc[ni][ti][1];
        const float h2 = bflo(hi.y) + bflo(lo.y) + acc[ni][ti][2], h3 = bfhi(hi.y) + bfhi(lo.y) + acc[ni][ti][3];
        u32x2 nh; nh.x = cvt_pk_bf16(h0, h1); nh.y = cvt_pk_bf16(h2, h3);
        u32x2 nl; nl.x = cvt_pk_bf16(h0 - bflo(nh.x), h1 - bfhi(nh.x)); nl.y = cvt_pk_bf16(h2 - bflo(nh.y), h3 - bfhi(nh.y));
        if (!dry) { *(u32x2*)(ws.HHI + off) = nh; *(u32x2*)(ws.HLO + off) = nl; }
      }
  }
}

template <bool RS, int EPI>
__device__ __forceinline__ void gemm_stream(const WS& ws, const bf16_t* A0, const bf16_t* A1, int lda, int ktsplit, int kstride,
                                            const bf16_t* __restrict__ W, int K, float invK, int ntn, int ntiles, int bid, bool dry) {
  bf16_t* As = (bf16_t*)smem;
  bf16_t* Bs = As + 2 * 128 * 72;
  float* rsl = (float*)(smem + 73728);
  const int tid = opaque_tid(), lane = tid & 63, w = tid >> 6, wm = w >> 1, wn = w & 1, lr = lane & 15, lq = lane >> 4;
  const int G = gridDim.x;
  const int nk = K >> 6;
  if (bid >= ntiles) return;
  const int my_tiles = (ntiles - 1 - bid) / G + 1;
  const int S = my_tiles * nk;
  f32x4 acc[4][4];
#pragma unroll
  for (int a = 0; a < 4; ++a)
#pragma unroll
    for (int b = 0; b < 4; ++b) acc[a][b] = (f32x4){0.f, 0.f, 0.f, 0.f};
  u32x4 ra0[4], rb0[4], ra1[4], rb1[4];
  float ss[4] = {0.f, 0.f, 0.f, 0.f};
  int l_id = bid, l_kt = 0, st_kt = 0, c_id = bid, c_kt = 0;

  auto issue = [&](u32x4 (&ra)[4], u32x4 (&rb)[4]) {
    const int mt = l_id / ntn, nt = l_id - mt * ntn;
    const bf16_t* A = (l_kt < ktsplit) ? A0 : A1;
    const int kk = (l_kt < ktsplit) ? l_kt : l_kt - ktsplit;
    const bf16_t* ap = A + (size_t)(mt * 128 + (tid >> 3)) * lda + kk * kstride + (tid & 7) * 8;
    const bf16_t* wp = W + (size_t)(nt * 128 + (tid >> 3)) * K + l_kt * 64 + (tid & 7) * 8;
#pragma unroll
    for (int i = 0; i < 4; ++i) {
      ra[i] = *(const u32x4*)(ap + (size_t)i * 32 * lda);
      rb[i] = *(const u32x4*)(wp + (size_t)i * 32 * K);
    }
    if (++l_kt == nk) { l_kt = 0; l_id += G; }
  };
  auto store = [&](const u32x4 (&ra)[4], const u32x4 (&rb)[4], int buf) {
    bf16_t* Ab = As + buf * 128 * 72;
    bf16_t* Bb = Bs + buf * 128 * 72;
#pragma unroll
    for (int i = 0; i < 4; ++i) {
      if (RS) {
        float s = 0.f, v;
        v = bflo(ra[i].x); s += v * v; v = bfhi(ra[i].x); s += v * v;
        v = bflo(ra[i].y); s += v * v; v = bfhi(ra[i].y); s += v * v;
        v = bflo(ra[i].z); s += v * v; v = bfhi(ra[i].z); s += v * v;
        v = bflo(ra[i].w); s += v * v; v = bfhi(ra[i].w); s += v * v;
        ss[i] += s;
      }
      *(u32x4*)(Ab + ((tid >> 3) + 32 * i) * 72 + (tid & 7) * 8) = ra[i];
      *(u32x4*)(Bb + ((tid >> 3) + 32 * i) * 72 + (tid & 7) * 8) = rb[i];
    }
    if (RS) {
      if (++st_kt == nk) {
        st_kt = 0;
#pragma unroll
        for (int i = 0; i < 4; ++i) {
          float s = ss[i];
          s += __shfl_xor(s, 1); s += __shfl_xor(s, 2); s += __shfl_xor(s, 4);
          if ((tid & 7) == 0) rsl[(tid >> 3) + 32 * i] = rsqrtf(s * invK + EPS_);
          ss[i] = 0.f;
        }
      }
    }
  };
  auto compute = [&](int buf) {
    const bf16_t* Ab = As + buf * 128 * 72 + (wn * 64 + lr) * 72 + lq * 8;
    const bf16_t* Bb = Bs + buf * 128 * 72 + (wm * 64 + lr) * 72 + lq * 8;
#pragma unroll
    for (int ks = 0; ks < 2; ++ks) {
      bf16x8 wf[4], xf[4];
#pragma unroll
      for (int i = 0; i < 4; ++i) {
        wf[i] = *(const bf16x8*)(Bb + i * 16 * 72 + ks * 32);
        xf[i] = *(const bf16x8*)(Ab + i * 16 * 72 + ks * 32);
      }
#pragma unroll
      for (int ni = 0; ni < 4; ++ni)
#pragma unroll
        for (int ti = 0; ti < 4; ++ti) acc[ni][ti] = MFMA16(wf[ni], xf[ti], acc[ni][ti]);
    }
  };
  auto tile_end = [&]() {
    float rs[4] = {1.f, 1.f, 1.f, 1.f};
    if (RS) {
#pragma unroll
      for (int ti = 0; ti < 4; ++ti) rs[ti] = rsl[wn * 64 + ti * 16 + lr];
    }
    const int mt = c_id / ntn, nt = c_id - mt * ntn;
    gemm_epilogue<EPI>(ws, acc, rs, mt * 128, nt * 128, wm, wn, lr, lq, dry);
#pragma unroll
    for (int a = 0; a < 4; ++a)
#pragma unroll
      for (int b = 0; b < 4; ++b) acc[a][b] = (f32x4){0.f, 0.f, 0.f, 0.f};
    c_id += G;
  };

  issue(ra0, rb0);
  issue(ra1, rb1);
  store(ra0, rb0, 0);
  __syncthreads();
#pragma unroll 1
  for (int s = 0; s < S; s += 2) {
    if (s + 2 < S) issue(ra0, rb0);
    compute(0);
    store(ra1, rb1, 1);
    __syncthreads();
    if (s + 3 < S) issue(ra1, rb1);
    compute(1);
    c_kt += 2;
    if (c_kt == nk) { c_kt = 0; tile_end(); }
    if (s + 2 < S) store(ra0, rb0, 0);
    __syncthreads();
  }
}


__device__ __forceinline__ void gla_decay_unit(const Params& p, const WS& ws, int j, int u) {
  const int c = u % 33; const int bh = u / 33; const int hd = bh & 3, b = bh >> 2;
  bf16_t* Qs = (bf16_t*)smem;
  bf16_t* Ks = Qs + 64 * 136;
  float* ADs = (float*)(smem + 2 * 64 * 136 * 2);
  float* HT = ADs + 64 * 16;
  const int tid = opaque_tid();
  const int tbase = 64 * c - 48;
#pragma unroll
  for (int i = 0; i < 4; ++i) {
    const int ci = tid + 256 * i; const int row = ci >> 4, ch = ci & 15; const int t = tbase + row;
    u32x4 qv = (u32x4){0, 0, 0, 0}, kv = (u32x4){0, 0, 0, 0};
    if (t >= 0) {
      qv = *(const u32x4*)(ws.Q + (size_t)(b * T_ + t) * 512 + hd * 128 + ch * 8);
      kv = *(const u32x4*)(ws.K + (size_t)(b * T_ + t) * 512 + hd * 128 + ch * 8);
    }
    *(u32x4*)(Qs + row * 136 + ch * 8) = qv;
    *(u32x4*)(Ks + row * 136 + ch * 8) = kv;
    const int t2 = tbase + (ci >> 4);
    ADs[ci] = t2 >= 0 ? bf2f(ws.AD[(size_t)(b * T_ + t2) * 16 + (ci & 15)]) : 0.f;
  }
  const int d = tid & 127, half = tid >> 7;
  float aw[16];
#pragma unroll
  for (int r = 0; r < 16; ++r) aw[r] = p.ab_alpha_w[(size_t)(j * 16 + r) * 512 + hd * 128 + d];
  const float abias = p.ab_alpha_b[j * 512 + hd * 128 + d];
  __syncthreads();
  float cs[32];
  float run = 0.f;
#pragma unroll
  for (int ii = 0; ii < 32; ++ii) {
    const int row = half * 32 + ii;
    float xv = abias;
#pragma unroll
    for (int r4 = 0; r4 < 4; ++r4) {
      const float4 a4 = *(const float4*)(ADs + row * 16 + r4 * 4);
      xv += a4.x * aw[r4 * 4] + a4.y * aw[r4 * 4 + 1] + a4.z * aw[r4 * 4 + 2] + a4.w * aw[r4 * 4 + 3];
    }
    float la = (fminf(xv, 0.f) - __logf(1.f + __expf(-fabsf(xv)))) * 0.0625f;
    if (tbase + row < 0) la = 0.f;
    run += la;
    cs[ii] = run;
  }
  HT[half * 128 + d] = run;
  __syncthreads();
  const float off = half ? HT[d] : 0.f;
  const float blast = HT[d] + HT[128 + d];
#pragma unroll
  for (int ii = 0; ii < 32; ++ii) {
    const int row = half * 32 + ii;
    const float bb = cs[ii] + off;
    const float eb = __expf(bb), ebi = __expf(-bb);
    Qs[row * 136 + d] = f2bf(bf2f(Qs[row * 136 + d]) * eb);
    Ks[row * 136 + d] = f2bf(bf2f(Ks[row * 136 + d]) * ebi);
  }
  if (half == 0) ws.BL[(size_t)((b * 4 + hd) * 33 + c) * 128 + d] = __expf(blast);
  __syncthreads();
#pragma unroll
  for (int i = 0; i < 4; ++i) {
    const int ci = tid + 256 * i; const int row = ci >> 4, ch = ci & 15; const int t = tbase + row;
    if (t >= 0) {
      *(u32x4*)(ws.Q + (size_t)(b * T_ + t) * 512 + hd * 128 + ch * 8) = *(const u32x4*)(Qs + row * 136 + ch * 8);
      *(u32x4*)(ws.K + (size_t)(b * T_ + t) * 512 + hd * 128 + ch * 8) = *(const u32x4*)(Ks + row * 136 + ch * 8);
    }
  }
  __syncthreads();
}

__device__ __forceinline__ void gla_unit(const Params& p, const WS& ws, int u, bool dry = false) {
  const int sl = u & 7; const int bh = u >> 3; const int hd = bh & 3, b = bh >> 2;
  bf16_t* QDs = (bf16_t*)smem;
  bf16_t* KIs = QDs + 64 * 136;
  bf16_t* KIT = KIs + 64 * 136;
  bf16_t* VTs = KIT + 128 * 72;
  bf16_t* STs = VTs + 32 * 72;
  bf16_t* Ps = STs + 32 * 136;
  const int tid = opaque_tid(), lane = tid & 63, w = tid >> 6, lr = lane & 15, lq = lane >> 4;
  for (int i = tid; i < 32 * 136 / 2; i += 256) ((unsigned*)STs)[i] = 0u;
  f32x4 sacc[2][2];
#pragma unroll
  for (int a = 0; a < 2; ++a)
#pragma unroll
    for (int bb = 0; bb < 2; ++bb) sacc[a][bb] = (f32x4){0.f, 0.f, 0.f, 0.f};
  u32x4 qr[4], kr[4], vr;
  float ebl[2];
  const float* BLp = ws.BL + (size_t)((b * 4 + hd) * 33) * 128;
  auto prefetch = [&](int c) {
    const int tbase = 64 * c - 48;
#pragma unroll
    for (int i = 0; i < 4; ++i) {
      const int ci = tid + 256 * i; const int row = ci >> 4, ch = ci & 15; const int t = tbase + row;
      qr[i] = (u32x4){0, 0, 0, 0}; kr[i] = (u32x4){0, 0, 0, 0};
      if (t >= 0) {
        qr[i] = *(const u32x4*)(ws.Q + (size_t)(b * T_ + t) * 512 + hd * 128 + ch * 8);
        kr[i] = *(const u32x4*)(ws.K + (size_t)(b * T_ + t) * 512 + hd * 128 + ch * 8);
      }
    }
    {
      const int row = tid >> 2, ch = tid & 3; const int t = tbase + row;
      vr = (u32x4){0, 0, 0, 0};
      if (t >= 0) vr = *(const u32x4*)(ws.V + (size_t)(b * T_ + t) * 1024 + hd * 256 + sl * 32 + ch * 8);
    }
    ebl[0] = BLp[c * 128 + 16 * (2 * w) + lr];
    ebl[1] = BLp[c * 128 + 16 * (2 * w + 1) + lr];
  };
  prefetch(0);
#pragma unroll 1
  for (int c = 0; c < 33; ++c) {
#pragma unroll
    for (int i = 0; i < 4; ++i) {
      const int ci = tid + 256 * i; const int row = ci >> 4, ch = ci & 15;
      *(u32x4*)(QDs + row * 136 + ch * 8) = qr[i];
      *(u32x4*)(KIs + row * 136 + ch * 8) = kr[i];
      const unsigned kk[4] = {kr[i].x, kr[i].y, kr[i].z, kr[i].w};
#pragma unroll
      for (int e = 0; e < 4; ++e) {
        KIT[(ch * 8 + 2 * e) * 72 + row] = (bf16_t)(kk[e] & 0xffffu);
        KIT[(ch * 8 + 2 * e + 1) * 72 + row] = (bf16_t)(kk[e] >> 16);
      }
    }
    {
      const int row = tid >> 2, ch = tid & 3;
      const unsigned vv[4] = {vr.x, vr.y, vr.z, vr.w};
#pragma unroll
      for (int e = 0; e < 4; ++e) {
        VTs[(ch * 8 + 2 * e) * 72 + row] = (bf16_t)(vv[e] & 0xffffu);
        VTs[(ch * 8 + 2 * e + 1) * 72 + row] = (bf16_t)(vv[e] >> 16);
      }
    }
    const float eb0 = ebl[0], eb1 = ebl[1];
    __syncthreads();
    if (c + 1 < 33) prefetch(c + 1);
    bf16x8 xq[4];
#pragma unroll
    for (int ks = 0; ks < 4; ++ks) xq[ks] = *(const bf16x8*)(QDs + (16 * w + lr) * 136 + 32 * ks + 8 * lq);
    const int irow = 16 * w + lr;
#pragma unroll
    for (int mt = 0; mt < 4; ++mt) {
      u32x2 pk = (u32x2){0u, 0u};
      if (mt <= w) {
        f32x4 a = (f32x4){0.f, 0.f, 0.f, 0.f};
#pragma unroll
        for (int ks = 0; ks < 4; ++ks) {
          const bf16x8 kf = *(const bf16x8*)(KIs + (16 * mt + lr) * 136 + 32 * ks + 8 * lq);
          a = MFMA16(kf, xq[ks], a);
        }
        const int ip = 16 * mt + 4 * lq;
        const float v0 = (ip + 0 <= irow) ? a[0] : 0.f, v1 = (ip + 1 <= irow) ? a[1] : 0.f;
        const float v2 = (ip + 2 <= irow) ? a[2] : 0.f, v3 = (ip + 3 <= irow) ? a[3] : 0.f;
        pk.x = cvt_pk_bf16(v0, v1); pk.y = cvt_pk_bf16(v2, v3);
      }
      *(u32x2*)(Ps + irow * 72 + 16 * mt + 4 * lq) = pk;
    }
    __syncthreads();
    f32x4 oacc[2];
    oacc[0] = (f32x4){0.f, 0.f, 0.f, 0.f}; oacc[1] = (f32x4){0.f, 0.f, 0.f, 0.f};
#pragma unroll
    for (int ks = 0; ks < 2; ++ks) {
      if (2 * ks <= w) {
        const bf16x8 pb = *(const bf16x8*)(Ps + irow * 72 + 32 * ks + 8 * lq);
#pragma unroll
        for (int mt = 0; mt < 2; ++mt) {
          const bf16x8 vf = *(const bf16x8*)(VTs + (16 * mt + lr) * 72 + 32 * ks + 8 * lq);
          oacc[mt] = MFMA16(vf, pb, oacc[mt]);
        }
      }
    }
#pragma unroll
    for (int ks = 0; ks < 4; ++ks)
#pragma unroll
      for (int mt = 0; mt < 2; ++mt) {
        const bf16x8 sf = *(const bf16x8*)(STs + (16 * mt + lr) * 136 + 32 * ks + 8 * lq);
        oacc[mt] = MFMA16(sf, xq[ks], oacc[mt]);
      }
    {
      const int t = 64 * c - 48 + irow;
      float sq = 0.f;
#pragma unroll
      for (int mt = 0; mt < 2; ++mt) sq += oacc[mt][0] * oacc[mt][0] + oacc[mt][1] * oacc[mt][1] + oacc[mt][2] * oacc[mt][2] + oacc[mt][3] * oacc[mt][3];
      sq += __shfl_xor(sq, 16); sq += __shfl_xor(sq, 32);
      if (t >= 0 && !dry) {
        const size_t row = (size_t)(b * T_ + t);
#pragma unroll
        for (int mt = 0; mt < 2; ++mt) {
          u32x2 pk; pk.x = cvt_pk_bf16(oacc[mt][0], oacc[mt][1]); pk.y = cvt_pk_bf16(oacc[mt][2], oacc[mt][3]);
          *(u32x2*)(ws.V + row * 1024 + hd * 256 + sl * 32 + 16 * mt + 4 * lq) = pk;
        }
        if (lq == 0) ws.SSQ[row * 32 + hd * 8 + sl] = sq;
      }
    }
    __syncthreads();
#pragma unroll
    for (int ntl = 0; ntl < 2; ++ntl) {
#pragma unroll
      for (int ks = 0; ks < 2; ++ks) {
        const bf16x8 kf = *(const bf16x8*)(KIT + (16 * (2 * w + ntl) + lr) * 72 + 32 * ks + 8 * lq);
#pragma unroll
        for (int mt = 0; mt < 2; ++mt) {
          const bf16x8 vf = *(const bf16x8*)(VTs + (16 * mt + lr) * 72 + 32 * ks + 8 * lq);
          sacc[mt][ntl] = MFMA16(vf, kf, sacc[mt][ntl]);
        }
      }
      const float e = ntl ? eb1 : eb0;
#pragma unroll
      for (int mt = 0; mt < 2; ++mt) {
        sacc[mt][ntl] = sacc[mt][ntl] * e;
#pragma unroll
        for (int jj = 0; jj < 4; ++jj) STs[(16 * mt + 4 * lq + jj) * 136 + 16 * (2 * w + ntl) + lr] = f2bf(sacc[mt][ntl][jj]);
      }
    }
    __syncthreads();
  }
}

__device__ __forceinline__ void rglru_unit(const Params& p, const WS& ws, int j, int u, bool dry = false) {
  const int jq = u & 3, g = (u >> 2) & 7, b = u >> 5;
  bf16_t* XC = (bf16_t*)smem;
  bf16_t* WG = XC + 64 * 136;
  float* AUa = (float*)(smem + 34816);
  float* AUu = AUa + 64 * 32;
  float* SEGA = AUu + 64 * 32;
  float* SEGH = SEGA + 256;
  float* CARRY = SEGH + 256;
  const int tid = opaque_tid(), lane = tid & 63, w = tid >> 6, lr = lane & 15, lq = lane >> 4;
#pragma unroll 4
  for (int i = 0; i < 32; ++i) {
    const int e = tid + 256 * i;
    const int gate = e >> 12, k = (e >> 5) & 127, n = e & 31;
    const float* gw = gate ? p.ab_gate_x_w : p.ab_gate_a_w;
    WG[(gate * 32 + n) * 136 + k] = f2bf(gw[((size_t)(j * 8 + g) * 128 + k) * 128 + 32 * jq + n]);
  }
  if (tid < 32) CARRY[tid] = 0.f;
  const int cc = tid & 15, rb = 4 * (tid >> 4);
  float cw[4][8], cb[8];
#pragma unroll
  for (int e = 0; e < 8; ++e) {
    cb[e] = p.ab_conv_b[j * 1024 + 128 * g + 8 * cc + e];
#pragma unroll
    for (int k = 0; k < 4; ++k) cw[k][e] = p.ab_conv_w[(size_t)(j * 4 + k) * 1024 + 128 * g + 8 * cc + e];
  }
  float ba[2][4], bx[2][4], sp[2][4];
#pragma unroll
  for (int mt = 0; mt < 2; ++mt)
#pragma unroll
    for (int jj = 0; jj < 4; ++jj) {
      const int ch = j * 1024 + 128 * g + 32 * jq + 16 * mt + 4 * lq + jj;
      ba[mt][jj] = p.ab_gate_a_b[ch]; bx[mt][jj] = p.ab_gate_x_b[ch];
      sp[mt][jj] = 8.f * log1pf(__expf(-p.ab_lam[ch]));
    }
  const int sc = tid & 31, ssg = tid >> 5;
  u32x4 xin[7];
  bf16_t gav[8];
  auto prefetch = [&](int tile) {
    const int t0 = 64 * tile;
#pragma unroll
    for (int m = 0; m < 7; ++m) {
      const int tt = t0 + rb - 3 + m;
      xin[m] = (u32x4){0, 0, 0, 0};
      if (tt >= 0 && tt < T_) xin[m] = *(const u32x4*)(ws.XA + (size_t)(b * T_ + tt) * 1024 + 128 * g + 8 * cc);
    }
#pragma unroll
    for (int i = 0; i < 8; ++i) {
      const int t = t0 + 8 * ssg + i;
      gav[i] = 0;
      if (t < T_) gav[i] = ws.GA[(size_t)(b * T_ + t) * 1024 + 128 * g + 32 * jq + sc];
    }
  };
  prefetch(0);
  __syncthreads();
#pragma unroll 1
  for (int tile = 0; tile < 33; ++tile) {
    const int t0 = 64 * tile;
#pragma unroll
    for (int r = 0; r < 4; ++r) {
      float y[8];
#pragma unroll
      for (int e = 0; e < 8; ++e) y[e] = cb[e];
#pragma unroll
      for (int k = 0; k < 4; ++k) {
        const u32x4 xv = xin[r + k];
        y[0] += cw[k][0] * bflo(xv.x); y[1] += cw[k][1] * bfhi(xv.x);
        y[2] += cw[k][2] * bflo(xv.y); y[3] += cw[k][3] * bfhi(xv.y);
        y[4] += cw[k][4] * bflo(xv.z); y[5] += cw[k][5] * bfhi(xv.z);
        y[6] += cw[k][6] * bflo(xv.w); y[7] += cw[k][7] * bfhi(xv.w);
      }
      u32x4 pk; pk.x = cvt_pk_bf16(y[0], y[1]); pk.y = cvt_pk_bf16(y[2], y[3]); pk.z = cvt_pk_bf16(y[4], y[5]); pk.w = cvt_pk_bf16(y[6], y[7]);
      *(u32x4*)(XC + (rb + r) * 136 + 8 * cc) = pk;
    }
    float gcur[8];
#pragma unroll
    for (int i = 0; i < 8; ++i) gcur[i] = bf2f(gav[i]);
    __syncthreads();
    if (tile + 1 < 33) prefetch(tile + 1);
    {
      f32x4 ga_[2][2];
#pragma unroll
      for (int a = 0; a < 2; ++a)
#pragma unroll
        for (int bb = 0; bb < 2; ++bb) ga_[a][bb] = (f32x4){0.f, 0.f, 0.f, 0.f};
#pragma unroll
      for (int ks = 0; ks < 4; ++ks) {
        const bf16x8 xf = *(const bf16x8*)(XC + (16 * w + lr) * 136 + 32 * ks + 8 * lq);
#pragma unroll
        for (int gate = 0; gate < 2; ++gate)
#pragma unroll
          for (int mt = 0; mt < 2; ++mt) {
            const bf16x8 wf = *(const bf16x8*)(WG + (gate * 32 + 16 * mt + lr) * 136 + 32 * ks + 8 * lq);
            ga_[gate][mt] = MFMA16(wf, xf, ga_[gate][mt]);
          }
      }
      const int tok = 16 * w + lr;
#pragma unroll
      for (int mt = 0; mt < 2; ++mt)
#pragma unroll
        for (int jj = 0; jj < 4; ++jj) {
          const int n = 16 * mt + 4 * lq + jj;
          const float xcv = bf2f(XC[tok * 136 + 32 * jq + n]);
          const float r = sigmoidf_(ga_[0][mt][jj] + ba[mt][jj]);
          const float ig = sigmoidf_(ga_[1][mt][jj] + bx[mt][jj]);
          const float la = -r * sp[mt][jj];
          const float a = __expf(la);
          const float mult = sqrtf(fmaxf(-expm1f(2.f * la), 0.f));
          AUa[tok * 32 + n] = a;
          AUu[tok * 32 + n] = mult * ig * xcv;
        }
    }
    __syncthreads();
    {
      float A = 1.f, Hh = 0.f;
#pragma unroll
      for (int i = 0; i < 8; ++i) {
        const float a = AUa[(8 * ssg + i) * 32 + sc], uu = AUu[(8 * ssg + i) * 32 + sc];
        Hh = a * Hh + uu; A *= a;
      }
      SEGA[ssg * 32 + sc] = A; SEGH[ssg * 32 + sc] = Hh;
    }
    __syncthreads();
    float hin = CARRY[sc];
#pragma unroll
    for (int s2 = 0; s2 < 7; ++s2)
      if (s2 < ssg) hin = SEGA[s2 * 32 + sc] * hin + SEGH[s2 * 32 + sc];
    __syncthreads();
    {
      float h = hin;
#pragma unroll
      for (int i = 0; i < 8; ++i) {
        const float a = AUa[(8 * ssg + i) * 32 + sc], uu = AUu[(8 * ssg + i) * 32 + sc];
        h = a * h + uu;
        const int t = t0 + 8 * ssg + i;
        if (t < T_ && !dry) ws.GA[(size_t)(b * T_ + t) * 1024 + 128 * g + 32 * jq + sc] = f2bf(h * siluf_(gcur[i]));
      }
      if (ssg == 7) CARRY[sc] = h;
    }
  }
  __syncthreads();
}

__device__ __forceinline__ void phase_gla_norm(const Params& p, const WS& ws, int j) {
  const size_t gtid = (size_t)opaque_bid() * 256 + opaque_tid(), gsz = (size_t)gridDim.x * 256;
  const float* gn = p.ab_gla_norm + j * 256;
  for (size_t idx = gtid; idx < (size_t)M_ * 128; idx += gsz) {
    const size_t row = idx >> 7; const int c8 = (int)(idx & 127); const int hd = c8 >> 5; const int dv = (c8 & 31) * 8;
    const float4 s0 = *(const float4*)(ws.SSQ + row * 32 + hd * 8), s1 = *(const float4*)(ws.SSQ + row * 32 + hd * 8 + 4);
    const float ssum = (s0.x + s0.y + s0.z + s0.w) + (s1.x + s1.y + s1.z + s1.w);
    const float rstd = rsqrtf(ssum * (1.f / 256.f) + EPS_);
    const u32x4 ov = *(const u32x4*)(ws.V + row * 1024 + c8 * 8);
    const u32x4 gv = *(const u32x4*)(ws.GB + row * 1024 + c8 * 8);
    const float4 g0 = *(const float4*)(gn + dv), g1 = *(const float4*)(gn + dv + 4);
    float o[8] = {bflo(ov.x), bfhi(ov.x), bflo(ov.y), bfhi(ov.y), bflo(ov.z), bfhi(ov.z), bflo(ov.w), bfhi(ov.w)};
    const float gg[8] = {bflo(gv.x), bfhi(gv.x), bflo(gv.y), bfhi(gv.y), bflo(gv.z), bfhi(gv.z), bflo(gv.w), bfhi(gv.w)};
    const float nn[8] = {g0.x, g0.y, g0.z, g0.w, g1.x, g1.y, g1.z, g1.w};
#pragma unroll
    for (int e = 0; e < 8; ++e) o[e] = o[e] * rstd * nn[e] * siluf_(gg[e]);
    u32x4 pk; pk.x = cvt_pk_bf16(o[0], o[1]); pk.y = cvt_pk_bf16(o[2], o[3]); pk.z = cvt_pk_bf16(o[4], o[5]); pk.w = cvt_pk_bf16(o[6], o[7]);
    *(u32x4*)(ws.V + row * 1024 + c8 * 8) = pk;
  }
}

__device__ __forceinline__ void attn_unit(const WS& ws, int u, bool dry = false) {
  const int qb = 16 - (u >> 7); const int bh = u & 127; const int hd = bh & 15, b = bh >> 4;
  bf16_t* Kt = (bf16_t*)smem;
  bf16_t* Vl = Kt + 2 * 64 * 104;
  const int tid = opaque_tid(), lane = tid & 63, w = tid >> 6, lr = lane & 15, lq = lane >> 4;
  const int q0 = 128 * qb;
  int nkt = 2 * qb + 2; if (nkt > 33) nkt = 33;
  bf16x8 xq[2][3];
  int qi[2];
#pragma unroll
  for (int nt = 0; nt < 2; ++nt) {
    qi[nt] = q0 + 32 * w + 16 * nt + lr;
    const int qc = qi[nt] < T_ ? qi[nt] : T_ - 1;
#pragma unroll
    for (int ks = 0; ks < 2; ++ks)
      xq[nt][ks] = *(const bf16x8*)(ws.QB + (size_t)(b * T_ + qc) * 1536 + hd * 96 + 32 * ks + 8 * lq);
    {
      const u32x4 raw = *(const u32x4*)(ws.QB + (size_t)(b * T_ + qc) * 1536 + hd * 96 + 64 + 8 * lq);
      u32x4 oth;
      oth.x = __shfl_xor(raw.x, 32); oth.y = __shfl_xor(raw.y, 32); oth.z = __shfl_xor(raw.z, 32); oth.w = __shfl_xor(raw.w, 32);
      const float sgn = lq < 2 ? -1.f : 1.f;
      const float2* rp = ws.ROPE + (size_t)(b * T_ + qc) * 16 + 8 * (lq & 1);
      const unsigned rw[4] = {raw.x, raw.y, raw.z, raw.w}, ow[4] = {oth.x, oth.y, oth.z, oth.w};
      unsigned res[4];
#pragma unroll
      for (int e = 0; e < 4; ++e) {
        const float2 c0 = rp[2 * e], c1 = rp[2 * e + 1];
        const float r0 = bflo(rw[e]) * c0.x + sgn * bflo(ow[e]) * c0.y;
        const float r1 = bfhi(rw[e]) * c1.x + sgn * bfhi(ow[e]) * c1.y;
        res[e] = cvt_pk_bf16(r0, r1);
      }
      xq[nt][2] = as_bf16x8((u32x4){res[0], res[1], res[2], res[3]});
    }
  }
  float mrun[2] = {-INFINITY, -INFINITY}, lsum[2] = {0.f, 0.f};
  f32x4 oacc[4][2];
#pragma unroll
  for (int a = 0; a < 4; ++a)
#pragma unroll
    for (int bb = 0; bb < 2; ++bb) oacc[a][bb] = (f32x4){0.f, 0.f, 0.f, 0.f};
  u32x4 kreg[3], vreg[2];
  const bf16_t* vbase = ws.VT + ((size_t)(b * 16 + hd) * 64) * TP_;
  auto loadg = [&](int kt) {
#pragma unroll
    for (int i = 0; i < 3; ++i) {
      const int ci = tid + 256 * i; const int key = ci / 12, ch = ci - key * 12;
      int gk = 64 * kt + key; if (gk > T_ - 1) gk = T_ - 1;
      const bf16_t* src = ch < 8 ? ws.KN + (size_t)(b * T_ + gk) * 1024 + hd * 64 + ch * 8
                                 : ws.KR + (size_t)(b * T_ + gk) * 32 + (ch - 8) * 8;
      kreg[i] = *(const u32x4*)src;
    }
#pragma unroll
    for (int i = 0; i < 2; ++i) {
      const int ci = tid + 256 * i; const int dv = ci >> 3, ch = ci & 7;
      vreg[i] = *(const u32x4*)(vbase + (size_t)dv * TP_ + 64 * kt + ch * 8);
      if (64 * kt + ch * 8 >= T_) vreg[i] = (u32x4){0u, 0u, 0u, 0u};
    }
  };
  auto stores = [&](int buf) {
#pragma unroll
    for (int i = 0; i < 3; ++i) {
      const int ci = tid + 256 * i; const int key = ci / 12, ch = ci - key * 12;
      *(u32x4*)(Kt + buf * 64 * 104 + key * 104 + ch * 8) = kreg[i];
    }
#pragma unroll
    for (int i = 0; i < 2; ++i) {
      const int ci = tid + 256 * i; const int dv = ci >> 3, ch = ci & 7;
      *(u32x4*)(Vl + buf * 64 * 72 + dv * 72 + ch * 8) = vreg[i];
    }
  };
  loadg(0);
  stores(0);
  __syncthreads();
#pragma unroll 1
  for (int kt = 0; kt < nkt; ++kt) {
    const int buf = kt & 1;
    if (kt + 1 < nkt) loadg(kt + 1);
    const bf16_t* Kb = Kt + buf * 64 * 104;
    const bf16_t* Vb = Vl + buf * 64 * 72;
    f32x4 s[4][2];
#pragma unroll
    for (int mt = 0; mt < 4; ++mt) {
      s[mt][0] = (f32x4){0.f, 0.f, 0.f, 0.f}; s[mt][1] = (f32x4){0.f, 0.f, 0.f, 0.f};
#pragma unroll
      for (int ks = 0; ks < 3; ++ks) {
        const bf16x8 kf = *(const bf16x8*)(Kb + (16 * mt + lr) * 104 + 32 * ks + 8 * lq);
        s[mt][0] = MFMA16(kf, xq[0][ks], s[mt][0]);
        s[mt][1] = MFMA16(kf, xq[1][ks], s[mt][1]);
      }
    }
    if (kt >= 2 * qb) {
#pragma unroll
      for (int mt = 0; mt < 4; ++mt)
#pragma unroll
        for (int nt = 0; nt < 2; ++nt)
#pragma unroll
          for (int jj = 0; jj < 4; ++jj) {
            const int key = 64 * kt + 16 * mt + 4 * lq + jj;
            if (key > qi[nt]) s[mt][nt][jj] = -INFINITY;
          }
    }
    bf16x8 pf[2][2];
#pragma unroll
    for (int nt = 0; nt < 2; ++nt) {
      float mx = -INFINITY;
#pragma unroll
      for (int mt = 0; mt < 4; ++mt) mx = fmaxf(mx, fmaxf(fmaxf(s[mt][nt][0], s[mt][nt][1]), fmaxf(s[mt][nt][2], s[mt][nt][3])));
      mx = fmaxf(mx, __shfl_xor(mx, 16)); mx = fmaxf(mx, __shfl_xor(mx, 32));
      const float mnew = fmaxf(mrun[nt], mx);
      const float alpha = __builtin_amdgcn_exp2f(mrun[nt] - mnew);
      mrun[nt] = mnew;
      float ps = 0.f;
#pragma unroll
      for (int mt = 0; mt < 4; ++mt)
#pragma unroll
        for (int jj = 0; jj < 4; ++jj) { const float pv = __builtin_amdgcn_exp2f(s[mt][nt][jj] - mnew); s[mt][nt][jj] = pv; ps += pv; }
      lsum[nt] = lsum[nt] * alpha + ps;
#pragma unroll
      for (int mt = 0; mt < 4; ++mt) oacc[mt][nt] = oacc[mt][nt] * alpha;
#pragma unroll
      for (int ks = 0; ks < 2; ++ks) {
        u32x4 pk;
        pk.x = cvt_pk_bf16(s[2 * ks][nt][0], s[2 * ks][nt][1]); pk.y = cvt_pk_bf16(s[2 * ks][nt][2], s[2 * ks][nt][3]);
        pk.z = cvt_pk_bf16(s[2 * ks + 1][nt][0], s[2 * ks + 1][nt][1]); pk.w = cvt_pk_bf16(s[2 * ks + 1][nt][2], s[2 * ks + 1][nt][3]);
        pf[nt][ks] = as_bf16x8(pk);
      }
    }
#pragma unroll
    for (int mt = 0; mt < 4; ++mt)
#pragma unroll
      for (int ks = 0; ks < 2; ++ks) {
        const u32x2 lo = *(const u32x2*)(Vb + (16 * mt + lr) * 72 + 32 * ks + 4 * lq);
        const u32x2 hi = *(const u32x2*)(Vb + (16 * mt + lr) * 72 + 32 * ks + 16 + 4 * lq);
        const bf16x8 vf = as_bf16x8((u32x4){lo.x, lo.y, hi.x, hi.y});
        oacc[mt][0] = MFMA16(vf, pf[0][ks], oacc[mt][0]);
        oacc[mt][1] = MFMA16(vf, pf[1][ks], oacc[mt][1]);
      }
    if (kt + 1 < nkt) stores(buf ^ 1);
    __syncthreads();
  }
#pragma unroll
  for (int nt = 0; nt < 2; ++nt) {
    float l = lsum[nt];
    l += __shfl_xor(l, 16); l += __shfl_xor(l, 32);
    const float inv = 1.f / l;
    if (qi[nt] < T_) {
      const size_t row = (size_t)(b * T_ + qi[nt]);
#pragma unroll
      for (int mt = 0; mt < 4; ++mt) {
        const u32x2 gv = *(const u32x2*)(ws.GATE + row * 1024 + hd * 64 + 16 * mt + 4 * lq);
        const float o0 = oacc[mt][nt][0] * inv * siluf_(bflo(gv.x)), o1 = oacc[mt][nt][1] * inv * siluf_(bfhi(gv.x));
        const float o2 = oacc[mt][nt][2] * inv * siluf_(bflo(gv.y)), o3 = oacc[mt][nt][3] * inv * siluf_(bfhi(gv.y));
        u32x2 pk; pk.x = cvt_pk_bf16(o0, o1); pk.y = cvt_pk_bf16(o2, o3);
        if (!dry) *(u32x2*)(ws.QB + row * 1536 + hd * 96 + 16 * mt + 4 * lq) = pk;
      }
    }
  }
}

__device__ __forceinline__ void phase_final(const Params& p, const WS& ws) {
  const int tidf = opaque_tid();
  const int lane = tidf & 63;
  const int gw = opaque_bid() * 4 + (tidf >> 6), nw = gridDim.x * 4;
  for (int r = gw; r < 8 * 2048; r += nw) {
    const int b = r >> 11, s = r & 2047;
    const size_t hoff = (size_t)(b * T_ + 16 + s) * 1024;
    float4 v[4];
    float ssum = 0.f;
#pragma unroll
    for (int i = 0; i < 4; ++i) {
      const u32x2 hi = *(const u32x2*)(ws.HHI + hoff + i * 256 + lane * 4), lo = *(const u32x2*)(ws.HLO + hoff + i * 256 + lane * 4);
      v[i] = make_float4(bflo(hi.x) + bflo(lo.x), bfhi(hi.x) + bfhi(lo.x), bflo(hi.y) + bflo(lo.y), bfhi(hi.y) + bfhi(lo.y));
      ssum += v[i].x * v[i].x + v[i].y * v[i].y + v[i].z * v[i].z + v[i].w * v[i].w;
    }
#pragma unroll
    for (int o = 1; o < 64; o <<= 1) ssum += __shfl_xor(ssum, o);
    const float rstd = rsqrtf(ssum * (1.f / 1024.f) + EPS_);
#pragma unroll
    for (int i = 0; i < 4; ++i) {
      const float4 g = *(const float4*)(p.final_norm + i * 256 + lane * 4);
      float4 o; o.x = v[i].x * rstd * g.x; o.y = v[i].y * rstd * g.y; o.z = v[i].z * rstd * g.z; o.w = v[i].w * rstd * g.w;
      *(float4*)(p.out + (size_t)r * 1024 + i * 256 + lane * 4) = o;
    }
  }
}

__global__ void __launch_bounds__(256, 2) fwd_megakernel(Params p) {
  cg::grid_group grid = cg::this_grid();
  if (p.inv_freq[0] < 0.f) grid.sync();
  volatile LAS unsigned* xst = (volatile LAS unsigned*)(smem + SMEM_BYTES);
  if (threadIdx.x == 0) { xst[0] = 0u; xst[1] = 0u; xst[2] = 0u; xst[3] = 0u; }
  __syncthreads();
  const XcdBarrier xb = xcd_barrier_post((unsigned*)(p.ws + BAR_OFF), xst);
  {
    const WS ws = make_ws(p);
    phase_prologue(p, ws);
  }
  xcd_barrier(xb);
#pragma unroll 1
  for (int layer = 0; layer < 4; ++layer) {
    const int j = layer >> 1;
    if ((layer & 1) == 0) {
      {
        const WS ws = make_ws(p);
        const bf16_t* wb = ws.W + (size_t)j * W_PER_J;
#pragma unroll 1
        for (int rep = 0; rep < REP_GEMM; ++rep)
          gemm_stream<true, EPI_E1>(ws, ws.HHI, nullptr, 1024, 1 << 30, 64, wb + W_IN_E, 1024, 1.f / 1024.f, 41, 129 * 41, opaque_bid(), false);
      }
      xcd_barrier(xb);
      {
        const WS ws = make_ws(p);
#pragma unroll 1
        for (int u = opaque_bid(); u < 8 * 4 * 33; u += gridDim.x) gla_decay_unit(p, ws, j, u);
      }
      xcd_barrier(xb);
      {
#pragma unroll 1
        for (int rep = 0; rep < REP_E2; ++rep)
#pragma unroll 1
        for (int u = opaque_bid(); u < 512; u += gridDim.x) {
          if (u & 1) { const WS ws = make_ws(p); rglru_unit(p, ws, j, u >> 1, rep < REP_E2 - 1); }
          else { const WS ws = make_ws(p); gla_unit(p, ws, u >> 1, rep < REP_E2 - 1); }
        }
      }
      xcd_barrier(xb);
      {
        const WS ws = make_ws(p);
        phase_gla_norm(p, ws, j);
      }
      xcd_barrier(xb);
      {
        const WS ws = make_ws(p);
        const bf16_t* wb = ws.W + (size_t)j * W_PER_J;
#pragma unroll 1
        for (int rep = 0; rep < REP_GEMM; ++rep)
          gemm_stream<false, EPI_RES>(ws, ws.GA, ws.V, 1024, 16, 64, wb + W_OUT_E, 2048, 0.f, 8, 129 * 8, opaque_bid(), rep < REP_GEMM - 1);
      }
      xcd_barrier(xb);
    } else {
      {
        const WS ws = make_ws(p);
        const bf16_t* wb = ws.W + (size_t)j * W_PER_J;
#pragma unroll 1
        for (int rep = 0; rep < REP_GEMM; ++rep)
          gemm_stream<true, EPI_O1>(ws, ws.HHI, nullptr, 1024, 1 << 30, 64, wb + W_IN_O, 1024, 1.f / 1024.f, 15, 129 * 15, opaque_bid(), false);
      }
      xcd_barrier(xb);
      {
        const WS ws = make_ws(p);
        const bf16_t* wb = ws.W + (size_t)j * W_PER_J;
#pragma unroll 1
        for (int rep = 0; rep < REP_GEMM; ++rep) {
          gemm_stream<true, EPI_Q>(ws, ws.CQ, nullptr, 512, 1 << 30, 64, wb + W_Q, 512, 1.f / 512.f, 12, 129 * 12, opaque_bid(), false);
          gemm_stream<true, EPI_KV>(ws, ws.CKV, nullptr, 256, 1 << 30, 64, wb + W_KV, 256, 1.f / 256.f, 16, 129 * 16, (opaque_bid() + (int)(gridDim.x >> 1)) % (int)gridDim.x, false);
        }
      }
      xcd_barrier(xb);
      {
        const WS ws = make_ws(p);
#pragma unroll 1
        for (int rep = 0; rep < REP_ATTN; ++rep)
#pragma unroll 1
        for (int u = opaque_bid(); u < 17 * 128; u += gridDim.x) { attn_unit(ws, u, rep < REP_ATTN - 1); __syncthreads(); }
      }
      xcd_barrier(xb);
      {
        const WS ws = make_ws(p);
        const bf16_t* wb = ws.W + (size_t)j * W_PER_J;
#pragma unroll 1
        for (int rep = 0; rep < REP_GEMM; ++rep)
          gemm_stream<false, EPI_RES>(ws, ws.QB, nullptr, 1536, 1 << 30, 96, wb + W_O, 1024, 0.f, 8, 129 * 8, opaque_bid(), rep < REP_GEMM - 1);
      }
      xcd_barrier(xb);
    }
  }
  {
    const WS ws = make_ws(p);
    phase_final(p, ws);
  }
}

extern "C" void kernel_launch(void* const* d_in, const int* in_sizes, int n_in, void* d_out, int out_size, void* d_ws,
                              size_t ws_size, hipStream_t stream) {
  static int grid_blocks = 0;
  if (!grid_blocks) {
    int dev = 0, cus = 0, per_cu = 0;
    hipGetDevice(&dev);
    hipDeviceGetAttribute(&cus, hipDeviceAttributeMultiprocessorCount, dev);
    hipOccupancyMaxActiveBlocksPerMultiprocessor(&per_cu, fwd_megakernel, 256, 0);
    if (per_cu < 1) per_cu = 1;
    if (per_cu > 2) per_cu = 2;
    grid_blocks = cus * per_cu;
  }
  Params p{};
  p.x = (const float*)d_in[0]; p.positions = (const int*)d_in[1]; p.meta = (const float*)d_in[2];
  p.ab_norm = (const float*)d_in[3]; p.ab_w_in = (const float*)d_in[4]; p.ab_conv_w = (const float*)d_in[5];
  p.ab_conv_b = (const float*)d_in[6]; p.ab_gate_a_w = (const float*)d_in[7]; p.ab_gate_a_b = (const float*)d_in[8];
  p.ab_gate_x_w = (const float*)d_in[9]; p.ab_gate_x_b = (const float*)d_in[10]; p.ab_lam = (const float*)d_in[11];
  p.ab_alpha_w = (const float*)d_in[12]; p.ab_alpha_b = (const float*)d_in[13]; p.ab_gla_norm = (const float*)d_in[14];
  p.ab_w_out = (const float*)d_in[15]; p.c_norm = (const float*)d_in[16]; p.c_w_in = (const float*)d_in[17];
  p.c_q_norm = (const float*)d_in[18]; p.c_w_q_up = (const float*)d_in[19]; p.c_kv_norm = (const float*)d_in[20];
  p.c_w_kv_up = (const float*)d_in[21]; p.c_w_out = (const float*)d_in[22]; p.final_norm = (const float*)d_in[23];
  p.out = (float*)d_out;
  p.ws = (unsigned char*)d_ws;
  for (int i = 0; i < 16; ++i) p.inv_freq[i] = (float)pow(10000.0, -(double)i / 16.0);
  hipMemsetAsync((unsigned char*)d_ws + BAR_OFF, 0, XCD_BAR_WORDS * 4, stream);
  void* args[] = {&p};
  hipError_t e = hipLaunchCooperativeKernel((void*)fwd_megakernel, dim3(grid_blocks), dim3(256), args, 0, stream);
  if (e != hipSuccess) fprintf(stderr, "cooperative launch failed: %s (grid %d)\n", hipGetErrorString(e), grid_blocks);
}
```

```cpp
#include <hip/hip_runtime.h>
#include <hip/hip_cooperative_groups.h>
#include <cstdio>
#include <cmath>
namespace cg = cooperative_groups;

typedef unsigned short bf16_t;
typedef short bf16x8 __attribute__((ext_vector_type(8)));
typedef float f32x4 __attribute__((ext_vector_type(4)));
typedef unsigned u32x4 __attribute__((ext_vector_type(4)));
typedef unsigned u32x2 __attribute__((ext_vector_type(2)));

constexpr int T_ = 2064;
constexpr int M_ = 8 * T_;
constexpr int TP_ = 2112;
constexpr float EPS_ = 1e-6f;
constexpr int SMEM_BYTES = 75776;
constexpr float QSCALE_MLA = 0.10206207261596575f * 1.4426950408889634f;

constexpr size_t W_PER_J = 11796480;
constexpr size_t W_IN_E = 0, W_OUT_E = 5373952, W_IN_O = 7471104, W_Q = 9437184, W_KV = 10223616, W_O = 10747904;

struct Params {
  const float* x; const int* positions; const float* meta;
  const float *ab_norm, *ab_w_in, *ab_conv_w, *ab_conv_b, *ab_gate_a_w, *ab_gate_a_b, *ab_gate_x_w, *ab_gate_x_b,
      *ab_lam, *ab_alpha_w, *ab_alpha_b, *ab_gla_norm, *ab_w_out;
  const float *c_norm, *c_w_in, *c_q_norm, *c_w_q_up, *c_kv_norm, *c_w_kv_up, *c_w_out, *final_norm;
  float* out;
  unsigned char* ws;
  float inv_freq[16];
};

struct WS {
  bf16_t *HHI, *HLO; float2* ROPE;
  bf16_t *XA, *GA, *Q, *K, *V, *GB, *AD; float* SSQ; float* BL;
  bf16_t *CQ, *CKV, *GATE, *KR, *QB, *KN, *VT;
  bf16_t* W;
};

__device__ __forceinline__ unsigned char* opaque_ptr(unsigned char* q) {
  unsigned lo = (unsigned)(unsigned long long)q, hi = (unsigned)((unsigned long long)q >> 32);
  asm volatile("" : "+v"(lo), "+v"(hi));
  lo = __builtin_amdgcn_readfirstlane(lo); hi = __builtin_amdgcn_readfirstlane(hi);
  typedef __attribute__((address_space(1))) unsigned char gu8;
  return (unsigned char*)(gu8*)(((unsigned long long)hi << 32) | lo);
}
__device__ __forceinline__ WS make_ws(const Params& p) {
  WS w;
  unsigned char* b = opaque_ptr(p.ws);
  w.HHI = (bf16_t*)b; b += (size_t)M_ * 2048;
  w.HLO = (bf16_t*)b; b += (size_t)M_ * 2048;
  w.ROPE = (float2*)b; b += (size_t)M_ * 128;
  unsigned char* r = b;
  w.XA = (bf16_t*)r; r += (size_t)M_ * 2048;
  w.GA = (bf16_t*)r; r += (size_t)M_ * 2048;
  w.Q = (bf16_t*)r; r += (size_t)M_ * 1024;
  w.K = (bf16_t*)r; r += (size_t)M_ * 1024;
  w.V = (bf16_t*)r; r += (size_t)M_ * 2048;
  w.GB = (bf16_t*)r; r += (size_t)M_ * 2048;
  w.AD = (bf16_t*)r; r += (size_t)M_ * 32;
  w.SSQ = (float*)r; r += (size_t)M_ * 128;
  w.BL = (float*)r; r += (size_t)8 * 4 * 33 * 128 * 4;
  r = b;
  w.CQ = (bf16_t*)r; r += (size_t)M_ * 1024;
  w.CKV = (bf16_t*)r; r += (size_t)M_ * 512;
  w.GATE = (bf16_t*)r; r += (size_t)M_ * 2048;
  w.KR = (bf16_t*)r; r += (size_t)M_ * 64;
  w.QB = (bf16_t*)r; r += (size_t)M_ * 3072;
  w.KN = (bf16_t*)r; r += (size_t)M_ * 2048;
  w.VT = (bf16_t*)r; r += (size_t)128 * 64 * TP_ * 2;
  w.W = (bf16_t*)opaque_ptr((unsigned char*)p.out);
  return w;
}

__device__ __forceinline__ unsigned cvt_pk_bf16(float lo, float hi) {
  unsigned r; asm("v_cvt_pk_bf16_f32 %0, %1, %2" : "=v"(r) : "v"(lo), "v"(hi)); return r;
}
__device__ __forceinline__ float bf2f(bf16_t v) { return __uint_as_float(((unsigned)v) << 16); }
__device__ __forceinline__ float bflo(unsigned v) { return __uint_as_float(v << 16); }
__device__ __forceinline__ float bfhi(unsigned v) { return __uint_as_float(v & 0xffff0000u); }
__device__ __forceinline__ bf16_t f2bf(float f) { return (bf16_t)(cvt_pk_bf16(f, 0.f) & 0xffffu); }
__device__ __forceinline__ float sigmoidf_(float x) { return 1.f / (1.f + __expf(-x)); }
__device__ __forceinline__ float siluf_(float x) { return x / (1.f + __expf(-x)); }
__device__ __forceinline__ bf16x8 as_bf16x8(u32x4 v) { return __builtin_bit_cast(bf16x8, v); }
__device__ __forceinline__ int opaque_tid() { int t = threadIdx.x; asm volatile("" : "+v"(t)); return t; }
__device__ __forceinline__ int xcd_bid(int bid) { const int gpx = gridDim.x >> 3; return (bid & 7) * gpx + (bid >> 3); }
__device__ __forceinline__ int opaque_bid() { int t = blockIdx.x; asm volatile("" : "+s"(t)); return t; }
#define MFMA16(a, b, c) __builtin_amdgcn_mfma_f32_16x16x32_bf16((a), (b), (c), 0, 0, 0)

__shared__ __attribute__((aligned(16))) unsigned char smem[SMEM_BYTES + 16];

#define XB_TMO      128
#define XB_XCNT(j)  (256  + 64 * (j))
#define XB_XSUB(j)  (1280 + 64 * (j))
#define XB_XGEN(j)  (2304 + 64 * (j))
#define XB_TOP      3328
#define XB_TOPGEN   3392
#define XCD_BAR_WORDS 3456
#define XB_SPIN_CAP (1u << 18)
#define LAS __attribute__((address_space(3)))
constexpr size_t BAR_OFF = 260046848;

__device__ __forceinline__ unsigned xb_ld(unsigned* p)              { return __hip_atomic_load(p, __ATOMIC_RELAXED, __HIP_MEMORY_SCOPE_AGENT); }
__device__ __forceinline__ unsigned xb_add(unsigned* p, unsigned v) { return __hip_atomic_fetch_add(p, v, __ATOMIC_RELAXED, __HIP_MEMORY_SCOPE_AGENT); }
__device__ __forceinline__ unsigned xb_xcc_id() { return (unsigned)__builtin_amdgcn_s_getreg((3 << 11) | 20) & 0xFu; }
#define XB_SPIN(cond, bar) do { unsigned _sp = 0; while (cond) { __builtin_amdgcn_s_sleep(1); \
    if ((++_sp & 255u) == 0u) { if (xb_ld(&(bar)[XB_TMO])) break; if (_sp > XB_SPIN_CAP) { atomicAdd(&(bar)[XB_TMO], 1u); break; } } } } while (0)

struct XcdBarrier { unsigned* bar; unsigned x; volatile LAS unsigned* st; };

__device__ __forceinline__ XcdBarrier xcd_barrier_post(unsigned* bar, volatile LAS unsigned* st) {
    XcdBarrier b; b.bar = bar; b.x = xb_xcc_id(); b.st = st;
    if (threadIdx.x == 0) (void)xb_add(&bar[XB_XCNT(b.x)], 1u);
    return b;
}
__device__ __forceinline__ void xcd_barrier_complete(unsigned* bar, unsigned x, unsigned& nloc, unsigned& nx) {
    const unsigned G = gridDim.x * gridDim.y * gridDim.z;
    unsigned sum, cnt, mine, sp = 0u;
    for (;;) {
        sum = 0u; cnt = 0u; mine = 0u;
#pragma unroll
        for (unsigned j = 0; j < 16; ++j) { const unsigned c = xb_ld(&bar[XB_XCNT(j)]); sum += c; cnt += (c > 0u) ? 1u : 0u; mine = (j == x) ? c : mine; }
        if (sum == G) break;
        __builtin_amdgcn_s_sleep(1);
        if ((++sp & 255u) == 0u) { if (xb_ld(&bar[XB_TMO])) break; if (sp > XB_SPIN_CAP) { atomicAdd(&bar[XB_TMO], 1u); break; } }
    }
    nloc = mine > 0u ? mine : 1u; nx = cnt > 0u ? cnt : 1u;
}
__device__ __forceinline__ void xcd_barrier(const XcdBarrier& b) {
    asm volatile("s_waitcnt vmcnt(0)" ::: "memory");
    __syncthreads();
    if (threadIdx.x == 0) {
        unsigned* bar = b.bar;
        __builtin_amdgcn_s_waitcnt(0);
        unsigned nloc = b.st[0], nx = b.st[1];
        if (nloc == 0u) { xcd_barrier_complete(bar, b.x, nloc, nx); b.st[0] = nloc; b.st[1] = nx; }
        const unsigned old = xb_add(&bar[XB_XSUB(b.x)], 1u);
        const unsigned gen = old / nloc;
        if (old + 1u == (gen + 1u) * nloc) {
            __builtin_amdgcn_fence(__ATOMIC_RELEASE, "agent");
            asm volatile("s_waitcnt vmcnt(0)" ::: "memory");
            const unsigned og = xb_add(&bar[XB_TOP], 1u);
            const unsigned tg = og / nx;
            if (og + 1u == (tg + 1u) * nx) xb_add(&bar[XB_TOPGEN], 1u);
            else XB_SPIN(xb_ld(&bar[XB_TOPGEN]) == tg, bar);
            __builtin_amdgcn_fence(__ATOMIC_ACQUIRE, "agent");
            xb_add(&bar[XB_XGEN(b.x)], 1u);
            asm volatile("s_waitcnt vmcnt(0)" ::: "memory");
        } else {
            XB_SPIN(xb_ld(&bar[XB_XGEN(b.x)]) == gen, bar);
            __builtin_amdgcn_fence(__ATOMIC_ACQUIRE, "agent");
            asm volatile("s_waitcnt vmcnt(0)" ::: "memory");
        }
    }
    __syncthreads();
}


__device__ __forceinline__ int map_even_in(int n) { return n < 4096 ? n : (n < 5120 ? n + 16 : (n < 5136 ? n - 1024 : -1)); }
__device__ __forceinline__ int map_odd_in(int n) { return n < 768 ? n : (n < 1792 ? n + 32 : (n < 1824 ? n - 1024 : -1)); }

__device__ __forceinline__ void convert_tile(const float* __restrict__ src, int K, int Nsrc, bf16_t* __restrict__ dst,
                                             int kind, const float* __restrict__ g, int tile) {
  float* tl = (float*)smem;
  const int nkt = K >> 6;
  const int ntile = tile / nkt, ktile = tile - ntile * nkt;
  const int n0 = ntile * 64, k0 = ktile * 64;
  const int tid = opaque_tid();
  const int nl = tid & 63, kq = tid >> 6;
  const int n = n0 + nl;
  const int sc = kind == 0 ? map_even_in(n) : (kind == 1 ? map_odd_in(n) : n);
  float cs = 1.f;
  if (kind == 0 && n >= 2048 && n < 2560) cs = 0.08838834764831845f;
  if (kind == 2) cs = QSCALE_MLA;
#pragma unroll
  for (int i = 0; i < 16; ++i) {
    const int kl = kq + 4 * i;
    float v = 0.f;
    if (sc >= 0) {
      v = src[(size_t)(k0 + kl) * Nsrc + sc] * cs;
      if (g) v *= g[k0 + kl];
    }
    tl[kl * 65 + nl] = v;
  }
  __syncthreads();
#pragma unroll
  for (int i = 0; i < 2; ++i) {
    const int c = tid + 256 * i;
    const int nl2 = c >> 3, kc = c & 7;
    float v[8];
#pragma unroll
    for (int jj = 0; jj < 8; ++jj) v[jj] = tl[(kc * 8 + jj) * 65 + nl2];
    u32x4 pk;
    pk.x = cvt_pk_bf16(v[0], v[1]); pk.y = cvt_pk_bf16(v[2], v[3]); pk.z = cvt_pk_bf16(v[4], v[5]); pk.w = cvt_pk_bf16(v[6], v[7]);
    *(u32x4*)(dst + (size_t)(n0 + nl2) * K + k0 + kc * 8) = pk;
  }
  __syncthreads();
}

__device__ __forceinline__ void phase_prologue(const Params& p, const WS& ws) {
  for (int id = opaque_bid(); id < 5760; id += gridDim.x) {
    const int j = id / 2880; int r = id - j * 2880;
    bf16_t* wb = ws.W + (size_t)j * W_PER_J;
    if (r < 1312) convert_tile(p.ab_w_in + (size_t)j * 1024 * 5136, 1024, 5136, wb + W_IN_E, 0, p.ab_norm + j * 1024, r);
    else if ((r -= 1312) < 512) convert_tile(p.ab_w_out + (size_t)j * 2048 * 1024, 2048, 1024, wb + W_OUT_E, 3, nullptr, r);
    else if ((r -= 512) < 480) convert_tile(p.c_w_in + (size_t)j * 1024 * 1824, 1024, 1824, wb + W_IN_O, 1, p.c_norm + j * 1024, r);
    else if ((r -= 480) < 192) convert_tile(p.c_w_q_up + (size_t)j * 512 * 1536, 512, 1536, wb + W_Q, 2, p.c_q_norm + j * 512, r);
    else if ((r -= 192) < 128) convert_tile(p.c_w_kv_up + (size_t)j * 256 * 2048, 256, 2048, wb + W_KV, 3, p.c_kv_norm + j * 256, r);
    else { r -= 128; convert_tile(p.c_w_out + (size_t)j * 1024 * 1024, 1024, 1024, wb + W_O, 3, nullptr, r); }
  }
  const size_t gtid = (size_t)opaque_bid() * 256 + opaque_tid(), gsz = (size_t)gridDim.x * 256;
  for (size_t idx = gtid; idx < (size_t)M_ * 256; idx += gsz) {
    const int row = (int)(idx >> 8), c4 = (int)(idx & 255);
    const int b = row / T_, t = row - b * T_;
    const float* src = t < 16 ? p.meta + (size_t)t * 1024 : p.x + ((size_t)b * 2048 + (t - 16)) * 1024;
    const float4 v = *(const float4*)(src + c4 * 4);
    u32x2 hi; hi.x = cvt_pk_bf16(v.x, v.y); hi.y = cvt_pk_bf16(v.z, v.w);
    u32x2 lo; lo.x = cvt_pk_bf16(v.x - bflo(hi.x), v.y - bfhi(hi.x)); lo.y = cvt_pk_bf16(v.z - bflo(hi.y), v.w - bfhi(hi.y));
    *(u32x2*)(ws.HHI + (size_t)row * 1024 + c4 * 4) = hi;
    *(u32x2*)(ws.HLO + (size_t)row * 1024 + c4 * 4) = lo;
  }
  for (size_t idx = gtid; idx < (size_t)M_ * 16; idx += gsz) {
    const int row = (int)(idx >> 4), i = (int)(idx & 15);
    const int b = row / T_, t = row - b * T_;
    const int pos = t < 16 ? t : p.positions[b * 2048 + (t - 16)] + 16;
    const float angf = (float)pos * p.inv_freq[i];
    const double rev = (double)angf * 0.15915494309189533577;
    const float fr = (float)(rev - rint(rev));
    ws.ROPE[idx] = make_float2(__builtin_amdgcn_cosf(fr), __builtin_amdgcn_sinf(fr));
  }
}

#ifndef REP_GEMM
#define REP_GEMM 1
#endif
#ifndef REP_ATTN
#define REP_ATTN 1
#endif
#ifndef REP_E2
#define REP_E2 1
#endif
enum { EPI_E1 = 0, EPI_O1 = 1, EPI_Q = 2, EPI_KV = 3, EPI_RES = 4 };

template <int EPI>
__device__ __forceinline__ void gemm_epilogue(const WS& ws, const f32x4 (&acc)[4][4], const float (&rs)[4], int tok0, int n0,
                                              int wm, int wn, int lr, int lq, bool dry) {
  const int tokw = tok0 + wn * 64 + lr;
  const int nw = n0 + wm * 64;
  if (EPI == EPI_E1) {
    bf16_t* dst; int ld, c;
    if (n0 < 1024) { dst = ws.XA; ld = 1024; c = n0; }
    else if (n0 < 2048) { dst = ws.GA; ld = 1024; c = n0 - 1024; }
    else if (n0 < 2560) { dst = ws.Q; ld = 512; c = n0 - 2048; }
    else if (n0 < 3072) { dst = ws.K; ld = 512; c = n0 - 2560; }
    else if (n0 < 4096) { dst = ws.V; ld = 1024; c = n0 - 3072; }
    else if (n0 < 5120) { dst = ws.GB; ld = 1024; c = n0 - 4096; }
    else { dst = ws.AD; ld = 16; c = 0; }
    const bool isad = n0 >= 5120;
#pragma unroll
    for (int ni = 0; ni < 4; ++ni) {
      if (isad && (wm != 0 || ni != 0)) continue;
#pragma unroll
      for (int ti = 0; ti < 4; ++ti) {
        const f32x4 v = acc[ni][ti] * rs[ti];
        u32x2 pk; pk.x = cvt_pk_bf16(v[0], v[1]); pk.y = cvt_pk_bf16(v[2], v[3]);
        *(u32x2*)(dst + (size_t)(tokw + ti * 16) * ld + c + wm * 64 + ni * 16 + 4 * lq) = pk;
      }
    }
  } else if (EPI == EPI_O1) {
    if (n0 < 1792) {
      bf16_t* dst; int ld, c;
      if (n0 < 512) { dst = ws.CQ; ld = 512; c = n0; }
      else if (n0 < 768) { dst = ws.CKV; ld = 256; c = n0 - 512; }
      else { dst = ws.GATE; ld = 1024; c = n0 - 768; }
#pragma unroll
      for (int ni = 0; ni < 4; ++ni)
#pragma unroll
        for (int ti = 0; ti < 4; ++ti) {
          const f32x4 v = acc[ni][ti] * rs[ti];
          u32x2 pk; pk.x = cvt_pk_bf16(v[0], v[1]); pk.y = cvt_pk_bf16(v[2], v[3]);
          *(u32x2*)(dst + (size_t)(tokw + ti * 16) * ld + c + wm * 64 + ni * 16 + 4 * lq) = pk;
        }
    } else if (wm == 0) {
#pragma unroll
      for (int ti = 0; ti < 4; ++ti) {
        const int tok = tokw + ti * 16;
        const f32x4 x1 = acc[0][ti] * rs[ti], x2 = acc[1][ti] * rs[ti];
        float o1[4], o2[4];
#pragma unroll
        for (int jj = 0; jj < 4; ++jj) {
          const float2 cs = ws.ROPE[(size_t)tok * 16 + 4 * lq + jj];
          o1[jj] = x1[jj] * cs.x - x2[jj] * cs.y;
          o2[jj] = x2[jj] * cs.x + x1[jj] * cs.y;
        }
        u32x2 pk; pk.x = cvt_pk_bf16(o1[0], o1[1]); pk.y = cvt_pk_bf16(o1[2], o1[3]);
        *(u32x2*)(ws.KR + (size_t)tok * 32 + 4 * lq) = pk;
        pk.x = cvt_pk_bf16(o2[0], o2[1]); pk.y = cvt_pk_bf16(o2[2], o2[3]);
        *(u32x2*)(ws.KR + (size_t)tok * 32 + 16 + 4 * lq) = pk;
      }
    }
  } else if (EPI == EPI_Q) {
#pragma unroll
    for (int ni = 0; ni < 4; ++ni)
#pragma unroll
      for (int ti = 0; ti < 4; ++ti) {
        const f32x4 v = acc[ni][ti] * rs[ti];
        u32x2 pk; pk.x = cvt_pk_bf16(v[0], v[1]); pk.y = cvt_pk_bf16(v[2], v[3]);
        *(u32x2*)(ws.QB + (size_t)(tokw + ti * 16) * 1536 + nw + ni * 16 + 4 * lq) = pk;
      }
  } else if (EPI == EPI_KV) {
    const int hd = nw >> 7;
    const bool isv = (nw & 127) >= 64;
    if (!isv) {
#pragma unroll
      for (int ni = 0; ni < 4; ++ni)
#pragma unroll
        for (int ti = 0; ti < 4; ++ti) {
          const f32x4 v = acc[ni][ti] * rs[ti];
          u32x2 pk; pk.x = cvt_pk_bf16(v[0], v[1]); pk.y = cvt_pk_bf16(v[2], v[3]);
          *(u32x2*)(ws.KN + (size_t)(tokw + ti * 16) * 1024 + hd * 64 + ni * 16 + 4 * lq) = pk;
        }
    } else {
#pragma unroll
      for (int ti = 0; ti < 4; ++ti) {
        const int tok = tokw + ti * 16;
        const int b = tok / T_, t = tok - b * T_;
        bf16_t* vb = ws.VT + ((size_t)(b * 16 + hd) * 64) * TP_ + t;
#pragma unroll
        for (int ni = 0; ni < 4; ++ni) {
          const f32x4 v = acc[ni][ti] * rs[ti];
#pragma unroll
          for (int jj = 0; jj < 4; ++jj) vb[(size_t)(ni * 16 + 4 * lq + jj) * TP_] = f2bf(v[jj]);
        }
      }
    }
  } else {
#pragma unroll
    for (int ni = 0; ni < 4; ++ni)
#pragma unroll
      for (int ti = 0; ti < 4; ++ti) {
        const size_t off = (size_t)(tokw + ti * 16) * 1024 + nw + ni * 16 + 4 * lq;
        const u32x2 hi = *(const u32x2*)(ws.HHI + off), lo = *(const u32x2*)(ws.HLO + off);
        const float h0 = bflo(hi.x) + bflo(lo.x) + acc[ni][ti][0], h1 = bfhi(hi.x) + bfhi(lo.x) + acc[ni][ti][1];
        const float h2 = bflo(hi.y) + bflo(lo.y) + acc[ni][ti][2], h3 = bfhi(hi.y) + bfhi(lo.y) + acc[ni][ti][3];
        u32x2 nh; nh.x = cvt_pk_bf16(h0, h1); nh.y = cvt_pk_bf16(h2, h3);
        u32x2 nl; nl.x = cvt_pk_bf16(h0 - bflo(nh.x), h1 - bfhi(nh.x)); nl.y = cvt_pk_bf16(h2 - bflo(nh.y), h3 - bfhi(nh.y));
        if (!dry) { *(u32x2*)(ws.HHI + off) = nh; *(u32x2*)(ws.HLO + off) = nl; }
      }
  }
}

__device__ __forceinline__ float sumsq8(bf16x8 v) {
  const u32x4 u = __builtin_bit_cast(u32x4, v);
  float s = 0.f, t;
  t = bflo(u.x); s += t * t; t = bfhi(u.x); s += t * t; t = bflo(u.y); s += t * t; t = bfhi(u.y); s += t * t;
  t = bflo(u.z); s += t * t; t = bfhi(u.z); s += t * t; t = bflo(u.w); s += t * t; t = bfhi(u.w); s += t * t;
  return s;
}
__device__ __forceinline__ void tile_of(int pos, int ntn, int& mt, int& nt) {
  const int full = 128 * ntn;
  if (pos < full) { const int panel = pos / (8 * ntn); const int rem = pos - panel * 8 * ntn; nt = rem >> 3; mt = panel * 8 + (rem & 7); }
  else { mt = 128; nt = pos - full; }
}
template <bool RS, int EPI>
__device__ __forceinline__ void gemm_stream(const WS& ws, const bf16_t* A0, const bf16_t* A1, int lda, int ktsplit, int kstride,
                                            const bf16_t* __restrict__ W, int K, float invK, int ntn, int ntiles, int bid, bool dry) {
  unsigned char* As = smem;
  unsigned char* Bs = smem + 32768;
  const int tid = opaque_tid(), lane = tid & 63, w = tid >> 6, wm = w >> 1, wn = w & 1, lr = lane & 15, lq = lane >> 4;
  const int G = gridDim.x;
  const int nk = K >> 6;
  if (bid < ntiles) {
    const int my_tiles = (ntiles - 1 - bid) / G + 1;
    const int last_id = bid + (my_tiles - 1) * G;
    const int S = my_tiles * nk;
    f32x4 acc[4][4];
#pragma unroll
    for (int a = 0; a < 4; ++a)
#pragma unroll
      for (int b = 0; b < 4; ++b) acc[a][b] = (f32x4){0.f, 0.f, 0.f, 0.f};
    u32x4 ra0[4], rb0[4], ra1[4], rb1[4];
    float ss[4] = {0.f, 0.f, 0.f, 0.f};
    int l_id = bid, l_kt = 0, c_id = bid, c_kt = 0, st_kt = 0;
    float* rsl = (float*)(smem + 65536);
    const int srow = tid >> 3;
    const int soff = srow * 128 + (((tid & 7) ^ (srow & 7)) << 4);

    auto issue = [&](u32x4 (&ra)[4], u32x4 (&rb)[4]) {
      const int idc = l_id < last_id ? l_id : last_id;
      int mt, nt; tile_of(idc, ntn, mt, nt);
      const bf16_t* A = (l_kt < ktsplit) ? A0 : A1;
      const int kk = (l_kt < ktsplit) ? l_kt : l_kt - ktsplit;
      const bf16_t* ap = A + (size_t)(mt * 128 + srow) * lda + kk * kstride + (tid & 7) * 8;
      const bf16_t* wp = W + (size_t)(nt * 128 + srow) * K + l_kt * 64 + (tid & 7) * 8;
#pragma unroll
      for (int i = 0; i < 4; ++i) {
        ra[i] = *(const u32x4*)(ap + (size_t)i * 32 * lda);
        rb[i] = *(const u32x4*)(wp + (size_t)i * 32 * K);
      }
      if (++l_kt == nk) { l_kt = 0; l_id += G; }
    };
    auto store = [&](const u32x4 (&ra)[4], const u32x4 (&rb)[4], int buf) {
#pragma unroll
      for (int i = 0; i < 4; ++i) {
        if (RS) ss[i] += sumsq8(__builtin_bit_cast(bf16x8, ra[i]));
        *(u32x4*)(As + buf * 16384 + i * 4096 + soff) = ra[i];
        *(u32x4*)(Bs + buf * 16384 + i * 4096 + soff) = rb[i];
      }
      if (RS) {
        if (++st_kt == nk) {
          st_kt = 0;
#pragma unroll
          for (int i = 0; i < 4; ++i) {
            float t = ss[i];
            t += __shfl_xor(t, 1); t += __shfl_xor(t, 2); t += __shfl_xor(t, 4);
            if ((tid & 7) == 0) rsl[srow + 32 * i] = rsqrtf(t * invK + EPS_);
            ss[i] = 0.f;
          }
        }
      }
    };
    auto compute = [&](int buf) {
      const unsigned char* Ab = As + buf * 16384 + (wn * 64 + lr) * 128;
      const unsigned char* Bb = Bs + buf * 16384 + (wm * 64 + lr) * 128;
#pragma unroll
      for (int ks = 0; ks < 2; ++ks) {
        const int sw = ((ks * 4 + lq) ^ (lr & 7)) << 4;
        bf16x8 wf[4], xf[4];
#pragma unroll
        for (int i = 0; i < 4; ++i) {
          wf[i] = *(const bf16x8*)(Bb + i * 2048 + sw);
          xf[i] = *(const bf16x8*)(Ab + i * 2048 + sw);
        }
#pragma unroll
        for (int ni = 0; ni < 4; ++ni)
#pragma unroll
          for (int ti = 0; ti < 4; ++ti) acc[ni][ti] = MFMA16(wf[ni], xf[ti], acc[ni][ti]);
      }
    };
    auto tile_end = [&]() {
      float rs[4] = {1.f, 1.f, 1.f, 1.f};
      if (RS) {
#pragma unroll
        for (int ti = 0; ti < 4; ++ti) rs[ti] = rsl[wn * 64 + ti * 16 + lr];
      }
      int mt, nt; tile_of(c_id, ntn, mt, nt);
      gemm_epilogue<EPI>(ws, acc, rs, mt * 128, nt * 128, wm, wn, lr, lq, dry);
#pragma unroll
      for (int a = 0; a < 4; ++a)
#pragma unroll
        for (int b = 0; b < 4; ++b) acc[a][b] = (f32x4){0.f, 0.f, 0.f, 0.f};
      c_id += G;
    };

    issue(ra0, rb0);
    issue(ra1, rb1);
    store(ra0, rb0, 0);
    __syncthreads();
#pragma unroll 1
    for (int s = 0; s < S; s += 2) {
      issue(ra0, rb0);
      compute(0);
      store(ra1, rb1, 1);
      __syncthreads();
      issue(ra1, rb1);
      compute(1);
      c_kt += 2;
      if (c_kt == nk) { c_kt = 0; tile_end(); }
      store(ra0, rb0, 0);
      __syncthreads();
    }
  }
  __syncthreads();
}

template <bool RS, int EPI>
__device__ __forceinline__ void gemm_glds(const WS& ws, const bf16_t* A0, const bf16_t* A1, int lda, int ktsplit, int kstride,
                                          const bf16_t* __restrict__ W, int K, float invK, int ntn, int ntiles, int bid, bool dry) {
  unsigned char* As = smem;
  unsigned char* Bs = smem + 32768;
  const int tid = opaque_tid(), lane = tid & 63, w = tid >> 6, wm = w >> 1, wn = w & 1, lr = lane & 15, lq = lane >> 4;
  const int G = gridDim.x;
  const int nk = K >> 6;
  if (bid < ntiles) {
    const int my_tiles = (ntiles - 1 - bid) / G + 1;
    const int S = my_tiles * nk;
    f32x4 acc[4][4];
#pragma unroll
    for (int a = 0; a < 4; ++a)
#pragma unroll
      for (int b = 0; b < 4; ++b) acc[a][b] = (f32x4){0.f, 0.f, 0.f, 0.f};
    float ss[4] = {0.f, 0.f, 0.f, 0.f};
    int l_id = bid, l_kt = 0, c_id = bid, c_kt = 0;
    const int lrow = lane >> 3;
    const int lc = (lane & 7) ^ lrow;
    auto issue = [&](int buf) {
      int mt, nt; tile_of(l_id, ntn, mt, nt);
      const bf16_t* A = (l_kt < ktsplit) ? A0 : A1;
      const int kk = (l_kt < ktsplit) ? l_kt : l_kt - ktsplit;
      const bf16_t* ap = A + (size_t)(mt * 128 + w * 32 + lrow) * lda + kk * kstride + lc * 8;
      const bf16_t* wp = W + (size_t)(nt * 128 + w * 32 + lrow) * K + l_kt * 64 + lc * 8;
      unsigned char* la = As + buf * 16384 + w * 4096 + lane * 16;
      unsigned char* lb = Bs + buf * 16384 + w * 4096 + lane * 16;
#pragma unroll
      for (int i = 0; i < 4; ++i) {
        __builtin_amdgcn_global_load_lds((const unsigned*)(ap + (size_t)i * 8 * lda), (unsigned*)(la + i * 1024), 16, 0, 0);
        __builtin_amdgcn_global_load_lds((const unsigned*)(wp + (size_t)i * 8 * K), (unsigned*)(lb + i * 1024), 16, 0, 0);
      }
      if (++l_kt == nk) { l_kt = 0; l_id += G; }
    };
    auto compute = [&](int buf) {
      const unsigned char* Ab = As + buf * 16384 + (wn * 64 + lr) * 128;
      const unsigned char* Bb = Bs + buf * 16384 + (wm * 64 + lr) * 128;
#pragma unroll
      for (int ks = 0; ks < 2; ++ks) {
        const int sw = ((ks * 4 + lq) ^ (lr & 7)) << 4;
        bf16x8 wf[4], xf[4];
#pragma unroll
        for (int i = 0; i < 4; ++i) {
          wf[i] = *(const bf16x8*)(Bb + i * 2048 + sw);
          xf[i] = *(const bf16x8*)(Ab + i * 2048 + sw);
        }
        if (RS) {
#pragma unroll
          for (int i = 0; i < 4; ++i) ss[i] += sumsq8(xf[i]);
        }
#pragma unroll
        for (int ni = 0; ni < 4; ++ni)
#pragma unroll
          for (int ti = 0; ti < 4; ++ti) acc[ni][ti] = MFMA16(wf[ni], xf[ti], acc[ni][ti]);
      }
    };
    auto tile_end = [&]() {
      float rs[4] = {1.f, 1.f, 1.f, 1.f};
      if (RS) {
#pragma unroll
        for (int ti = 0; ti < 4; ++ti) {
          float t = ss[ti];
          t += __shfl_xor(t, 16); t += __shfl_xor(t, 32);
          rs[ti] = rsqrtf(t * invK + EPS_);
          ss[ti] = 0.f;
        }
      }
      int mt, nt; tile_of(c_id, ntn, mt, nt);
      gemm_epilogue<EPI>(ws, acc, rs, mt * 128, nt * 128, wm, wn, lr, lq, dry);
#pragma unroll
      for (int a = 0; a < 4; ++a)
#pragma unroll
        for (int b = 0; b < 4; ++b) acc[a][b] = (f32x4){0.f, 0.f, 0.f, 0.f};
      c_id += G;
    };
    issue(0);
#pragma unroll 1
    for (int s = 0; s < S; ++s) {
      asm volatile("s_waitcnt vmcnt(0)" ::: "memory");
      __builtin_amdgcn_s_barrier();
      asm volatile("" ::: "memory");
      if (s + 1 < S) issue((s + 1) & 1);
      compute(s & 1);
      if (++c_kt == nk) { c_kt = 0; tile_end(); }
    }
  }
  __syncthreads();
}

__device__ __forceinline__ void gla_decay_unit(const Params& p, const WS& ws, int j, int u) {
  const int c = u % 33; const int bh = u / 33; const int hd = bh & 3, b = bh >> 2;
  bf16_t* Qs = (bf16_t*)smem;
  bf16_t* Ks = Qs + 64 * 136;
  float* ADs = (float*)(smem + 2 * 64 * 136 * 2);
  float* HT = ADs + 64 * 16;
  const int tid = opaque_tid();
  const int tbase = 64 * c - 48;
#pragma unroll
  for (int i = 0; i < 4; ++i) {
    const int ci = tid + 256 * i; const int row = ci >> 4, ch = ci & 15; const int t = tbase + row;
    u32x4 qv = (u32x4){0, 0, 0, 0}, kv = (u32x4){0, 0, 0, 0};
    if (t >= 0) {
      qv = *(const u32x4*)(ws.Q + (size_t)(b * T_ + t) * 512 + hd * 128 + ch * 8);
      kv = *(const u32x4*)(ws.K + (size_t)(b * T_ + t) * 512 + hd * 128 + ch * 8);
    }
    *(u32x4*)(Qs + row * 136 + ch * 8) = qv;
    *(u32x4*)(Ks + row * 136 + ch * 8) = kv;
    const int t2 = tbase + (ci >> 4);
    ADs[ci] = t2 >= 0 ? bf2f(ws.AD[(size_t)(b * T_ + t2) * 16 + (ci & 15)]) : 0.f;
  }
  const int d = tid & 127, half = tid >> 7;
  float aw[16];
#pragma unroll
  for (int r = 0; r < 16; ++r) aw[r] = p.ab_alpha_w[(size_t)(j * 16 + r) * 512 + hd * 128 + d];
  const float abias = p.ab_alpha_b[j * 512 + hd * 128 + d];
  __syncthreads();
  float cs[32];
  float run = 0.f;
#pragma unroll
  for (int ii = 0; ii < 32; ++ii) {
    const int row = half * 32 + ii;
    float xv = abias;
#pragma unroll
    for (int r4 = 0; r4 < 4; ++r4) {
      const float4 a4 = *(const float4*)(ADs + row * 16 + r4 * 4);
      xv += a4.x * aw[r4 * 4] + a4.y * aw[r4 * 4 + 1] + a4.z * aw[r4 * 4 + 2] + a4.w * aw[r4 * 4 + 3];
    }
    float la = (fminf(xv, 0.f) - __logf(1.f + __expf(-fabsf(xv)))) * 0.0625f;
    if (tbase + row < 0) la = 0.f;
    run += la;
    cs[ii] = run;
  }
  HT[half * 128 + d] = run;
  __syncthreads();
  const float off = half ? HT[d] : 0.f;
  const float blast = HT[d] + HT[128 + d];
#pragma unroll
  for (int ii = 0; ii < 32; ++ii) {
    const int row = half * 32 + ii;
    const float bb = cs[ii] + off;
    const float eb = __expf(bb), ebi = __expf(-bb);
    Qs[row * 136 + d] = f2bf(bf2f(Qs[row * 136 + d]) * eb);
    Ks[row * 136 + d] = f2bf(bf2f(Ks[row * 136 + d]) * ebi);
  }
  if (half == 0) ws.BL[(size_t)((b * 4 + hd) * 33 + c) * 128 + d] = __expf(blast);
  __syncthreads();
#pragma unroll
  for (int i = 0; i < 4; ++i) {
    const int ci = tid + 256 * i; const int row = ci >> 4, ch = ci & 15; const int t = tbase + row;
    if (t >= 0) {
      *(u32x4*)(ws.Q + (size_t)(b * T_ + t) * 512 + hd * 128 + ch * 8) = *(const u32x4*)(Qs + row * 136 + ch * 8);
      *(u32x4*)(ws.K + (size_t)(b * T_ + t) * 512 + hd * 128 + ch * 8) = *(const u32x4*)(Ks + row * 136 + ch * 8);
    }
  }
  __syncthreads();
}

__device__ __forceinline__ void gla_unit(const Params& p, const WS& ws, int u, bool dry = false) {
  const int sl = u & 7; const int bh = u >> 3; const int hd = bh & 3, b = bh >> 2;
  bf16_t* QDs = (bf16_t*)smem;
  bf16_t* KIs = QDs + 64 * 136;
  bf16_t* KIT = KIs + 64 * 136;
  bf16_t* VTs = KIT + 128 * 72;
  bf16_t* STs = VTs + 32 * 72;
  bf16_t* Ps = STs + 32 * 136;
  const int tid = opaque_tid(), lane = tid & 63, w = tid >> 6, lr = lane & 15, lq = lane >> 4;
  for (int i = tid; i < 32 * 136 / 2; i += 256) ((unsigned*)STs)[i] = 0u;
  f32x4 sacc[2][2];
#pragma unroll
  for (int a = 0; a < 2; ++a)
#pragma unroll
    for (int bb = 0; bb < 2; ++bb) sacc[a][bb] = (f32x4){0.f, 0.f, 0.f, 0.f};
  u32x4 qr[4], kr[4], vr;
  float ebl[2];
  const float* BLp = ws.BL + (size_t)((b * 4 + hd) * 33) * 128;
  auto prefetch = [&](int c) {
    const int tbase = 64 * c - 48;
#pragma unroll
    for (int i = 0; i < 4; ++i) {
      const int ci = tid + 256 * i; const int row = ci >> 4, ch = ci & 15; const int t = tbase + row;
      qr[i] = (u32x4){0, 0, 0, 0}; kr[i] = (u32x4){0, 0, 0, 0};
      if (t >= 0) {
        qr[i] = *(const u32x4*)(ws.Q + (size_t)(b * T_ + t) * 512 + hd * 128 + ch * 8);
        kr[i] = *(const u32x4*)(ws.K + (size_t)(b * T_ + t) * 512 + hd * 128 + ch * 8);
      }
    }
    {
      const int row = tid >> 2, ch = tid & 3; const int t = tbase + row;
      vr = (u32x4){0, 0, 0, 0};
      if (t >= 0) vr = *(const u32x4*)(ws.V + (size_t)(b * T_ + t) * 1024 + hd * 256 + sl * 32 + ch * 8);
    }
    ebl[0] = BLp[c * 128 + 16 * (2 * w) + lr];
    ebl[1] = BLp[c * 128 + 16 * (2 * w + 1) + lr];
  };
  prefetch(0);
#pragma unroll 1
  for (int c = 0; c < 33; ++c) {
#pragma unroll
    for (int i = 0; i < 4; ++i) {
      const int ci = tid + 256 * i; const int row = ci >> 4, ch = ci & 15;
      *(u32x4*)(QDs + row * 136 + ch * 8) = qr[i];
      *(u32x4*)(KIs + row * 136 + ch * 8) = kr[i];
      const unsigned kk[4] = {kr[i].x, kr[i].y, kr[i].z, kr[i].w};
#pragma unroll
      for (int e = 0; e < 4; ++e) {
        KIT[(ch * 8 + 2 * e) * 72 + (row ^ ((ch & 7) << 3))] = (bf16_t)(kk[e] & 0xffffu);
        KIT[(ch * 8 + 2 * e + 1) * 72 + (row ^ ((ch & 7) << 3))] = (bf16_t)(kk[e] >> 16);
      }
    }
    {
      const int row = tid >> 2, ch = tid & 3;
      const unsigned vv[4] = {vr.x, vr.y, vr.z, vr.w};
#pragma unroll
      for (int e = 0; e < 4; ++e) {
        VTs[(ch * 8 + 2 * e) * 72 + (row ^ (ch << 3))] = (bf16_t)(vv[e] & 0xffffu);
        VTs[(ch * 8 + 2 * e + 1) * 72 + (row ^ (ch << 3))] = (bf16_t)(vv[e] >> 16);
      }
    }
    const float eb0 = ebl[0], eb1 = ebl[1];
    __syncthreads();
    if (c + 1 < 33) prefetch(c + 1);
    bf16x8 xq[4];
#pragma unroll
    for (int ks = 0; ks < 4; ++ks) xq[ks] = *(const bf16x8*)(QDs + (16 * w + lr) * 136 + 32 * ks + 8 * lq);
    const int irow = 16 * w + lr;
#pragma unroll
    for (int mt = 0; mt < 4; ++mt) {
      u32x2 pk = (u32x2){0u, 0u};
      if (mt <= w) {
        f32x4 a = (f32x4){0.f, 0.f, 0.f, 0.f};
#pragma unroll
        for (int ks = 0; ks < 4; ++ks) {
          const bf16x8 kf = *(const bf16x8*)(KIs + (16 * mt + lr) * 136 + 32 * ks + 8 * lq);
          a = MFMA16(kf, xq[ks], a);
        }
        const int ip = 16 * mt + 4 * lq;
        const float v0 = (ip + 0 <= irow) ? a[0] : 0.f, v1 = (ip + 1 <= irow) ? a[1] : 0.f;
        const float v2 = (ip + 2 <= irow) ? a[2] : 0.f, v3 = (ip + 3 <= irow) ? a[3] : 0.f;
        pk.x = cvt_pk_bf16(v0, v1); pk.y = cvt_pk_bf16(v2, v3);
      }
      *(u32x2*)(Ps + irow * 72 + 16 * mt + 4 * lq) = pk;
    }
    __syncthreads();
    f32x4 oacc[2];
    oacc[0] = (f32x4){0.f, 0.f, 0.f, 0.f}; oacc[1] = (f32x4){0.f, 0.f, 0.f, 0.f};
#pragma unroll
    for (int ks = 0; ks < 2; ++ks) {
      if (2 * ks <= w) {
        const bf16x8 pb = *(const bf16x8*)(Ps + irow * 72 + 32 * ks + 8 * lq);
#pragma unroll
        for (int mt = 0; mt < 2; ++mt) {
          const bf16x8 vf = *(const bf16x8*)(VTs + (16 * mt + lr) * 72 + (((4 * ks + lq) ^ (((16 * mt + lr) >> 3) & 3)) << 3));
          oacc[mt] = MFMA16(vf, pb, oacc[mt]);
        }
      }
    }
#pragma unroll
    for (int ks = 0; ks < 4; ++ks)
#pragma unroll
      for (int mt = 0; mt < 2; ++mt) {
        const bf16x8 sf = *(const bf16x8*)(STs + (16 * mt + lr) * 136 + 32 * ks + 8 * lq);
        oacc[mt] = MFMA16(sf, xq[ks], oacc[mt]);
      }
    {
      const int t = 64 * c - 48 + irow;
      float sq = 0.f;
#pragma unroll
      for (int mt = 0; mt < 2; ++mt) sq += oacc[mt][0] * oacc[mt][0] + oacc[mt][1] * oacc[mt][1] + oacc[mt][2] * oacc[mt][2] + oacc[mt][3] * oacc[mt][3];
      sq += __shfl_xor(sq, 16); sq += __shfl_xor(sq, 32);
      if (t >= 0 && !dry) {
        const size_t row = (size_t)(b * T_ + t);
#pragma unroll
        for (int mt = 0; mt < 2; ++mt) {
          u32x2 pk; pk.x = cvt_pk_bf16(oacc[mt][0], oacc[mt][1]); pk.y = cvt_pk_bf16(oacc[mt][2], oacc[mt][3]);
          *(u32x2*)(ws.V + row * 1024 + hd * 256 + sl * 32 + 16 * mt + 4 * lq) = pk;
        }
        if (lq == 0) ws.SSQ[row * 32 + hd * 8 + sl] = sq;
      }
    }
    __syncthreads();
#pragma unroll
    for (int ntl = 0; ntl < 2; ++ntl) {
#pragma unroll
      for (int ks = 0; ks < 2; ++ks) {
        const bf16x8 kf = *(const bf16x8*)(KIT + (16 * (2 * w + ntl) + lr) * 72 + (((4 * ks + lq) ^ (((16 * (2 * w + ntl) + lr) >> 3) & 7)) << 3));
#pragma unroll
        for (int mt = 0; mt < 2; ++mt) {
          const bf16x8 vf = *(const bf16x8*)(VTs + (16 * mt + lr) * 72 + (((4 * ks + lq) ^ (((16 * mt + lr) >> 3) & 3)) << 3));
          sacc[mt][ntl] = MFMA16(vf, kf, sacc[mt][ntl]);
        }
      }
      const float e = ntl ? eb1 : eb0;
#pragma unroll
      for (int mt = 0; mt < 2; ++mt) {
        sacc[mt][ntl] = sacc[mt][ntl] * e;
#pragma unroll
        for (int jj = 0; jj < 4; ++jj) STs[(16 * mt + 4 * lq + jj) * 136 + 16 * (2 * w + ntl) + lr] = f2bf(sacc[mt][ntl][jj]);
      }
    }
    __syncthreads();
  }
}

__device__ __forceinline__ void rglru_unit(const Params& p, const WS& ws, int j, int u, bool dry = false) {
  const int jq = u & 3, g = (u >> 2) & 7, b = u >> 5;
  bf16_t* XC = (bf16_t*)smem;
  bf16_t* WG = XC + 64 * 136;
  float* AUa = (float*)(smem + 34816);
  float* AUu = AUa + 64 * 33;
  float* SEGA = AUu + 64 * 33;
  float* SEGH = SEGA + 256;
  float* CARRY = SEGH + 256;
  const int tid = opaque_tid(), lane = tid & 63, w = tid >> 6, lr = lane & 15, lq = lane >> 4;
#pragma unroll 4
  for (int i = 0; i < 32; ++i) {
    const int e = tid + 256 * i;
    const int gate = e >> 12, k = (e >> 5) & 127, n = e & 31;
    const float* gw = gate ? p.ab_gate_x_w : p.ab_gate_a_w;
    WG[(gate * 32 + n) * 136 + k] = f2bf(gw[((size_t)(j * 8 + g) * 128 + k) * 128 + 32 * jq + n]);
  }
  if (tid < 32) CARRY[tid] = 0.f;
  const int cc = tid & 15, rb = 4 * (tid >> 4);
  float cw[4][8], cb[8];
#pragma unroll
  for (int e = 0; e < 8; ++e) {
    cb[e] = p.ab_conv_b[j * 1024 + 128 * g + 8 * cc + e];
#pragma unroll
    for (int k = 0; k < 4; ++k) cw[k][e] = p.ab_conv_w[(size_t)(j * 4 + k) * 1024 + 128 * g + 8 * cc + e];
  }
  float ba[2][4], bx[2][4], sp[2][4];
#pragma unroll
  for (int mt = 0; mt < 2; ++mt)
#pragma unroll
    for (int jj = 0; jj < 4; ++jj) {
      const int ch = j * 1024 + 128 * g + 32 * jq + 16 * mt + 4 * lq + jj;
      ba[mt][jj] = p.ab_gate_a_b[ch]; bx[mt][jj] = p.ab_gate_x_b[ch];
      sp[mt][jj] = 8.f * log1pf(__expf(-p.ab_lam[ch]));
    }
  const int sc = tid & 31, ssg = tid >> 5;
  u32x4 xin[7];
  bf16_t gav[8];
  auto prefetch = [&](int tile) {
    const int t0 = 64 * tile;
#pragma unroll
    for (int m = 0; m < 7; ++m) {
      const int tt = t0 + rb - 3 + m;
      xin[m] = (u32x4){0, 0, 0, 0};
      if (tt >= 0 && tt < T_) xin[m] = *(const u32x4*)(ws.XA + (size_t)(b * T_ + tt) * 1024 + 128 * g + 8 * cc);
    }
#pragma unroll
    for (int i = 0; i < 8; ++i) {
      const int t = t0 + 8 * ssg + i;
      gav[i] = 0;
      if (t < T_) gav[i] = ws.GA[(size_t)(b * T_ + t) * 1024 + 128 * g + 32 * jq + sc];
    }
  };
  prefetch(0);
  __syncthreads();
#pragma unroll 1
  for (int tile = 0; tile < 33; ++tile) {
    const int t0 = 64 * tile;
#pragma unroll
    for (int r = 0; r < 4; ++r) {
      float y[8];
#pragma unroll
      for (int e = 0; e < 8; ++e) y[e] = cb[e];
#pragma unroll
      for (int k = 0; k < 4; ++k) {
        const u32x4 xv = xin[r + k];
        y[0] += cw[k][0] * bflo(xv.x); y[1] += cw[k][1] * bfhi(xv.x);
        y[2] += cw[k][2] * bflo(xv.y); y[3] += cw[k][3] * bfhi(xv.y);
        y[4] += cw[k][4] * bflo(xv.z); y[5] += cw[k][5] * bfhi(xv.z);
        y[6] += cw[k][6] * bflo(xv.w); y[7] += cw[k][7] * bfhi(xv.w);
      }
      u32x4 pk; pk.x = cvt_pk_bf16(y[0], y[1]); pk.y = cvt_pk_bf16(y[2], y[3]); pk.z = cvt_pk_bf16(y[4], y[5]); pk.w = cvt_pk_bf16(y[6], y[7]);
      *(u32x4*)(XC + (rb + r) * 136 + 8 * cc) = pk;
    }
    float gcur[8];
#pragma unroll
    for (int i = 0; i < 8; ++i) gcur[i] = bf2f(gav[i]);
    __syncthreads();
    if (tile + 1 < 33) prefetch(tile + 1);
    {
      f32x4 ga_[2][2];
#pragma unroll
      for (int a = 0; a < 2; ++a)
#pragma unroll
        for (int bb = 0; bb < 2; ++bb) ga_[a][bb] = (f32x4){0.f, 0.f, 0.f, 0.f};
#pragma unroll
      for (int ks = 0; ks < 4; ++ks) {
        const bf16x8 xf = *(const bf16x8*)(XC + (16 * w + lr) * 136 + 32 * ks + 8 * lq);
#pragma unroll
        for (int gate = 0; gate < 2; ++gate)
#pragma unroll
          for (int mt = 0; mt < 2; ++mt) {
            const bf16x8 wf = *(const bf16x8*)(WG + (gate * 32 + 16 * mt + lr) * 136 + 32 * ks + 8 * lq);
            ga_[gate][mt] = MFMA16(wf, xf, ga_[gate][mt]);
          }
      }
      const int tok = 16 * w + lr;
#pragma unroll
      for (int mt = 0; mt < 2; ++mt)
#pragma unroll
        for (int jj = 0; jj < 4; ++jj) {
          const int n = 16 * mt + 4 * lq + jj;
          const float xcv = bf2f(XC[tok * 136 + 32 * jq + n]);
          const float r = sigmoidf_(ga_[0][mt][jj] + ba[mt][jj]);
          const float ig = sigmoidf_(ga_[1][mt][jj] + bx[mt][jj]);
          const float la = -r * sp[mt][jj];
          const float a = __expf(la);
          const float mult = sqrtf(fmaxf(-expm1f(2.f * la), 0.f));
          AUa[tok * 33 + n] = a;
          AUu[tok * 33 + n] = mult * ig * xcv;
        }
    }
    __syncthreads();
    {
      float A = 1.f, Hh = 0.f;
#pragma unroll
      for (int i = 0; i < 8; ++i) {
        const float a = AUa[(8 * ssg + i) * 33 + sc], uu = AUu[(8 * ssg + i) * 33 + sc];
        Hh = a * Hh + uu; A *= a;
      }
      SEGA[ssg * 32 + sc] = A; SEGH[ssg * 32 + sc] = Hh;
    }
    __syncthreads();
    float hin = CARRY[sc];
#pragma unroll
    for (int s2 = 0; s2 < 7; ++s2)
      if (s2 < ssg) hin = SEGA[s2 * 32 + sc] * hin + SEGH[s2 * 32 + sc];
    __syncthreads();
    {
      float h = hin;
#pragma unroll
      for (int i = 0; i < 8; ++i) {
        const float a = AUa[(8 * ssg + i) * 33 + sc], uu = AUu[(8 * ssg + i) * 33 + sc];
        h = a * h + uu;
        const int t = t0 + 8 * ssg + i;
        if (t < T_ && !dry) ws.GA[(size_t)(b * T_ + t) * 1024 + 128 * g + 32 * jq + sc] = f2bf(h * siluf_(gcur[i]));
      }
      if (ssg == 7) CARRY[sc] = h;
    }
  }
  __syncthreads();
}

__device__ __forceinline__ void phase_gla_norm(const Params& p, const WS& ws, int j) {
  const size_t gtid = (size_t)opaque_bid() * 256 + opaque_tid(), gsz = (size_t)gridDim.x * 256;
  const float* gn = p.ab_gla_norm + j * 256;
  for (size_t idx = gtid; idx < (size_t)M_ * 128; idx += gsz) {
    const size_t row = idx >> 7; const int c8 = (int)(idx & 127); const int hd = c8 >> 5; const int dv = (c8 & 31) * 8;
    const float4 s0 = *(const float4*)(ws.SSQ + row * 32 + hd * 8), s1 = *(const float4*)(ws.SSQ + row * 32 + hd * 8 + 4);
    const float ssum = (s0.x + s0.y + s0.z + s0.w) + (s1.x + s1.y + s1.z + s1.w);
    const float rstd = rsqrtf(ssum * (1.f / 256.f) + EPS_);
    const u32x4 ov = *(const u32x4*)(ws.V + row * 1024 + c8 * 8);
    const u32x4 gv = *(const u32x4*)(ws.GB + row * 1024 + c8 * 8);
    const float4 g0 = *(const float4*)(gn + dv), g1 = *(const float4*)(gn + dv + 4);
    float o[8] = {bflo(ov.x), bfhi(ov.x), bflo(ov.y), bfhi(ov.y), bflo(ov.z), bfhi(ov.z), bflo(ov.w), bfhi(ov.w)};
    const float gg[8] = {bflo(gv.x), bfhi(gv.x), bflo(gv.y), bfhi(gv.y), bflo(gv.z), bfhi(gv.z), bflo(gv.w), bfhi(gv.w)};
    const float nn[8] = {g0.x, g0.y, g0.z, g0.w, g1.x, g1.y, g1.z, g1.w};
#pragma unroll
    for (int e = 0; e < 8; ++e) o[e] = o[e] * rstd * nn[e] * siluf_(gg[e]);
    u32x4 pk; pk.x = cvt_pk_bf16(o[0], o[1]); pk.y = cvt_pk_bf16(o[2], o[3]); pk.z = cvt_pk_bf16(o[4], o[5]); pk.w = cvt_pk_bf16(o[6], o[7]);
    *(u32x4*)(ws.V + row * 1024 + c8 * 8) = pk;
  }
}

__device__ __forceinline__ void attn_unit(const WS& ws, int u, bool dry = false) {
  const int qb = 16 - (u >> 7); const int bh = u & 127; const int hd = bh & 15, b = bh >> 4;
  bf16_t* Kt = (bf16_t*)smem;
  bf16_t* Vl = Kt + 2 * 64 * 104;
  const int tid = opaque_tid(), lane = tid & 63, w = tid >> 6, lr = lane & 15, lq = lane >> 4;
  const int q0 = 128 * qb;
  int nkt = 2 * qb + 2; if (nkt > 33) nkt = 33;
  bf16x8 xq[2][3];
  int qi[2];
#pragma unroll
  for (int nt = 0; nt < 2; ++nt) {
    qi[nt] = q0 + 32 * w + 16 * nt + lr;
    const int qc = qi[nt] < T_ ? qi[nt] : T_ - 1;
#pragma unroll
    for (int ks = 0; ks < 2; ++ks)
      xq[nt][ks] = *(const bf16x8*)(ws.QB + (size_t)(b * T_ + qc) * 1536 + hd * 96 + 32 * ks + 8 * lq);
    {
      const u32x4 raw = *(const u32x4*)(ws.QB + (size_t)(b * T_ + qc) * 1536 + hd * 96 + 64 + 8 * lq);
      u32x4 oth;
      oth.x = __shfl_xor(raw.x, 32); oth.y = __shfl_xor(raw.y, 32); oth.z = __shfl_xor(raw.z, 32); oth.w = __shfl_xor(raw.w, 32);
      const float sgn = lq < 2 ? -1.f : 1.f;
      const float2* rp = ws.ROPE + (size_t)(b * T_ + qc) * 16 + 8 * (lq & 1);
      const unsigned rw[4] = {raw.x, raw.y, raw.z, raw.w}, ow[4] = {oth.x, oth.y, oth.z, oth.w};
      unsigned res[4];
#pragma unroll
      for (int e = 0; e < 4; ++e) {
        const float2 c0 = rp[2 * e], c1 = rp[2 * e + 1];
        const float r0 = bflo(rw[e]) * c0.x + sgn * bflo(ow[e]) * c0.y;
        const float r1 = bfhi(rw[e]) * c1.x + sgn * bfhi(ow[e]) * c1.y;
        res[e] = cvt_pk_bf16(r0, r1);
      }
      xq[nt][2] = as_bf16x8((u32x4){res[0], res[1], res[2], res[3]});
    }
  }
  float mrun[2] = {-INFINITY, -INFINITY}, lsum[2] = {0.f, 0.f};
  f32x4 oacc[4][2];
#pragma unroll
  for (int a = 0; a < 4; ++a)
#pragma unroll
    for (int bb = 0; bb < 2; ++bb) oacc[a][bb] = (f32x4){0.f, 0.f, 0.f, 0.f};
  u32x4 kreg[3], vreg[2];
  const bf16_t* vbase = ws.VT + ((size_t)(b * 16 + hd) * 64) * TP_;
  auto loadg = [&](int kt) {
#pragma unroll
    for (int i = 0; i < 3; ++i) {
      const int ci = tid + 256 * i; const int key = ci / 12, ch = ci - key * 12;
      int gk = 64 * kt + key; if (gk > T_ - 1) gk = T_ - 1;
      const bf16_t* src = ch < 8 ? ws.KN + (size_t)(b * T_ + gk) * 1024 + hd * 64 + ch * 8
                                 : ws.KR + (size_t)(b * T_ + gk) * 32 + (ch - 8) * 8;
      kreg[i] = *(const u32x4*)src;
    }
#pragma unroll
    for (int i = 0; i < 2; ++i) {
      const int ci = tid + 256 * i; const int dv = ci >> 3, ch = ci & 7;
      vreg[i] = *(const u32x4*)(vbase + (size_t)dv * TP_ + 64 * kt + ch * 8);
      if (64 * kt + ch * 8 >= T_) vreg[i] = (u32x4){0u, 0u, 0u, 0u};
    }
  };
  auto stores = [&](int buf) {
#pragma unroll
    for (int i = 0; i < 3; ++i) {
      const int ci = tid + 256 * i; const int key = ci / 12, ch = ci - key * 12;
      *(u32x4*)(Kt + buf * 64 * 104 + key * 104 + ch * 8) = kreg[i];
    }
#pragma unroll
    for (int i = 0; i < 2; ++i) {
      const int ci = tid + 256 * i; const int dv = ci >> 3, ch = ci & 7;
      *(u32x4*)(Vl + buf * 64 * 72 + dv * 72 + ch * 8) = vreg[i];
    }
  };
  loadg(0);
  stores(0);
  __syncthreads();
#pragma unroll 1
  for (int kt = 0; kt < nkt; ++kt) {
    const int buf = kt & 1;
    if (kt + 1 < nkt) loadg(kt + 1);
    const bf16_t* Kb = Kt + buf * 64 * 104;
    const bf16_t* Vb = Vl + buf * 64 * 72;
    f32x4 s[4][2];
#pragma unroll
    for (int mt = 0; mt < 4; ++mt) {
      s[mt][0] = (f32x4){0.f, 0.f, 0.f, 0.f}; s[mt][1] = (f32x4){0.f, 0.f, 0.f, 0.f};
#pragma unroll
      for (int ks = 0; ks < 3; ++ks) {
        const bf16x8 kf = *(const bf16x8*)(Kb + (16 * mt + lr) * 104 + 32 * ks + 8 * lq);
        s[mt][0] = MFMA16(kf, xq[0][ks], s[mt][0]);
        s[mt][1] = MFMA16(kf, xq[1][ks], s[mt][1]);
      }
    }
    if (kt >= 2 * qb) {
#pragma unroll
      for (int mt = 0; mt < 4; ++mt)
#pragma unroll
        for (int nt = 0; nt < 2; ++nt)
#pragma unroll
          for (int jj = 0; jj < 4; ++jj) {
            const int key = 64 * kt + 16 * mt + 4 * lq + jj;
            if (key > qi[nt]) s[mt][nt][jj] = -INFINITY;
          }
    }
    bf16x8 pf[2][2];
#pragma unroll
    for (int nt = 0; nt < 2; ++nt) {
      float mx = -INFINITY;
#pragma unroll
      for (int mt = 0; mt < 4; ++mt) mx = fmaxf(mx, fmaxf(fmaxf(s[mt][nt][0], s[mt][nt][1]), fmaxf(s[mt][nt][2], s[mt][nt][3])));
      mx = fmaxf(mx, __shfl_xor(mx, 16)); mx = fmaxf(mx, __shfl_xor(mx, 32));
      const float mnew = fmaxf(mrun[nt], mx);
      const float alpha = __builtin_amdgcn_exp2f(mrun[nt] - mnew);
      mrun[nt] = mnew;
      float ps = 0.f;
#pragma unroll
      for (int mt = 0; mt < 4; ++mt)
#pragma unroll
        for (int jj = 0; jj < 4; ++jj) { const float pv = __builtin_amdgcn_exp2f(s[mt][nt][jj] - mnew); s[mt][nt][jj] = pv; ps += pv; }
      lsum[nt] = lsum[nt] * alpha + ps;
#pragma unroll
      for (int mt = 0; mt < 4; ++mt) oacc[mt][nt] = oacc[mt][nt] * alpha;
#pragma unroll
      for (int ks = 0; ks < 2; ++ks) {
        u32x4 pk;
        pk.x = cvt_pk_bf16(s[2 * ks][nt][0], s[2 * ks][nt][1]); pk.y = cvt_pk_bf16(s[2 * ks][nt][2], s[2 * ks][nt][3]);
        pk.z = cvt_pk_bf16(s[2 * ks + 1][nt][0], s[2 * ks + 1][nt][1]); pk.w = cvt_pk_bf16(s[2 * ks + 1][nt][2], s[2 * ks + 1][nt][3]);
        pf[nt][ks] = as_bf16x8(pk);
      }
    }
#pragma unroll
    for (int mt = 0; mt < 4; ++mt)
#pragma unroll
      for (int ks = 0; ks < 2; ++ks) {
        const u32x2 lo = *(const u32x2*)(Vb + (16 * mt + lr) * 72 + 32 * ks + 4 * lq);
        const u32x2 hi = *(const u32x2*)(Vb + (16 * mt + lr) * 72 + 32 * ks + 16 + 4 * lq);
        const bf16x8 vf = as_bf16x8((u32x4){lo.x, lo.y, hi.x, hi.y});
        oacc[mt][0] = MFMA16(vf, pf[0][ks], oacc[mt][0]);
        oacc[mt][1] = MFMA16(vf, pf[1][ks], oacc[mt][1]);
      }
    if (kt + 1 < nkt) stores(buf ^ 1);
    __syncthreads();
  }
#pragma unroll
  for (int nt = 0; nt < 2; ++nt) {
    float l = lsum[nt];
    l += __shfl_xor(l, 16); l += __shfl_xor(l, 32);
    const float inv = 1.f / l;
    if (qi[nt] < T_) {
      const size_t row = (size_t)(b * T_ + qi[nt]);
#pragma unroll
      for (int mt = 0; mt < 4; ++mt) {
        const u32x2 gv = *(const u32x2*)(ws.GATE + row * 1024 + hd * 64 + 16 * mt + 4 * lq);
        const float o0 = oacc[mt][nt][0] * inv * siluf_(bflo(gv.x)), o1 = oacc[mt][nt][1] * inv * siluf_(bfhi(gv.x));
        const float o2 = oacc[mt][nt][2] * inv * siluf_(bflo(gv.y)), o3 = oacc[mt][nt][3] * inv * siluf_(bfhi(gv.y));
        u32x2 pk; pk.x = cvt_pk_bf16(o0, o1); pk.y = cvt_pk_bf16(o2, o3);
        if (!dry) *(u32x2*)(ws.QB + row * 1536 + hd * 96 + 16 * mt + 4 * lq) = pk;
      }
    }
  }
}

__device__ __forceinline__ void phase_final(const Params& p, const WS& ws) {
  const int tidf = opaque_tid();
  const int lane = tidf & 63;
  const int gw = opaque_bid() * 4 + (tidf >> 6), nw = gridDim.x * 4;
  for (int r = gw; r < 8 * 2048; r += nw) {
    const int b = r >> 11, s = r & 2047;
    const size_t hoff = (size_t)(b * T_ + 16 + s) * 1024;
    float4 v[4];
    float ssum = 0.f;
#pragma unroll
    for (int i = 0; i < 4; ++i) {
      const u32x2 hi = *(const u32x2*)(ws.HHI + hoff + i * 256 + lane * 4), lo = *(const u32x2*)(ws.HLO + hoff + i * 256 + lane * 4);
      v[i] = make_float4(bflo(hi.x) + bflo(lo.x), bfhi(hi.x) + bfhi(lo.x), bflo(hi.y) + bflo(lo.y), bfhi(hi.y) + bfhi(lo.y));
      ssum += v[i].x * v[i].x + v[i].y * v[i].y + v[i].z * v[i].z + v[i].w * v[i].w;
    }
#pragma unroll
    for (int o = 1; o < 64; o <<= 1) ssum += __shfl_xor(ssum, o);
    const float rstd = rsqrtf(ssum * (1.f / 1024.f) + EPS_);
#pragma unroll
    for (int i = 0; i < 4; ++i) {
      const float4 g = *(const float4*)(p.final_norm + i * 256 + lane * 4);
      float4 o; o.x = v[i].x * rstd * g.x; o.y = v[i].y * rstd * g.y; o.z = v[i].z * rstd * g.z; o.w = v[i].w * rstd * g.w;
      *(float4*)(p.out + (size_t)r * 1024 + i * 256 + lane * 4) = o;
    }
  }
}

__global__ void __launch_bounds__(256, 2) fwd_megakernel(Params p) {
  cg::grid_group grid = cg::this_grid();
  if (p.inv_freq[0] < 0.f) grid.sync();
  volatile LAS unsigned* xst = (volatile LAS unsigned*)(smem + SMEM_BYTES);
  if (threadIdx.x == 0) { xst[0] = 0u; xst[1] = 0u; xst[2] = 0u; xst[3] = 0u; }
  __syncthreads();
  const XcdBarrier xb = xcd_barrier_post((unsigned*)(p.ws + BAR_OFF), xst);
  {
    const WS ws = make_ws(p);
    phase_prologue(p, ws);
  }
  xcd_barrier(xb);
#pragma unroll 1
  for (int layer = 0; layer < 4; ++layer) {
    const int j = layer >> 1;
    if ((layer & 1) == 0) {
      {
        const WS ws = make_ws(p);
        const bf16_t* wb = ws.W + (size_t)j * W_PER_J;
#pragma unroll 1
        for (int rep = 0; rep < REP_GEMM; ++rep)
          gemm_stream<true, EPI_E1>(ws, ws.HHI, nullptr, 1024, 1 << 30, 64, wb + W_IN_E, 1024, 1.f / 1024.f, 41, 129 * 41, xcd_bid(opaque_bid()), false);
      }
      xcd_barrier(xb);
      {
        const WS ws = make_ws(p);
#pragma unroll 1
        for (int u = opaque_bid(); u < 8 * 4 * 33; u += gridDim.x) gla_decay_unit(p, ws, j, u);
      }
      xcd_barrier(xb);
      {
#pragma unroll 1
        for (int rep = 0; rep < REP_E2; ++rep)
#pragma unroll 1
        for (int u = opaque_bid(); u < 512; u += gridDim.x) {
          if (u & 1) { const WS ws = make_ws(p); rglru_unit(p, ws, j, u >> 1, rep < REP_E2 - 1); }
          else { const WS ws = make_ws(p); gla_unit(p, ws, u >> 1, rep < REP_E2 - 1); }
        }
      }
      xcd_barrier(xb);
      {
        const WS ws = make_ws(p);
        phase_gla_norm(p, ws, j);
      }
      xcd_barrier(xb);
      {
        const WS ws = make_ws(p);
        const bf16_t* wb = ws.W + (size_t)j * W_PER_J;
#pragma unroll 1
        for (int rep = 0; rep < REP_GEMM; ++rep)
          gemm_stream<false, EPI_RES>(ws, ws.GA, ws.V, 1024, 16, 64, wb + W_OUT_E, 2048, 0.f, 8, 129 * 8, xcd_bid(opaque_bid()), rep < REP_GEMM - 1);
      }
      xcd_barrier(xb);
    } else {
      {
        const WS ws = make_ws(p);
        const bf16_t* wb = ws.W + (size_t)j * W_PER_J;
#pragma unroll 1
        for (int rep = 0; rep < REP_GEMM; ++rep)
          gemm_stream<true, EPI_O1>(ws, ws.HHI, nullptr, 1024, 1 << 30, 64, wb + W_IN_O, 1024, 1.f / 1024.f, 15, 129 * 15, xcd_bid(opaque_bid()), false);
      }
      xcd_barrier(xb);
      {
        const WS ws = make_ws(p);
        const bf16_t* wb = ws.W + (size_t)j * W_PER_J;
#pragma unroll 1
        for (int rep = 0; rep < REP_GEMM; ++rep) {
          gemm_stream<true, EPI_Q>(ws, ws.CQ, nullptr, 512, 1 << 30, 64, wb + W_Q, 512, 1.f / 512.f, 12, 129 * 12, xcd_bid(opaque_bid()), false);
          gemm_stream<true, EPI_KV>(ws, ws.CKV, nullptr, 256, 1 << 30, 64, wb + W_KV, 256, 1.f / 256.f, 16, 129 * 16, xcd_bid((opaque_bid() + (int)(gridDim.x >> 1)) % (int)gridDim.x), false);
        }
      }
      xcd_barrier(xb);
      {
        const WS ws = make_ws(p);
#pragma unroll 1
        for (int rep = 0; rep < REP_ATTN; ++rep)
#pragma unroll 1
        for (int r = 0, b0 = opaque_bid(); r * (int)gridDim.x < 17 * 128; ++r) {
          const int u = r * (int)gridDim.x + ((r & 1) ? (int)gridDim.x - 1 - b0 : b0);
          if (u < 17 * 128) attn_unit(ws, u, rep < REP_ATTN - 1);
          __syncthreads();
        }
      }
      xcd_barrier(xb);
      {
        const WS ws = make_ws(p);
        const bf16_t* wb = ws.W + (size_t)j * W_PER_J;
#pragma unroll 1
        for (int rep = 0; rep < REP_GEMM; ++rep)
          gemm_stream<false, EPI_RES>(ws, ws.QB, nullptr, 1536, 1 << 30, 96, wb + W_O, 1024, 0.f, 8, 129 * 8, xcd_bid(opaque_bid()), rep < REP_GEMM - 1);
      }
      xcd_barrier(xb);
    }
  }
  {
    const WS ws = make_ws(p);
    phase_final(p, ws);
  }
}

extern "C" void kernel_launch(void* const* d_in, const int* in_sizes, int n_in, void* d_out, int out_size, void* d_ws,
                              size_t ws_size, hipStream_t stream) {
  static int grid_blocks = 0;
  if (!grid_blocks) {
    int dev = 0, cus = 0, per_cu = 0;
    hipGetDevice(&dev);
    hipDeviceGetAttribute(&cus, hipDeviceAttributeMultiprocessorCount, dev);
    hipOccupancyMaxActiveBlocksPerMultiprocessor(&per_cu, fwd_megakernel, 256, 0);
    if (per_cu < 1) per_cu = 1;
    if (per_cu > 2) per_cu = 2;
    grid_blocks = cus * per_cu;
  }
  Params p{};
  p.x = (const float*)d_in[0]; p.positions = (const int*)d_in[1]; p.meta = (const float*)d_in[2];
  p.ab_norm = (const float*)d_in[3]; p.ab_w_in = (const float*)d_in[4]; p.ab_conv_w = (const float*)d_in[5];
  p.ab_conv_b = (const float*)d_in[6]; p.ab_gate_a_w = (const float*)d_in[7]; p.ab_gate_a_b = (const float*)d_in[8];
  p.ab_gate_x_w = (const float*)d_in[9]; p.ab_gate_x_b = (const float*)d_in[10]; p.ab_lam = (const float*)d_in[11];
  p.ab_alpha_w = (const float*)d_in[12]; p.ab_alpha_b = (const float*)d_in[13]; p.ab_gla_norm = (const float*)d_in[14];
  p.ab_w_out = (const float*)d_in[15]; p.c_norm = (const float*)d_in[16]; p.c_w_in = (const float*)d_in[17];
  p.c_q_norm = (const float*)d_in[18]; p.c_w_q_up = (const float*)d_in[19]; p.c_kv_norm = (const float*)d_in[20];
  p.c_w_kv_up = (const float*)d_in[21]; p.c_w_out = (const float*)d_in[22]; p.final_norm = (const float*)d_in[23];
  p.out = (float*)d_out;
  p.ws = (unsigned char*)d_ws;
  for (int i = 0; i < 16; ++i) p.inv_freq[i] = (float)pow(10000.0, -(double)i / 16.0);
  hipMemsetAsync((unsigned char*)d_ws + BAR_OFF, 0, XCD_BAR_WORDS * 4, stream);
  void* args[] = {&p};
  hipError_t e = hipLaunchCooperativeKernel((void*)fwd_megakernel, dim3(grid_blocks), dim3(256), args, 0, stream);
  if (e != hipSuccess) fprintf(stderr, "cooperative launch failed: %s (grid %d)\n", hipGetErrorString(e), grid_blocks);
}
```

```cpp
#include <hip/hip_runtime.h>
#include <hip/hip_cooperative_groups.h>
#include <cstdio>
#include <cmath>
namespace cg = cooperative_groups;

typedef unsigned short bf16_t;
typedef short bf16x8 __attribute__((ext_vector_type(8)));
typedef float f32x4 __attribute__((ext_vector_type(4)));
typedef unsigned u32x4 __attribute__((ext_vector_type(4)));
typedef unsigned u32x2 __attribute__((ext_vector_type(2)));

constexpr int T_ = 2064;
constexpr int M_ = 8 * T_;
constexpr int TP_ = 2112;
constexpr float EPS_ = 1e-6f;
constexpr int SMEM_BYTES = 75776;
constexpr float QSCALE_MLA = 0.10206207261596575f * 1.4426950408889634f;

constexpr size_t W_PER_J = 11796480;
constexpr size_t W_IN_E = 0, W_OUT_E = 5373952, W_IN_O = 7471104, W_Q = 9437184, W_KV = 10223616, W_O = 10747904;

struct Params {
  const float* x; const int* positions; const float* meta;
  const float *ab_norm, *ab_w_in, *ab_conv_w, *ab_conv_b, *ab_gate_a_w, *ab_gate_a_b, *ab_gate_x_w, *ab_gate_x_b,
      *ab_lam, *ab_alpha_w, *ab_alpha_b, *ab_gla_norm, *ab_w_out;
  const float *c_norm, *c_w_in, *c_q_norm, *c_w_q_up, *c_kv_norm, *c_w_kv_up, *c_w_out, *final_norm;
  float* out;
  unsigned char* ws;
  float inv_freq[16];
};

struct WS {
  bf16_t *HHI, *HLO; float2* ROPE;
  bf16_t *XA, *GA, *Q, *K, *V, *GB, *AD; float* SSQ; float* BL;
  bf16_t *CQ, *CKV, *GATE, *KR, *QB, *KN, *VT;
  bf16_t* W;
};

__device__ __forceinline__ unsigned char* opaque_ptr(unsigned char* q) {
  unsigned lo = (unsigned)(unsigned long long)q, hi = (unsigned)((unsigned long long)q >> 32);
  asm volatile("" : "+v"(lo), "+v"(hi));
  lo = __builtin_amdgcn_readfirstlane(lo); hi = __builtin_amdgcn_readfirstlane(hi);
  typedef __attribute__((address_space(1))) unsigned char gu8;
  return (unsigned char*)(gu8*)(((unsigned long long)hi << 32) | lo);
}
__device__ __forceinline__ WS make_ws(const Params& p) {
  WS w;
  unsigned char* b = opaque_ptr(p.ws);
  w.HHI = (bf16_t*)b; b += (size_t)M_ * 2048;
  w.HLO = (bf16_t*)b; b += (size_t)M_ * 2048;
  w.ROPE = (float2*)b; b += (size_t)M_ * 128;
  unsigned char* r = b;
  w.XA = (bf16_t*)r; r += (size_t)M_ * 2048;
  w.GA = (bf16_t*)r; r += (size_t)M_ * 2048;
  w.Q = (bf16_t*)r; r += (size_t)M_ * 1024;
  w.K = (bf16_t*)r; r += (size_t)M_ * 1024;
  w.V = (bf16_t*)r; r += (size_t)M_ * 2048;
  w.GB = (bf16_t*)r; r += (size_t)M_ * 2048;
  w.AD = (bf16_t*)r; r += (size_t)M_ * 32;
  w.SSQ = (float*)r; r += (size_t)M_ * 128;
  w.BL = (float*)r; r += (size_t)8 * 4 * 33 * 128 * 4;
  r = b;
  w.CQ = (bf16_t*)r; r += (size_t)M_ * 1024;
  w.CKV = (bf16_t*)r; r += (size_t)M_ * 512;
  w.GATE = (bf16_t*)r; r += (size_t)M_ * 2048;
  w.KR = (bf16_t*)r; r += (size_t)M_ * 64;
  w.QB = (bf16_t*)r; r += (size_t)M_ * 3072;
  w.KN = (bf16_t*)r; r += (size_t)M_ * 2048;
  w.VT = (bf16_t*)r; r += (size_t)128 * 64 * TP_ * 2;
  w.W = (bf16_t*)opaque_ptr((unsigned char*)p.out);
  return w;
}

__device__ __forceinline__ unsigned cvt_pk_bf16(float lo, float hi) {
  unsigned r; asm("v_cvt_pk_bf16_f32 %0, %1, %2" : "=v"(r) : "v"(lo), "v"(hi)); return r;
}
__device__ __forceinline__ float bf2f(bf16_t v) { return __uint_as_float(((unsigned)v) << 16); }
__device__ __forceinline__ float bflo(unsigned v) { return __uint_as_float(v << 16); }
__device__ __forceinline__ float bfhi(unsigned v) { return __uint_as_float(v & 0xffff0000u); }
__device__ __forceinline__ bf16_t f2bf(float f) { return (bf16_t)(cvt_pk_bf16(f, 0.f) & 0xffffu); }
__device__ __forceinline__ float sigmoidf_(float x) { return __builtin_amdgcn_rcpf(1.f + __expf(-x)); }
__device__ __forceinline__ float siluf_(float x) { return x * __builtin_amdgcn_rcpf(1.f + __expf(-x)); }
__device__ __forceinline__ bf16x8 as_bf16x8(u32x4 v) { return __builtin_bit_cast(bf16x8, v); }
__device__ __forceinline__ int opaque_tid() { int t = threadIdx.x; asm volatile("" : "+v"(t)); return t; }
__device__ __forceinline__ int xcd_bid(int bid) { const int gpx = gridDim.x >> 3; return (bid & 7) * gpx + (bid >> 3); }
__device__ __forceinline__ int opaque_bid() { int t = blockIdx.x; asm volatile("" : "+s"(t)); return t; }
#define MFMA16(a, b, c) __builtin_amdgcn_mfma_f32_16x16x32_bf16((a), (b), (c), 0, 0, 0)

__shared__ __attribute__((aligned(16))) unsigned char smem[SMEM_BYTES + 16];

#define XB_TMO      128
#define XB_XCNT(j)  (256  + 64 * (j))
#define XB_XSUB(j)  (1280 + 64 * (j))
#define XB_XGEN(j)  (2304 + 64 * (j))
#define XB_TOP      3328
#define XB_TOPGEN   3392
#define XCD_BAR_WORDS 3456
#define XB_SPIN_CAP (1u << 18)
#define LAS __attribute__((address_space(3)))
constexpr size_t BAR_OFF = 260046848;

__device__ __forceinline__ unsigned xb_ld(unsigned* p)              { return __hip_atomic_load(p, __ATOMIC_RELAXED, __HIP_MEMORY_SCOPE_AGENT); }
__device__ __forceinline__ unsigned xb_add(unsigned* p, unsigned v) { return __hip_atomic_fetch_add(p, v, __ATOMIC_RELAXED, __HIP_MEMORY_SCOPE_AGENT); }
__device__ __forceinline__ unsigned xb_xcc_id() { return (unsigned)__builtin_amdgcn_s_getreg((3 << 11) | 20) & 0xFu; }
#define XB_SPIN(cond, bar) do { unsigned _sp = 0; while (cond) { __builtin_amdgcn_s_sleep(1); \
    if ((++_sp & 255u) == 0u) { if (xb_ld(&(bar)[XB_TMO])) break; if (_sp > XB_SPIN_CAP) { atomicAdd(&(bar)[XB_TMO], 1u); break; } } } } while (0)

struct XcdBarrier { unsigned* bar; unsigned x; volatile LAS unsigned* st; };

__device__ __forceinline__ XcdBarrier xcd_barrier_post(unsigned* bar, volatile LAS unsigned* st) {
    XcdBarrier b; b.bar = bar; b.x = xb_xcc_id(); b.st = st;
    if (threadIdx.x == 0) (void)xb_add(&bar[XB_XCNT(b.x)], 1u);
    return b;
}
__device__ __forceinline__ void xcd_barrier_complete(unsigned* bar, unsigned x, unsigned& nloc, unsigned& nx) {
    const unsigned G = gridDim.x * gridDim.y * gridDim.z;
    unsigned sum, cnt, mine, sp = 0u;
    for (;;) {
        sum = 0u; cnt = 0u; mine = 0u;
#pragma unroll
        for (unsigned j = 0; j < 16; ++j) { const unsigned c = xb_ld(&bar[XB_XCNT(j)]); sum += c; cnt += (c > 0u) ? 1u : 0u; mine = (j == x) ? c : mine; }
        if (sum == G) break;
        __builtin_amdgcn_s_sleep(1);
        if ((++sp & 255u) == 0u) { if (xb_ld(&bar[XB_TMO])) break; if (sp > XB_SPIN_CAP) { atomicAdd(&bar[XB_TMO], 1u); break; } }
    }
    nloc = mine > 0u ? mine : 1u; nx = cnt > 0u ? cnt : 1u;
}
__device__ __forceinline__ void xcd_barrier(const XcdBarrier& b) {
    asm volatile("s_waitcnt vmcnt(0)" ::: "memory");
    __syncthreads();
    if (threadIdx.x == 0) {
        unsigned* bar = b.bar;
        __builtin_amdgcn_s_waitcnt(0);
        unsigned nloc = b.st[0], nx = b.st[1];
        if (nloc == 0u) { xcd_barrier_complete(bar, b.x, nloc, nx); b.st[0] = nloc; b.st[1] = nx; }
        const unsigned old = xb_add(&bar[XB_XSUB(b.x)], 1u);
        const unsigned gen = old / nloc;
        if (old + 1u == (gen + 1u) * nloc) {
            __builtin_amdgcn_fence(__ATOMIC_RELEASE, "agent");
            asm volatile("s_waitcnt vmcnt(0)" ::: "memory");
            const unsigned og = xb_add(&bar[XB_TOP], 1u);
            const unsigned tg = og / nx;
            if (og + 1u == (tg + 1u) * nx) xb_add(&bar[XB_TOPGEN], 1u);
            else XB_SPIN(xb_ld(&bar[XB_TOPGEN]) == tg, bar);
            __builtin_amdgcn_fence(__ATOMIC_ACQUIRE, "agent");
            xb_add(&bar[XB_XGEN(b.x)], 1u);
            asm volatile("s_waitcnt vmcnt(0)" ::: "memory");
        } else {
            XB_SPIN(xb_ld(&bar[XB_XGEN(b.x)]) == gen, bar);
            __builtin_amdgcn_fence(__ATOMIC_ACQUIRE, "agent");
            asm volatile("s_waitcnt vmcnt(0)" ::: "memory");
        }
    }
    __syncthreads();
}


__device__ __forceinline__ int map_even_in(int n) { return n < 4096 ? n : (n < 5120 ? n + 16 : (n < 5136 ? n - 1024 : -1)); }
__device__ __forceinline__ int map_odd_in(int n) { return n < 768 ? n : (n < 1792 ? n + 32 : (n < 1824 ? n - 1024 : -1)); }

__device__ __forceinline__ void convert_tile(const float* __restrict__ src, int K, int Nsrc, bf16_t* __restrict__ dst,
                                             int kind, const float* __restrict__ g, int tile) {
  float* tl = (float*)smem;
  const int nkt = K >> 6;
  const int ntile = tile / nkt, ktile = tile - ntile * nkt;
  const int n0 = ntile * 64, k0 = ktile * 64;
  const int tid = opaque_tid();
  const int nl = tid & 63, kq = tid >> 6;
  const int n = n0 + nl;
  const int sc = kind == 0 ? map_even_in(n) : (kind == 1 ? map_odd_in(n) : n);
  float cs = 1.f;
  if (kind == 0 && n >= 2048 && n < 2560) cs = 0.08838834764831845f;
  if (kind == 2) cs = QSCALE_MLA;
#pragma unroll
  for (int i = 0; i < 16; ++i) {
    const int kl = kq + 4 * i;
    float v = 0.f;
    if (sc >= 0) {
      v = src[(size_t)(k0 + kl) * Nsrc + sc] * cs;
      if (g) v *= g[k0 + kl];
    }
    tl[kl * 65 + nl] = v;
  }
  __syncthreads();
#pragma unroll
  for (int i = 0; i < 2; ++i) {
    const int c = tid + 256 * i;
    const int nl2 = c >> 3, kc = c & 7;
    float v[8];
#pragma unroll
    for (int jj = 0; jj < 8; ++jj) v[jj] = tl[(kc * 8 + jj) * 65 + nl2];
    u32x4 pk;
    pk.x = cvt_pk_bf16(v[0], v[1]); pk.y = cvt_pk_bf16(v[2], v[3]); pk.z = cvt_pk_bf16(v[4], v[5]); pk.w = cvt_pk_bf16(v[6], v[7]);
    *(u32x4*)(dst + (size_t)(n0 + nl2) * K + k0 + kc * 8) = pk;
  }
  __syncthreads();
}

__device__ __forceinline__ void phase_prologue(const Params& p, const WS& ws) {
  for (int id = opaque_bid(); id < 5760; id += gridDim.x) {
    const int j = id / 2880; int r = id - j * 2880;
    bf16_t* wb = ws.W + (size_t)j * W_PER_J;
    if (r < 1312) convert_tile(p.ab_w_in + (size_t)j * 1024 * 5136, 1024, 5136, wb + W_IN_E, 0, p.ab_norm + j * 1024, r);
    else if ((r -= 1312) < 512) convert_tile(p.ab_w_out + (size_t)j * 2048 * 1024, 2048, 1024, wb + W_OUT_E, 3, nullptr, r);
    else if ((r -= 512) < 480) convert_tile(p.c_w_in + (size_t)j * 1024 * 1824, 1024, 1824, wb + W_IN_O, 1, p.c_norm + j * 1024, r);
    else if ((r -= 480) < 192) convert_tile(p.c_w_q_up + (size_t)j * 512 * 1536, 512, 1536, wb + W_Q, 2, p.c_q_norm + j * 512, r);
    else if ((r -= 192) < 128) convert_tile(p.c_w_kv_up + (size_t)j * 256 * 2048, 256, 2048, wb + W_KV, 3, p.c_kv_norm + j * 256, r);
    else { r -= 128; convert_tile(p.c_w_out + (size_t)j * 1024 * 1024, 1024, 1024, wb + W_O, 3, nullptr, r); }
  }
  const size_t gtid = (size_t)opaque_bid() * 256 + opaque_tid(), gsz = (size_t)gridDim.x * 256;
  for (size_t idx0 = gtid; idx0 < (size_t)M_ * 256; idx0 += 4 * gsz) {
    float4 v4[4];
#pragma unroll
    for (int q = 0; q < 4; ++q) {
      const size_t idx = idx0 + q * gsz;
      v4[q] = make_float4(0.f, 0.f, 0.f, 0.f);
      if (idx < (size_t)M_ * 256) {
        const int row = (int)(idx >> 8), c4 = (int)(idx & 255);
        const int b = row / T_, t = row - b * T_;
        const float* src = t < 16 ? p.meta + (size_t)t * 1024 : p.x + ((size_t)b * 2048 + (t - 16)) * 1024;
        v4[q] = *(const float4*)(src + c4 * 4);
      }
    }
#pragma unroll
    for (int q = 0; q < 4; ++q) {
      const size_t idx = idx0 + q * gsz;
      if (idx < (size_t)M_ * 256) {
        const float4 v = v4[q];
        u32x2 hi; hi.x = cvt_pk_bf16(v.x, v.y); hi.y = cvt_pk_bf16(v.z, v.w);
        u32x2 lo; lo.x = cvt_pk_bf16(v.x - bflo(hi.x), v.y - bfhi(hi.x)); lo.y = cvt_pk_bf16(v.z - bflo(hi.y), v.w - bfhi(hi.y));
        *(u32x2*)(ws.HHI + idx * 4) = hi;
        *(u32x2*)(ws.HLO + idx * 4) = lo;
      }
    }
  }
  for (size_t idx = gtid; idx < (size_t)M_ * 16; idx += gsz) {
    const int row = (int)(idx >> 4), i = (int)(idx & 15);
    const int b = row / T_, t = row - b * T_;
    const int pos = t < 16 ? t : p.positions[b * 2048 + (t - 16)] + 16;
    const float angf = (float)pos * p.inv_freq[i];
    const double rev = (double)angf * 0.15915494309189533577;
    const float fr = (float)(rev - rint(rev));
    ws.ROPE[idx] = make_float2(__builtin_amdgcn_cosf(fr), __builtin_amdgcn_sinf(fr));
  }
}

#ifndef REP_GEMM
#define REP_GEMM 1
#endif
#ifndef REP_ATTN
#define REP_ATTN 1
#endif
#ifndef REP_E2
#define REP_E2 1
#endif
enum { EPI_E1 = 0, EPI_O1 = 1, EPI_Q = 2, EPI_KV = 3, EPI_RES = 4 };

template <int EPI>
__device__ __forceinline__ void gemm_epilogue(const WS& ws, const f32x4 (&acc)[4][4], const float (&rs)[4], int tok0, int n0,
                                              int wm, int wn, int lr, int lq, bool dry) {
  const int tokw = tok0 + wn * 64 + lr;
  const int nw = n0 + wm * 64;
  if (EPI == EPI_E1) {
    bf16_t* dst; int ld, c;
    if (n0 < 1024) { dst = ws.XA; ld = 1024; c = n0; }
    else if (n0 < 2048) { dst = ws.GA; ld = 1024; c = n0 - 1024; }
    else if (n0 < 2560) { dst = ws.Q; ld = 512; c = n0 - 2048; }
    else if (n0 < 3072) { dst = ws.K; ld = 512; c = n0 - 2560; }
    else if (n0 < 4096) { dst = ws.V; ld = 1024; c = n0 - 3072; }
    else if (n0 < 5120) { dst = ws.GB; ld = 1024; c = n0 - 4096; }
    else { dst = ws.AD; ld = 16; c = 0; }
    const bool isad = n0 >= 5120;
#pragma unroll
    for (int ni = 0; ni < 4; ++ni) {
      if (isad && (wm != 0 || ni != 0)) continue;
#pragma unroll
      for (int ti = 0; ti < 4; ++ti) {
        const f32x4 v = acc[ni][ti] * rs[ti];
        u32x2 pk; pk.x = cvt_pk_bf16(v[0], v[1]); pk.y = cvt_pk_bf16(v[2], v[3]);
        *(u32x2*)(dst + (size_t)(tokw + ti * 16) * ld + c + wm * 64 + ni * 16 + 4 * lq) = pk;
      }
    }
  } else if (EPI == EPI_O1) {
    if (n0 < 1792) {
      bf16_t* dst; int ld, c;
      if (n0 < 512) { dst = ws.CQ; ld = 512; c = n0; }
      else if (n0 < 768) { dst = ws.CKV; ld = 256; c = n0 - 512; }
      else { dst = ws.GATE; ld = 1024; c = n0 - 768; }
#pragma unroll
      for (int ni = 0; ni < 4; ++ni)
#pragma unroll
        for (int ti = 0; ti < 4; ++ti) {
          const f32x4 v = acc[ni][ti] * rs[ti];
          u32x2 pk; pk.x = cvt_pk_bf16(v[0], v[1]); pk.y = cvt_pk_bf16(v[2], v[3]);
          *(u32x2*)(dst + (size_t)(tokw + ti * 16) * ld + c + wm * 64 + ni * 16 + 4 * lq) = pk;
        }
    } else if (wm == 0) {
#pragma unroll
      for (int ti = 0; ti < 4; ++ti) {
        const int tok = tokw + ti * 16;
        const f32x4 x1 = acc[0][ti] * rs[ti], x2 = acc[1][ti] * rs[ti];
        float o1[4], o2[4];
#pragma unroll
        for (int jj = 0; jj < 4; ++jj) {
          const float2 cs = ws.ROPE[(size_t)tok * 16 + 4 * lq + jj];
          o1[jj] = x1[jj] * cs.x - x2[jj] * cs.y;
          o2[jj] = x2[jj] * cs.x + x1[jj] * cs.y;
        }
        u32x2 pk; pk.x = cvt_pk_bf16(o1[0], o1[1]); pk.y = cvt_pk_bf16(o1[2], o1[3]);
        *(u32x2*)(ws.KR + (size_t)tok * 32 + 4 * lq) = pk;
        pk.x = cvt_pk_bf16(o2[0], o2[1]); pk.y = cvt_pk_bf16(o2[2], o2[3]);
        *(u32x2*)(ws.KR + (size_t)tok * 32 + 16 + 4 * lq) = pk;
      }
    }
  } else if (EPI == EPI_Q) {
#pragma unroll
    for (int ni = 0; ni < 4; ++ni)
#pragma unroll
      for (int ti = 0; ti < 4; ++ti) {
        const f32x4 v = acc[ni][ti] * rs[ti];
        u32x2 pk; pk.x = cvt_pk_bf16(v[0], v[1]); pk.y = cvt_pk_bf16(v[2], v[3]);
        *(u32x2*)(ws.QB + (size_t)(tokw + ti * 16) * 1536 + nw + ni * 16 + 4 * lq) = pk;
      }
  } else if (EPI == EPI_KV) {
    const int hd = nw >> 7;
    const bool isv = (nw & 127) >= 64;
    if (!isv) {
#pragma unroll
      for (int ni = 0; ni < 4; ++ni)
#pragma unroll
        for (int ti = 0; ti < 4; ++ti) {
          const f32x4 v = acc[ni][ti] * rs[ti];
          u32x2 pk; pk.x = cvt_pk_bf16(v[0], v[1]); pk.y = cvt_pk_bf16(v[2], v[3]);
          *(u32x2*)(ws.KN + (size_t)(tokw + ti * 16) * 1024 + hd * 64 + ni * 16 + 4 * lq) = pk;
        }
    } else {
#pragma unroll
      for (int ti = 0; ti < 4; ++ti) {
        const int tok = tokw + ti * 16;
        const int b = tok / T_, t = tok - b * T_;
        bf16_t* vb = ws.VT + ((size_t)(b * 16 + hd) * 64) * TP_ + t;
#pragma unroll
        for (int ni = 0; ni < 4; ++ni) {
          const f32x4 v = acc[ni][ti] * rs[ti];
#pragma unroll
          for (int jj = 0; jj < 4; ++jj) vb[(size_t)(ni * 16 + 4 * lq + jj) * TP_] = f2bf(v[jj]);
        }
      }
    }
  } else {
#pragma unroll
    for (int ni = 0; ni < 4; ++ni)
#pragma unroll
      for (int ti = 0; ti < 4; ++ti) {
        const size_t off = (size_t)(tokw + ti * 16) * 1024 + nw + ni * 16 + 4 * lq;
        const u32x2 hi = *(const u32x2*)(ws.HHI + off), lo = *(const u32x2*)(ws.HLO + off);
        const float h0 = bflo(hi.x) + bflo(lo.x) + acc[ni][ti][0], h1 = bfhi(hi.x) + bfhi(lo.x) + acc[ni][ti][1];
        const float h2 = bflo(hi.y) + bflo(lo.y) + acc[ni][ti][2], h3 = bfhi(hi.y) + bfhi(lo.y) + acc[ni][ti][3];
        u32x2 nh; nh.x = cvt_pk_bf16(h0, h1); nh.y = cvt_pk_bf16(h2, h3);
        u32x2 nl; nl.x = cvt_pk_bf16(h0 - bflo(nh.x), h1 - bfhi(nh.x)); nl.y = cvt_pk_bf16(h2 - bflo(nh.y), h3 - bfhi(nh.y));
        if (!dry) { *(u32x2*)(ws.HHI + off) = nh; *(u32x2*)(ws.HLO + off) = nl; }
      }
  }
}

__device__ __forceinline__ float sumsq8(bf16x8 v) {
  const u32x4 u = __builtin_bit_cast(u32x4, v);
  float s = 0.f, t;
  t = bflo(u.x); s += t * t; t = bfhi(u.x); s += t * t; t = bflo(u.y); s += t * t; t = bfhi(u.y); s += t * t;
  t = bflo(u.z); s += t * t; t = bfhi(u.z); s += t * t; t = bflo(u.w); s += t * t; t = bfhi(u.w); s += t * t;
  return s;
}
__device__ __forceinline__ void tile_of(int pos, int ntn, int& mt, int& nt) {
  const int full = 128 * ntn;
  if (pos < full) { const int panel = pos / (8 * ntn); const int rem = pos - panel * 8 * ntn; nt = rem >> 3; mt = panel * 8 + (rem & 7); }
  else { mt = 128; nt = pos - full; }
}
template <bool RS, int EPI>
__device__ __forceinline__ void gemm_stream(const WS& ws, const bf16_t* A0, const bf16_t* A1, int lda, int ktsplit, int kstride,
                                            const bf16_t* __restrict__ W, int K, float invK, int ntn, int ntiles, int bid, bool dry) {
  unsigned char* As = smem;
  unsigned char* Bs = smem + 32768;
  const int tid = opaque_tid(), lane = tid & 63, w = tid >> 6, wm = w >> 1, wn = w & 1, lr = lane & 15, lq = lane >> 4;
  const int G = gridDim.x;
  const int nk = K >> 6;
  if (bid < ntiles) {
    const int my_tiles = (ntiles - 1 - bid) / G + 1;
    const int last_id = bid + (my_tiles - 1) * G;
    const int S = my_tiles * nk;
    f32x4 acc[4][4];
#pragma unroll
    for (int a = 0; a < 4; ++a)
#pragma unroll
      for (int b = 0; b < 4; ++b) acc[a][b] = (f32x4){0.f, 0.f, 0.f, 0.f};
    u32x4 ra0[4], rb0[4], ra1[4], rb1[4];
    float ss[4] = {0.f, 0.f, 0.f, 0.f};
    int l_id = bid, l_kt = 0, c_id = bid, c_kt = 0, st_kt = 0;
    float* rsl = (float*)(smem + 65536);
    const int srow = tid >> 3;
    const int soff = srow * 128 + (((tid & 7) ^ (srow & 7)) << 4);

    auto issue = [&](u32x4 (&ra)[4], u32x4 (&rb)[4]) {
      const int idc = l_id < last_id ? l_id : last_id;
      int mt, nt; tile_of(idc, ntn, mt, nt);
      const bf16_t* A = (l_kt < ktsplit) ? A0 : A1;
      const int kk = (l_kt < ktsplit) ? l_kt : l_kt - ktsplit;
      const bf16_t* ap = A + (size_t)(mt * 128 + srow) * lda + kk * kstride + (tid & 7) * 8;
      const bf16_t* wp = W + (size_t)(nt * 128 + srow) * K + l_kt * 64 + (tid & 7) * 8;
#pragma unroll
      for (int i = 0; i < 4; ++i) {
        ra[i] = *(const u32x4*)(ap + (size_t)i * 32 * lda);
        rb[i] = *(const u32x4*)(wp + (size_t)i * 32 * K);
      }
      if (++l_kt == nk) { l_kt = 0; l_id += G; }
    };
    auto store = [&](const u32x4 (&ra)[4], const u32x4 (&rb)[4], int buf) {
#pragma unroll
      for (int i = 0; i < 4; ++i) {
        if (RS) ss[i] += sumsq8(__builtin_bit_cast(bf16x8, ra[i]));
        *(u32x4*)(As + buf * 16384 + i * 4096 + soff) = ra[i];
        *(u32x4*)(Bs + buf * 16384 + i * 4096 + soff) = rb[i];
      }
      if (RS) {
        if (++st_kt == nk) {
          st_kt = 0;
#pragma unroll
          for (int i = 0; i < 4; ++i) {
            float t = ss[i];
            t += __shfl_xor(t, 1); t += __shfl_xor(t, 2); t += __shfl_xor(t, 4);
            if ((tid & 7) == 0) rsl[srow + 32 * i] = rsqrtf(t * invK + EPS_);
            ss[i] = 0.f;
          }
        }
      }
    };
    auto compute = [&](int buf) {
      const unsigned char* Ab = As + buf * 16384 + (wn * 64 + lr) * 128;
      const unsigned char* Bb = Bs + buf * 16384 + (wm * 64 + lr) * 128;
#pragma unroll
      for (int ks = 0; ks < 2; ++ks) {
        const int sw = ((ks * 4 + lq) ^ (lr & 7)) << 4;
        bf16x8 wf[4], xf[4];
#pragma unroll
        for (int i = 0; i < 4; ++i) {
          wf[i] = *(const bf16x8*)(Bb + i * 2048 + sw);
          xf[i] = *(const bf16x8*)(Ab + i * 2048 + sw);
        }
#pragma unroll
        for (int ni = 0; ni < 4; ++ni)
#pragma unroll
          for (int ti = 0; ti < 4; ++ti) acc[ni][ti] = MFMA16(wf[ni], xf[ti], acc[ni][ti]);
      }
    };
    auto tile_end = [&]() {
      float rs[4] = {1.f, 1.f, 1.f, 1.f};
      if (RS) {
#pragma unroll
        for (int ti = 0; ti < 4; ++ti) rs[ti] = rsl[wn * 64 + ti * 16 + lr];
      }
      int mt, nt; tile_of(c_id, ntn, mt, nt);
      gemm_epilogue<EPI>(ws, acc, rs, mt * 128, nt * 128, wm, wn, lr, lq, dry);
#pragma unroll
      for (int a = 0; a < 4; ++a)
#pragma unroll
        for (int b = 0; b < 4; ++b) acc[a][b] = (f32x4){0.f, 0.f, 0.f, 0.f};
      c_id += G;
    };

    issue(ra0, rb0);
    issue(ra1, rb1);
    store(ra0, rb0, 0);
    __syncthreads();
#pragma unroll 1
    for (int s = 0; s < S; s += 2) {
      issue(ra0, rb0);
      compute(0);
      store(ra1, rb1, 1);
      __syncthreads();
      issue(ra1, rb1);
      compute(1);
      c_kt += 2;
      if (c_kt == nk) { c_kt = 0; tile_end(); }
      store(ra0, rb0, 0);
      __syncthreads();
    }
  }
  __syncthreads();
}

template <bool RS, int EPI>
__device__ __forceinline__ void gemm_glds(const WS& ws, const bf16_t* A0, const bf16_t* A1, int lda, int ktsplit, int kstride,
                                          const bf16_t* __restrict__ W, int K, float invK, int ntn, int ntiles, int bid, bool dry) {
  unsigned char* As = smem;
  unsigned char* Bs = smem + 32768;
  const int tid = opaque_tid(), lane = tid & 63, w = tid >> 6, wm = w >> 1, wn = w & 1, lr = lane & 15, lq = lane >> 4;
  const int G = gridDim.x;
  const int nk = K >> 6;
  if (bid < ntiles) {
    const int my_tiles = (ntiles - 1 - bid) / G + 1;
    const int S = my_tiles * nk;
    f32x4 acc[4][4];
#pragma unroll
    for (int a = 0; a < 4; ++a)
#pragma unroll
      for (int b = 0; b < 4; ++b) acc[a][b] = (f32x4){0.f, 0.f, 0.f, 0.f};
    float ss[4] = {0.f, 0.f, 0.f, 0.f};
    int l_id = bid, l_kt = 0, c_id = bid, c_kt = 0;
    const int lrow = lane >> 3;
    const int lc = (lane & 7) ^ lrow;
    auto issue = [&](int buf) {
      int mt, nt; tile_of(l_id, ntn, mt, nt);
      const bf16_t* A = (l_kt < ktsplit) ? A0 : A1;
      const int kk = (l_kt < ktsplit) ? l_kt : l_kt - ktsplit;
      const bf16_t* ap = A + (size_t)(mt * 128 + w * 32 + lrow) * lda + kk * kstride + lc * 8;
      const bf16_t* wp = W + (size_t)(nt * 128 + w * 32 + lrow) * K + l_kt * 64 + lc * 8;
      unsigned char* la = As + buf * 16384 + w * 4096 + lane * 16;
      unsigned char* lb = Bs + buf * 16384 + w * 4096 + lane * 16;
#pragma unroll
      for (int i = 0; i < 4; ++i) {
        __builtin_amdgcn_global_load_lds((const unsigned*)(ap + (size_t)i * 8 * lda), (unsigned*)(la + i * 1024), 16, 0, 0);
        __builtin_amdgcn_global_load_lds((const unsigned*)(wp + (size_t)i * 8 * K), (unsigned*)(lb + i * 1024), 16, 0, 0);
      }
      if (++l_kt == nk) { l_kt = 0; l_id += G; }
    };
    auto compute = [&](int buf) {
      const unsigned char* Ab = As + buf * 16384 + (wn * 64 + lr) * 128;
      const unsigned char* Bb = Bs + buf * 16384 + (wm * 64 + lr) * 128;
#pragma unroll
      for (int ks = 0; ks < 2; ++ks) {
        const int sw = ((ks * 4 + lq) ^ (lr & 7)) << 4;
        bf16x8 wf[4], xf[4];
#pragma unroll
        for (int i = 0; i < 4; ++i) {
          wf[i] = *(const bf16x8*)(Bb + i * 2048 + sw);
          xf[i] = *(const bf16x8*)(Ab + i * 2048 + sw);
        }
        if (RS) {
#pragma unroll
          for (int i = 0; i < 4; ++i) ss[i] += sumsq8(xf[i]);
        }
#pragma unroll
        for (int ni = 0; ni < 4; ++ni)
#pragma unroll
          for (int ti = 0; ti < 4; ++ti) acc[ni][ti] = MFMA16(wf[ni], xf[ti], acc[ni][ti]);
      }
    };
    auto tile_end = [&]() {
      float rs[4] = {1.f, 1.f, 1.f, 1.f};
      if (RS) {
#pragma unroll
        for (int ti = 0; ti < 4; ++ti) {
          float t = ss[ti];
          t += __shfl_xor(t, 16); t += __shfl_xor(t, 32);
          rs[ti] = rsqrtf(t * invK + EPS_);
          ss[ti] = 0.f;
        }
      }
      int mt, nt; tile_of(c_id, ntn, mt, nt);
      gemm_epilogue<EPI>(ws, acc, rs, mt * 128, nt * 128, wm, wn, lr, lq, dry);
#pragma unroll
      for (int a = 0; a < 4; ++a)
#pragma unroll
        for (int b = 0; b < 4; ++b) acc[a][b] = (f32x4){0.f, 0.f, 0.f, 0.f};
      c_id += G;
    };
    issue(0);
#pragma unroll 1
    for (int s = 0; s < S; ++s) {
      asm volatile("s_waitcnt vmcnt(0)" ::: "memory");
      __builtin_amdgcn_s_barrier();
      asm volatile("" ::: "memory");
      if (s + 1 < S) issue((s + 1) & 1);
      compute(s & 1);
      if (++c_kt == nk) { c_kt = 0; tile_end(); }
    }
  }
  __syncthreads();
}

__device__ __forceinline__ void gla_decay_unit(const Params& p, const WS& ws, int j, int u) {
  const int c = u % 33; const int bh = u / 33; const int hd = bh & 3, b = bh >> 2;
  bf16_t* Qs = (bf16_t*)smem;
  bf16_t* Ks = Qs + 64 * 136;
  float* ADs = (float*)(smem + 2 * 64 * 136 * 2);
  float* HT = ADs + 64 * 16;
  const int tid = opaque_tid();
  const int tbase = 64 * c - 48;
#pragma unroll
  for (int i = 0; i < 4; ++i) {
    const int ci = tid + 256 * i; const int row = ci >> 4, ch = ci & 15; const int t = tbase + row;
    u32x4 qv = (u32x4){0, 0, 0, 0}, kv = (u32x4){0, 0, 0, 0};
    if (t >= 0) {
      qv = *(const u32x4*)(ws.Q + (size_t)(b * T_ + t) * 512 + hd * 128 + ch * 8);
      kv = *(const u32x4*)(ws.K + (size_t)(b * T_ + t) * 512 + hd * 128 + ch * 8);
    }
    *(u32x4*)(Qs + row * 136 + ch * 8) = qv;
    *(u32x4*)(Ks + row * 136 + ch * 8) = kv;
    const int t2 = tbase + (ci >> 4);
    ADs[ci] = t2 >= 0 ? bf2f(ws.AD[(size_t)(b * T_ + t2) * 16 + (ci & 15)]) : 0.f;
  }
  const int d = tid & 127, half = tid >> 7;
  float aw[16];
#pragma unroll
  for (int r = 0; r < 16; ++r) aw[r] = p.ab_alpha_w[(size_t)(j * 16 + r) * 512 + hd * 128 + d];
  const float abias = p.ab_alpha_b[j * 512 + hd * 128 + d];
  __syncthreads();
  float cs[32];
  float run = 0.f;
#pragma unroll
  for (int ii = 0; ii < 32; ++ii) {
    const int row = half * 32 + ii;
    float xv = abias;
#pragma unroll
    for (int r4 = 0; r4 < 4; ++r4) {
      const float4 a4 = *(const float4*)(ADs + row * 16 + r4 * 4);
      xv += a4.x * aw[r4 * 4] + a4.y * aw[r4 * 4 + 1] + a4.z * aw[r4 * 4 + 2] + a4.w * aw[r4 * 4 + 3];
    }
    float la = (fminf(xv, 0.f) - __logf(1.f + __expf(-fabsf(xv)))) * 0.0625f;
    if (tbase + row < 0) la = 0.f;
    run += la;
    cs[ii] = run;
  }
  HT[half * 128 + d] = run;
  __syncthreads();
  const float off = half ? HT[d] : 0.f;
  const float blast = HT[d] + HT[128 + d];
#pragma unroll
  for (int ii = 0; ii < 32; ++ii) {
    const int row = half * 32 + ii;
    const float bb = cs[ii] + off;
    const float eb = __expf(bb), ebi = __expf(-bb);
    Qs[row * 136 + d] = f2bf(bf2f(Qs[row * 136 + d]) * eb);
    Ks[row * 136 + d] = f2bf(bf2f(Ks[row * 136 + d]) * ebi);
  }
  if (half == 0) ws.BL[(size_t)((b * 4 + hd) * 33 + c) * 128 + d] = __expf(blast);
  __syncthreads();
#pragma unroll
  for (int i = 0; i < 4; ++i) {
    const int ci = tid + 256 * i; const int row = ci >> 4, ch = ci & 15; const int t = tbase + row;
    if (t >= 0) {
      *(u32x4*)(ws.Q + (size_t)(b * T_ + t) * 512 + hd * 128 + ch * 8) = *(const u32x4*)(Qs + row * 136 + ch * 8);
      *(u32x4*)(ws.K + (size_t)(b * T_ + t) * 512 + hd * 128 + ch * 8) = *(const u32x4*)(Ks + row * 136 + ch * 8);
    }
  }
  __syncthreads();
}

__device__ __forceinline__ void gla_unit(const Params& p, const WS& ws, int u, bool dry = false) {
  const int sl = u & 7; const int bh = u >> 3; const int hd = bh & 3, b = bh >> 2;
  bf16_t* QDs = (bf16_t*)smem;
  bf16_t* KIs = QDs + 64 * 136;
  bf16_t* KIT = KIs + 64 * 136;
  bf16_t* VTs = KIT + 128 * 72;
  bf16_t* STs = VTs + 32 * 72;
  bf16_t* Ps = STs + 32 * 136;
  const int tid = opaque_tid(), lane = tid & 63, w = tid >> 6, lr = lane & 15, lq = lane >> 4;
  for (int i = tid; i < 32 * 136 / 2; i += 256) ((unsigned*)STs)[i] = 0u;
  f32x4 sacc[2][2];
#pragma unroll
  for (int a = 0; a < 2; ++a)
#pragma unroll
    for (int bb = 0; bb < 2; ++bb) sacc[a][bb] = (f32x4){0.f, 0.f, 0.f, 0.f};
  u32x4 qr[4], kr[4], vr;
  float ebl[2];
  const float* BLp = ws.BL + (size_t)((b * 4 + hd) * 33) * 128;
  auto prefetch = [&](int c) {
    const int tbase = 64 * c - 48;
#pragma unroll
    for (int i = 0; i < 4; ++i) {
      const int ci = tid + 256 * i; const int row = ci >> 4, ch = ci & 15; const int t = tbase + row;
      qr[i] = (u32x4){0, 0, 0, 0}; kr[i] = (u32x4){0, 0, 0, 0};
      if (t >= 0) {
        qr[i] = *(const u32x4*)(ws.Q + (size_t)(b * T_ + t) * 512 + hd * 128 + ch * 8);
        kr[i] = *(const u32x4*)(ws.K + (size_t)(b * T_ + t) * 512 + hd * 128 + ch * 8);
      }
    }
    {
      const int row = tid >> 2, ch = tid & 3; const int t = tbase + row;
      vr = (u32x4){0, 0, 0, 0};
      if (t >= 0) vr = *(const u32x4*)(ws.V + (size_t)(b * T_ + t) * 1024 + hd * 256 + sl * 32 + ch * 8);
    }
    ebl[0] = BLp[c * 128 + 16 * (2 * w) + lr];
    ebl[1] = BLp[c * 128 + 16 * (2 * w + 1) + lr];
  };
  prefetch(0);
#pragma unroll 1
  for (int c = 0; c < 33; ++c) {
#pragma unroll
    for (int i = 0; i < 4; ++i) {
      const int ci = tid + 256 * i; const int row = ci >> 4, ch = ci & 15;
      *(u32x4*)(QDs + row * 136 + ch * 8) = qr[i];
      *(u32x4*)(KIs + row * 136 + ch * 8) = kr[i];
      const unsigned kk[4] = {kr[i].x, kr[i].y, kr[i].z, kr[i].w};
#pragma unroll
      for (int e = 0; e < 4; ++e) {
        KIT[(ch * 8 + 2 * e) * 72 + (row ^ ((ch & 7) << 3))] = (bf16_t)(kk[e] & 0xffffu);
        KIT[(ch * 8 + 2 * e + 1) * 72 + (row ^ ((ch & 7) << 3))] = (bf16_t)(kk[e] >> 16);
      }
    }
    {
      const int row = tid >> 2, ch = tid & 3;
      const unsigned vv[4] = {vr.x, vr.y, vr.z, vr.w};
#pragma unroll
      for (int e = 0; e < 4; ++e) {
        VTs[(ch * 8 + 2 * e) * 72 + (row ^ (ch << 3))] = (bf16_t)(vv[e] & 0xffffu);
        VTs[(ch * 8 + 2 * e + 1) * 72 + (row ^ (ch << 3))] = (bf16_t)(vv[e] >> 16);
      }
    }
    const float eb0 = ebl[0], eb1 = ebl[1];
    __syncthreads();
    if (c + 1 < 33) prefetch(c + 1);
    bf16x8 xq[4];
#pragma unroll
    for (int ks = 0; ks < 4; ++ks) xq[ks] = *(const bf16x8*)(QDs + (16 * w + lr) * 136 + 32 * ks + 8 * lq);
    const int irow = 16 * w + lr;
#pragma unroll
    for (int mt = 0; mt < 4; ++mt) {
      u32x2 pk = (u32x2){0u, 0u};
      if (mt <= w) {
        f32x4 a = (f32x4){0.f, 0.f, 0.f, 0.f};
#pragma unroll
        for (int ks = 0; ks < 4; ++ks) {
          const bf16x8 kf = *(const bf16x8*)(KIs + (16 * mt + lr) * 136 + 32 * ks + 8 * lq);
          a = MFMA16(kf, xq[ks], a);
        }
        const int ip = 16 * mt + 4 * lq;
        const float v0 = (ip + 0 <= irow) ? a[0] : 0.f, v1 = (ip + 1 <= irow) ? a[1] : 0.f;
        const float v2 = (ip + 2 <= irow) ? a[2] : 0.f, v3 = (ip + 3 <= irow) ? a[3] : 0.f;
        pk.x = cvt_pk_bf16(v0, v1); pk.y = cvt_pk_bf16(v2, v3);
      }
      *(u32x2*)(Ps + irow * 72 + 16 * mt + 4 * lq) = pk;
    }
    __syncthreads();
    f32x4 oacc[2];
    oacc[0] = (f32x4){0.f, 0.f, 0.f, 0.f}; oacc[1] = (f32x4){0.f, 0.f, 0.f, 0.f};
#pragma unroll
    for (int ks = 0; ks < 2; ++ks) {
      if (2 * ks <= w) {
        const bf16x8 pb = *(const bf16x8*)(Ps + irow * 72 + 32 * ks + 8 * lq);
#pragma unroll
        for (int mt = 0; mt < 2; ++mt) {
          const bf16x8 vf = *(const bf16x8*)(VTs + (16 * mt + lr) * 72 + (((4 * ks + lq) ^ (((16 * mt + lr) >> 3) & 3)) << 3));
          oacc[mt] = MFMA16(vf, pb, oacc[mt]);
        }
      }
    }
#pragma unroll
    for (int ks = 0; ks < 4; ++ks)
#pragma unroll
      for (int mt = 0; mt < 2; ++mt) {
        const bf16x8 sf = *(const bf16x8*)(STs + (16 * mt + lr) * 136 + 32 * ks + 8 * lq);
        oacc[mt] = MFMA16(sf, xq[ks], oacc[mt]);
      }
    {
      const int t = 64 * c - 48 + irow;
      float sq = 0.f;
#pragma unroll
      for (int mt = 0; mt < 2; ++mt) sq += oacc[mt][0] * oacc[mt][0] + oacc[mt][1] * oacc[mt][1] + oacc[mt][2] * oacc[mt][2] + oacc[mt][3] * oacc[mt][3];
      sq += __shfl_xor(sq, 16); sq += __shfl_xor(sq, 32);
      if (t >= 0 && !dry) {
        const size_t row = (size_t)(b * T_ + t);
#pragma unroll
        for (int mt = 0; mt < 2; ++mt) {
          u32x2 pk; pk.x = cvt_pk_bf16(oacc[mt][0], oacc[mt][1]); pk.y = cvt_pk_bf16(oacc[mt][2], oacc[mt][3]);
          *(u32x2*)(ws.V + row * 1024 + hd * 256 + sl * 32 + 16 * mt + 4 * lq) = pk;
        }
        if (lq == 0) ws.SSQ[row * 32 + hd * 8 + sl] = sq;
      }
    }
    __syncthreads();
#pragma unroll
    for (int ntl = 0; ntl < 2; ++ntl) {
#pragma unroll
      for (int ks = 0; ks < 2; ++ks) {
        const bf16x8 kf = *(const bf16x8*)(KIT + (16 * (2 * w + ntl) + lr) * 72 + (((4 * ks + lq) ^ (((16 * (2 * w + ntl) + lr) >> 3) & 7)) << 3));
#pragma unroll
        for (int mt = 0; mt < 2; ++mt) {
          const bf16x8 vf = *(const bf16x8*)(VTs + (16 * mt + lr) * 72 + (((4 * ks + lq) ^ (((16 * mt + lr) >> 3) & 3)) << 3));
          sacc[mt][ntl] = MFMA16(vf, kf, sacc[mt][ntl]);
        }
      }
      const float e = ntl ? eb1 : eb0;
#pragma unroll
      for (int mt = 0; mt < 2; ++mt) {
        sacc[mt][ntl] = sacc[mt][ntl] * e;
#pragma unroll
        for (int jj = 0; jj < 4; ++jj) STs[(16 * mt + 4 * lq + jj) * 136 + 16 * (2 * w + ntl) + lr] = f2bf(sacc[mt][ntl][jj]);
      }
    }
    __syncthreads();
  }
}

__device__ __forceinline__ void rglru_unit(const Params& p, const WS& ws, int j, int u, bool dry = false) {
  const int jq = u & 3, g = (u >> 2) & 7, b = u >> 5;
  bf16_t* XC = (bf16_t*)smem;
  bf16_t* WG = XC + 64 * 136;
  float* AUa = (float*)(smem + 34816);
  float* AUu = AUa + 64 * 33;
  float* SEGA = AUu + 64 * 33;
  float* SEGH = SEGA + 256;
  float* CARRY = SEGH + 256;
  const int tid = opaque_tid(), lane = tid & 63, w = tid >> 6, lr = lane & 15, lq = lane >> 4;
#pragma unroll 4
  for (int i = 0; i < 32; ++i) {
    const int e = tid + 256 * i;
    const int gate = e >> 12, k = (e >> 5) & 127, n = e & 31;
    const float* gw = gate ? p.ab_gate_x_w : p.ab_gate_a_w;
    WG[(gate * 32 + n) * 136 + k] = f2bf(gw[((size_t)(j * 8 + g) * 128 + k) * 128 + 32 * jq + n]);
  }
  if (tid < 32) CARRY[tid] = 0.f;
  const int cc = tid & 15, rb = 4 * (tid >> 4);
  float cw[4][8], cb[8];
#pragma unroll
  for (int e = 0; e < 8; ++e) {
    cb[e] = p.ab_conv_b[j * 1024 + 128 * g + 8 * cc + e];
#pragma unroll
    for (int k = 0; k < 4; ++k) cw[k][e] = p.ab_conv_w[(size_t)(j * 4 + k) * 1024 + 128 * g + 8 * cc + e];
  }
  float ba[2][4], bx[2][4], sp[2][4];
#pragma unroll
  for (int mt = 0; mt < 2; ++mt)
#pragma unroll
    for (int jj = 0; jj < 4; ++jj) {
      const int ch = j * 1024 + 128 * g + 32 * jq + 16 * mt + 4 * lq + jj;
      ba[mt][jj] = p.ab_gate_a_b[ch]; bx[mt][jj] = p.ab_gate_x_b[ch];
      sp[mt][jj] = 8.f * log1pf(__expf(-p.ab_lam[ch]));
    }
  const int sc = tid & 31, ssg = tid >> 5;
  u32x4 xin[7];
  bf16_t gav[8];
  auto prefetch = [&](int tile) {
    const int t0 = 64 * tile;
#pragma unroll
    for (int m = 0; m < 7; ++m) {
      const int tt = t0 + rb - 3 + m;
      xin[m] = (u32x4){0, 0, 0, 0};
      if (tt >= 0 && tt < T_) xin[m] = *(const u32x4*)(ws.XA + (size_t)(b * T_ + tt) * 1024 + 128 * g + 8 * cc);
    }
#pragma unroll
    for (int i = 0; i < 8; ++i) {
      const int t = t0 + 8 * ssg + i;
      gav[i] = 0;
      if (t < T_) gav[i] = ws.GA[(size_t)(b * T_ + t) * 1024 + 128 * g + 32 * jq + sc];
    }
  };
  prefetch(0);
  __syncthreads();
#pragma unroll 1
  for (int tile = 0; tile < 33; ++tile) {
    const int t0 = 64 * tile;
#pragma unroll
    for (int r = 0; r < 4; ++r) {
      float y[8];
#pragma unroll
      for (int e = 0; e < 8; ++e) y[e] = cb[e];
#pragma unroll
      for (int k = 0; k < 4; ++k) {
        const u32x4 xv = xin[r + k];
        y[0] += cw[k][0] * bflo(xv.x); y[1] += cw[k][1] * bfhi(xv.x);
        y[2] += cw[k][2] * bflo(xv.y); y[3] += cw[k][3] * bfhi(xv.y);
        y[4] += cw[k][4] * bflo(xv.z); y[5] += cw[k][5] * bfhi(xv.z);
        y[6] += cw[k][6] * bflo(xv.w); y[7] += cw[k][7] * bfhi(xv.w);
      }
      u32x4 pk; pk.x = cvt_pk_bf16(y[0], y[1]); pk.y = cvt_pk_bf16(y[2], y[3]); pk.z = cvt_pk_bf16(y[4], y[5]); pk.w = cvt_pk_bf16(y[6], y[7]);
      *(u32x4*)(XC + (rb + r) * 136 + 8 * cc) = pk;
    }
    float gcur[8];
#pragma unroll
    for (int i = 0; i < 8; ++i) gcur[i] = bf2f(gav[i]);
    __syncthreads();
    if (tile + 1 < 33) prefetch(tile + 1);
    {
      f32x4 ga_[2][2];
#pragma unroll
      for (int a = 0; a < 2; ++a)
#pragma unroll
        for (int bb = 0; bb < 2; ++bb) ga_[a][bb] = (f32x4){0.f, 0.f, 0.f, 0.f};
#pragma unroll
      for (int ks = 0; ks < 4; ++ks) {
        const bf16x8 xf = *(const bf16x8*)(XC + (16 * w + lr) * 136 + 32 * ks + 8 * lq);
#pragma unroll
        for (int gate = 0; gate < 2; ++gate)
#pragma unroll
          for (int mt = 0; mt < 2; ++mt) {
            const bf16x8 wf = *(const bf16x8*)(WG + (gate * 32 + 16 * mt + lr) * 136 + 32 * ks + 8 * lq);
            ga_[gate][mt] = MFMA16(wf, xf, ga_[gate][mt]);
          }
      }
      const int tok = 16 * w + lr;
#pragma unroll
      for (int mt = 0; mt < 2; ++mt)
#pragma unroll
        for (int jj = 0; jj < 4; ++jj) {
          const int n = 16 * mt + 4 * lq + jj;
          const float xcv = bf2f(XC[tok * 136 + 32 * jq + n]);
          const float r = sigmoidf_(ga_[0][mt][jj] + ba[mt][jj]);
          const float ig = sigmoidf_(ga_[1][mt][jj] + bx[mt][jj]);
          const float la = -r * sp[mt][jj];
          const float a = __expf(la);
          const float x2 = 2.f * la;
          const float om = x2 > -0.02f ? -x2 * (1.f + 0.5f * x2 * (1.f + x2 * (1.f / 3.f))) : 1.f - a * a;
          const float mult = sqrtf(fmaxf(om, 0.f));
          AUa[tok * 33 + n] = a;
          AUu[tok * 33 + n] = mult * ig * xcv;
        }
    }
    __syncthreads();
    {
      float A = 1.f, Hh = 0.f;
#pragma unroll
      for (int i = 0; i < 8; ++i) {
        const float a = AUa[(8 * ssg + i) * 33 + sc], uu = AUu[(8 * ssg + i) * 33 + sc];
        Hh = a * Hh + uu; A *= a;
      }
      SEGA[ssg * 32 + sc] = A; SEGH[ssg * 32 + sc] = Hh;
    }
    __syncthreads();
    float hin = CARRY[sc];
#pragma unroll
    for (int s2 = 0; s2 < 7; ++s2)
      if (s2 < ssg) hin = SEGA[s2 * 32 + sc] * hin + SEGH[s2 * 32 + sc];
    __syncthreads();
    {
      float h = hin;
#pragma unroll
      for (int i = 0; i < 8; ++i) {
        const float a = AUa[(8 * ssg + i) * 33 + sc], uu = AUu[(8 * ssg + i) * 33 + sc];
        h = a * h + uu;
        const int t = t0 + 8 * ssg + i;
        if (t < T_ && !dry) ws.GA[(size_t)(b * T_ + t) * 1024 + 128 * g + 32 * jq + sc] = f2bf(h * siluf_(gcur[i]));
      }
      if (ssg == 7) CARRY[sc] = h;
    }
  }
  __syncthreads();
}

__device__ __forceinline__ void phase_gla_norm(const Params& p, const WS& ws, int j) {
  const size_t gtid = (size_t)opaque_bid() * 256 + opaque_tid(), gsz = (size_t)gridDim.x * 256;
  const float* gn = p.ab_gla_norm + j * 256;
#pragma unroll 4
  for (size_t idx = gtid; idx < (size_t)M_ * 128; idx += gsz) {
    const size_t row = idx >> 7; const int c8 = (int)(idx & 127); const int hd = c8 >> 5; const int dv = (c8 & 31) * 8;
    const float4 s0 = *(const float4*)(ws.SSQ + row * 32 + hd * 8), s1 = *(const float4*)(ws.SSQ + row * 32 + hd * 8 + 4);
    const float ssum = (s0.x + s0.y + s0.z + s0.w) + (s1.x + s1.y + s1.z + s1.w);
    const float rstd = rsqrtf(ssum * (1.f / 256.f) + EPS_);
    const u32x4 ov = *(const u32x4*)(ws.V + row * 1024 + c8 * 8);
    const u32x4 gv = *(const u32x4*)(ws.GB + row * 1024 + c8 * 8);
    const float4 g0 = *(const float4*)(gn + dv), g1 = *(const float4*)(gn + dv + 4);
    float o[8] = {bflo(ov.x), bfhi(ov.x), bflo(ov.y), bfhi(ov.y), bflo(ov.z), bfhi(ov.z), bflo(ov.w), bfhi(ov.w)};
    const float gg[8] = {bflo(gv.x), bfhi(gv.x), bflo(gv.y), bfhi(gv.y), bflo(gv.z), bfhi(gv.z), bflo(gv.w), bfhi(gv.w)};
    const float nn[8] = {g0.x, g0.y, g0.z, g0.w, g1.x, g1.y, g1.z, g1.w};
#pragma unroll
    for (int e = 0; e < 8; ++e) o[e] = o[e] * rstd * nn[e] * siluf_(gg[e]);
    u32x4 pk; pk.x = cvt_pk_bf16(o[0], o[1]); pk.y = cvt_pk_bf16(o[2], o[3]); pk.z = cvt_pk_bf16(o[4], o[5]); pk.w = cvt_pk_bf16(o[6], o[7]);
    *(u32x4*)(ws.V + row * 1024 + c8 * 8) = pk;
  }
}

__device__ __forceinline__ void attn_unit(const WS& ws, int u, bool dry = false) {
  const int qb = 16 - (u >> 7); const int bh = u & 127; const int hd = bh & 15, b = bh >> 4;
  bf16_t* Kt = (bf16_t*)smem;
  bf16_t* Vl = Kt + 2 * 64 * 104;
  const int tid = opaque_tid(), lane = tid & 63, w = tid >> 6, lr = lane & 15, lq = lane >> 4;
  const int q0 = 128 * qb;
  int nkt = 2 * qb + 2; if (nkt > 33) nkt = 33;
  bf16x8 xq[2][3];
  int qi[2];
#pragma unroll
  for (int nt = 0; nt < 2; ++nt) {
    qi[nt] = q0 + 32 * w + 16 * nt + lr;
    const int qc = qi[nt] < T_ ? qi[nt] : T_ - 1;
#pragma unroll
    for (int ks = 0; ks < 2; ++ks)
      xq[nt][ks] = *(const bf16x8*)(ws.QB + (size_t)(b * T_ + qc) * 1536 + hd * 96 + 32 * ks + 8 * lq);
    {
      const u32x4 raw = *(const u32x4*)(ws.QB + (size_t)(b * T_ + qc) * 1536 + hd * 96 + 64 + 8 * lq);
      u32x4 oth;
      oth.x = __shfl_xor(raw.x, 32); oth.y = __shfl_xor(raw.y, 32); oth.z = __shfl_xor(raw.z, 32); oth.w = __shfl_xor(raw.w, 32);
      const float sgn = lq < 2 ? -1.f : 1.f;
      const float2* rp = ws.ROPE + (size_t)(b * T_ + qc) * 16 + 8 * (lq & 1);
      const unsigned rw[4] = {raw.x, raw.y, raw.z, raw.w}, ow[4] = {oth.x, oth.y, oth.z, oth.w};
      unsigned res[4];
#pragma unroll
      for (int e = 0; e < 4; ++e) {
        const float2 c0 = rp[2 * e], c1 = rp[2 * e + 1];
        const float r0 = bflo(rw[e]) * c0.x + sgn * bflo(ow[e]) * c0.y;
        const float r1 = bfhi(rw[e]) * c1.x + sgn * bfhi(ow[e]) * c1.y;
        res[e] = cvt_pk_bf16(r0, r1);
      }
      xq[nt][2] = as_bf16x8((u32x4){res[0], res[1], res[2], res[3]});
    }
  }
  float mrun[2] = {-INFINITY, -INFINITY}, lsum[2] = {0.f, 0.f};
  f32x4 oacc[4][2];
#pragma unroll
  for (int a = 0; a < 4; ++a)
#pragma unroll
    for (int bb = 0; bb < 2; ++bb) oacc[a][bb] = (f32x4){0.f, 0.f, 0.f, 0.f};
  u32x4 kreg[3], vreg[2];
  const bf16_t* vbase = ws.VT + ((size_t)(b * 16 + hd) * 64) * TP_;
  auto loadg = [&](int kt) {
#pragma unroll
    for (int i = 0; i < 3; ++i) {
      const int ci = tid + 256 * i; const int key = ci / 12, ch = ci - key * 12;
      int gk = 64 * kt + key; if (gk > T_ - 1) gk = T_ - 1;
      const bf16_t* src = ch < 8 ? ws.KN + (size_t)(b * T_ + gk) * 1024 + hd * 64 + ch * 8
                                 : ws.KR + (size_t)(b * T_ + gk) * 32 + (ch - 8) * 8;
      kreg[i] = *(const u32x4*)src;
    }
#pragma unroll
    for (int i = 0; i < 2; ++i) {
      const int ci = tid + 256 * i; const int dv = ci >> 3, ch = ci & 7;
      vreg[i] = *(const u32x4*)(vbase + (size_t)dv * TP_ + 64 * kt + ch * 8);
      if (64 * kt + ch * 8 >= T_) vreg[i] = (u32x4){0u, 0u, 0u, 0u};
    }
  };
  auto stores = [&](int buf) {
#pragma unroll
    for (int i = 0; i < 3; ++i) {
      const int ci = tid + 256 * i; const int key = ci / 12, ch = ci - key * 12;
      *(u32x4*)(Kt + buf * 64 * 104 + key * 104 + ch * 8) = kreg[i];
    }
#pragma unroll
    for (int i = 0; i < 2; ++i) {
      const int ci = tid + 256 * i; const int dv = ci >> 3, ch = ci & 7;
      *(u32x4*)(Vl + buf * 64 * 72 + dv * 72 + ch * 8) = vreg[i];
    }
  };
  loadg(0);
  stores(0);
  __syncthreads();
#pragma unroll 1
  for (int kt = 0; kt < nkt; ++kt) {
    const int buf = kt & 1;
    if (kt + 1 < nkt) loadg(kt + 1);
    const bf16_t* Kb = Kt + buf * 64 * 104;
    const bf16_t* Vb = Vl + buf * 64 * 72;
    f32x4 s[4][2];
#pragma unroll
    for (int mt = 0; mt < 4; ++mt) {
      s[mt][0] = (f32x4){0.f, 0.f, 0.f, 0.f}; s[mt][1] = (f32x4){0.f, 0.f, 0.f, 0.f};
#pragma unroll
      for (int ks = 0; ks < 3; ++ks) {
        const bf16x8 kf = *(const bf16x8*)(Kb + (16 * mt + lr) * 104 + 32 * ks + 8 * lq);
        s[mt][0] = MFMA16(kf, xq[0][ks], s[mt][0]);
        s[mt][1] = MFMA16(kf, xq[1][ks], s[mt][1]);
      }
    }
    if (kt >= 2 * qb) {
#pragma unroll
      for (int mt = 0; mt < 4; ++mt)
#pragma unroll
        for (int nt = 0; nt < 2; ++nt)
#pragma unroll
          for (int jj = 0; jj < 4; ++jj) {
            const int key = 64 * kt + 16 * mt + 4 * lq + jj;
            if (key > qi[nt]) s[mt][nt][jj] = -INFINITY;
          }
    }
    bf16x8 pf[2][2];
#pragma unroll
    for (int nt = 0; nt < 2; ++nt) {
      float mx = -INFINITY;
#pragma unroll
      for (int mt = 0; mt < 4; ++mt) mx = fmaxf(mx, fmaxf(fmaxf(s[mt][nt][0], s[mt][nt][1]), fmaxf(s[mt][nt][2], s[mt][nt][3])));
      mx = fmaxf(mx, __shfl_xor(mx, 16)); mx = fmaxf(mx, __shfl_xor(mx, 32));
      const float mnew = fmaxf(mrun[nt], mx);
      const float alpha = __builtin_amdgcn_exp2f(mrun[nt] - mnew);
      mrun[nt] = mnew;
      float ps = 0.f;
#pragma unroll
      for (int mt = 0; mt < 4; ++mt)
#pragma unroll
        for (int jj = 0; jj < 4; ++jj) { const float pv = __builtin_amdgcn_exp2f(s[mt][nt][jj] - mnew); s[mt][nt][jj] = pv; ps += pv; }
      lsum[nt] = lsum[nt] * alpha + ps;
#pragma unroll
      for (int mt = 0; mt < 4; ++mt) oacc[mt][nt] = oacc[mt][nt] * alpha;
#pragma unroll
      for (int ks = 0; ks < 2; ++ks) {
        u32x4 pk;
        pk.x = cvt_pk_bf16(s[2 * ks][nt][0], s[2 * ks][nt][1]); pk.y = cvt_pk_bf16(s[2 * ks][nt][2], s[2 * ks][nt][3]);
        pk.z = cvt_pk_bf16(s[2 * ks + 1][nt][0], s[2 * ks + 1][nt][1]); pk.w = cvt_pk_bf16(s[2 * ks + 1][nt][2], s[2 * ks + 1][nt][3]);
        pf[nt][ks] = as_bf16x8(pk);
      }
    }
#pragma unroll
    for (int mt = 0; mt < 4; ++mt)
#pragma unroll
      for (int ks = 0; ks < 2; ++ks) {
        const u32x2 lo = *(const u32x2*)(Vb + (16 * mt + lr) * 72 + 32 * ks + 4 * lq);
        const u32x2 hi = *(const u32x2*)(Vb + (16 * mt + lr) * 72 + 32 * ks + 16 + 4 * lq);
        const bf16x8 vf = as_bf16x8((u32x4){lo.x, lo.y, hi.x, hi.y});
        oacc[mt][0] = MFMA16(vf, pf[0][ks], oacc[mt][0]);
        oacc[mt][1] = MFMA16(vf, pf[1][ks], oacc[mt][1]);
      }
    if (kt + 1 < nkt) stores(buf ^ 1);
    __syncthreads();
  }
#pragma unroll
  for (int nt = 0; nt < 2; ++nt) {
    float l = lsum[nt];
    l += __shfl_xor(l, 16); l += __shfl_xor(l, 32);
    const float inv = 1.f / l;
    if (qi[nt] < T_) {
      const size_t row = (size_t)(b * T_ + qi[nt]);
#pragma unroll
      for (int mt = 0; mt < 4; ++mt) {
        const u32x2 gv = *(const u32x2*)(ws.GATE + row * 1024 + hd * 64 + 16 * mt + 4 * lq);
        const float o0 = oacc[mt][nt][0] * inv * siluf_(bflo(gv.x)), o1 = oacc[mt][nt][1] * inv * siluf_(bfhi(gv.x));
        const float o2 = oacc[mt][nt][2] * inv * siluf_(bflo(gv.y)), o3 = oacc[mt][nt][3] * inv * siluf_(bfhi(gv.y));
        u32x2 pk; pk.x = cvt_pk_bf16(o0, o1); pk.y = cvt_pk_bf16(o2, o3);
        if (!dry) *(u32x2*)(ws.QB + row * 1536 + hd * 96 + 16 * mt + 4 * lq) = pk;
      }
    }
  }
}

__device__ __forceinline__ void phase_final(const Params& p, const WS& ws) {
  const int tidf = opaque_tid();
  const int lane = tidf & 63;
  const int gw = opaque_bid() * 4 + (tidf >> 6), nw = gridDim.x * 4;
  for (int r = gw; r < 8 * 2048; r += nw) {
    const int b = r >> 11, s = r & 2047;
    const size_t hoff = (size_t)(b * T_ + 16 + s) * 1024;
    float4 v[4];
    float ssum = 0.f;
#pragma unroll
    for (int i = 0; i < 4; ++i) {
      const u32x2 hi = *(const u32x2*)(ws.HHI + hoff + i * 256 + lane * 4), lo = *(const u32x2*)(ws.HLO + hoff + i * 256 + lane * 4);
      v[i] = make_float4(bflo(hi.x) + bflo(lo.x), bfhi(hi.x) + bfhi(lo.x), bflo(hi.y) + bflo(lo.y), bfhi(hi.y) + bfhi(lo.y));
      ssum += v[i].x * v[i].x + v[i].y * v[i].y + v[i].z * v[i].z + v[i].w * v[i].w;
    }
#pragma unroll
    for (int o = 1; o < 64; o <<= 1) ssum += __shfl_xor(ssum, o);
    const float rstd = rsqrtf(ssum * (1.f / 1024.f) + EPS_);
#pragma unroll
    for (int i = 0; i < 4; ++i) {
      const float4 g = *(const float4*)(p.final_norm + i * 256 + lane * 4);
      float4 o; o.x = v[i].x * rstd * g.x; o.y = v[i].y * rstd * g.y; o.z = v[i].z * rstd * g.z; o.w = v[i].w * rstd * g.w;
      *(float4*)(p.out + (size_t)r * 1024 + i * 256 + lane * 4) = o;
    }
  }
}

__global__ void __launch_bounds__(256, 2) fwd_megakernel(Params p) {
  cg::grid_group grid = cg::this_grid();
  if (p.inv_freq[0] < 0.f) grid.sync();
  volatile LAS unsigned* xst = (volatile LAS unsigned*)(smem + SMEM_BYTES);
  if (threadIdx.x == 0) { xst[0] = 0u; xst[1] = 0u; xst[2] = 0u; xst[3] = 0u; }
  __syncthreads();
  const XcdBarrier xb = xcd_barrier_post((unsigned*)(p.ws + BAR_OFF), xst);
  {
    const WS ws = make_ws(p);
    phase_prologue(p, ws);
  }
  xcd_barrier(xb);
#pragma unroll 1
  for (int layer = 0; layer < 4; ++layer) {
    const int j = layer >> 1;
    if ((layer & 1) == 0) {
      {
        const WS ws = make_ws(p);
        const bf16_t* wb = ws.W + (size_t)j * W_PER_J;
#pragma unroll 1
        for (int rep = 0; rep < REP_GEMM; ++rep)
          gemm_stream<true, EPI_E1>(ws, ws.HHI, nullptr, 1024, 1 << 30, 64, wb + W_IN_E, 1024, 1.f / 1024.f, 41, 129 * 41, xcd_bid(opaque_bid()), false);
      }
      xcd_barrier(xb);
      {
        const WS ws = make_ws(p);
#pragma unroll 1
        for (int u = opaque_bid(); u < 8 * 4 * 33; u += gridDim.x) gla_decay_unit(p, ws, j, u);
      }
      xcd_barrier(xb);
      {
#pragma unroll 1
        for (int rep = 0; rep < REP_E2; ++rep)
#pragma unroll 1
        for (int u = opaque_bid(); u < 512; u += gridDim.x) {
          if (u & 1) { const WS ws = make_ws(p); rglru_unit(p, ws, j, u >> 1, rep < REP_E2 - 1); }
          else { const WS ws = make_ws(p); gla_unit(p, ws, u >> 1, rep < REP_E2 - 1); }
        }
      }
      xcd_barrier(xb);
      {
        const WS ws = make_ws(p);
        phase_gla_norm(p, ws, j);
      }
      xcd_barrier(xb);
      {
        const WS ws = make_ws(p);
        const bf16_t* wb = ws.W + (size_t)j * W_PER_J;
#pragma unroll 1
        for (int rep = 0; rep < REP_GEMM; ++rep)
          gemm_stream<false, EPI_RES>(ws, ws.GA, ws.V, 1024, 16, 64, wb + W_OUT_E, 2048, 0.f, 8, 129 * 8, xcd_bid(opaque_bid()), rep < REP_GEMM - 1);
      }
      xcd_barrier(xb);
    } else {
      {
        const WS ws = make_ws(p);
        const bf16_t* wb = ws.W + (size_t)j * W_PER_J;
#pragma unroll 1
        for (int rep = 0; rep < REP_GEMM; ++rep)
          gemm_stream<true, EPI_O1>(ws, ws.HHI, nullptr, 1024, 1 << 30, 64, wb + W_IN_O, 1024, 1.f / 1024.f, 15, 129 * 15, xcd_bid(opaque_bid()), false);
      }
      xcd_barrier(xb);
      {
        const WS ws = make_ws(p);
        const bf16_t* wb = ws.W + (size_t)j * W_PER_J;
#pragma unroll 1
        for (int rep = 0; rep < REP_GEMM; ++rep) {
          gemm_stream<true, EPI_Q>(ws, ws.CQ, nullptr, 512, 1 << 30, 64, wb + W_Q, 512, 1.f / 512.f, 12, 129 * 12, xcd_bid(opaque_bid()), false);
          gemm_stream<true, EPI_KV>(ws, ws.CKV, nullptr, 256, 1 << 30, 64, wb + W_KV, 256, 1.f / 256.f, 16, 129 * 16, xcd_bid((opaque_bid() + (int)(gridDim.x >> 1)) % (int)gridDim.x), false);
        }
      }
      xcd_barrier(xb);
      {
        const WS ws = make_ws(p);
#pragma unroll 1
        for (int rep = 0; rep < REP_ATTN; ++rep)
#pragma unroll 1
        for (int r = 0, b0 = opaque_bid(); r * (int)gridDim.x < 17 * 128; ++r) {
          const int u = r * (int)gridDim.x + ((r & 1) ? (int)gridDim.x - 1 - b0 : b0);
          if (u < 17 * 128) attn_unit(ws, u, rep < REP_ATTN - 1);
          __syncthreads();
        }
      }
      xcd_barrier(xb);
      {
        const WS ws = make_ws(p);
        const bf16_t* wb = ws.W + (size_t)j * W_PER_J;
#pragma unroll 1
        for (int rep = 0; rep < REP_GEMM; ++rep)
          gemm_stream<false, EPI_RES>(ws, ws.QB, nullptr, 1536, 1 << 30, 96, wb + W_O, 1024, 0.f, 8, 129 * 8, xcd_bid(opaque_bid()), rep < REP_GEMM - 1);
      }
      xcd_barrier(xb);
    }
  }
  {
    const WS ws = make_ws(p);
    phase_final(p, ws);
  }
}

extern "C" void kernel_launch(void* const* d_in, const int* in_sizes, int n_in, void* d_out, int out_size, void* d_ws,
                              size_t ws_size, hipStream_t stream) {
  static int grid_blocks = 0;
  if (!grid_blocks) {
    int dev = 0, cus = 0, per_cu = 0;
    hipGetDevice(&dev);
    hipDeviceGetAttribute(&cus, hipDeviceAttributeMultiprocessorCount, dev);
    hipOccupancyMaxActiveBlocksPerMultiprocessor(&per_cu, fwd_megakernel, 256, 0);
    if (per_cu < 1) per_cu = 1;
    if (per_cu > 2) per_cu = 2;
    grid_blocks = cus * per_cu;
  }
  Params p{};
  p.x = (const float*)d_in[0]; p.positions = (const int*)d_in[1]; p.meta = (const float*)d_in[2];
  p.ab_norm = (const float*)d_in[3]; p.ab_w_in = (const float*)d_in[4]; p.ab_conv_w = (const float*)d_in[5];
  p.ab_conv_b = (const float*)d_in[6]; p.ab_gate_a_w = (const float*)d_in[7]; p.ab_gate_a_b = (const float*)d_in[8];
  p.ab_gate_x_w = (const float*)d_in[9]; p.ab_gate_x_b = (const float*)d_in[10]; p.ab_lam = (const float*)d_in[11];
  p.ab_alpha_w = (const float*)d_in[12]; p.ab_alpha_b = (const float*)d_in[13]; p.ab_gla_norm = (const float*)d_in[14];
  p.ab_w_out = (const float*)d_in[15]; p.c_norm = (const float*)d_in[16]; p.c_w_in = (const float*)d_in[17];
  p.c_q_norm = (const float*)d_in[18]; p.c_w_q_up = (const float*)d_in[19]; p.c_kv_norm = (const float*)d_in[20];
  p.c_w_kv_up = (const float*)d_in[21]; p.c_w_out = (const float*)d_in[22]; p.final_norm = (const float*)d_in[23];
  p.out = (float*)d_out;
  p.ws = (unsigned char*)d_ws;
  for (int i = 0; i < 16; ++i) p.inv_freq[i] = (float)pow(10000.0, -(double)i / 16.0);
  hipMemsetAsync((unsigned char*)d_ws + BAR_OFF, 0, XCD_BAR_WORDS * 4, stream);
  void* args[] = {&p};
  hipError_t e = hipLaunchCooperativeKernel((void*)fwd_megakernel, dim3(grid_blocks), dim3(256), args, 0, stream);
  if (e != hipSuccess) fprintf(stderr, "cooperative launch failed: %s (grid %d)\n", hipGetErrorString(e), grid_blocks);
}
```

```cpp
#include <hip/hip_runtime.h>
#include <hip/hip_cooperative_groups.h>
#include <cstdio>
#include <cmath>
namespace cg = cooperative_groups;

typedef unsigned short bf16_t;
typedef short bf16x8 __attribute__((ext_vector_type(8)));
typedef float f32x4 __attribute__((ext_vector_type(4)));
typedef unsigned u32x4 __attribute__((ext_vector_type(4)));
typedef unsigned u32x2 __attribute__((ext_vector_type(2)));

constexpr int T_ = 2064;
constexpr int M_ = 8 * T_;
constexpr int TP_ = 2112;
constexpr float EPS_ = 1e-6f;
constexpr int SMEM_BYTES = 75776;
constexpr float QSCALE_MLA = 0.10206207261596575f * 1.4426950408889634f;

constexpr size_t W_PER_J = 11796480;
constexpr size_t W_IN_E = 0, W_OUT_E = 5373952, W_IN_O = 7471104, W_Q = 9437184, W_KV = 10223616, W_O = 10747904;

struct Params {
  const float* x; const int* positions; const float* meta;
  const float *ab_norm, *ab_w_in, *ab_conv_w, *ab_conv_b, *ab_gate_a_w, *ab_gate_a_b, *ab_gate_x_w, *ab_gate_x_b,
      *ab_lam, *ab_alpha_w, *ab_alpha_b, *ab_gla_norm, *ab_w_out;
  const float *c_norm, *c_w_in, *c_q_norm, *c_w_q_up, *c_kv_norm, *c_w_kv_up, *c_w_out, *final_norm;
  float* out;
  unsigned char* ws;
  float inv_freq[16];
};

struct WS {
  bf16_t *HHI, *HLO; float2* ROPE;
  bf16_t *XA, *GA, *Q, *K, *V, *GB, *AD; float* SSQ; float* BL;
  bf16_t *CQ, *CKV, *GATE, *KR, *QB, *KN, *VT;
  bf16_t* W;
};

__device__ __forceinline__ unsigned char* opaque_ptr(unsigned char* q) {
  unsigned lo = (unsigned)(unsigned long long)q, hi = (unsigned)((unsigned long long)q >> 32);
  asm volatile("" : "+v"(lo), "+v"(hi));
  lo = __builtin_amdgcn_readfirstlane(lo); hi = __builtin_amdgcn_readfirstlane(hi);
  typedef __attribute__((address_space(1))) unsigned char gu8;
  return (unsigned char*)(gu8*)(((unsigned long long)hi << 32) | lo);
}
__device__ __forceinline__ WS make_ws(const Params& p) {
  WS w;
  unsigned char* b = opaque_ptr(p.ws);
  w.HHI = (bf16_t*)b; b += (size_t)M_ * 2048;
  w.HLO = (bf16_t*)b; b += (size_t)M_ * 2048;
  w.ROPE = (float2*)b; b += (size_t)M_ * 128;
  unsigned char* r = b;
  w.XA = (bf16_t*)r; r += (size_t)M_ * 2048;
  w.GA = (bf16_t*)r; r += (size_t)M_ * 2048;
  w.Q = (bf16_t*)r; r += (size_t)M_ * 1024;
  w.K = (bf16_t*)r; r += (size_t)M_ * 1024;
  w.V = (bf16_t*)r; r += (size_t)M_ * 2048;
  w.GB = (bf16_t*)r; r += (size_t)M_ * 2048;
  w.AD = (bf16_t*)r; r += (size_t)M_ * 32;
  w.SSQ = (float*)r; r += (size_t)M_ * 128;
  w.BL = (float*)r; r += (size_t)8 * 4 * 33 * 128 * 4;
  r = b;
  w.CQ = (bf16_t*)r; r += (size_t)M_ * 1024;
  w.CKV = (bf16_t*)r; r += (size_t)M_ * 512;
  w.GATE = (bf16_t*)r; r += (size_t)M_ * 2048;
  w.KR = (bf16_t*)r; r += (size_t)M_ * 64;
  w.QB = (bf16_t*)r; r += (size_t)M_ * 3072;
  w.KN = (bf16_t*)r; r += (size_t)M_ * 2048;
  w.VT = (bf16_t*)r; r += (size_t)128 * 64 * TP_ * 2;
  w.W = (bf16_t*)opaque_ptr((unsigned char*)p.out);
  return w;
}

__device__ __forceinline__ unsigned cvt_pk_bf16(float lo, float hi) {
  unsigned r; asm("v_cvt_pk_bf16_f32 %0, %1, %2" : "=v"(r) : "v"(lo), "v"(hi)); return r;
}
__device__ __forceinline__ float bf2f(bf16_t v) { return __uint_as_float(((unsigned)v) << 16); }
__device__ __forceinline__ float bflo(unsigned v) { return __uint_as_float(v << 16); }
__device__ __forceinline__ float bfhi(unsigned v) { return __uint_as_float(v & 0xffff0000u); }
__device__ __forceinline__ bf16_t f2bf(float f) { return (bf16_t)(cvt_pk_bf16(f, 0.f) & 0xffffu); }
__device__ __forceinline__ float sigmoidf_(float x) { return __builtin_amdgcn_rcpf(1.f + __expf(-x)); }
__device__ __forceinline__ float siluf_(float x) { return x * __builtin_amdgcn_rcpf(1.f + __expf(-x)); }
__device__ __forceinline__ bf16x8 as_bf16x8(u32x4 v) { return __builtin_bit_cast(bf16x8, v); }
__device__ __forceinline__ int opaque_tid() { int t = threadIdx.x; asm volatile("" : "+v"(t)); return t; }
__device__ __forceinline__ int xcd_bid(int bid) { const int gpx = gridDim.x >> 3; return (bid & 7) * gpx + (bid >> 3); }
__device__ __forceinline__ int opaque_bid() { int t = blockIdx.x; asm volatile("" : "+s"(t)); return t; }
#define MFMA16(a, b, c) __builtin_amdgcn_mfma_f32_16x16x32_bf16((a), (b), (c), 0, 0, 0)

__shared__ __attribute__((aligned(16))) unsigned char smem[SMEM_BYTES + 16];

#define XB_TMO      128
#define XB_XCNT(j)  (256  + 64 * (j))
#define XB_XSUB(j)  (1280 + 64 * (j))
#define XB_XGEN(j)  (2304 + 64 * (j))
#define XB_TOP      3328
#define XB_TOPGEN   3392
#define XCD_BAR_WORDS 3456
#define XB_SPIN_CAP (1u << 18)
#define LAS __attribute__((address_space(3)))
constexpr size_t BAR_OFF = 260046848;

__device__ __forceinline__ unsigned xb_ld(unsigned* p)              { return __hip_atomic_load(p, __ATOMIC_RELAXED, __HIP_MEMORY_SCOPE_AGENT); }
__device__ __forceinline__ unsigned xb_add(unsigned* p, unsigned v) { return __hip_atomic_fetch_add(p, v, __ATOMIC_RELAXED, __HIP_MEMORY_SCOPE_AGENT); }
__device__ __forceinline__ unsigned xb_xcc_id() { return (unsigned)__builtin_amdgcn_s_getreg((3 << 11) | 20) & 0xFu; }
#define XB_SPIN(cond, bar) do { unsigned _sp = 0; while (cond) { __builtin_amdgcn_s_sleep(1); \
    if ((++_sp & 255u) == 0u) { if (xb_ld(&(bar)[XB_TMO])) break; if (_sp > XB_SPIN_CAP) { atomicAdd(&(bar)[XB_TMO], 1u); break; } } } } while (0)

struct XcdBarrier { unsigned* bar; unsigned x; volatile LAS unsigned* st; };

__device__ __forceinline__ XcdBarrier xcd_barrier_post(unsigned* bar, volatile LAS unsigned* st) {
    XcdBarrier b; b.bar = bar; b.x = xb_xcc_id(); b.st = st;
    if (threadIdx.x == 0) (void)xb_add(&bar[XB_XCNT(b.x)], 1u);
    return b;
}
__device__ __forceinline__ void xcd_barrier_complete(unsigned* bar, unsigned x, unsigned& nloc, unsigned& nx) {
    const unsigned G = gridDim.x * gridDim.y * gridDim.z;
    unsigned sum, cnt, mine, sp = 0u;
    for (;;) {
        sum = 0u; cnt = 0u; mine = 0u;
#pragma unroll
        for (unsigned j = 0; j < 16; ++j) { const unsigned c = xb_ld(&bar[XB_XCNT(j)]); sum += c; cnt += (c > 0u) ? 1u : 0u; mine = (j == x) ? c : mine; }
        if (sum == G) break;
        __builtin_amdgcn_s_sleep(1);
        if ((++sp & 255u) == 0u) { if (xb_ld(&bar[XB_TMO])) break; if (sp > XB_SPIN_CAP) { atomicAdd(&bar[XB_TMO], 1u); break; } }
    }
    nloc = mine > 0u ? mine : 1u; nx = cnt > 0u ? cnt : 1u;
}
__device__ __forceinline__ void xcd_barrier(const XcdBarrier& b) {
    asm volatile("s_waitcnt vmcnt(0)" ::: "memory");
    __syncthreads();
    if (threadIdx.x == 0) {
        unsigned* bar = b.bar;
        __builtin_amdgcn_s_waitcnt(0);
        unsigned nloc = b.st[0], nx = b.st[1];
        if (nloc == 0u) { xcd_barrier_complete(bar, b.x, nloc, nx); b.st[0] = nloc; b.st[1] = nx; }
        const unsigned old = xb_add(&bar[XB_XSUB(b.x)], 1u);
        const unsigned gen = old / nloc;
        if (old + 1u == (gen + 1u) * nloc) {
            __builtin_amdgcn_fence(__ATOMIC_RELEASE, "agent");
            asm volatile("s_waitcnt vmcnt(0)" ::: "memory");
            const unsigned og = xb_add(&bar[XB_TOP], 1u);
            const unsigned tg = og / nx;
            if (og + 1u == (tg + 1u) * nx) xb_add(&bar[XB_TOPGEN], 1u);
            else XB_SPIN(xb_ld(&bar[XB_TOPGEN]) == tg, bar);
            __builtin_amdgcn_fence(__ATOMIC_ACQUIRE, "agent");
            xb_add(&bar[XB_XGEN(b.x)], 1u);
            asm volatile("s_waitcnt vmcnt(0)" ::: "memory");
        } else {
            XB_SPIN(xb_ld(&bar[XB_XGEN(b.x)]) == gen, bar);
            __builtin_amdgcn_fence(__ATOMIC_ACQUIRE, "agent");
            asm volatile("s_waitcnt vmcnt(0)" ::: "memory");
        }
    }
    __syncthreads();
}


__device__ __forceinline__ int map_even_in(int n) { return n < 4096 ? n : (n < 5120 ? n + 16 : (n < 5136 ? n - 1024 : -1)); }
__device__ __forceinline__ int map_odd_in(int n) { return n < 768 ? n : (n < 1792 ? n + 32 : (n < 1824 ? n - 1024 : -1)); }

__device__ __forceinline__ void convert_tile(const float* __restrict__ src, int K, int Nsrc, bf16_t* __restrict__ dst,
                                             int kind, const float* __restrict__ g, int tile) {
  float* tl = (float*)smem;
  const int nkt = K >> 7;
  const int ntile = tile / nkt, ktile = tile - ntile * nkt;
  const int n0 = ntile * 64, k0 = ktile * 128;
  const int tid = opaque_tid();
  const int nl = tid & 63, kq = tid >> 6;
  const int n = n0 + nl;
  const int sc = kind == 0 ? map_even_in(n) : (kind == 1 ? map_odd_in(n) : n);
  float cs = 1.f;
  if (kind == 0 && n >= 2048 && n < 2560) cs = 0.08838834764831845f;
  if (kind == 2) cs = QSCALE_MLA;
  float v[32];
#pragma unroll
  for (int i = 0; i < 32; ++i) {
    const int kl = kq + 4 * i;
    v[i] = 0.f;
    if (sc >= 0) v[i] = src[(size_t)(k0 + kl) * Nsrc + sc];
  }
#pragma unroll
  for (int i = 0; i < 32; ++i) {
    const int kl = kq + 4 * i;
    float t = v[i] * cs;
    if (g) t *= g[k0 + kl];
    tl[kl * 65 + nl] = t;
  }
  __syncthreads();
#pragma unroll
  for (int i = 0; i < 4; ++i) {
    const int c = tid + 256 * i;
    const int nl2 = c >> 4, kc = c & 15;
    float t[8];
#pragma unroll
    for (int jj = 0; jj < 8; ++jj) t[jj] = tl[(kc * 8 + jj) * 65 + nl2];
    u32x4 pk;
    pk.x = cvt_pk_bf16(t[0], t[1]); pk.y = cvt_pk_bf16(t[2], t[3]); pk.z = cvt_pk_bf16(t[4], t[5]); pk.w = cvt_pk_bf16(t[6], t[7]);
    *(u32x4*)(dst + (size_t)(n0 + nl2) * K + k0 + kc * 8) = pk;
  }
  __syncthreads();
}

__device__ __forceinline__ void phase_prologue(const Params& p, const WS& ws) {
  for (int id = opaque_bid(); id < 2880; id += gridDim.x) {
    const int j = id / 1440; int r = id - j * 1440;
    bf16_t* wb = ws.W + (size_t)j * W_PER_J;
    if (r < 656) convert_tile(p.ab_w_in + (size_t)j * 1024 * 5136, 1024, 5136, wb + W_IN_E, 0, p.ab_norm + j * 1024, r);
    else if ((r -= 656) < 256) convert_tile(p.ab_w_out + (size_t)j * 2048 * 1024, 2048, 1024, wb + W_OUT_E, 3, nullptr, r);
    else if ((r -= 256) < 240) convert_tile(p.c_w_in + (size_t)j * 1024 * 1824, 1024, 1824, wb + W_IN_O, 1, p.c_norm + j * 1024, r);
    else if ((r -= 240) < 96) convert_tile(p.c_w_q_up + (size_t)j * 512 * 1536, 512, 1536, wb + W_Q, 2, p.c_q_norm + j * 512, r);
    else if ((r -= 96) < 64) convert_tile(p.c_w_kv_up + (size_t)j * 256 * 2048, 256, 2048, wb + W_KV, 3, p.c_kv_norm + j * 256, r);
    else { r -= 64; convert_tile(p.c_w_out + (size_t)j * 1024 * 1024, 1024, 1024, wb + W_O, 3, nullptr, r); }
  }
  const size_t gtid = (size_t)opaque_bid() * 256 + opaque_tid(), gsz = (size_t)gridDim.x * 256;
  for (size_t idx0 = gtid; idx0 < (size_t)M_ * 256; idx0 += 4 * gsz) {
    float4 v4[4];
#pragma unroll
    for (int q = 0; q < 4; ++q) {
      const size_t idx = idx0 + q * gsz;
      v4[q] = make_float4(0.f, 0.f, 0.f, 0.f);
      if (idx < (size_t)M_ * 256) {
        const int row = (int)(idx >> 8), c4 = (int)(idx & 255);
        const int b = row / T_, t = row - b * T_;
        const float* src = t < 16 ? p.meta + (size_t)t * 1024 : p.x + ((size_t)b * 2048 + (t - 16)) * 1024;
        v4[q] = *(const float4*)(src + c4 * 4);
      }
    }
#pragma unroll
    for (int q = 0; q < 4; ++q) {
      const size_t idx = idx0 + q * gsz;
      if (idx < (size_t)M_ * 256) {
        const float4 v = v4[q];
        u32x2 hi; hi.x = cvt_pk_bf16(v.x, v.y); hi.y = cvt_pk_bf16(v.z, v.w);
        u32x2 lo; lo.x = cvt_pk_bf16(v.x - bflo(hi.x), v.y - bfhi(hi.x)); lo.y = cvt_pk_bf16(v.z - bflo(hi.y), v.w - bfhi(hi.y));
        *(u32x2*)(ws.HHI + idx * 4) = hi;
        *(u32x2*)(ws.HLO + idx * 4) = lo;
      }
    }
  }
  for (size_t idx = gtid; idx < (size_t)M_ * 16; idx += gsz) {
    const int row = (int)(idx >> 4), i = (int)(idx & 15);
    const int b = row / T_, t = row - b * T_;
    const int pos = t < 16 ? t : p.positions[b * 2048 + (t - 16)] + 16;
    const float angf = (float)pos * p.inv_freq[i];
    const double rev = (double)angf * 0.15915494309189533577;
    const float fr = (float)(rev - rint(rev));
    ws.ROPE[idx] = make_float2(__builtin_amdgcn_cosf(fr), __builtin_amdgcn_sinf(fr));
  }
}

#ifndef REP_GEMM
#define REP_GEMM 1
#endif
#ifndef REP_ATTN
#define REP_ATTN 1
#endif
#ifndef REP_E2
#define REP_E2 1
#endif
enum { EPI_E1 = 0, EPI_O1 = 1, EPI_Q = 2, EPI_KV = 3, EPI_RES = 4 };

template <int EPI>
__device__ __forceinline__ void gemm_epilogue(const WS& ws, const f32x4 (&acc)[4][4], const float (&rs)[4], int tok0, int n0,
                                              int wm, int wn, int lr, int lq, bool dry) {
  const int tokw = tok0 + wn * 64 + lr;
  const int nw = n0 + wm * 64;
  if (EPI == EPI_E1) {
    bf16_t* dst; int ld, c;
    if (n0 < 1024) { dst = ws.XA; ld = 1024; c = n0; }
    else if (n0 < 2048) { dst = ws.GA; ld = 1024; c = n0 - 1024; }
    else if (n0 < 2560) { dst = ws.Q; ld = 512; c = n0 - 2048; }
    else if (n0 < 3072) { dst = ws.K; ld = 512; c = n0 - 2560; }
    else if (n0 < 4096) { dst = ws.V; ld = 1024; c = n0 - 3072; }
    else if (n0 < 5120) { dst = ws.GB; ld = 1024; c = n0 - 4096; }
    else { dst = ws.AD; ld = 16; c = 0; }
    const bool isad = n0 >= 5120;
#pragma unroll
    for (int ni = 0; ni < 4; ++ni) {
      if (isad && (wm != 0 || ni != 0)) continue;
#pragma unroll
      for (int ti = 0; ti < 4; ++ti) {
        const f32x4 v = acc[ni][ti] * rs[ti];
        u32x2 pk; pk.x = cvt_pk_bf16(v[0], v[1]); pk.y = cvt_pk_bf16(v[2], v[3]);
        *(u32x2*)(dst + (size_t)(tokw + ti * 16) * ld + c + wm * 64 + ni * 16 + 4 * lq) = pk;
      }
    }
  } else if (EPI == EPI_O1) {
    if (n0 < 1792) {
      bf16_t* dst; int ld, c;
      if (n0 < 512) { dst = ws.CQ; ld = 512; c = n0; }
      else if (n0 < 768) { dst = ws.CKV; ld = 256; c = n0 - 512; }
      else { dst = ws.GATE; ld = 1024; c = n0 - 768; }
#pragma unroll
      for (int ni = 0; ni < 4; ++ni)
#pragma unroll
        for (int ti = 0; ti < 4; ++ti) {
          const f32x4 v = acc[ni][ti] * rs[ti];
          u32x2 pk; pk.x = cvt_pk_bf16(v[0], v[1]); pk.y = cvt_pk_bf16(v[2], v[3]);
          *(u32x2*)(dst + (size_t)(tokw + ti * 16) * ld + c + wm * 64 + ni * 16 + 4 * lq) = pk;
        }
    } else if (wm == 0) {
#pragma unroll
      for (int ti = 0; ti < 4; ++ti) {
        const int tok = tokw + ti * 16;
        const f32x4 x1 = acc[0][ti] * rs[ti], x2 = acc[1][ti] * rs[ti];
        float o1[4], o2[4];
#pragma unroll
        for (int jj = 0; jj < 4; ++jj) {
          const float2 cs = ws.ROPE[(size_t)tok * 16 + 4 * lq + jj];
          o1[jj] = x1[jj] * cs.x - x2[jj] * cs.y;
          o2[jj] = x2[jj] * cs.x + x1[jj] * cs.y;
        }
        u32x2 pk; pk.x = cvt_pk_bf16(o1[0], o1[1]); pk.y = cvt_pk_bf16(o1[2], o1[3]);
        *(u32x2*)(ws.KR + (size_t)tok * 32 + 4 * lq) = pk;
        pk.x = cvt_pk_bf16(o2[0], o2[1]); pk.y = cvt_pk_bf16(o2[2], o2[3]);
        *(u32x2*)(ws.KR + (size_t)tok * 32 + 16 + 4 * lq) = pk;
      }
    }
  } else if (EPI == EPI_Q) {
#pragma unroll
    for (int ni = 0; ni < 4; ++ni)
#pragma unroll
      for (int ti = 0; ti < 4; ++ti) {
        const f32x4 v = acc[ni][ti] * rs[ti];
        u32x2 pk; pk.x = cvt_pk_bf16(v[0], v[1]); pk.y = cvt_pk_bf16(v[2], v[3]);
        *(u32x2*)(ws.QB + (size_t)(tokw + ti * 16) * 1536 + nw + ni * 16 + 4 * lq) = pk;
      }
  } else if (EPI == EPI_KV) {
    const int hd = nw >> 7;
    const bool isv = (nw & 127) >= 64;
    if (!isv) {
#pragma unroll
      for (int ni = 0; ni < 4; ++ni)
#pragma unroll
        for (int ti = 0; ti < 4; ++ti) {
          const f32x4 v = acc[ni][ti] * rs[ti];
          u32x2 pk; pk.x = cvt_pk_bf16(v[0], v[1]); pk.y = cvt_pk_bf16(v[2], v[3]);
          *(u32x2*)(ws.KN + (size_t)(tokw + ti * 16) * 1024 + hd * 64 + ni * 16 + 4 * lq) = pk;
        }
    } else {
#pragma unroll
      for (int ti = 0; ti < 4; ++ti) {
        const int tok = tokw + ti * 16;
        const int b = tok / T_, t = tok - b * T_;
        bf16_t* vb = ws.VT + ((size_t)(b * 16 + hd) * 64) * TP_ + t;
#pragma unroll
        for (int ni = 0; ni < 4; ++ni) {
          const f32x4 v = acc[ni][ti] * rs[ti];
#pragma unroll
          for (int jj = 0; jj < 4; ++jj) vb[(size_t)(ni * 16 + 4 * lq + jj) * TP_] = f2bf(v[jj]);
        }
      }
    }
  } else {
#pragma unroll
    for (int ni = 0; ni < 4; ++ni)
#pragma unroll
      for (int ti = 0; ti < 4; ++ti) {
        const size_t off = (size_t)(tokw + ti * 16) * 1024 + nw + ni * 16 + 4 * lq;
        const u32x2 hi = *(const u32x2*)(ws.HHI + off), lo = *(const u32x2*)(ws.HLO + off);
        const float h0 = bflo(hi.x) + bflo(lo.x) + acc[ni][ti][0], h1 = bfhi(hi.x) + bfhi(lo.x) + acc[ni][ti][1];
        const float h2 = bflo(hi.y) + bflo(lo.y) + acc[ni][ti][2], h3 = bfhi(hi.y) + bfhi(lo.y) + acc[ni][ti][3];
        u32x2 nh; nh.x = cvt_pk_bf16(h0, h1); nh.y = cvt_pk_bf16(h2, h3);
        u32x2 nl; nl.x = cvt_pk_bf16(h0 - bflo(nh.x), h1 - bfhi(nh.x)); nl.y = cvt_pk_bf16(h2 - bflo(nh.y), h3 - bfhi(nh.y));
        if (!dry) { *(u32x2*)(ws.HHI + off) = nh; *(u32x2*)(ws.HLO + off) = nl; }
      }
  }
}

__device__ __forceinline__ float sumsq8(bf16x8 v) {
  const u32x4 u = __builtin_bit_cast(u32x4, v);
  float s = 0.f, t;
  t = bflo(u.x); s += t * t; t = bfhi(u.x); s += t * t; t = bflo(u.y); s += t * t; t = bfhi(u.y); s += t * t;
  t = bflo(u.z); s += t * t; t = bfhi(u.z); s += t * t; t = bflo(u.w); s += t * t; t = bfhi(u.w); s += t * t;
  return s;
}
__device__ __forceinline__ void tile_of(int pos, int ntn, int& mt, int& nt) {
  const int full = 128 * ntn;
  if (pos < full) { const int panel = pos / (8 * ntn); const int rem = pos - panel * 8 * ntn; nt = rem >> 3; mt = panel * 8 + (rem & 7); }
  else { mt = 128; nt = pos - full; }
}
template <bool RS, int EPI>
__device__ __forceinline__ void gemm_stream(const WS& ws, const bf16_t* A0, const bf16_t* A1, int lda, int ktsplit, int kstride,
                                            const bf16_t* __restrict__ W, int K, float invK, int ntn, int ntiles, int bid, bool dry) {
  unsigned char* As = smem;
  unsigned char* Bs = smem + 32768;
  const int tid = opaque_tid(), lane = tid & 63, w = tid >> 6, wm = w >> 1, wn = w & 1, lr = lane & 15, lq = lane >> 4;
  const int G = gridDim.x;
  const int nk = K >> 6;
  if (bid < ntiles) {
    const int my_tiles = (ntiles - 1 - bid) / G + 1;
    const int last_id = bid + (my_tiles - 1) * G;
    const int S = my_tiles * nk;
    f32x4 acc[4][4];
#pragma unroll
    for (int a = 0; a < 4; ++a)
#pragma unroll
      for (int b = 0; b < 4; ++b) acc[a][b] = (f32x4){0.f, 0.f, 0.f, 0.f};
    u32x4 ra0[4], rb0[4], ra1[4], rb1[4];
    float ss[4] = {0.f, 0.f, 0.f, 0.f};
    int l_id = bid, l_kt = 0, c_id = bid, c_kt = 0, st_kt = 0;
    float* rsl = (float*)(smem + 65536);
    const int srow = tid >> 3;
    const int soff = srow * 128 + (((tid & 7) ^ (srow & 7)) << 4);

    auto issue = [&](u32x4 (&ra)[4], u32x4 (&rb)[4]) {
      const int idc = l_id < last_id ? l_id : last_id;
      int mt, nt; tile_of(idc, ntn, mt, nt);
      const bf16_t* A = (l_kt < ktsplit) ? A0 : A1;
      const int kk = (l_kt < ktsplit) ? l_kt : l_kt - ktsplit;
      const bf16_t* ap = A + (size_t)(mt * 128 + srow) * lda + kk * kstride + (tid & 7) * 8;
      const bf16_t* wp = W + (size_t)(nt * 128 + srow) * K + l_kt * 64 + (tid & 7) * 8;
#pragma unroll
      for (int i = 0; i < 4; ++i) {
        ra[i] = *(const u32x4*)(ap + (size_t)i * 32 * lda);
        rb[i] = *(const u32x4*)(wp + (size_t)i * 32 * K);
      }
      if (++l_kt == nk) { l_kt = 0; l_id += G; }
    };
    auto store = [&](const u32x4 (&ra)[4], const u32x4 (&rb)[4], int buf) {
#pragma unroll
      for (int i = 0; i < 4; ++i) {
        if (RS) ss[i] += sumsq8(__builtin_bit_cast(bf16x8, ra[i]));
        *(u32x4*)(As + buf * 16384 + i * 4096 + soff) = ra[i];
        *(u32x4*)(Bs + buf * 16384 + i * 4096 + soff) = rb[i];
      }
      if (RS) {
        if (++st_kt == nk) {
          st_kt = 0;
#pragma unroll
          for (int i = 0; i < 4; ++i) {
            float t = ss[i];
            t += __shfl_xor(t, 1); t += __shfl_xor(t, 2); t += __shfl_xor(t, 4);
            if ((tid & 7) == 0) rsl[srow + 32 * i] = rsqrtf(t * invK + EPS_);
            ss[i] = 0.f;
          }
        }
      }
    };
    auto compute = [&](int buf) {
      const unsigned char* Ab = As + buf * 16384 + (wn * 64 + lr) * 128;
      const unsigned char* Bb = Bs + buf * 16384 + (wm * 64 + lr) * 128;
#pragma unroll
      for (int ks = 0; ks < 2; ++ks) {
        const int sw = ((ks * 4 + lq) ^ (lr & 7)) << 4;
        bf16x8 wf[4], xf[4];
#pragma unroll
        for (int i = 0; i < 4; ++i) {
          wf[i] = *(const bf16x8*)(Bb + i * 2048 + sw);
          xf[i] = *(const bf16x8*)(Ab + i * 2048 + sw);
        }
#pragma unroll
        for (int ni = 0; ni < 4; ++ni)
#pragma unroll
          for (int ti = 0; ti < 4; ++ti) acc[ni][ti] = MFMA16(wf[ni], xf[ti], acc[ni][ti]);
      }
    };
    auto tile_end = [&]() {
      float rs[4] = {1.f, 1.f, 1.f, 1.f};
      if (RS) {
#pragma unroll
        for (int ti = 0; ti < 4; ++ti) rs[ti] = rsl[wn * 64 + ti * 16 + lr];
      }
      int mt, nt; tile_of(c_id, ntn, mt, nt);
      gemm_epilogue<EPI>(ws, acc, rs, mt * 128, nt * 128, wm, wn, lr, lq, dry);
#pragma unroll
      for (int a = 0; a < 4; ++a)
#pragma unroll
        for (int b = 0; b < 4; ++b) acc[a][b] = (f32x4){0.f, 0.f, 0.f, 0.f};
      c_id += G;
    };

    issue(ra0, rb0);
    issue(ra1, rb1);
    store(ra0, rb0, 0);
    __syncthreads();
#pragma unroll 1
    for (int s = 0; s < S; s += 2) {
      issue(ra0, rb0);
      compute(0);
      store(ra1, rb1, 1);
      __syncthreads();
      issue(ra1, rb1);
      compute(1);
      c_kt += 2;
      if (c_kt == nk) { c_kt = 0; tile_end(); }
      store(ra0, rb0, 0);
      __syncthreads();
    }
  }
  __syncthreads();
}

template <bool RS, int EPI>
__device__ __forceinline__ void gemm_glds(const WS& ws, const bf16_t* A0, const bf16_t* A1, int lda, int ktsplit, int kstride,
                                          const bf16_t* __restrict__ W, int K, float invK, int ntn, int ntiles, int bid, bool dry) {
  unsigned char* As = smem;
  unsigned char* Bs = smem + 32768;
  const int tid = opaque_tid(), lane = tid & 63, w = tid >> 6, wm = w >> 1, wn = w & 1, lr = lane & 15, lq = lane >> 4;
  const int G = gridDim.x;
  const int nk = K >> 6;
  if (bid < ntiles) {
    const int my_tiles = (ntiles - 1 - bid) / G + 1;
    const int S = my_tiles * nk;
    f32x4 acc[4][4];
#pragma unroll
    for (int a = 0; a < 4; ++a)
#pragma unroll
      for (int b = 0; b < 4; ++b) acc[a][b] = (f32x4){0.f, 0.f, 0.f, 0.f};
    float ss[4] = {0.f, 0.f, 0.f, 0.f};
    int l_id = bid, l_kt = 0, c_id = bid, c_kt = 0;
    const int lrow = lane >> 3;
    const int lc = (lane & 7) ^ lrow;
    auto issue = [&](int buf) {
      int mt, nt; tile_of(l_id, ntn, mt, nt);
      const bf16_t* A = (l_kt < ktsplit) ? A0 : A1;
      const int kk = (l_kt < ktsplit) ? l_kt : l_kt - ktsplit;
      const bf16_t* ap = A + (size_t)(mt * 128 + w * 32 + lrow) * lda + kk * kstride + lc * 8;
      const bf16_t* wp = W + (size_t)(nt * 128 + w * 32 + lrow) * K + l_kt * 64 + lc * 8;
      unsigned char* la = As + buf * 16384 + w * 4096 + lane * 16;
      unsigned char* lb = Bs + buf * 16384 + w * 4096 + lane * 16;
#pragma unroll
      for (int i = 0; i < 4; ++i) {
        __builtin_amdgcn_global_load_lds((const unsigned*)(ap + (size_t)i * 8 * lda), (unsigned*)(la + i * 1024), 16, 0, 0);
        __builtin_amdgcn_global_load_lds((const unsigned*)(wp + (size_t)i * 8 * K), (unsigned*)(lb + i * 1024), 16, 0, 0);
      }
      if (++l_kt == nk) { l_kt = 0; l_id += G; }
    };
    auto compute = [&](int buf) {
      const unsigned char* Ab = As + buf * 16384 + (wn * 64 + lr) * 128;
      const unsigned char* Bb = Bs + buf * 16384 + (wm * 64 + lr) * 128;
#pragma unroll
      for (int ks = 0; ks < 2; ++ks) {
        const int sw = ((ks * 4 + lq) ^ (lr & 7)) << 4;
        bf16x8 wf[4], xf[4];
#pragma unroll
        for (int i = 0; i < 4; ++i) {
          wf[i] = *(const bf16x8*)(Bb + i * 2048 + sw);
          xf[i] = *(const bf16x8*)(Ab + i * 2048 + sw);
        }
        if (RS) {
#pragma unroll
          for (int i = 0; i < 4; ++i) ss[i] += sumsq8(xf[i]);
        }
#pragma unroll
        for (int ni = 0; ni < 4; ++ni)
#pragma unroll
          for (int ti = 0; ti < 4; ++ti) acc[ni][ti] = MFMA16(wf[ni], xf[ti], acc[ni][ti]);
      }
    };
    auto tile_end = [&]() {
      float rs[4] = {1.f, 1.f, 1.f, 1.f};
      if (RS) {
#pragma unroll
        for (int ti = 0; ti < 4; ++ti) {
          float t = ss[ti];
          t += __shfl_xor(t, 16); t += __shfl_xor(t, 32);
          rs[ti] = rsqrtf(t * invK + EPS_);
          ss[ti] = 0.f;
        }
      }
      int mt, nt; tile_of(c_id, ntn, mt, nt);
      gemm_epilogue<EPI>(ws, acc, rs, mt * 128, nt * 128, wm, wn, lr, lq, dry);
#pragma unroll
      for (int a = 0; a < 4; ++a)
#pragma unroll
        for (int b = 0; b < 4; ++b) acc[a][b] = (f32x4){0.f, 0.f, 0.f, 0.f};
      c_id += G;
    };
    issue(0);
#pragma unroll 1
    for (int s = 0; s < S; ++s) {
      asm volatile("s_waitcnt vmcnt(0)" ::: "memory");
      __builtin_amdgcn_s_barrier();
      asm volatile("" ::: "memory");
      if (s + 1 < S) issue((s + 1) & 1);
      compute(s & 1);
      if (++c_kt == nk) { c_kt = 0; tile_end(); }
    }
  }
  __syncthreads();
}

__device__ __forceinline__ void gla_decay_unit(const Params& p, const WS& ws, int j, int u) {
  const int c = u % 33; const int bh = u / 33; const int hd = bh & 3, b = bh >> 2;
  bf16_t* Qs = (bf16_t*)smem;
  bf16_t* Ks = Qs + 64 * 136;
  float* ADs = (float*)(smem + 2 * 64 * 136 * 2);
  float* HT = ADs + 64 * 16;
  const int tid = opaque_tid();
  const int tbase = 64 * c - 48;
#pragma unroll
  for (int i = 0; i < 4; ++i) {
    const int ci = tid + 256 * i; const int row = ci >> 4, ch = ci & 15; const int t = tbase + row;
    u32x4 qv = (u32x4){0, 0, 0, 0}, kv = (u32x4){0, 0, 0, 0};
    if (t >= 0) {
      qv = *(const u32x4*)(ws.Q + (size_t)(b * T_ + t) * 512 + hd * 128 + ch * 8);
      kv = *(const u32x4*)(ws.K + (size_t)(b * T_ + t) * 512 + hd * 128 + ch * 8);
    }
    *(u32x4*)(Qs + row * 136 + ch * 8) = qv;
    *(u32x4*)(Ks + row * 136 + ch * 8) = kv;
    const int t2 = tbase + (ci >> 4);
    ADs[ci] = t2 >= 0 ? bf2f(ws.AD[(size_t)(b * T_ + t2) * 16 + (ci & 15)]) : 0.f;
  }
  const int d = tid & 127, half = tid >> 7;
  float aw[16];
#pragma unroll
  for (int r = 0; r < 16; ++r) aw[r] = p.ab_alpha_w[(size_t)(j * 16 + r) * 512 + hd * 128 + d];
  const float abias = p.ab_alpha_b[j * 512 + hd * 128 + d];
  __syncthreads();
  float cs[32];
  float run = 0.f;
#pragma unroll
  for (int ii = 0; ii < 32; ++ii) {
    const int row = half * 32 + ii;
    float xv = abias;
#pragma unroll
    for (int r4 = 0; r4 < 4; ++r4) {
      const float4 a4 = *(const float4*)(ADs + row * 16 + r4 * 4);
      xv += a4.x * aw[r4 * 4] + a4.y * aw[r4 * 4 + 1] + a4.z * aw[r4 * 4 + 2] + a4.w * aw[r4 * 4 + 3];
    }
    float la = (fminf(xv, 0.f) - __logf(1.f + __expf(-fabsf(xv)))) * 0.0625f;
    if (tbase + row < 0) la = 0.f;
    run += la;
    cs[ii] = run;
  }
  HT[half * 128 + d] = run;
  __syncthreads();
  const float off = half ? HT[d] : 0.f;
  const float blast = HT[d] + HT[128 + d];
#pragma unroll
  for (int ii = 0; ii < 32; ++ii) {
    const int row = half * 32 + ii;
    const float bb = cs[ii] + off;
    const float eb = __expf(bb), ebi = __expf(-bb);
    Qs[row * 136 + d] = f2bf(bf2f(Qs[row * 136 + d]) * eb);
    Ks[row * 136 + d] = f2bf(bf2f(Ks[row * 136 + d]) * ebi);
  }
  if (half == 0) ws.BL[(size_t)((b * 4 + hd) * 33 + c) * 128 + d] = __expf(blast);
  __syncthreads();
#pragma unroll
  for (int i = 0; i < 4; ++i) {
    const int ci = tid + 256 * i; const int row = ci >> 4, ch = ci & 15; const int t = tbase + row;
    if (t >= 0) {
      *(u32x4*)(ws.Q + (size_t)(b * T_ + t) * 512 + hd * 128 + ch * 8) = *(const u32x4*)(Qs + row * 136 + ch * 8);
      *(u32x4*)(ws.K + (size_t)(b * T_ + t) * 512 + hd * 128 + ch * 8) = *(const u32x4*)(Ks + row * 136 + ch * 8);
    }
  }
  __syncthreads();
}

__device__ __forceinline__ void gla_unit(const Params& p, const WS& ws, int u, bool dry = false) {
  const int sl = u & 7; const int bh = u >> 3; const int hd = bh & 3, b = bh >> 2;
  bf16_t* QDs = (bf16_t*)smem;
  bf16_t* KIs = QDs + 64 * 136;
  bf16_t* KIT = KIs + 64 * 136;
  bf16_t* VTs = KIT + 128 * 72;
  bf16_t* STs = VTs + 32 * 72;
  bf16_t* Ps = STs + 32 * 136;
  const int tid = opaque_tid(), lane = tid & 63, w = tid >> 6, lr = lane & 15, lq = lane >> 4;
  for (int i = tid; i < 32 * 136 / 2; i += 256) ((unsigned*)STs)[i] = 0u;
  f32x4 sacc[2][2];
#pragma unroll
  for (int a = 0; a < 2; ++a)
#pragma unroll
    for (int bb = 0; bb < 2; ++bb) sacc[a][bb] = (f32x4){0.f, 0.f, 0.f, 0.f};
  u32x4 qrA[4], krA[4], vrA, qrB[4], krB[4], vrB;
  float eblA[2], eblB[2];
  const float* BLp = ws.BL + (size_t)((b * 4 + hd) * 33) * 128;
  auto prefetch = [&](int c, u32x4 (&qr)[4], u32x4 (&kr)[4], u32x4& vr, float (&ebl)[2]) {
    const int tbase = 64 * c - 48;
#pragma unroll
    for (int i = 0; i < 4; ++i) {
      const int ci = tid + 256 * i; const int row = ci >> 4, ch = ci & 15; const int t = tbase + row;
      qr[i] = (u32x4){0, 0, 0, 0}; kr[i] = (u32x4){0, 0, 0, 0};
      if (t >= 0) {
        qr[i] = *(const u32x4*)(ws.Q + (size_t)(b * T_ + t) * 512 + hd * 128 + ch * 8);
        kr[i] = *(const u32x4*)(ws.K + (size_t)(b * T_ + t) * 512 + hd * 128 + ch * 8);
      }
    }
    {
      const int row = tid >> 2, ch = tid & 3; const int t = tbase + row;
      vr = (u32x4){0, 0, 0, 0};
      if (t >= 0) vr = *(const u32x4*)(ws.V + (size_t)(b * T_ + t) * 1024 + hd * 256 + sl * 32 + ch * 8);
    }
    ebl[0] = BLp[c * 128 + 16 * (2 * w) + lr];
    ebl[1] = BLp[c * 128 + 16 * (2 * w + 1) + lr];
  };
  prefetch(0, qrA, krA, vrA, eblA);
  prefetch(1, qrB, krB, vrB, eblB);
  auto body = [&](int c, u32x4 (&qr)[4], u32x4 (&kr)[4], u32x4& vr, float (&ebl)[2]) {
#pragma unroll
    for (int i = 0; i < 4; ++i) {
      const int ci = tid + 256 * i; const int row = ci >> 4, ch = ci & 15;
      *(u32x4*)(QDs + row * 136 + ch * 8) = qr[i];
      *(u32x4*)(KIs + row * 136 + ch * 8) = kr[i];
      const unsigned kk[4] = {kr[i].x, kr[i].y, kr[i].z, kr[i].w};
#pragma unroll
      for (int e = 0; e < 4; ++e) {
        KIT[(ch * 8 + 2 * e) * 72 + (row ^ ((ch & 7) << 3))] = (bf16_t)(kk[e] & 0xffffu);
        KIT[(ch * 8 + 2 * e + 1) * 72 + (row ^ ((ch & 7) << 3))] = (bf16_t)(kk[e] >> 16);
      }
    }
    {
      const int row = tid >> 2, ch = tid & 3;
      const unsigned vv[4] = {vr.x, vr.y, vr.z, vr.w};
#pragma unroll
      for (int e = 0; e < 4; ++e) {
        VTs[(ch * 8 + 2 * e) * 72 + (row ^ (ch << 3))] = (bf16_t)(vv[e] & 0xffffu);
        VTs[(ch * 8 + 2 * e + 1) * 72 + (row ^ (ch << 3))] = (bf16_t)(vv[e] >> 16);
      }
    }
    const float eb0 = ebl[0], eb1 = ebl[1];
    __syncthreads();
    if (c + 2 < 33) prefetch(c + 2, qr, kr, vr, ebl);
    bf16x8 xq[4];
#pragma unroll
    for (int ks = 0; ks < 4; ++ks) xq[ks] = *(const bf16x8*)(QDs + (16 * w + lr) * 136 + 32 * ks + 8 * lq);
    const int irow = 16 * w + lr;
#pragma unroll
    for (int mt = 0; mt < 4; ++mt) {
      u32x2 pk = (u32x2){0u, 0u};
      if (mt <= w) {
        f32x4 a = (f32x4){0.f, 0.f, 0.f, 0.f};
#pragma unroll
        for (int ks = 0; ks < 4; ++ks) {
          const bf16x8 kf = *(const bf16x8*)(KIs + (16 * mt + lr) * 136 + 32 * ks + 8 * lq);
          a = MFMA16(kf, xq[ks], a);
        }
        const int ip = 16 * mt + 4 * lq;
        const float v0 = (ip + 0 <= irow) ? a[0] : 0.f, v1 = (ip + 1 <= irow) ? a[1] : 0.f;
        const float v2 = (ip + 2 <= irow) ? a[2] : 0.f, v3 = (ip + 3 <= irow) ? a[3] : 0.f;
        pk.x = cvt_pk_bf16(v0, v1); pk.y = cvt_pk_bf16(v2, v3);
      }
      *(u32x2*)(Ps + irow * 72 + 16 * mt + 4 * lq) = pk;
    }
    __syncthreads();
    f32x4 oacc[2];
    oacc[0] = (f32x4){0.f, 0.f, 0.f, 0.f}; oacc[1] = (f32x4){0.f, 0.f, 0.f, 0.f};
#pragma unroll
    for (int ks = 0; ks < 2; ++ks) {
      if (2 * ks <= w) {
        const bf16x8 pb = *(const bf16x8*)(Ps + irow * 72 + 32 * ks + 8 * lq);
#pragma unroll
        for (int mt = 0; mt < 2; ++mt) {
          const bf16x8 vf = *(const bf16x8*)(VTs + (16 * mt + lr) * 72 + (((4 * ks + lq) ^ (((16 * mt + lr) >> 3) & 3)) << 3));
          oacc[mt] = MFMA16(vf, pb, oacc[mt]);
        }
      }
    }
#pragma unroll
    for (int ks = 0; ks < 4; ++ks)
#pragma unroll
      for (int mt = 0; mt < 2; ++mt) {
        const bf16x8 sf = *(const bf16x8*)(STs + (16 * mt + lr) * 136 + 32 * ks + 8 * lq);
        oacc[mt] = MFMA16(sf, xq[ks], oacc[mt]);
      }
    {
      const int t = 64 * c - 48 + irow;
      float sq = 0.f;
#pragma unroll
      for (int mt = 0; mt < 2; ++mt) sq += oacc[mt][0] * oacc[mt][0] + oacc[mt][1] * oacc[mt][1] + oacc[mt][2] * oacc[mt][2] + oacc[mt][3] * oacc[mt][3];
      sq += __shfl_xor(sq, 16); sq += __shfl_xor(sq, 32);
      if (t >= 0 && !dry) {
        const size_t row = (size_t)(b * T_ + t);
#pragma unroll
        for (int mt = 0; mt < 2; ++mt) {
          u32x2 pk; pk.x = cvt_pk_bf16(oacc[mt][0], oacc[mt][1]); pk.y = cvt_pk_bf16(oacc[mt][2], oacc[mt][3]);
          *(u32x2*)(ws.V + row * 1024 + hd * 256 + sl * 32 + 16 * mt + 4 * lq) = pk;
        }
        if (lq == 0) ws.SSQ[row * 32 + hd * 8 + sl] = sq;
      }
    }
    __syncthreads();
#pragma unroll
    for (int ntl = 0; ntl < 2; ++ntl) {
#pragma unroll
      for (int ks = 0; ks < 2; ++ks) {
        const bf16x8 kf = *(const bf16x8*)(KIT + (16 * (2 * w + ntl) + lr) * 72 + (((4 * ks + lq) ^ (((16 * (2 * w + ntl) + lr) >> 3) & 7)) << 3));
#pragma unroll
        for (int mt = 0; mt < 2; ++mt) {
          const bf16x8 vf = *(const bf16x8*)(VTs + (16 * mt + lr) * 72 + (((4 * ks + lq) ^ (((16 * mt + lr) >> 3) & 3)) << 3));
          sacc[mt][ntl] = MFMA16(vf, kf, sacc[mt][ntl]);
        }
      }
      const float e = ntl ? eb1 : eb0;
#pragma unroll
      for (int mt = 0; mt < 2; ++mt) {
        sacc[mt][ntl] = sacc[mt][ntl] * e;
#pragma unroll
        for (int jj = 0; jj < 4; ++jj) STs[(16 * mt + 4 * lq + jj) * 136 + 16 * (2 * w + ntl) + lr] = f2bf(sacc[mt][ntl][jj]);
      }
    }
    __syncthreads();
  };
#pragma unroll 1
  for (int c = 0; c < 33; c += 2) {
    body(c, qrA, krA, vrA, eblA);
    if (c + 1 < 33) body(c + 1, qrB, krB, vrB, eblB);
  }
}

__device__ __forceinline__ void rglru_unit(const Params& p, const WS& ws, int j, int u, bool dry = false) {
  const int jq = u & 3, g = (u >> 2) & 7, b = u >> 5;
  bf16_t* XC = (bf16_t*)smem;
  bf16_t* WG = XC + 64 * 136;
  float* AUa = (float*)(smem + 34816);
  float* AUu = AUa + 64 * 33;
  float* SEGA = AUu + 64 * 33;
  float* SEGH = SEGA + 256;
  float* CARRY = SEGH + 256;
  const int tid = opaque_tid(), lane = tid & 63, w = tid >> 6, lr = lane & 15, lq = lane >> 4;
#pragma unroll 4
  for (int i = 0; i < 32; ++i) {
    const int e = tid + 256 * i;
    const int gate = e >> 12, k = (e >> 5) & 127, n = e & 31;
    const float* gw = gate ? p.ab_gate_x_w : p.ab_gate_a_w;
    WG[(gate * 32 + n) * 136 + k] = f2bf(gw[((size_t)(j * 8 + g) * 128 + k) * 128 + 32 * jq + n]);
  }
  if (tid < 32) CARRY[tid] = 0.f;
  const int cc = tid & 15, rb = 4 * (tid >> 4);
  float cw[4][8], cb[8];
#pragma unroll
  for (int e = 0; e < 8; ++e) {
    cb[e] = p.ab_conv_b[j * 1024 + 128 * g + 8 * cc + e];
#pragma unroll
    for (int k = 0; k < 4; ++k) cw[k][e] = p.ab_conv_w[(size_t)(j * 4 + k) * 1024 + 128 * g + 8 * cc + e];
  }
  float ba[2][4], bx[2][4], sp[2][4];
#pragma unroll
  for (int mt = 0; mt < 2; ++mt)
#pragma unroll
    for (int jj = 0; jj < 4; ++jj) {
      const int ch = j * 1024 + 128 * g + 32 * jq + 16 * mt + 4 * lq + jj;
      ba[mt][jj] = p.ab_gate_a_b[ch]; bx[mt][jj] = p.ab_gate_x_b[ch];
      sp[mt][jj] = 8.f * log1pf(__expf(-p.ab_lam[ch]));
    }
  const int sc = tid & 31, ssg = tid >> 5;
  u32x4 xinA[7], xinB[7];
  bf16_t gavA[8], gavB[8];
  auto prefetch = [&](int tile, u32x4 (&xin)[7], bf16_t (&gav)[8]) {
    const int t0 = 64 * tile;
#pragma unroll
    for (int m = 0; m < 7; ++m) {
      const int tt = t0 + rb - 3 + m;
      xin[m] = (u32x4){0, 0, 0, 0};
      if (tt >= 0 && tt < T_) xin[m] = *(const u32x4*)(ws.XA + (size_t)(b * T_ + tt) * 1024 + 128 * g + 8 * cc);
    }
#pragma unroll
    for (int i = 0; i < 8; ++i) {
      const int t = t0 + 8 * ssg + i;
      gav[i] = 0;
      if (t < T_) gav[i] = ws.GA[(size_t)(b * T_ + t) * 1024 + 128 * g + 32 * jq + sc];
    }
  };
  prefetch(0, xinA, gavA);
  prefetch(1, xinB, gavB);
  __syncthreads();
  auto body = [&](int tile, u32x4 (&xin)[7], bf16_t (&gav)[8]) {
    const int t0 = 64 * tile;
#pragma unroll
    for (int r = 0; r < 4; ++r) {
      float y[8];
#pragma unroll
      for (int e = 0; e < 8; ++e) y[e] = cb[e];
#pragma unroll
      for (int k = 0; k < 4; ++k) {
        const u32x4 xv = xin[r + k];
        y[0] += cw[k][0] * bflo(xv.x); y[1] += cw[k][1] * bfhi(xv.x);
        y[2] += cw[k][2] * bflo(xv.y); y[3] += cw[k][3] * bfhi(xv.y);
        y[4] += cw[k][4] * bflo(xv.z); y[5] += cw[k][5] * bfhi(xv.z);
        y[6] += cw[k][6] * bflo(xv.w); y[7] += cw[k][7] * bfhi(xv.w);
      }
      u32x4 pk; pk.x = cvt_pk_bf16(y[0], y[1]); pk.y = cvt_pk_bf16(y[2], y[3]); pk.z = cvt_pk_bf16(y[4], y[5]); pk.w = cvt_pk_bf16(y[6], y[7]);
      *(u32x4*)(XC + (rb + r) * 136 + 8 * cc) = pk;
    }
    float gcur[8];
#pragma unroll
    for (int i = 0; i < 8; ++i) gcur[i] = bf2f(gav[i]);
    __syncthreads();
    if (tile + 2 < 33) prefetch(tile + 2, xin, gav);
    {
      f32x4 ga_[2][2];
#pragma unroll
      for (int a = 0; a < 2; ++a)
#pragma unroll
        for (int bb = 0; bb < 2; ++bb) ga_[a][bb] = (f32x4){0.f, 0.f, 0.f, 0.f};
#pragma unroll
      for (int ks = 0; ks < 4; ++ks) {
        const bf16x8 xf = *(const bf16x8*)(XC + (16 * w + lr) * 136 + 32 * ks + 8 * lq);
#pragma unroll
        for (int gate = 0; gate < 2; ++gate)
#pragma unroll
          for (int mt = 0; mt < 2; ++mt) {
            const bf16x8 wf = *(const bf16x8*)(WG + (gate * 32 + 16 * mt + lr) * 136 + 32 * ks + 8 * lq);
            ga_[gate][mt] = MFMA16(wf, xf, ga_[gate][mt]);
          }
      }
      const int tok = 16 * w + lr;
#pragma unroll
      for (int mt = 0; mt < 2; ++mt)
#pragma unroll
        for (int jj = 0; jj < 4; ++jj) {
          const int n = 16 * mt + 4 * lq + jj;
          const float xcv = bf2f(XC[tok * 136 + 32 * jq + n]);
          const float r = sigmoidf_(ga_[0][mt][jj] + ba[mt][jj]);
          const float ig = sigmoidf_(ga_[1][mt][jj] + bx[mt][jj]);
          const float la = -r * sp[mt][jj];
          const float a = __expf(la);
          const float x2 = 2.f * la;
          const float om = x2 > -0.02f ? -x2 * (1.f + 0.5f * x2 * (1.f + x2 * (1.f / 3.f))) : 1.f - a * a;
          const float mult = __builtin_amdgcn_sqrtf(fmaxf(om, 0.f));
          AUa[tok * 33 + n] = a;
          AUu[tok * 33 + n] = mult * ig * xcv;
        }
    }
    __syncthreads();
    {
      float A = 1.f, Hh = 0.f;
#pragma unroll
      for (int i = 0; i < 8; ++i) {
        const float a = AUa[(8 * ssg + i) * 33 + sc], uu = AUu[(8 * ssg + i) * 33 + sc];
        Hh = a * Hh + uu; A *= a;
      }
      SEGA[ssg * 32 + sc] = A; SEGH[ssg * 32 + sc] = Hh;
    }
    __syncthreads();
    float hin = CARRY[sc];
#pragma unroll
    for (int s2 = 0; s2 < 7; ++s2)
      if (s2 < ssg) hin = SEGA[s2 * 32 + sc] * hin + SEGH[s2 * 32 + sc];
    __syncthreads();
    {
      float h = hin;
#pragma unroll
      for (int i = 0; i < 8; ++i) {
        const float a = AUa[(8 * ssg + i) * 33 + sc], uu = AUu[(8 * ssg + i) * 33 + sc];
        h = a * h + uu;
        const int t = t0 + 8 * ssg + i;
        if (t < T_ && !dry) ws.GA[(size_t)(b * T_ + t) * 1024 + 128 * g + 32 * jq + sc] = f2bf(h * siluf_(gcur[i]));
      }
      if (ssg == 7) CARRY[sc] = h;
    }
  };
#pragma unroll 1
  for (int tile = 0; tile < 33; tile += 2) {
    body(tile, xinA, gavA);
    if (tile + 1 < 33) body(tile + 1, xinB, gavB);
  }
  __syncthreads();
}

__device__ __forceinline__ void phase_gla_norm(const Params& p, const WS& ws, int j) {
  const size_t gtid = (size_t)opaque_bid() * 256 + opaque_tid(), gsz = (size_t)gridDim.x * 256;
  const float* gn = p.ab_gla_norm + j * 256;
#pragma unroll 4
  for (size_t idx = gtid; idx < (size_t)M_ * 128; idx += gsz) {
    const size_t row = idx >> 7; const int c8 = (int)(idx & 127); const int hd = c8 >> 5; const int dv = (c8 & 31) * 8;
    const float4 s0 = *(const float4*)(ws.SSQ + row * 32 + hd * 8), s1 = *(const float4*)(ws.SSQ + row * 32 + hd * 8 + 4);
    const float ssum = (s0.x + s0.y + s0.z + s0.w) + (s1.x + s1.y + s1.z + s1.w);
    const float rstd = rsqrtf(ssum * (1.f / 256.f) + EPS_);
    const u32x4 ov = *(const u32x4*)(ws.V + row * 1024 + c8 * 8);
    const u32x4 gv = *(const u32x4*)(ws.GB + row * 1024 + c8 * 8);
    const float4 g0 = *(const float4*)(gn + dv), g1 = *(const float4*)(gn + dv + 4);
    float o[8] = {bflo(ov.x), bfhi(ov.x), bflo(ov.y), bfhi(ov.y), bflo(ov.z), bfhi(ov.z), bflo(ov.w), bfhi(ov.w)};
    const float gg[8] = {bflo(gv.x), bfhi(gv.x), bflo(gv.y), bfhi(gv.y), bflo(gv.z), bfhi(gv.z), bflo(gv.w), bfhi(gv.w)};
    const float nn[8] = {g0.x, g0.y, g0.z, g0.w, g1.x, g1.y, g1.z, g1.w};
#pragma unroll
    for (int e = 0; e < 8; ++e) o[e] = o[e] * rstd * nn[e] * siluf_(gg[e]);
    u32x4 pk; pk.x = cvt_pk_bf16(o[0], o[1]); pk.y = cvt_pk_bf16(o[2], o[3]); pk.z = cvt_pk_bf16(o[4], o[5]); pk.w = cvt_pk_bf16(o[6], o[7]);
    *(u32x4*)(ws.V + row * 1024 + c8 * 8) = pk;
  }
}

__device__ __forceinline__ void attn_unit(const WS& ws, int u, bool dry = false) {
  const int qb = 16 - (u >> 7); const int bh = u & 127; const int hd = bh & 15, b = bh >> 4;
  bf16_t* Kt = (bf16_t*)smem;
  bf16_t* Vl = Kt + 2 * 64 * 104;
  const int tid = opaque_tid(), lane = tid & 63, w = tid >> 6, lr = lane & 15, lq = lane >> 4;
  const int q0 = 128 * qb;
  int nkt = 2 * qb + 2; if (nkt > 33) nkt = 33;
  bf16x8 xq[2][3];
  int qi[2];
#pragma unroll
  for (int nt = 0; nt < 2; ++nt) {
    qi[nt] = q0 + 32 * w + 16 * nt + lr;
    const int qc = qi[nt] < T_ ? qi[nt] : T_ - 1;
#pragma unroll
    for (int ks = 0; ks < 2; ++ks)
      xq[nt][ks] = *(const bf16x8*)(ws.QB + (size_t)(b * T_ + qc) * 1536 + hd * 96 + 32 * ks + 8 * lq);
    {
      const u32x4 raw = *(const u32x4*)(ws.QB + (size_t)(b * T_ + qc) * 1536 + hd * 96 + 64 + 8 * lq);
      u32x4 oth;
      oth.x = __shfl_xor(raw.x, 32); oth.y = __shfl_xor(raw.y, 32); oth.z = __shfl_xor(raw.z, 32); oth.w = __shfl_xor(raw.w, 32);
      const float sgn = lq < 2 ? -1.f : 1.f;
      const float2* rp = ws.ROPE + (size_t)(b * T_ + qc) * 16 + 8 * (lq & 1);
      const unsigned rw[4] = {raw.x, raw.y, raw.z, raw.w}, ow[4] = {oth.x, oth.y, oth.z, oth.w};
      unsigned res[4];
#pragma unroll
      for (int e = 0; e < 4; ++e) {
        const float2 c0 = rp[2 * e], c1 = rp[2 * e + 1];
        const float r0 = bflo(rw[e]) * c0.x + sgn * bflo(ow[e]) * c0.y;
        const float r1 = bfhi(rw[e]) * c1.x + sgn * bfhi(ow[e]) * c1.y;
        res[e] = cvt_pk_bf16(r0, r1);
      }
      xq[nt][2] = as_bf16x8((u32x4){res[0], res[1], res[2], res[3]});
    }
  }
  float mrun[2] = {-INFINITY, -INFINITY}, lsum[2] = {0.f, 0.f};
  f32x4 oacc[4][2];
#pragma unroll
  for (int a = 0; a < 4; ++a)
#pragma unroll
    for (int bb = 0; bb < 2; ++bb) oacc[a][bb] = (f32x4){0.f, 0.f, 0.f, 0.f};
  u32x4 kreg[3], vreg[2];
  const bf16_t* vbase = ws.VT + ((size_t)(b * 16 + hd) * 64) * TP_;
  auto loadg = [&](int kt) {
#pragma unroll
    for (int i = 0; i < 3; ++i) {
      const int ci = tid + 256 * i; const int key = ci / 12, ch = ci - key * 12;
      int gk = 64 * kt + key; if (gk > T_ - 1) gk = T_ - 1;
      const bf16_t* src = ch < 8 ? ws.KN + (size_t)(b * T_ + gk) * 1024 + hd * 64 + ch * 8
                                 : ws.KR + (size_t)(b * T_ + gk) * 32 + (ch - 8) * 8;
      kreg[i] = *(const u32x4*)src;
    }
#pragma unroll
    for (int i = 0; i < 2; ++i) {
      const int ci = tid + 256 * i; const int dv = ci >> 3, ch = ci & 7;
      vreg[i] = *(const u32x4*)(vbase + (size_t)dv * TP_ + 64 * kt + ch * 8);
      if (64 * kt + ch * 8 >= T_) vreg[i] = (u32x4){0u, 0u, 0u, 0u};
    }
  };
  auto stores = [&](int buf) {
#pragma unroll
    for (int i = 0; i < 3; ++i) {
      const int ci = tid + 256 * i; const int key = ci / 12, ch = ci - key * 12;
      *(u32x4*)(Kt + buf * 64 * 104 + key * 104 + ch * 8) = kreg[i];
    }
#pragma unroll
    for (int i = 0; i < 2; ++i) {
      const int ci = tid + 256 * i; const int dv = ci >> 3, ch = ci & 7;
      *(u32x4*)(Vl + buf * 64 * 72 + dv * 72 + ch * 8) = vreg[i];
    }
  };
  loadg(0);
  stores(0);
  __syncthreads();
#pragma unroll 1
  for (int kt = 0; kt < nkt; ++kt) {
    const int buf = kt & 1;
    if (kt + 1 < nkt) loadg(kt + 1);
    const bf16_t* Kb = Kt + buf * 64 * 104;
    const bf16_t* Vb = Vl + buf * 64 * 72;
    f32x4 s[4][2];
#pragma unroll
    for (int mt = 0; mt < 4; ++mt) {
      s[mt][0] = (f32x4){0.f, 0.f, 0.f, 0.f}; s[mt][1] = (f32x4){0.f, 0.f, 0.f, 0.f};
#pragma unroll
      for (int ks = 0; ks < 3; ++ks) {
        const bf16x8 kf = *(const bf16x8*)(Kb + (16 * mt + lr) * 104 + 32 * ks + 8 * lq);
        s[mt][0] = MFMA16(kf, xq[0][ks], s[mt][0]);
        s[mt][1] = MFMA16(kf, xq[1][ks], s[mt][1]);
      }
    }
    if (kt >= 2 * qb) {
#pragma unroll
      for (int mt = 0; mt < 4; ++mt)
#pragma unroll
        for (int nt = 0; nt < 2; ++nt)
#pragma unroll
          for (int jj = 0; jj < 4; ++jj) {
            const int key = 64 * kt + 16 * mt + 4 * lq + jj;
            if (key > qi[nt]) s[mt][nt][jj] = -INFINITY;
          }
    }
    bf16x8 pf[2][2];
#pragma unroll
    for (int nt = 0; nt < 2; ++nt) {
      float mx = -INFINITY;
#pragma unroll
      for (int mt = 0; mt < 4; ++mt) mx = fmaxf(mx, fmaxf(fmaxf(s[mt][nt][0], s[mt][nt][1]), fmaxf(s[mt][nt][2], s[mt][nt][3])));
      mx = fmaxf(mx, __shfl_xor(mx, 16)); mx = fmaxf(mx, __shfl_xor(mx, 32));
      const float mnew = fmaxf(mrun[nt], mx);
      const float alpha = __builtin_amdgcn_exp2f(mrun[nt] - mnew);
      mrun[nt] = mnew;
      float ps = 0.f;
#pragma unroll
      for (int mt = 0; mt < 4; ++mt)
#pragma unroll
        for (int jj = 0; jj < 4; ++jj) { const float pv = __builtin_amdgcn_exp2f(s[mt][nt][jj] - mnew); s[mt][nt][jj] = pv; ps += pv; }
      lsum[nt] = lsum[nt] * alpha + ps;
#pragma unroll
      for (int mt = 0; mt < 4; ++mt) oacc[mt][nt] = oacc[mt][nt] * alpha;
#pragma unroll
      for (int ks = 0; ks < 2; ++ks) {
        u32x4 pk;
        pk.x = cvt_pk_bf16(s[2 * ks][nt][0], s[2 * ks][nt][1]); pk.y = cvt_pk_bf16(s[2 * ks][nt][2], s[2 * ks][nt][3]);
        pk.z = cvt_pk_bf16(s[2 * ks + 1][nt][0], s[2 * ks + 1][nt][1]); pk.w = cvt_pk_bf16(s[2 * ks + 1][nt][2], s[2 * ks + 1][nt][3]);
        pf[nt][ks] = as_bf16x8(pk);
      }
    }
#pragma unroll
    for (int mt = 0; mt < 4; ++mt)
#pragma unroll
      for (int ks = 0; ks < 2; ++ks) {
        const u32x2 lo = *(const u32x2*)(Vb + (16 * mt + lr) * 72 + 32 * ks + 4 * lq);
        const u32x2 hi = *(const u32x2*)(Vb + (16 * mt + lr) * 72 + 32 * ks + 16 + 4 * lq);
        const bf16x8 vf = as_bf16x8((u32x4){lo.x, lo.y, hi.x, hi.y});
        oacc[mt][0] = MFMA16(vf, pf[0][ks], oacc[mt][0]);
        oacc[mt][1] = MFMA16(vf, pf[1][ks], oacc[mt][1]);
      }
    if (kt + 1 < nkt) stores(buf ^ 1);
    __syncthreads();
  }
#pragma unroll
  for (int nt = 0; nt < 2; ++nt) {
    float l = lsum[nt];
    l += __shfl_xor(l, 16); l += __shfl_xor(l, 32);
    const float inv = 1.f / l;
    if (qi[nt] < T_) {
      const size_t row = (size_t)(b * T_ + qi[nt]);
#pragma unroll
      for (int mt = 0; mt < 4; ++mt) {
        const u32x2 gv = *(const u32x2*)(ws.GATE + row * 1024 + hd * 64 + 16 * mt + 4 * lq);
        const float o0 = oacc[mt][nt][0] * inv * siluf_(bflo(gv.x)), o1 = oacc[mt][nt][1] * inv * siluf_(bfhi(gv.x));
        const float o2 = oacc[mt][nt][2] * inv * siluf_(bflo(gv.y)), o3 = oacc[mt][nt][3] * inv * siluf_(bfhi(gv.y));
        u32x2 pk; pk.x = cvt_pk_bf16(o0, o1); pk.y = cvt_pk_bf16(o2, o3);
        if (!dry) *(u32x2*)(ws.QB + row * 1536 + hd * 96 + 16 * mt + 4 * lq) = pk;
      }
    }
  }
}

__device__ __forceinline__ void phase_final(const Params& p, const WS& ws) {
  const int tidf = opaque_tid();
  const int lane = tidf & 63;
  const int gw = opaque_bid() * 4 + (tidf >> 6), nw = gridDim.x * 4;
#pragma unroll 2
  for (int r = gw; r < 8 * 2048; r += nw) {
    const int b = r >> 11, s = r & 2047;
    const size_t hoff = (size_t)(b * T_ + 16 + s) * 1024;
    float4 v[4];
    float ssum = 0.f;
#pragma unroll
    for (int i = 0; i < 4; ++i) {
      const u32x2 hi = *(const u32x2*)(ws.HHI + hoff + i * 256 + lane * 4), lo = *(const u32x2*)(ws.HLO + hoff + i * 256 + lane * 4);
      v[i] = make_float4(bflo(hi.x) + bflo(lo.x), bfhi(hi.x) + bfhi(lo.x), bflo(hi.y) + bflo(lo.y), bfhi(hi.y) + bfhi(lo.y));
      ssum += v[i].x * v[i].x + v[i].y * v[i].y + v[i].z * v[i].z + v[i].w * v[i].w;
    }
#pragma unroll
    for (int o = 1; o < 64; o <<= 1) ssum += __shfl_xor(ssum, o);
    const float rstd = rsqrtf(ssum * (1.f / 1024.f) + EPS_);
#pragma unroll
    for (int i = 0; i < 4; ++i) {
      const float4 g = *(const float4*)(p.final_norm + i * 256 + lane * 4);
      float4 o; o.x = v[i].x * rstd * g.x; o.y = v[i].y * rstd * g.y; o.z = v[i].z * rstd * g.z; o.w = v[i].w * rstd * g.w;
      *(float4*)(p.out + (size_t)r * 1024 + i * 256 + lane * 4) = o;
    }
  }
}

__global__ void __launch_bounds__(256, 2) fwd_megakernel(Params p) {
  cg::grid_group grid = cg::this_grid();
  if (p.inv_freq[0] < 0.f) grid.sync();
  volatile LAS unsigned* xst = (volatile LAS unsigned*)(smem + SMEM_BYTES);
  if (threadIdx.x == 0) { xst[0] = 0u; xst[1] = 0u; xst[2] = 0u; xst[3] = 0u; }
  __syncthreads();
  const XcdBarrier xb = xcd_barrier_post((unsigned*)(p.ws + BAR_OFF), xst);
  {
    const WS ws = make_ws(p);
    phase_prologue(p, ws);
  }
  xcd_barrier(xb);
#pragma unroll 1
  for (int layer = 0; layer < 4; ++layer) {
    const int j = layer >> 1;
    if ((layer & 1) == 0) {
      {
        const WS ws = make_ws(p);
        const bf16_t* wb = ws.W + (size_t)j * W_PER_J;
#pragma unroll 1
        for (int rep = 0; rep < REP_GEMM; ++rep)
          gemm_stream<true, EPI_E1>(ws, ws.HHI, nullptr, 1024, 1 << 30, 64, wb + W_IN_E, 1024, 1.f / 1024.f, 41, 129 * 41, xcd_bid(opaque_bid()), false);
      }
      xcd_barrier(xb);
      {
        const WS ws = make_ws(p);
#pragma unroll 1
        for (int u = opaque_bid(); u < 8 * 4 * 33; u += gridDim.x) gla_decay_unit(p, ws, j, u);
      }
      xcd_barrier(xb);
      {
#pragma unroll 1
        for (int rep = 0; rep < REP_E2; ++rep)
#pragma unroll 1
        for (int u = opaque_bid(); u < 512; u += gridDim.x) {
          if (u >= 256) { const WS ws = make_ws(p); rglru_unit(p, ws, j, u - 256, rep < REP_E2 - 1); }
          else { const WS ws = make_ws(p); gla_unit(p, ws, u, rep < REP_E2 - 1); }
        }
      }
      xcd_barrier(xb);
      {
        const WS ws = make_ws(p);
        phase_gla_norm(p, ws, j);
      }
      xcd_barrier(xb);
      {
        const WS ws = make_ws(p);
        const bf16_t* wb = ws.W + (size_t)j * W_PER_J;
#pragma unroll 1
        for (int rep = 0; rep < REP_GEMM; ++rep)
          gemm_stream<false, EPI_RES>(ws, ws.GA, ws.V, 1024, 16, 64, wb + W_OUT_E, 2048, 0.f, 8, 129 * 8, xcd_bid(opaque_bid()), rep < REP_GEMM - 1);
      }
      xcd_barrier(xb);
    } else {
      {
        const WS ws = make_ws(p);
        const bf16_t* wb = ws.W + (size_t)j * W_PER_J;
#pragma unroll 1
        for (int rep = 0; rep < REP_GEMM; ++rep)
          gemm_stream<true, EPI_O1>(ws, ws.HHI, nullptr, 1024, 1 << 30, 64, wb + W_IN_O, 1024, 1.f / 1024.f, 15, 129 * 15, xcd_bid(opaque_bid()), false);
      }
      xcd_barrier(xb);
      {
        const WS ws = make_ws(p);
        const bf16_t* wb = ws.W + (size_t)j * W_PER_J;
#pragma unroll 1
        for (int rep = 0; rep < REP_GEMM; ++rep) {
          gemm_stream<true, EPI_Q>(ws, ws.CQ, nullptr, 512, 1 << 30, 64, wb + W_Q, 512, 1.f / 512.f, 12, 129 * 12, xcd_bid(opaque_bid()), false);
          gemm_stream<true, EPI_KV>(ws, ws.CKV, nullptr, 256, 1 << 30, 64, wb + W_KV, 256, 1.f / 256.f, 16, 129 * 16, xcd_bid((opaque_bid() + (int)(gridDim.x >> 1)) % (int)gridDim.x), false);
        }
      }
      xcd_barrier(xb);
      {
        const WS ws = make_ws(p);
#pragma unroll 1
        for (int rep = 0; rep < REP_ATTN; ++rep)
#pragma unroll 1
        for (int r = 0, b0 = opaque_bid(); r * (int)gridDim.x < 17 * 128; ++r) {
          const int u = r * (int)gridDim.x + ((r & 1) ? (int)gridDim.x - 1 - b0 : b0);
          if (u < 17 * 128) attn_unit(ws, u, rep < REP_ATTN - 1);
          __syncthreads();
        }
      }
      xcd_barrier(xb);
      {
        const WS ws = make_ws(p);
        const bf16_t* wb = ws.W + (size_t)j * W_PER_J;
#pragma unroll 1
        for (int rep = 0; rep < REP_GEMM; ++rep)
          gemm_stream<false, EPI_RES>(ws, ws.QB, nullptr, 1536, 1 << 30, 96, wb + W_O, 1024, 0.f, 8, 129 * 8, xcd_bid(opaque_bid()), rep < REP_GEMM - 1);
      }
      xcd_barrier(xb);
    }
  }
  {
    const WS ws = make_ws(p);
    phase_final(p, ws);
  }
}

extern "C" void kernel_launch(void* const* d_in, const int* in_sizes, int n_in, void* d_out, int out_size, void* d_ws,
                              size_t ws_size, hipStream_t stream) {
  static int grid_blocks = 0;
  if (!grid_blocks) {
    int dev = 0, cus = 0, per_cu = 0;
    hipGetDevice(&dev);
    hipDeviceGetAttribute(&cus, hipDeviceAttributeMultiprocessorCount, dev);
    hipOccupancyMaxActiveBlocksPerMultiprocessor(&per_cu, fwd_megakernel, 256, 0);
    if (per_cu < 1) per_cu = 1;
    if (per_cu > 2) per_cu = 2;
    grid_blocks = cus * per_cu;
  }
  Params p{};
  p.x = (const float*)d_in[0]; p.positions = (const int*)d_in[1]; p.meta = (const float*)d_in[2];
  p.ab_norm = (const float*)d_in[3]; p.ab_w_in = (const float*)d_in[4]; p.ab_conv_w = (const float*)d_in[5];
  p.ab_conv_b = (const float*)d_in[6]; p.ab_gate_a_w = (const float*)d_in[7]; p.ab_gate_a_b = (const float*)d_in[8];
  p.ab_gate_x_w = (const float*)d_in[9]; p.ab_gate_x_b = (const float*)d_in[10]; p.ab_lam = (const float*)d_in[11];
  p.ab_alpha_w = (const float*)d_in[12]; p.ab_alpha_b = (const float*)d_in[13]; p.ab_gla_norm = (const float*)d_in[14];
  p.ab_w_out = (const float*)d_in[15]; p.c_norm = (const float*)d_in[16]; p.c_w_in = (const float*)d_in[17];
  p.c_q_norm = (const float*)d_in[18]; p.c_w_q_up = (const float*)d_in[19]; p.c_kv_norm = (const float*)d_in[20];
  p.c_w_kv_up = (const float*)d_in[21]; p.c_w_out = (const float*)d_in[22]; p.final_norm = (const float*)d_in[23];
  p.out = (float*)d_out;
  p.ws = (unsigned char*)d_ws;
  for (int i = 0; i < 16; ++i) p.inv_freq[i] = (float)pow(10000.0, -(double)i / 16.0);
  hipMemsetAsync((unsigned char*)d_ws + BAR_OFF, 0, XCD_BAR_WORDS * 4, stream);
  void* args[] = {&p};
  hipError_t e = hipLaunchCooperativeKernel((void*)fwd_megakernel, dim3(grid_blocks), dim3(256), args, 0, stream);
  if (e != hipSuccess) fprintf(stderr, "cooperative launch failed: %s (grid %d)\n", hipGetErrorString(e), grid_blocks);
}
```

```cpp
#include <hip/hip_runtime.h>
#include <hip/hip_cooperative_groups.h>
#include <cstdio>
#include <cmath>
namespace cg = cooperative_groups;

typedef unsigned short bf16_t;
typedef short bf16x8 __attribute__((ext_vector_type(8)));
typedef float f32x4 __attribute__((ext_vector_type(4)));
typedef unsigned u32x4 __attribute__((ext_vector_type(4)));
typedef unsigned u32x2 __attribute__((ext_vector_type(2)));

constexpr int T_ = 2064;
constexpr int M_ = 8 * T_;
constexpr int TP_ = 2112;
constexpr float EPS_ = 1e-6f;
constexpr int SMEM_BYTES = 75776;
constexpr float QSCALE_MLA = 0.10206207261596575f * 1.4426950408889634f;

constexpr size_t W_PER_J = 11796480;
constexpr size_t W_IN_E = 0, W_OUT_E = 5373952, W_IN_O = 7471104, W_Q = 9437184, W_KV = 10223616, W_O = 10747904;

struct Params {
  const float* x; const int* positions; const float* meta;
  const float *ab_norm, *ab_w_in, *ab_conv_w, *ab_conv_b, *ab_gate_a_w, *ab_gate_a_b, *ab_gate_x_w, *ab_gate_x_b,
      *ab_lam, *ab_alpha_w, *ab_alpha_b, *ab_gla_norm, *ab_w_out;
  const float *c_norm, *c_w_in, *c_q_norm, *c_w_q_up, *c_kv_norm, *c_w_kv_up, *c_w_out, *final_norm;
  float* out;
  unsigned char* ws;
  float inv_freq[16];
};

struct WS {
  bf16_t *HHI, *HLO; float2* ROPE;
  bf16_t *XA, *GA, *Q, *K, *V, *GB, *AD; float* SSQ; float* BL;
  bf16_t *CQ, *CKV, *GATE, *KR, *QB, *KN, *VT;
  bf16_t* W;
};

__device__ __forceinline__ unsigned char* opaque_ptr(unsigned char* q) {
  unsigned lo = (unsigned)(unsigned long long)q, hi = (unsigned)((unsigned long long)q >> 32);
  asm volatile("" : "+v"(lo), "+v"(hi));
  lo = __builtin_amdgcn_readfirstlane(lo); hi = __builtin_amdgcn_readfirstlane(hi);
  typedef __attribute__((address_space(1))) unsigned char gu8;
  return (unsigned char*)(gu8*)(((unsigned long long)hi << 32) | lo);
}
__device__ __forceinline__ WS make_ws(const Params& p) {
  WS w;
  unsigned char* b = opaque_ptr(p.ws);
  w.HHI = (bf16_t*)b; b += (size_t)M_ * 2048;
  w.HLO = (bf16_t*)b; b += (size_t)M_ * 2048;
  w.ROPE = (float2*)b; b += (size_t)M_ * 128;
  unsigned char* r = b;
  w.XA = (bf16_t*)r; r += (size_t)M_ * 2048;
  w.GA = (bf16_t*)r; r += (size_t)M_ * 2048;
  w.Q = (bf16_t*)r; r += (size_t)M_ * 1024;
  w.K = (bf16_t*)r; r += (size_t)M_ * 1024;
  w.V = (bf16_t*)r; r += (size_t)M_ * 2048;
  w.GB = (bf16_t*)r; r += (size_t)M_ * 2048;
  w.AD = (bf16_t*)r; r += (size_t)M_ * 32;
  w.SSQ = (float*)r; r += (size_t)M_ * 128;
  w.BL = (float*)r; r += (size_t)8 * 4 * 33 * 128 * 4;
  r = b;
  w.CQ = (bf16_t*)r; r += (size_t)M_ * 1024;
  w.CKV = (bf16_t*)r; r += (size_t)M_ * 512;
  w.GATE = (bf16_t*)r; r += (size_t)M_ * 2048;
  w.KR = (bf16_t*)r; r += (size_t)M_ * 64;
  w.QB = (bf16_t*)r; r += (size_t)M_ * 3072;
  w.KN = (bf16_t*)r; r += (size_t)M_ * 2048;
  w.VT = (bf16_t*)r; r += (size_t)128 * 64 * TP_ * 2;
  w.W = (bf16_t*)opaque_ptr((unsigned char*)p.out);
  return w;
}

__device__ __forceinline__ unsigned cvt_pk_bf16(float lo, float hi) {
  typedef float f32x2_t __attribute__((ext_vector_type(2)));
  typedef __bf16 bf16x2_t __attribute__((ext_vector_type(2)));
  const f32x2_t v = {lo, hi};
  const bf16x2_t r = __builtin_convertvector(v, bf16x2_t);
  return __builtin_bit_cast(unsigned, r);
}
__device__ __forceinline__ f32x4 scale4(f32x4 a, float r) {
  asm volatile("" : "+v"(r));
  float x0 = a[0] * r, x1 = a[1] * r, x2 = a[2] * r, x3 = a[3] * r;
  asm volatile("" : "+v"(x0), "+v"(x1), "+v"(x2), "+v"(x3));
  return (f32x4){x0, x1, x2, x3};
}
__device__ __forceinline__ float bf2f(bf16_t v) { return __uint_as_float(((unsigned)v) << 16); }
__device__ __forceinline__ float bflo(unsigned v) { return __uint_as_float(v << 16); }
__device__ __forceinline__ float bfhi(unsigned v) { return __uint_as_float(v & 0xffff0000u); }
__device__ __forceinline__ bf16_t f2bf(float f) { return (bf16_t)(cvt_pk_bf16(f, 0.f) & 0xffffu); }
__device__ __forceinline__ float sigmoidf_(float x) { return __builtin_amdgcn_rcpf(1.f + __expf(-x)); }
__device__ __forceinline__ float siluf_(float x) { return x * __builtin_amdgcn_rcpf(1.f + __expf(-x)); }
__device__ __forceinline__ bf16x8 as_bf16x8(u32x4 v) { return __builtin_bit_cast(bf16x8, v); }
__device__ __forceinline__ int opaque_tid() { int t = threadIdx.x; asm volatile("" : "+v"(t)); return t; }
__device__ __forceinline__ int xcd_bid(int bid) { const int gpx = gridDim.x >> 3; return (bid & 7) * gpx + (bid >> 3); }
__device__ __forceinline__ int opaque_bid() { int t = blockIdx.x; asm volatile("" : "+s"(t)); return t; }
#define MFMA16(a, b, c) __builtin_amdgcn_mfma_f32_16x16x32_bf16((a), (b), (c), 0, 0, 0)

__shared__ __attribute__((aligned(16))) unsigned char smem[SMEM_BYTES + 16];

#define XB_TMO      128
#define XB_XCNT(j)  (256  + 64 * (j))
#define XB_XSUB(j)  (1280 + 64 * (j))
#define XB_XGEN(j)  (2304 + 64 * (j))
#define XB_TOP      3328
#define XB_TOPGEN   3392
#define XCD_BAR_WORDS 3456
#define XB_SPIN_CAP (1u << 18)
#define LAS __attribute__((address_space(3)))
constexpr size_t BAR_OFF = 260046848;

__device__ __forceinline__ unsigned xb_ld(unsigned* p)              { return __hip_atomic_load(p, __ATOMIC_RELAXED, __HIP_MEMORY_SCOPE_AGENT); }
__device__ __forceinline__ unsigned xb_add(unsigned* p, unsigned v) { return __hip_atomic_fetch_add(p, v, __ATOMIC_RELAXED, __HIP_MEMORY_SCOPE_AGENT); }
__device__ __forceinline__ unsigned xb_xcc_id() { return (unsigned)__builtin_amdgcn_s_getreg((3 << 11) | 20) & 0xFu; }
#define XB_SPIN(cond, bar) do { unsigned _sp = 0; while (cond) { __builtin_amdgcn_s_sleep(1); \
    if ((++_sp & 255u) == 0u) { if (xb_ld(&(bar)[XB_TMO])) break; if (_sp > XB_SPIN_CAP) { atomicAdd(&(bar)[XB_TMO], 1u); break; } } } } while (0)

struct XcdBarrier { unsigned* bar; unsigned x; volatile LAS unsigned* st; };

__device__ __forceinline__ XcdBarrier xcd_barrier_post(unsigned* bar, volatile LAS unsigned* st) {
    XcdBarrier b; b.bar = bar; b.x = xb_xcc_id(); b.st = st;
    if (threadIdx.x == 0) (void)xb_add(&bar[XB_XCNT(b.x)], 1u);
    return b;
}
__device__ __forceinline__ void xcd_barrier_complete(unsigned* bar, unsigned x, unsigned& nloc, unsigned& nx) {
    const unsigned G = gridDim.x * gridDim.y * gridDim.z;
    unsigned sum, cnt, mine, sp = 0u;
    for (;;) {
        sum = 0u; cnt = 0u; mine = 0u;
#pragma unroll
        for (unsigned j = 0; j < 16; ++j) { const unsigned c = xb_ld(&bar[XB_XCNT(j)]); sum += c; cnt += (c > 0u) ? 1u : 0u; mine = (j == x) ? c : mine; }
        if (sum == G) break;
        __builtin_amdgcn_s_sleep(1);
        if ((++sp & 255u) == 0u) { if (xb_ld(&bar[XB_TMO])) break; if (sp > XB_SPIN_CAP) { atomicAdd(&bar[XB_TMO], 1u); break; } }
    }
    nloc = mine > 0u ? mine : 1u; nx = cnt > 0u ? cnt : 1u;
}
__device__ __forceinline__ void xcd_barrier(const XcdBarrier& b) {
    asm volatile("s_waitcnt vmcnt(0)" ::: "memory");
    __syncthreads();
    if (threadIdx.x == 0) {
        unsigned* bar = b.bar;
        __builtin_amdgcn_s_waitcnt(0);
        unsigned nloc = b.st[0], nx = b.st[1];
        if (nloc == 0u) { xcd_barrier_complete(bar, b.x, nloc, nx); b.st[0] = nloc; b.st[1] = nx; }
        const unsigned old = xb_add(&bar[XB_XSUB(b.x)], 1u);
        const unsigned gen = old / nloc;
        if (old + 1u == (gen + 1u) * nloc) {
            __builtin_amdgcn_fence(__ATOMIC_RELEASE, "agent");
            asm volatile("s_waitcnt vmcnt(0)" ::: "memory");
            const unsigned og = xb_add(&bar[XB_TOP], 1u);
            const unsigned tg = og / nx;
            if (og + 1u == (tg + 1u) * nx) xb_add(&bar[XB_TOPGEN], 1u);
            else XB_SPIN(xb_ld(&bar[XB_TOPGEN]) == tg, bar);
            __builtin_amdgcn_fence(__ATOMIC_ACQUIRE, "agent");
            xb_add(&bar[XB_XGEN(b.x)], 1u);
            asm volatile("s_waitcnt vmcnt(0)" ::: "memory");
        } else {
            XB_SPIN(xb_ld(&bar[XB_XGEN(b.x)]) == gen, bar);
            __builtin_amdgcn_fence(__ATOMIC_ACQUIRE, "agent");
            asm volatile("s_waitcnt vmcnt(0)" ::: "memory");
        }
    }
    __syncthreads();
}


__device__ __forceinline__ int map_even_in(int n) { return n < 4096 ? n : (n < 5120 ? n + 16 : (n < 5136 ? n - 1024 : -1)); }
__device__ __forceinline__ int map_odd_in(int n) { return n < 768 ? n : (n < 1792 ? n + 32 : (n < 1824 ? n - 1024 : -1)); }

__device__ __forceinline__ void convert_tile(const float* __restrict__ src, int K, int Nsrc, bf16_t* __restrict__ dst,
                                             int kind, const float* __restrict__ g, int tile) {
  float* tl = (float*)smem;
  const int nkt = K >> 7;
  const int ntile = tile / nkt, ktile = tile - ntile * nkt;
  const int n0 = ntile * 64, k0 = ktile * 128;
  const int tid = opaque_tid();
  const int nl = tid & 63, kq = tid >> 6;
  const int n = n0 + nl;
  const int sc = kind == 0 ? map_even_in(n) : (kind == 1 ? map_odd_in(n) : n);
  float cs = 1.f;
  if (kind == 0 && n >= 2048 && n < 2560) cs = 0.08838834764831845f;
  if (kind == 2) cs = QSCALE_MLA;
  float v[32];
#pragma unroll
  for (int i = 0; i < 32; ++i) {
    const int kl = kq + 4 * i;
    v[i] = 0.f;
    if (sc >= 0) v[i] = src[(size_t)(k0 + kl) * Nsrc + sc];
  }
#pragma unroll
  for (int i = 0; i < 32; ++i) {
    const int kl = kq + 4 * i;
    float t = v[i] * cs;
    if (g) t *= g[k0 + kl];
    tl[kl * 65 + nl] = t;
  }
  __syncthreads();
#pragma unroll
  for (int i = 0; i < 4; ++i) {
    const int c = tid + 256 * i;
    const int nl2 = c >> 4, kc = c & 15;
    float t[8];
#pragma unroll
    for (int jj = 0; jj < 8; ++jj) t[jj] = tl[(kc * 8 + jj) * 65 + nl2];
    u32x4 pk;
    pk.x = cvt_pk_bf16(t[0], t[1]); pk.y = cvt_pk_bf16(t[2], t[3]); pk.z = cvt_pk_bf16(t[4], t[5]); pk.w = cvt_pk_bf16(t[6], t[7]);
    *(u32x4*)(dst + (size_t)(n0 + nl2) * K + k0 + kc * 8) = pk;
  }
  __syncthreads();
}

__device__ __forceinline__ void phase_prologue(const Params& p, const WS& ws) {
  for (int id = opaque_bid(); id < 2880; id += gridDim.x) {
    const int j = id / 1440; int r = id - j * 1440;
    bf16_t* wb = ws.W + (size_t)j * W_PER_J;
    if (r < 656) convert_tile(p.ab_w_in + (size_t)j * 1024 * 5136, 1024, 5136, wb + W_IN_E, 0, p.ab_norm + j * 1024, r);
    else if ((r -= 656) < 256) convert_tile(p.ab_w_out + (size_t)j * 2048 * 1024, 2048, 1024, wb + W_OUT_E, 3, nullptr, r);
    else if ((r -= 256) < 240) convert_tile(p.c_w_in + (size_t)j * 1024 * 1824, 1024, 1824, wb + W_IN_O, 1, p.c_norm + j * 1024, r);
    else if ((r -= 240) < 96) convert_tile(p.c_w_q_up + (size_t)j * 512 * 1536, 512, 1536, wb + W_Q, 2, p.c_q_norm + j * 512, r);
    else if ((r -= 96) < 64) convert_tile(p.c_w_kv_up + (size_t)j * 256 * 2048, 256, 2048, wb + W_KV, 3, p.c_kv_norm + j * 256, r);
    else { r -= 64; convert_tile(p.c_w_out + (size_t)j * 1024 * 1024, 1024, 1024, wb + W_O, 3, nullptr, r); }
  }
  const size_t gtid = (size_t)opaque_bid() * 256 + opaque_tid(), gsz = (size_t)gridDim.x * 256;
  for (size_t idx0 = gtid; idx0 < (size_t)M_ * 256; idx0 += 4 * gsz) {
    float4 v4[4];
#pragma unroll
    for (int q = 0; q < 4; ++q) {
      const size_t idx = idx0 + q * gsz;
      v4[q] = make_float4(0.f, 0.f, 0.f, 0.f);
      if (idx < (size_t)M_ * 256) {
        const int row = (int)(idx >> 8), c4 = (int)(idx & 255);
        const int b = row / T_, t = row - b * T_;
        const float* src = t < 16 ? p.meta + (size_t)t * 1024 : p.x + ((size_t)b * 2048 + (t - 16)) * 1024;
        v4[q] = *(const float4*)(src + c4 * 4);
      }
    }
#pragma unroll
    for (int q = 0; q < 4; ++q) {
      const size_t idx = idx0 + q * gsz;
      if (idx < (size_t)M_ * 256) {
        const float4 v = v4[q];
        u32x2 hi; hi.x = cvt_pk_bf16(v.x, v.y); hi.y = cvt_pk_bf16(v.z, v.w);
        u32x2 lo; lo.x = cvt_pk_bf16(v.x - bflo(hi.x), v.y - bfhi(hi.x)); lo.y = cvt_pk_bf16(v.z - bflo(hi.y), v.w - bfhi(hi.y));
        *(u32x2*)(ws.HHI + idx * 4) = hi;
        *(u32x2*)(ws.HLO + idx * 4) = lo;
      }
    }
  }
  for (size_t idx = gtid; idx < (size_t)M_ * 16; idx += gsz) {
    const int row = (int)(idx >> 4), i = (int)(idx & 15);
    const int b = row / T_, t = row - b * T_;
    const int pos = t < 16 ? t : p.positions[b * 2048 + (t - 16)] + 16;
    const float angf = (float)pos * p.inv_freq[i];
    const double rev = (double)angf * 0.15915494309189533577;
    const float fr = (float)(rev - rint(rev));
    ws.ROPE[idx] = make_float2(__builtin_amdgcn_cosf(fr), __builtin_amdgcn_sinf(fr));
  }
}

#ifndef REP_GEMM
#define REP_GEMM 1
#endif
#ifndef REP_ATTN
#define REP_ATTN 1
#endif
#ifndef REP_E2
#define REP_E2 1
#endif
enum { EPI_E1 = 0, EPI_O1 = 1, EPI_Q = 2, EPI_KV = 3, EPI_RES = 4 };

template <int EPI, int TI>
__device__ __forceinline__ void gemm_epilogue(const WS& ws, const f32x4 (&acc)[4][TI], const float (&rs)[TI], int tok0, int n0,
                                              int wm, int wn, int lr, int lq, bool dry) {
  auto tokr = [&](int ti) { return tok0 + (ti < 4 ? wn * 64 + ti * 16 : 128 + wn * 16) + lr; };
  auto okr = [&](int ti) { return ti < 4 || (wn == 0 && lr == 0); };
  const int nw = n0 + wm * 64;
  if (EPI == EPI_E1) {
    bf16_t* dst; int ld, c;
    if (n0 < 1024) { dst = ws.XA; ld = 1024; c = n0; }
    else if (n0 < 2048) { dst = ws.GA; ld = 1024; c = n0 - 1024; }
    else if (n0 < 2560) { dst = ws.Q; ld = 512; c = n0 - 2048; }
    else if (n0 < 3072) { dst = ws.K; ld = 512; c = n0 - 2560; }
    else if (n0 < 4096) { dst = ws.V; ld = 1024; c = n0 - 3072; }
    else if (n0 < 5120) { dst = ws.GB; ld = 1024; c = n0 - 4096; }
    else { dst = ws.AD; ld = 16; c = 0; }
    const bool isad = n0 >= 5120;
#pragma unroll
    for (int ni = 0; ni < 4; ++ni) {
      if (isad && (wm != 0 || ni != 0)) continue;
#pragma unroll
      for (int ti = 0; ti < TI; ++ti) {
        const f32x4 v = scale4(acc[ni][ti], rs[ti]);
        u32x2 pk; pk.x = cvt_pk_bf16(v[0], v[1]); pk.y = cvt_pk_bf16(v[2], v[3]);
        if (okr(ti)) *(u32x2*)(dst + (size_t)tokr(ti) * ld + c + wm * 64 + ni * 16 + 4 * lq) = pk;
      }
    }
  } else if (EPI == EPI_O1) {
    if (n0 < 1792) {
      bf16_t* dst; int ld, c;
      if (n0 < 512) { dst = ws.CQ; ld = 512; c = n0; }
      else if (n0 < 768) { dst = ws.CKV; ld = 256; c = n0 - 512; }
      else { dst = ws.GATE; ld = 1024; c = n0 - 768; }
#pragma unroll
      for (int ni = 0; ni < 4; ++ni)
#pragma unroll
        for (int ti = 0; ti < TI; ++ti) {
          const f32x4 v = scale4(acc[ni][ti], rs[ti]);
          u32x2 pk; pk.x = cvt_pk_bf16(v[0], v[1]); pk.y = cvt_pk_bf16(v[2], v[3]);
          if (okr(ti)) *(u32x2*)(dst + (size_t)tokr(ti) * ld + c + wm * 64 + ni * 16 + 4 * lq) = pk;
        }
    } else if (wm == 0) {
#pragma unroll
      for (int ti = 0; ti < TI; ++ti) {
        const int tok = tokr(ti);
        const f32x4 x1 = scale4(acc[0][ti], rs[ti]), x2 = scale4(acc[1][ti], rs[ti]);
        float o1[4], o2[4];
#pragma unroll
        for (int jj = 0; jj < 4; ++jj) {
          const float2 cs = ws.ROPE[(size_t)tok * 16 + 4 * lq + jj];
          o1[jj] = x1[jj] * cs.x - x2[jj] * cs.y;
          o2[jj] = x2[jj] * cs.x + x1[jj] * cs.y;
        }
        u32x2 pk; pk.x = cvt_pk_bf16(o1[0], o1[1]); pk.y = cvt_pk_bf16(o1[2], o1[3]);
        *(u32x2*)(ws.KR + (size_t)tok * 32 + 4 * lq) = pk;
        pk.x = cvt_pk_bf16(o2[0], o2[1]); pk.y = cvt_pk_bf16(o2[2], o2[3]);
        *(u32x2*)(ws.KR + (size_t)tok * 32 + 16 + 4 * lq) = pk;
      }
    }
  } else if (EPI == EPI_Q) {
#pragma unroll
    for (int ni = 0; ni < 4; ++ni)
#pragma unroll
      for (int ti = 0; ti < TI; ++ti) {
        const f32x4 v = scale4(acc[ni][ti], rs[ti]);
        u32x2 pk; pk.x = cvt_pk_bf16(v[0], v[1]); pk.y = cvt_pk_bf16(v[2], v[3]);
        if (okr(ti)) *(u32x2*)(ws.QB + (size_t)tokr(ti) * 1536 + nw + ni * 16 + 4 * lq) = pk;
      }
  } else if (EPI == EPI_KV) {
    const int hd = nw >> 7;
    const bool isv = (nw & 127) >= 64;
    if (!isv) {
#pragma unroll
      for (int ni = 0; ni < 4; ++ni)
#pragma unroll
        for (int ti = 0; ti < TI; ++ti) {
          const f32x4 v = scale4(acc[ni][ti], rs[ti]);
          u32x2 pk; pk.x = cvt_pk_bf16(v[0], v[1]); pk.y = cvt_pk_bf16(v[2], v[3]);
          if (okr(ti)) *(u32x2*)(ws.KN + (size_t)tokr(ti) * 1024 + hd * 64 + ni * 16 + 4 * lq) = pk;
        }
    } else {
#pragma unroll
      for (int ti = 0; ti < TI; ++ti) {
        const int tok = tokr(ti);
        const int b = tok / T_, t = tok - b * T_;
        bf16_t* vb = ws.VT + ((size_t)(b * 16 + hd) * 64) * TP_ + t;
#pragma unroll
        for (int ni = 0; ni < 4; ++ni) {
          const f32x4 v = scale4(acc[ni][ti], rs[ti]);
#pragma unroll
          for (int jj = 0; jj < 4; ++jj) if (okr(ti)) vb[(size_t)(ni * 16 + 4 * lq + jj) * TP_] = f2bf(v[jj]);
        }
      }
    }
  } else {
#pragma unroll
    for (int ni = 0; ni < 4; ++ni)
#pragma unroll
      for (int ti = 0; ti < TI; ++ti) {
        if (!okr(ti)) continue;
        const size_t off = (size_t)tokr(ti) * 1024 + nw + ni * 16 + 4 * lq;
        const u32x2 hi = *(const u32x2*)(ws.HHI + off), lo = *(const u32x2*)(ws.HLO + off);
        const float h0 = bflo(hi.x) + bflo(lo.x) + acc[ni][ti][0], h1 = bfhi(hi.x) + bfhi(lo.x) + acc[ni][ti][1];
        const float h2 = bflo(hi.y) + bflo(lo.y) + acc[ni][ti][2], h3 = bfhi(hi.y) + bfhi(lo.y) + acc[ni][ti][3];
        u32x2 nh; nh.x = cvt_pk_bf16(h0, h1); nh.y = cvt_pk_bf16(h2, h3);
        u32x2 nl; nl.x = cvt_pk_bf16(h0 - bflo(nh.x), h1 - bfhi(nh.x)); nl.y = cvt_pk_bf16(h2 - bflo(nh.y), h3 - bfhi(nh.y));
        if (!dry) { *(u32x2*)(ws.HHI + off) = nh; *(u32x2*)(ws.HLO + off) = nl; }
      }
  }
}

__device__ __forceinline__ float sumsq8(bf16x8 v) {
  const u32x4 u = __builtin_bit_cast(u32x4, v);
  float s = 0.f, t;
  t = bflo(u.x); s += t * t; t = bfhi(u.x); s += t * t; t = bflo(u.y); s += t * t; t = bfhi(u.y); s += t * t;
  t = bflo(u.z); s += t * t; t = bfhi(u.z); s += t * t; t = bflo(u.w); s += t * t; t = bfhi(u.w); s += t * t;
  return s;
}
__device__ __forceinline__ void tile_of(int pos, int ntn, int& mt, int& nt) {
  const int full = 128 * ntn;
  if (pos < full) { const int panel = pos / (8 * ntn); const int rem = pos - panel * 8 * ntn; nt = rem >> 3; mt = panel * 8 + (rem & 7); }
  else { mt = 128; nt = pos - full; }
}
template <bool RS, int EPI, int TI>
__device__ __forceinline__ void gemm_stream(const WS& ws, const bf16_t* A0, const bf16_t* A1, int lda, int ktsplit, int kstride,
                                            const bf16_t* __restrict__ W, int K, float invK, int ntn, int ntiles, int bid, bool dry) {
  constexpr int BM = (TI == 5) ? 129 : 128;
  constexpr int ASTG = 16384;
  unsigned char* As = smem;
  unsigned char* Bs = smem + 2 * ASTG;
  float* rsl = (float*)(smem + 65536);
  int xbase = 66048;
  asm volatile("" : "+v"(xbase));
  unsigned char* Ax0 = smem + xbase;
  const int tid = opaque_tid(), lane = tid & 63, w = tid >> 6, wm = w >> 1, wn = w & 1, lr = lane & 15, lq = lane >> 4;
  const int G = gridDim.x;
  const int nk = K >> 6;
  if (bid < ntiles) {
    const int my_tiles = (ntiles - 1 - bid) / G + 1;
    const int last_id = bid + (my_tiles - 1) * G;
    const int S = my_tiles * nk;
    f32x4 acc[4][TI];
#pragma unroll
    for (int a = 0; a < 4; ++a)
#pragma unroll
      for (int b = 0; b < TI; ++b) acc[a][b] = (f32x4){0.f, 0.f, 0.f, 0.f};
    u32x4 ra0[4], rb0[4], ra1[4], rb1[4];
    u32x4 rx0 = (u32x4){0u, 0u, 0u, 0u}, rx1 = (u32x4){0u, 0u, 0u, 0u};
    float ss[5] = {0.f, 0.f, 0.f, 0.f, 0.f};
    int l_id = bid, l_kt = 0, c_id = bid, c_kt = 0, st_kt = 0;
    const int srow = tid >> 3;
    const int soff = srow * 128 + (((tid & 7) ^ (srow & 7)) << 4);

    auto issue = [&](u32x4 (&ra)[4], u32x4 (&rb)[4], u32x4& rx) {
      const int idc = l_id < last_id ? l_id : last_id;
      int mt, nt; tile_of(idc, ntn, mt, nt);
      const bf16_t* A = (l_kt < ktsplit) ? A0 : A1;
      const int kk = (l_kt < ktsplit) ? l_kt : l_kt - ktsplit;
      const bf16_t* ap = A + (size_t)(mt * BM + srow) * lda + kk * kstride + (tid & 7) * 8;
      const bf16_t* wp = W + (size_t)(nt * 128 + srow) * K + l_kt * 64 + (tid & 7) * 8;
#pragma unroll
      for (int i = 0; i < 4; ++i) {
        ra[i] = *(const u32x4*)(ap + (size_t)i * 32 * lda);
        rb[i] = *(const u32x4*)(wp + (size_t)i * 32 * K);
      }
      if (TI == 5) { if (srow == 0) rx = *(const u32x4*)(ap + (size_t)128 * lda); }
      if (++l_kt == nk) { l_kt = 0; l_id += G; }
    };
    auto store = [&](const u32x4 (&ra)[4], const u32x4 (&rb)[4], const u32x4& rx, int buf) {
#pragma unroll
      for (int i = 0; i < 4; ++i) {
        if (RS) ss[i] += sumsq8(__builtin_bit_cast(bf16x8, ra[i]));
        *(u32x4*)(As + buf * ASTG + i * 4096 + soff) = ra[i];
        *(u32x4*)(Bs + buf * 16384 + i * 4096 + soff) = rb[i];
      }
      if (TI == 5) {
        if (RS) ss[4] += sumsq8(__builtin_bit_cast(bf16x8, rx));
        if (srow == 0) *(u32x4*)(Ax0 + buf * 128 + ((tid & 7) << 4)) = rx;
      }
      if (RS) {
        if (++st_kt == nk) {
          st_kt = 0;
#pragma unroll
          for (int i = 0; i < TI; ++i) {
            float t = ss[i];
            t += __shfl_xor(t, 1); t += __shfl_xor(t, 2); t += __shfl_xor(t, 4);
            if ((tid & 7) == 0 && i < 4) rsl[srow + 32 * i] = rsqrtf(t * invK + EPS_);
            ss[i] = 0.f;
          }
        }
      }
    };
    auto compute = [&](int buf) {
      const unsigned char* Ab = As + buf * ASTG + (wn * 64 + lr) * 128;
      const unsigned char* Ax = Ax0 + buf * 128;
      const unsigned char* Bb = Bs + buf * 16384 + (wm * 64 + lr) * 128;
#pragma unroll
      for (int ks = 0; ks < 2; ++ks) {
        if (TI == 5 && ks == 1) __builtin_amdgcn_sched_barrier(0);
        const int sw = ((ks * 4 + lq) ^ (lr & 7)) << 4;
        bf16x8 wf[4], xf[TI];
#pragma unroll
        for (int i = 0; i < 4; ++i) {
          wf[i] = *(const bf16x8*)(Bb + i * 2048 + sw);
          xf[i] = *(const bf16x8*)(Ab + i * 2048 + sw);
        }
        if (TI == 5) xf[TI - 1] = *(const bf16x8*)(Ax + ((ks * 4 + lq) << 4));
#pragma unroll
        for (int ni = 0; ni < 4; ++ni)
#pragma unroll
          for (int ti = 0; ti < TI; ++ti) acc[ni][ti] = MFMA16(wf[ni], xf[ti], acc[ni][ti]);
      }
    };
    auto tile_end = [&]() {
      float rs[TI];
#pragma unroll
      for (int ti = 0; ti < TI; ++ti) rs[ti] = 1.f;
      if (RS) {
#pragma unroll
        for (int ti = 0; ti < TI; ++ti) rs[ti] = rsl[(ti < 4 ? wn * 64 + ti * 16 : 0) + lr];
      }
      int mt, nt; tile_of(c_id, ntn, mt, nt);
      gemm_epilogue<EPI, TI>(ws, acc, rs, mt * BM, nt * 128, wm, wn, lr, lq, dry);
#pragma unroll
      for (int a = 0; a < 4; ++a)
#pragma unroll
        for (int b = 0; b < TI; ++b) acc[a][b] = (f32x4){0.f, 0.f, 0.f, 0.f};
      c_id += G;
    };

    issue(ra0, rb0, rx0);
    issue(ra1, rb1, rx1);
    store(ra0, rb0, rx0, 0);
    __syncthreads();
#pragma unroll 1
    for (int s = 0; s < S; s += 2) {
      issue(ra0, rb0, rx0);
      compute(0);
      store(ra1, rb1, rx1, 1);
      __syncthreads();
      issue(ra1, rb1, rx1);
      compute(1);
      c_kt += 2;
      if (c_kt == nk) { c_kt = 0; tile_end(); }
      store(ra0, rb0, rx0, 0);
      __syncthreads();
    }
  }
  __syncthreads();
}

__device__ __forceinline__ void gla_decay_unit(const Params& p, const WS& ws, int j, int u) {
  const int c = u % 33; const int bh = u / 33; const int hd = bh & 3, b = bh >> 2;
  bf16_t* Qs = (bf16_t*)smem;
  bf16_t* Ks = Qs + 64 * 136;
  float* ADs = (float*)(smem + 2 * 64 * 136 * 2);
  float* HT = ADs + 64 * 16;
  const int tid = opaque_tid();
  const int tbase = 64 * c - 48;
#pragma unroll
  for (int i = 0; i < 4; ++i) {
    const int ci = tid + 256 * i; const int row = ci >> 4, ch = ci & 15; const int t = tbase + row;
    u32x4 qv = (u32x4){0, 0, 0, 0}, kv = (u32x4){0, 0, 0, 0};
    if (t >= 0) {
      qv = *(const u32x4*)(ws.Q + (size_t)(b * T_ + t) * 512 + hd * 128 + ch * 8);
      kv = *(const u32x4*)(ws.K + (size_t)(b * T_ + t) * 512 + hd * 128 + ch * 8);
    }
    *(u32x4*)(Qs + row * 136 + ch * 8) = qv;
    *(u32x4*)(Ks + row * 136 + ch * 8) = kv;
    const int t2 = tbase + (ci >> 4);
    ADs[ci] = t2 >= 0 ? bf2f(ws.AD[(size_t)(b * T_ + t2) * 16 + (ci & 15)]) : 0.f;
  }
  const int d = tid & 127, half = tid >> 7;
  float aw[16];
#pragma unroll
  for (int r = 0; r < 16; ++r) aw[r] = p.ab_alpha_w[(size_t)(j * 16 + r) * 512 + hd * 128 + d];
  const float abias = p.ab_alpha_b[j * 512 + hd * 128 + d];
  __syncthreads();
  float cs[32];
  float run = 0.f;
#pragma unroll
  for (int ii = 0; ii < 32; ++ii) {
    const int row = half * 32 + ii;
    float xv = abias;
#pragma unroll
    for (int r4 = 0; r4 < 4; ++r4) {
      const float4 a4 = *(const float4*)(ADs + row * 16 + r4 * 4);
      xv += a4.x * aw[r4 * 4] + a4.y * aw[r4 * 4 + 1] + a4.z * aw[r4 * 4 + 2] + a4.w * aw[r4 * 4 + 3];
    }
    float la = (fminf(xv, 0.f) - __logf(1.f + __expf(-fabsf(xv)))) * 0.0625f;
    if (tbase + row < 0) la = 0.f;
    run += la;
    cs[ii] = run;
  }
  HT[half * 128 + d] = run;
  __syncthreads();
  const float off = half ? HT[d] : 0.f;
  const float blast = HT[d] + HT[128 + d];
#pragma unroll
  for (int ii = 0; ii < 32; ++ii) {
    const int row = half * 32 + ii;
    const float bb = cs[ii] + off;
    const float eb = __expf(bb), ebi = __expf(-bb);
    Qs[row * 136 + d] = f2bf(bf2f(Qs[row * 136 + d]) * eb);
    Ks[row * 136 + d] = f2bf(bf2f(Ks[row * 136 + d]) * ebi);
  }
  if (half == 0) ws.BL[(size_t)((b * 4 + hd) * 33 + c) * 128 + d] = __expf(blast);
  __syncthreads();
#pragma unroll
  for (int i = 0; i < 4; ++i) {
    const int ci = tid + 256 * i; const int row = ci >> 4, ch = ci & 15; const int t = tbase + row;
    if (t >= 0) {
      *(u32x4*)(ws.Q + (size_t)(b * T_ + t) * 512 + hd * 128 + ch * 8) = *(const u32x4*)(Qs + row * 136 + ch * 8);
      *(u32x4*)(ws.K + (size_t)(b * T_ + t) * 512 + hd * 128 + ch * 8) = *(const u32x4*)(Ks + row * 136 + ch * 8);
    }
  }
  __syncthreads();
}

__device__ __forceinline__ void gla_unit(const Params& p, const WS& ws, int u, bool dry = false) {
  const int sl = u & 7; const int bh = u >> 3; const int hd = bh & 3, b = bh >> 2;
  bf16_t* QDs = (bf16_t*)smem;
  bf16_t* KIs = QDs + 64 * 136;
  bf16_t* KIT = KIs + 64 * 136;
  bf16_t* VTs = KIT + 128 * 72;
  bf16_t* STs = VTs + 32 * 72;
  bf16_t* Ps = STs + 32 * 136;
  const int tid = opaque_tid(), lane = tid & 63, w = tid >> 6, lr = lane & 15, lq = lane >> 4;
  for (int i = tid; i < 32 * 136 / 2; i += 256) ((unsigned*)STs)[i] = 0u;
  f32x4 sacc[2][2];
#pragma unroll
  for (int a = 0; a < 2; ++a)
#pragma unroll
    for (int bb = 0; bb < 2; ++bb) sacc[a][bb] = (f32x4){0.f, 0.f, 0.f, 0.f};
  u32x4 qrA[4], krA[4], vrA, qrB[4], krB[4], vrB;
  float eblA[2], eblB[2];
  const float* BLp = ws.BL + (size_t)((b * 4 + hd) * 33) * 128;
  auto prefetch = [&](int c, u32x4 (&qr)[4], u32x4 (&kr)[4], u32x4& vr, float (&ebl)[2]) {
    const int tbase = 64 * c - 48;
#pragma unroll
    for (int i = 0; i < 4; ++i) {
      const int ci = tid + 256 * i; const int row = ci >> 4, ch = ci & 15; const int t = tbase + row;
      qr[i] = (u32x4){0, 0, 0, 0}; kr[i] = (u32x4){0, 0, 0, 0};
      if (t >= 0) {
        qr[i] = *(const u32x4*)(ws.Q + (size_t)(b * T_ + t) * 512 + hd * 128 + ch * 8);
        kr[i] = *(const u32x4*)(ws.K + (size_t)(b * T_ + t) * 512 + hd * 128 + ch * 8);
      }
    }
    {
      const int row = tid >> 2, ch = tid & 3; const int t = tbase + row;
      vr = (u32x4){0, 0, 0, 0};
      if (t >= 0) vr = *(const u32x4*)(ws.V + (size_t)(b * T_ + t) * 1024 + hd * 256 + sl * 32 + ch * 8);
    }
    ebl[0] = BLp[c * 128 + 16 * (2 * w) + lr];
    ebl[1] = BLp[c * 128 + 16 * (2 * w + 1) + lr];
  };
  prefetch(0, qrA, krA, vrA, eblA);
  prefetch(1, qrB, krB, vrB, eblB);
  auto body = [&](int c, u32x4 (&qr)[4], u32x4 (&kr)[4], u32x4& vr, float (&ebl)[2]) {
#pragma unroll
    for (int i = 0; i < 4; ++i) {
      const int ci = tid + 256 * i; const int row = ci >> 4, ch = ci & 15;
      *(u32x4*)(QDs + row * 136 + ch * 8) = qr[i];
      *(u32x4*)(KIs + row * 136 + ch * 8) = kr[i];
      const unsigned kk[4] = {kr[i].x, kr[i].y, kr[i].z, kr[i].w};
#pragma unroll
      for (int e = 0; e < 4; ++e) {
        KIT[(ch * 8 + 2 * e) * 72 + (row ^ ((ch & 7) << 3))] = (bf16_t)(kk[e] & 0xffffu);
        KIT[(ch * 8 + 2 * e + 1) * 72 + (row ^ ((ch & 7) << 3))] = (bf16_t)(kk[e] >> 16);
      }
    }
    {
      const int row = tid >> 2, ch = tid & 3;
      const unsigned vv[4] = {vr.x, vr.y, vr.z, vr.w};
#pragma unroll
      for (int e = 0; e < 4; ++e) {
        VTs[(ch * 8 + 2 * e) * 72 + (row ^ (ch << 3))] = (bf16_t)(vv[e] & 0xffffu);
        VTs[(ch * 8 + 2 * e + 1) * 72 + (row ^ (ch << 3))] = (bf16_t)(vv[e] >> 16);
      }
    }
    const float eb0 = ebl[0], eb1 = ebl[1];
    __syncthreads();
    if (c + 2 < 33) prefetch(c + 2, qr, kr, vr, ebl);
    bf16x8 xq[4];
#pragma unroll
    for (int ks = 0; ks < 4; ++ks) xq[ks] = *(const bf16x8*)(QDs + (16 * w + lr) * 136 + 32 * ks + 8 * lq);
    const int irow = 16 * w + lr;
#pragma unroll
    for (int mt = 0; mt < 4; ++mt) {
      u32x2 pk = (u32x2){0u, 0u};
      if (mt <= w) {
        f32x4 a = (f32x4){0.f, 0.f, 0.f, 0.f};
#pragma unroll
        for (int ks = 0; ks < 4; ++ks) {
          const bf16x8 kf = *(const bf16x8*)(KIs + (16 * mt + lr) * 136 + 32 * ks + 8 * lq);
          a = MFMA16(kf, xq[ks], a);
        }
        const int ip = 16 * mt + 4 * lq;
        const float v0 = (ip + 0 <= irow) ? a[0] : 0.f, v1 = (ip + 1 <= irow) ? a[1] : 0.f;
        const float v2 = (ip + 2 <= irow) ? a[2] : 0.f, v3 = (ip + 3 <= irow) ? a[3] : 0.f;
        pk.x = cvt_pk_bf16(v0, v1); pk.y = cvt_pk_bf16(v2, v3);
      }
      *(u32x2*)(Ps + irow * 72 + 16 * mt + 4 * lq) = pk;
    }
    __syncthreads();
    f32x4 oacc[2];
    oacc[0] = (f32x4){0.f, 0.f, 0.f, 0.f}; oacc[1] = (f32x4){0.f, 0.f, 0.f, 0.f};
#pragma unroll
    for (int ks = 0; ks < 2; ++ks) {
      if (2 * ks <= w) {
        const bf16x8 pb = *(const bf16x8*)(Ps + irow * 72 + 32 * ks + 8 * lq);
#pragma unroll
        for (int mt = 0; mt < 2; ++mt) {
          const bf16x8 vf = *(const bf16x8*)(VTs + (16 * mt + lr) * 72 + (((4 * ks + lq) ^ (((16 * mt + lr) >> 3) & 3)) << 3));
          oacc[mt] = MFMA16(vf, pb, oacc[mt]);
        }
      }
    }
#pragma unroll
    for (int ks = 0; ks < 4; ++ks)
#pragma unroll
      for (int mt = 0; mt < 2; ++mt) {
        const bf16x8 sf = *(const bf16x8*)(STs + (16 * mt + lr) * 136 + 32 * ks + 8 * lq);
        oacc[mt] = MFMA16(sf, xq[ks], oacc[mt]);
      }
    {
      const int t = 64 * c - 48 + irow;
      float sq = 0.f;
#pragma unroll
      for (int mt = 0; mt < 2; ++mt) sq += oacc[mt][0] * oacc[mt][0] + oacc[mt][1] * oacc[mt][1] + oacc[mt][2] * oacc[mt][2] + oacc[mt][3] * oacc[mt][3];
      sq += __shfl_xor(sq, 16); sq += __shfl_xor(sq, 32);
      if (t >= 0 && !dry) {
        const size_t row = (size_t)(b * T_ + t);
#pragma unroll
        for (int mt = 0; mt < 2; ++mt) {
          u32x2 pk; pk.x = cvt_pk_bf16(oacc[mt][0], oacc[mt][1]); pk.y = cvt_pk_bf16(oacc[mt][2], oacc[mt][3]);
          *(u32x2*)(ws.V + row * 1024 + hd * 256 + sl * 32 + 16 * mt + 4 * lq) = pk;
        }
        if (lq == 0) ws.SSQ[row * 32 + hd * 8 + sl] = sq;
      }
    }
    __syncthreads();
#pragma unroll
    for (int ntl = 0; ntl < 2; ++ntl) {
#pragma unroll
      for (int ks = 0; ks < 2; ++ks) {
        const bf16x8 kf = *(const bf16x8*)(KIT + (16 * (2 * w + ntl) + lr) * 72 + (((4 * ks + lq) ^ (((16 * (2 * w + ntl) + lr) >> 3) & 7)) << 3));
#pragma unroll
        for (int mt = 0; mt < 2; ++mt) {
          const bf16x8 vf = *(const bf16x8*)(VTs + (16 * mt + lr) * 72 + (((4 * ks + lq) ^ (((16 * mt + lr) >> 3) & 3)) << 3));
          sacc[mt][ntl] = MFMA16(vf, kf, sacc[mt][ntl]);
        }
      }
      const float e = ntl ? eb1 : eb0;
#pragma unroll
      for (int mt = 0; mt < 2; ++mt) {
        sacc[mt][ntl] = sacc[mt][ntl] * e;
#pragma unroll
        for (int jj = 0; jj < 4; ++jj) STs[(16 * mt + 4 * lq + jj) * 136 + 16 * (2 * w + ntl) + lr] = f2bf(sacc[mt][ntl][jj]);
      }
    }
    __syncthreads();
  };
#pragma unroll 1
  for (int c = 0; c < 33; c += 2) {
    body(c, qrA, krA, vrA, eblA);
    if (c + 1 < 33) body(c + 1, qrB, krB, vrB, eblB);
  }
}

__device__ __forceinline__ void rglru_unit(const Params& p, const WS& ws, int j, int u, bool dry = false) {
  const int jq = u & 3, g = (u >> 2) & 7, b = u >> 5;
  bf16_t* XC = (bf16_t*)smem;
  bf16_t* WG = XC + 64 * 136;
  float* AUa = (float*)(smem + 34816);
  float* AUu = AUa + 64 * 33;
  float* SEGA = AUu + 64 * 33;
  float* SEGH = SEGA + 256;
  float* CARRY = SEGH + 256;
  const int tid = opaque_tid(), lane = tid & 63, w = tid >> 6, lr = lane & 15, lq = lane >> 4;
#pragma unroll 4
  for (int i = 0; i < 32; ++i) {
    const int e = tid + 256 * i;
    const int gate = e >> 12, k = (e >> 5) & 127, n = e & 31;
    const float* gw = gate ? p.ab_gate_x_w : p.ab_gate_a_w;
    WG[(gate * 32 + n) * 136 + k] = f2bf(gw[((size_t)(j * 8 + g) * 128 + k) * 128 + 32 * jq + n]);
  }
  if (tid < 32) CARRY[tid] = 0.f;
  const int cc = tid & 15, rb = 4 * (tid >> 4);
  float cw[4][8], cb[8];
#pragma unroll
  for (int e = 0; e < 8; ++e) {
    cb[e] = p.ab_conv_b[j * 1024 + 128 * g + 8 * cc + e];
#pragma unroll
    for (int k = 0; k < 4; ++k) cw[k][e] = p.ab_conv_w[(size_t)(j * 4 + k) * 1024 + 128 * g + 8 * cc + e];
  }
  float ba[2][4], bx[2][4], sp[2][4];
#pragma unroll
  for (int mt = 0; mt < 2; ++mt)
#pragma unroll
    for (int jj = 0; jj < 4; ++jj) {
      const int ch = j * 1024 + 128 * g + 32 * jq + 16 * mt + 4 * lq + jj;
      ba[mt][jj] = p.ab_gate_a_b[ch]; bx[mt][jj] = p.ab_gate_x_b[ch];
      sp[mt][jj] = 8.f * log1pf(__expf(-p.ab_lam[ch]));
    }
  const int sc = tid & 31, ssg = tid >> 5;
  u32x4 xinA[7], xinB[7];
  bf16_t gavA[8], gavB[8];
  auto prefetch = [&](int tile, u32x4 (&xin)[7], bf16_t (&gav)[8]) {
    const int t0 = 64 * tile;
#pragma unroll
    for (int m = 0; m < 7; ++m) {
      const int tt = t0 + rb - 3 + m;
      xin[m] = (u32x4){0, 0, 0, 0};
      if (tt >= 0 && tt < T_) xin[m] = *(const u32x4*)(ws.XA + (size_t)(b * T_ + tt) * 1024 + 128 * g + 8 * cc);
    }
#pragma unroll
    for (int i = 0; i < 8; ++i) {
      const int t = t0 + 8 * ssg + i;
      gav[i] = 0;
      if (t < T_) gav[i] = ws.GA[(size_t)(b * T_ + t) * 1024 + 128 * g + 32 * jq + sc];
    }
  };
  prefetch(0, xinA, gavA);
  prefetch(1, xinB, gavB);
  __syncthreads();
  auto body = [&](int tile, u32x4 (&xin)[7], bf16_t (&gav)[8]) {
    const int t0 = 64 * tile;
#pragma unroll
    for (int r = 0; r < 4; ++r) {
      float y[8];
#pragma unroll
      for (int e = 0; e < 8; ++e) y[e] = cb[e];
#pragma unroll
      for (int k = 0; k < 4; ++k) {
        const u32x4 xv = xin[r + k];
        y[0] += cw[k][0] * bflo(xv.x); y[1] += cw[k][1] * bfhi(xv.x);
        y[2] += cw[k][2] * bflo(xv.y); y[3] += cw[k][3] * bfhi(xv.y);
        y[4] += cw[k][4] * bflo(xv.z); y[5] += cw[k][5] * bfhi(xv.z);
        y[6] += cw[k][6] * bflo(xv.w); y[7] += cw[k][7] * bfhi(xv.w);
      }
      u32x4 pk; pk.x = cvt_pk_bf16(y[0], y[1]); pk.y = cvt_pk_bf16(y[2], y[3]); pk.z = cvt_pk_bf16(y[4], y[5]); pk.w = cvt_pk_bf16(y[6], y[7]);
      *(u32x4*)(XC + (rb + r) * 136 + 8 * cc) = pk;
    }
    float gcur[8];
#pragma unroll
    for (int i = 0; i < 8; ++i) gcur[i] = bf2f(gav[i]);
    __syncthreads();
    if (tile + 2 < 33) prefetch(tile + 2, xin, gav);
    {
      f32x4 ga_[2][2];
#pragma unroll
      for (int a = 0; a < 2; ++a)
#pragma unroll
        for (int bb = 0; bb < 2; ++bb) ga_[a][bb] = (f32x4){0.f, 0.f, 0.f, 0.f};
#pragma unroll
      for (int ks = 0; ks < 4; ++ks) {
        const bf16x8 xf = *(const bf16x8*)(XC + (16 * w + lr) * 136 + 32 * ks + 8 * lq);
#pragma unroll
        for (int gate = 0; gate < 2; ++gate)
#pragma unroll
          for (int mt = 0; mt < 2; ++mt) {
            const bf16x8 wf = *(const bf16x8*)(WG + (gate * 32 + 16 * mt + lr) * 136 + 32 * ks + 8 * lq);
            ga_[gate][mt] = MFMA16(wf, xf, ga_[gate][mt]);
          }
      }
      const int tok = 16 * w + lr;
#pragma unroll
      for (int mt = 0; mt < 2; ++mt)
#pragma unroll
        for (int jj = 0; jj < 4; ++jj) {
          const int n = 16 * mt + 4 * lq + jj;
          const float xcv = bf2f(XC[tok * 136 + 32 * jq + n]);
          const float r = sigmoidf_(ga_[0][mt][jj] + ba[mt][jj]);
          const float ig = sigmoidf_(ga_[1][mt][jj] + bx[mt][jj]);
          const float la = -r * sp[mt][jj];
          const float a = __expf(la);
          const float x2 = 2.f * la;
          const float om = x2 > -0.02f ? -x2 * (1.f + 0.5f * x2 * (1.f + x2 * (1.f / 3.f))) : 1.f - a * a;
          const float mult = __builtin_amdgcn_sqrtf(fmaxf(om, 0.f));
          AUa[tok * 33 + n] = a;
          AUu[tok * 33 + n] = mult * ig * xcv;
        }
    }
    __syncthreads();
    {
      float A = 1.f, Hh = 0.f;
#pragma unroll
      for (int i = 0; i < 8; ++i) {
        const float a = AUa[(8 * ssg + i) * 33 + sc], uu = AUu[(8 * ssg + i) * 33 + sc];
        Hh = a * Hh + uu; A *= a;
      }
      SEGA[ssg * 32 + sc] = A; SEGH[ssg * 32 + sc] = Hh;
    }
    __syncthreads();
    float hin = CARRY[sc];
#pragma unroll
    for (int s2 = 0; s2 < 7; ++s2)
      if (s2 < ssg) hin = SEGA[s2 * 32 + sc] * hin + SEGH[s2 * 32 + sc];
    __syncthreads();
    {
      float h = hin;
#pragma unroll
      for (int i = 0; i < 8; ++i) {
        const float a = AUa[(8 * ssg + i) * 33 + sc], uu = AUu[(8 * ssg + i) * 33 + sc];
        h = a * h + uu;
        const int t = t0 + 8 * ssg + i;
        if (t < T_ && !dry) ws.GA[(size_t)(b * T_ + t) * 1024 + 128 * g + 32 * jq + sc] = f2bf(h * siluf_(gcur[i]));
      }
      if (ssg == 7) CARRY[sc] = h;
    }
  };
#pragma unroll 1
  for (int tile = 0; tile < 33; tile += 2) {
    body(tile, xinA, gavA);
    if (tile + 1 < 33) body(tile + 1, xinB, gavB);
  }
  __syncthreads();
}

__device__ __forceinline__ void phase_gla_norm(const Params& p, const WS& ws, int j) {
  const size_t gtid = (size_t)opaque_bid() * 256 + opaque_tid(), gsz = (size_t)gridDim.x * 256;
  const float* gn = p.ab_gla_norm + j * 256;
#pragma unroll 4
  for (size_t idx = gtid; idx < (size_t)M_ * 128; idx += gsz) {
    const size_t row = idx >> 7; const int c8 = (int)(idx & 127); const int hd = c8 >> 5; const int dv = (c8 & 31) * 8;
    const float4 s0 = *(const float4*)(ws.SSQ + row * 32 + hd * 8), s1 = *(const float4*)(ws.SSQ + row * 32 + hd * 8 + 4);
    const float ssum = (s0.x + s0.y + s0.z + s0.w) + (s1.x + s1.y + s1.z + s1.w);
    const float rstd = rsqrtf(ssum * (1.f / 256.f) + EPS_);
    const u32x4 ov = *(const u32x4*)(ws.V + row * 1024 + c8 * 8);
    const u32x4 gv = *(const u32x4*)(ws.GB + row * 1024 + c8 * 8);
    const float4 g0 = *(const float4*)(gn + dv), g1 = *(const float4*)(gn + dv + 4);
    float o[8] = {bflo(ov.x), bfhi(ov.x), bflo(ov.y), bfhi(ov.y), bflo(ov.z), bfhi(ov.z), bflo(ov.w), bfhi(ov.w)};
    const float gg[8] = {bflo(gv.x), bfhi(gv.x), bflo(gv.y), bfhi(gv.y), bflo(gv.z), bfhi(gv.z), bflo(gv.w), bfhi(gv.w)};
    const float nn[8] = {g0.x, g0.y, g0.z, g0.w, g1.x, g1.y, g1.z, g1.w};
#pragma unroll
    for (int e = 0; e < 8; ++e) o[e] = o[e] * rstd * nn[e] * siluf_(gg[e]);
    u32x4 pk; pk.x = cvt_pk_bf16(o[0], o[1]); pk.y = cvt_pk_bf16(o[2], o[3]); pk.z = cvt_pk_bf16(o[4], o[5]); pk.w = cvt_pk_bf16(o[6], o[7]);
    *(u32x4*)(ws.V + row * 1024 + c8 * 8) = pk;
  }
}

__device__ __forceinline__ void attn_unit(const WS& ws, int u, bool dry = false) {
  const int qb = 16 - (u >> 7); const int bh = u & 127; const int hd = bh & 15, b = bh >> 4;
  bf16_t* Kt = (bf16_t*)smem;
  bf16_t* Vl = Kt + 2 * 64 * 104;
  const int tid = opaque_tid(), lane = tid & 63, w = tid >> 6, lr = lane & 15, lq = lane >> 4;
  const int q0 = 128 * qb;
  int nkt = 2 * qb + 2; if (nkt > 33) nkt = 33;
  bf16x8 xq[2][3];
  int qi[2];
#pragma unroll
  for (int nt = 0; nt < 2; ++nt) {
    qi[nt] = q0 + 32 * w + 16 * nt + lr;
    const int qc = qi[nt] < T_ ? qi[nt] : T_ - 1;
#pragma unroll
    for (int ks = 0; ks < 2; ++ks)
      xq[nt][ks] = *(const bf16x8*)(ws.QB + (size_t)(b * T_ + qc) * 1536 + hd * 96 + 32 * ks + 8 * lq);
    {
      const u32x4 raw = *(const u32x4*)(ws.QB + (size_t)(b * T_ + qc) * 1536 + hd * 96 + 64 + 8 * lq);
      u32x4 oth;
      oth.x = __shfl_xor(raw.x, 32); oth.y = __shfl_xor(raw.y, 32); oth.z = __shfl_xor(raw.z, 32); oth.w = __shfl_xor(raw.w, 32);
      const float sgn = lq < 2 ? -1.f : 1.f;
      const float2* rp = ws.ROPE + (size_t)(b * T_ + qc) * 16 + 8 * (lq & 1);
      const unsigned rw[4] = {raw.x, raw.y, raw.z, raw.w}, ow[4] = {oth.x, oth.y, oth.z, oth.w};
      unsigned res[4];
#pragma unroll
      for (int e = 0; e < 4; ++e) {
        const float2 c0 = rp[2 * e], c1 = rp[2 * e + 1];
        const float r0 = bflo(rw[e]) * c0.x + sgn * bflo(ow[e]) * c0.y;
        const float r1 = bfhi(rw[e]) * c1.x + sgn * bfhi(ow[e]) * c1.y;
        res[e] = cvt_pk_bf16(r0, r1);
      }
      xq[nt][2] = as_bf16x8((u32x4){res[0], res[1], res[2], res[3]});
    }
  }
  float mrun[2] = {-INFINITY, -INFINITY}, lsum[2] = {0.f, 0.f};
  f32x4 oacc[4][2];
#pragma unroll
  for (int a = 0; a < 4; ++a)
#pragma unroll
    for (int bb = 0; bb < 2; ++bb) oacc[a][bb] = (f32x4){0.f, 0.f, 0.f, 0.f};
  u32x4 kreg[3], vreg[2];
  const bf16_t* vbase = ws.VT + ((size_t)(b * 16 + hd) * 64) * TP_;
  auto loadg = [&](int kt) {
#pragma unroll
    for (int i = 0; i < 3; ++i) {
      const int ci = tid + 256 * i; const int key = ci / 12, ch = ci - key * 12;
      int gk = 64 * kt + key; if (gk > T_ - 1) gk = T_ - 1;
      const bf16_t* src = ch < 8 ? ws.KN + (size_t)(b * T_ + gk) * 1024 + hd * 64 + ch * 8
                                 : ws.KR + (size_t)(b * T_ + gk) * 32 + (ch - 8) * 8;
      kreg[i] = *(const u32x4*)src;
    }
#pragma unroll
    for (int i = 0; i < 2; ++i) {
      const int ci = tid + 256 * i; const int dv = ci >> 3, ch = ci & 7;
      vreg[i] = *(const u32x4*)(vbase + (size_t)dv * TP_ + 64 * kt + ch * 8);
      if (64 * kt + ch * 8 >= T_) vreg[i] = (u32x4){0u, 0u, 0u, 0u};
    }
  };
  auto stores = [&](int buf) {
#pragma unroll
    for (int i = 0; i < 3; ++i) {
      const int ci = tid + 256 * i; const int key = ci / 12, ch = ci - key * 12;
      *(u32x4*)(Kt + buf * 64 * 104 + key * 104 + ch * 8) = kreg[i];
    }
#pragma unroll
    for (int i = 0; i < 2; ++i) {
      const int ci = tid + 256 * i; const int dv = ci >> 3, ch = ci & 7;
      *(u32x4*)(Vl + buf * 64 * 72 + dv * 72 + ch * 8) = vreg[i];
    }
  };
  loadg(0);
  stores(0);
  __syncthreads();
#pragma unroll 1
  for (int kt = 0; kt < nkt; ++kt) {
    const int buf = kt & 1;
    if (kt + 1 < nkt) loadg(kt + 1);
    const bf16_t* Kb = Kt + buf * 64 * 104;
    const bf16_t* Vb = Vl + buf * 64 * 72;
    f32x4 s[4][2];
#pragma unroll
    for (int mt = 0; mt < 4; ++mt) {
      s[mt][0] = (f32x4){0.f, 0.f, 0.f, 0.f}; s[mt][1] = (f32x4){0.f, 0.f, 0.f, 0.f};
#pragma unroll
      for (int ks = 0; ks < 3; ++ks) {
        const bf16x8 kf = *(const bf16x8*)(Kb + (16 * mt + lr) * 104 + 32 * ks + 8 * lq);
        s[mt][0] = MFMA16(kf, xq[0][ks], s[mt][0]);
        s[mt][1] = MFMA16(kf, xq[1][ks], s[mt][1]);
      }
    }
    if (kt >= 2 * qb) {
#pragma unroll
      for (int mt = 0; mt < 4; ++mt)
#pragma unroll
        for (int nt = 0; nt < 2; ++nt)
#pragma unroll
          for (int jj = 0; jj < 4; ++jj) {
            const int key = 64 * kt + 16 * mt + 4 * lq + jj;
            if (key > qi[nt]) s[mt][nt][jj] = -INFINITY;
          }
    }
    bf16x8 pf[2][2];
#pragma unroll
    for (int nt = 0; nt < 2; ++nt) {
      float mx = -INFINITY;
#pragma unroll
      for (int mt = 0; mt < 4; ++mt) mx = fmaxf(mx, fmaxf(fmaxf(s[mt][nt][0], s[mt][nt][1]), fmaxf(s[mt][nt][2], s[mt][nt][3])));
      mx = fmaxf(mx, __shfl_xor(mx, 16)); mx = fmaxf(mx, __shfl_xor(mx, 32));
      const float mnew = fmaxf(mrun[nt], mx);
      const float alpha = __builtin_amdgcn_exp2f(mrun[nt] - mnew);
      mrun[nt] = mnew;
      float ps = 0.f;
#pragma unroll
      for (int mt = 0; mt < 4; ++mt)
#pragma unroll
        for (int jj = 0; jj < 4; ++jj) { const float pv = __builtin_amdgcn_exp2f(s[mt][nt][jj] - mnew); s[mt][nt][jj] = pv; ps += pv; }
      lsum[nt] = lsum[nt] * alpha + ps;
#pragma unroll
      for (int mt = 0; mt < 4; ++mt) oacc[mt][nt] = oacc[mt][nt] * alpha;
#pragma unroll
      for (int ks = 0; ks < 2; ++ks) {
        u32x4 pk;
        pk.x = cvt_pk_bf16(s[2 * ks][nt][0], s[2 * ks][nt][1]); pk.y = cvt_pk_bf16(s[2 * ks][nt][2], s[2 * ks][nt][3]);
        pk.z = cvt_pk_bf16(s[2 * ks + 1][nt][0], s[2 * ks + 1][nt][1]); pk.w = cvt_pk_bf16(s[2 * ks + 1][nt][2], s[2 * ks + 1][nt][3]);
        pf[nt][ks] = as_bf16x8(pk);
      }
    }
#pragma unroll
    for (int mt = 0; mt < 4; ++mt)
#pragma unroll
      for (int ks = 0; ks < 2; ++ks) {
        const u32x2 lo = *(const u32x2*)(Vb + (16 * mt + lr) * 72 + 32 * ks + 4 * lq);
        const u32x2 hi = *(const u32x2*)(Vb + (16 * mt + lr) * 72 + 32 * ks + 16 + 4 * lq);
        const bf16x8 vf = as_bf16x8((u32x4){lo.x, lo.y, hi.x, hi.y});
        oacc[mt][0] = MFMA16(vf, pf[0][ks], oacc[mt][0]);
        oacc[mt][1] = MFMA16(vf, pf[1][ks], oacc[mt][1]);
      }
    if (kt + 1 < nkt) stores(buf ^ 1);
    __syncthreads();
  }
#pragma unroll
  for (int nt = 0; nt < 2; ++nt) {
    float l = lsum[nt];
    l += __shfl_xor(l, 16); l += __shfl_xor(l, 32);
    const float inv = 1.f / l;
    if (qi[nt] < T_) {
      const size_t row = (size_t)(b * T_ + qi[nt]);
#pragma unroll
      for (int mt = 0; mt < 4; ++mt) {
        const u32x2 gv = *(const u32x2*)(ws.GATE + row * 1024 + hd * 64 + 16 * mt + 4 * lq);
        const float o0 = oacc[mt][nt][0] * inv * siluf_(bflo(gv.x)), o1 = oacc[mt][nt][1] * inv * siluf_(bfhi(gv.x));
        const float o2 = oacc[mt][nt][2] * inv * siluf_(bflo(gv.y)), o3 = oacc[mt][nt][3] * inv * siluf_(bfhi(gv.y));
        u32x2 pk; pk.x = cvt_pk_bf16(o0, o1); pk.y = cvt_pk_bf16(o2, o3);
        if (!dry) *(u32x2*)(ws.QB + row * 1536 + hd * 96 + 16 * mt + 4 * lq) = pk;
      }
    }
  }
}

__device__ __forceinline__ void phase_final(const Params& p, const WS& ws) {
  const int tidf = opaque_tid();
  const int lane = tidf & 63;
  const int gw = opaque_bid() * 4 + (tidf >> 6), nw = gridDim.x * 4;
#pragma unroll 2
  for (int r = gw; r < 8 * 2048; r += nw) {
    const int b = r >> 11, s = r & 2047;
    const size_t hoff = (size_t)(b * T_ + 16 + s) * 1024;
    float4 v[4];
    float ssum = 0.f;
#pragma unroll
    for (int i = 0; i < 4; ++i) {
      const u32x2 hi = *(const u32x2*)(ws.HHI + hoff + i * 256 + lane * 4), lo = *(const u32x2*)(ws.HLO + hoff + i * 256 + lane * 4);
      v[i] = make_float4(bflo(hi.x) + bflo(lo.x), bfhi(hi.x) + bfhi(lo.x), bflo(hi.y) + bflo(lo.y), bfhi(hi.y) + bfhi(lo.y));
      ssum += v[i].x * v[i].x + v[i].y * v[i].y + v[i].z * v[i].z + v[i].w * v[i].w;
    }
#pragma unroll
    for (int o = 1; o < 64; o <<= 1) ssum += __shfl_xor(ssum, o);
    const float rstd = rsqrtf(ssum * (1.f / 1024.f) + EPS_);
#pragma unroll
    for (int i = 0; i < 4; ++i) {
      const float4 g = *(const float4*)(p.final_norm + i * 256 + lane * 4);
      float4 o; o.x = v[i].x * rstd * g.x; o.y = v[i].y * rstd * g.y; o.z = v[i].z * rstd * g.z; o.w = v[i].w * rstd * g.w;
      *(float4*)(p.out + (size_t)r * 1024 + i * 256 + lane * 4) = o;
    }
  }
}

__global__ void __launch_bounds__(256, 2) fwd_megakernel(Params p) {
  cg::grid_group grid = cg::this_grid();
  if (p.inv_freq[0] < 0.f) grid.sync();
  volatile LAS unsigned* xst = (volatile LAS unsigned*)(smem + SMEM_BYTES);
  if (threadIdx.x == 0) { xst[0] = 0u; xst[1] = 0u; xst[2] = 0u; xst[3] = 0u; }
  __syncthreads();
  const XcdBarrier xb = xcd_barrier_post((unsigned*)(p.ws + BAR_OFF), xst);
  {
    const WS ws = make_ws(p);
    phase_prologue(p, ws);
  }
  xcd_barrier(xb);
#pragma unroll 1
  for (int layer = 0; layer < 4; ++layer) {
    const int j = layer >> 1;
    if ((layer & 1) == 0) {
      {
        const WS ws = make_ws(p);
        const bf16_t* wb = ws.W + (size_t)j * W_PER_J;
#pragma unroll 1
        for (int rep = 0; rep < REP_GEMM; ++rep)
          gemm_stream<true, EPI_E1, 4>(ws, ws.HHI, nullptr, 1024, 1 << 30, 64, wb + W_IN_E, 1024, 1.f / 1024.f, 41, 129 * 41, xcd_bid(opaque_bid()), false);
      }
      xcd_barrier(xb);
      {
        const WS ws = make_ws(p);
#pragma unroll 1
        for (int u = opaque_bid(); u < 8 * 4 * 33; u += gridDim.x) gla_decay_unit(p, ws, j, u);
      }
      xcd_barrier(xb);
      {
#pragma unroll 1
        for (int rep = 0; rep < REP_E2; ++rep)
#pragma unroll 1
        for (int u = opaque_bid(); u < 512; u += gridDim.x) {
          if (u >= 256) { const WS ws = make_ws(p); rglru_unit(p, ws, j, u - 256, rep < REP_E2 - 1); }
          else { const WS ws = make_ws(p); gla_unit(p, ws, u, rep < REP_E2 - 1); }
        }
      }
      xcd_barrier(xb);
      {
        const WS ws = make_ws(p);
        phase_gla_norm(p, ws, j);
      }
      xcd_barrier(xb);
      {
        const WS ws = make_ws(p);
        const bf16_t* wb = ws.W + (size_t)j * W_PER_J;
#pragma unroll 1
        for (int rep = 0; rep < REP_GEMM; ++rep)
          gemm_stream<false, EPI_RES, 5>(ws, ws.GA, ws.V, 1024, 16, 64, wb + W_OUT_E, 2048, 0.f, 8, 128 * 8, xcd_bid(opaque_bid()), rep < REP_GEMM - 1);
      }
      xcd_barrier(xb);
    } else {
      {
        const WS ws = make_ws(p);
        const bf16_t* wb = ws.W + (size_t)j * W_PER_J;
#pragma unroll 1
        for (int rep = 0; rep < REP_GEMM; ++rep)
          gemm_stream<true, EPI_O1, 4>(ws, ws.HHI, nullptr, 1024, 1 << 30, 64, wb + W_IN_O, 1024, 1.f / 1024.f, 15, 129 * 15, xcd_bid(opaque_bid()), false);
      }
      xcd_barrier(xb);
      {
        const WS ws = make_ws(p);
        const bf16_t* wb = ws.W + (size_t)j * W_PER_J;
#pragma unroll 1
        for (int rep = 0; rep < REP_GEMM; ++rep) {
          gemm_stream<true, EPI_Q, 4>(ws, ws.CQ, nullptr, 512, 1 << 30, 64, wb + W_Q, 512, 1.f / 512.f, 12, 129 * 12, xcd_bid(opaque_bid()), false);
          gemm_stream<true, EPI_KV, 4>(ws, ws.CKV, nullptr, 256, 1 << 30, 64, wb + W_KV, 256, 1.f / 256.f, 16, 129 * 16, xcd_bid((opaque_bid() + (int)(gridDim.x >> 1)) % (int)gridDim.x), false);
        }
      }
      xcd_barrier(xb);
      {
        const WS ws = make_ws(p);
#pragma unroll 1
        for (int rep = 0; rep < REP_ATTN; ++rep)
#pragma unroll 1
        for (int r = 0, b0 = opaque_bid(); r * (int)gridDim.x < 17 * 128; ++r) {
          const int u = r * (int)gridDim.x + ((r & 1) ? (int)gridDim.x - 1 - b0 : b0);
          if (u < 17 * 128) attn_unit(ws, u, rep < REP_ATTN - 1);
          __syncthreads();
        }
      }
      xcd_barrier(xb);
      {
        const WS ws = make_ws(p);
        const bf16_t* wb = ws.W + (size_t)j * W_PER_J;
#pragma unroll 1
        for (int rep = 0; rep < REP_GEMM; ++rep)
          gemm_stream<false, EPI_RES, 5>(ws, ws.QB, nullptr, 1536, 1 << 30, 96, wb + W_O, 1024, 0.f, 8, 128 * 8, xcd_bid(opaque_bid()), rep < REP_GEMM - 1);
      }
      xcd_barrier(xb);
    }
  }
  {
    const WS ws = make_ws(p);
    phase_final(p, ws);
  }
}

extern "C" void kernel_launch(void* const* d_in, const int* in_sizes, int n_in, void* d_out, int out_size, void* d_ws,
                              size_t ws_size, hipStream_t stream) {
  static int grid_blocks = 0;
  if (!grid_blocks) {
    int dev = 0, cus = 0, per_cu = 0;
    hipGetDevice(&dev);
    hipDeviceGetAttribute(&cus, hipDeviceAttributeMultiprocessorCount, dev);
    hipOccupancyMaxActiveBlocksPerMultiprocessor(&per_cu, fwd_megakernel, 256, 0);
    if (per_cu < 1) per_cu = 1;
    if (per_cu > 2) per_cu = 2;
    grid_blocks = cus * per_cu;
  }
  Params p{};
  p.x = (const float*)d_in[0]; p.positions = (const int*)d_in[1]; p.meta = (const float*)d_in[2];
  p.ab_norm = (const float*)d_in[3]; p.ab_w_in = (const float*)d_in[4]; p.ab_conv_w = (const float*)d_in[5];
  p.ab_conv_b = (const float*)d_in[6]; p.ab_gate_a_w = (const float*)d_in[7]; p.ab_gate_a_b = (const float*)d_in[8];
  p.ab_gate_x_w = (const float*)d_in[9]; p.ab_gate_x_b = (const float*)d_in[10]; p.ab_lam = (const float*)d_in[11];
  p.ab_alpha_w = (const float*)d_in[12]; p.ab_alpha_b = (const float*)d_in[13]; p.ab_gla_norm = (const float*)d_in[14];
  p.ab_w_out = (const float*)d_in[15]; p.c_norm = (const float*)d_in[16]; p.c_w_in = (const float*)d_in[17];
  p.c_q_norm = (const float*)d_in[18]; p.c_w_q_up = (const float*)d_in[19]; p.c_kv_norm = (const float*)d_in[20];
  p.c_w_kv_up = (const float*)d_in[21]; p.c_w_out = (const float*)d_in[22]; p.final_norm = (const float*)d_in[23];
  p.out = (float*)d_out;
  p.ws = (unsigned char*)d_ws;
  for (int i = 0; i < 16; ++i) p.inv_freq[i] = (float)pow(10000.0, -(double)i / 16.0);
  hipMemsetAsync((unsigned char*)d_ws + BAR_OFF, 0, XCD_BAR_WORDS * 4, stream);
  void* args[] = {&p};
  hipError_t e = hipLaunchCooperativeKernel((void*)fwd_megakernel, dim3(grid_blocks), dim3(256), args, 0, stream);
  if (e != hipSuccess) fprintf(stderr, "cooperative launch failed: %s (grid %d)\n", hipGetErrorString(e), grid_blocks);
}
```

```cpp
#include <hip/hip_runtime.h>
#include <hip/hip_cooperative_groups.h>
#include <cstdio>
#include <cmath>
namespace cg = cooperative_groups;

typedef unsigned short bf16_t;
typedef short bf16x8 __attribute__((ext_vector_type(8)));
typedef float f32x4 __attribute__((ext_vector_type(4)));
typedef unsigned u32x4 __attribute__((ext_vector_type(4)));
typedef unsigned u32x2 __attribute__((ext_vector_type(2)));

constexpr int T_ = 2064;
constexpr int M_ = 8 * T_;
constexpr int TP_ = 2112;
constexpr float EPS_ = 1e-6f;
constexpr int SMEM_BYTES = 75776;
constexpr float QSCALE_MLA = 0.10206207261596575f * 1.4426950408889634f;

constexpr size_t W_PER_J = 11796480;
constexpr size_t W_IN_E = 0, W_OUT_E = 5373952, W_IN_O = 7471104, W_Q = 9437184, W_KV = 10223616, W_O = 10747904;

struct Params {
  const float* x; const int* positions; const float* meta;
  const float *ab_norm, *ab_w_in, *ab_conv_w, *ab_conv_b, *ab_gate_a_w, *ab_gate_a_b, *ab_gate_x_w, *ab_gate_x_b,
      *ab_lam, *ab_alpha_w, *ab_alpha_b, *ab_gla_norm, *ab_w_out;
  const float *c_norm, *c_w_in, *c_q_norm, *c_w_q_up, *c_kv_norm, *c_w_kv_up, *c_w_out, *final_norm;
  float* out;
  unsigned char* ws;
  float inv_freq[16];
};

struct WS {
  bf16_t *HHI, *HLO; float2* ROPE;
  bf16_t *XA, *GA, *Q, *K, *V, *GB, *AD; float* SSQ; float* BL;
  bf16_t *CQ, *CKV, *GATE, *KR, *QB, *KN, *VT;
  bf16_t* W;
};

__device__ __forceinline__ unsigned char* opaque_ptr(unsigned char* q) {
  unsigned lo = (unsigned)(unsigned long long)q, hi = (unsigned)((unsigned long long)q >> 32);
  asm volatile("" : "+v"(lo), "+v"(hi));
  lo = __builtin_amdgcn_readfirstlane(lo); hi = __builtin_amdgcn_readfirstlane(hi);
  typedef __attribute__((address_space(1))) unsigned char gu8;
  return (unsigned char*)(gu8*)(((unsigned long long)hi << 32) | lo);
}
__device__ __forceinline__ WS make_ws(const Params& p) {
  WS w;
  unsigned char* b = opaque_ptr(p.ws);
  w.HHI = (bf16_t*)b; b += (size_t)M_ * 2048;
  w.HLO = (bf16_t*)b; b += (size_t)M_ * 2048;
  w.ROPE = (float2*)b; b += (size_t)M_ * 128;
  unsigned char* r = b;
  w.XA = (bf16_t*)r; r += (size_t)M_ * 2048;
  w.GA = (bf16_t*)r; r += (size_t)M_ * 2048;
  w.Q = (bf16_t*)r; r += (size_t)M_ * 1024;
  w.K = (bf16_t*)r; r += (size_t)M_ * 1024;
  w.V = (bf16_t*)r; r += (size_t)M_ * 2048;
  w.GB = (bf16_t*)r; r += (size_t)M_ * 2048;
  w.AD = (bf16_t*)r; r += (size_t)M_ * 32;
  w.SSQ = (float*)r; r += (size_t)M_ * 128;
  w.BL = (float*)r; r += (size_t)8 * 4 * 33 * 128 * 4;
  r = b;
  w.CQ = (bf16_t*)r; r += (size_t)M_ * 1024;
  w.CKV = (bf16_t*)r; r += (size_t)M_ * 512;
  w.GATE = (bf16_t*)r; r += (size_t)M_ * 2048;
  w.KR = (bf16_t*)r; r += (size_t)M_ * 64;
  w.QB = (bf16_t*)r; r += (size_t)M_ * 3072;
  w.KN = (bf16_t*)r; r += (size_t)M_ * 2048;
  w.VT = (bf16_t*)r; r += (size_t)128 * 64 * TP_ * 2;
  w.W = (bf16_t*)opaque_ptr((unsigned char*)p.out);
  return w;
}

__device__ __forceinline__ unsigned cvt_pk_bf16(float lo, float hi) {
  typedef float f32x2_t __attribute__((ext_vector_type(2)));
  typedef __bf16 bf16x2_t __attribute__((ext_vector_type(2)));
  const f32x2_t v = {lo, hi};
  const bf16x2_t r = __builtin_convertvector(v, bf16x2_t);
  return __builtin_bit_cast(unsigned, r);
}
__device__ __forceinline__ f32x4 scale4(f32x4 a, float r) {
  asm volatile("" : "+v"(r));
  float x0 = a[0] * r, x1 = a[1] * r, x2 = a[2] * r, x3 = a[3] * r;
  asm volatile("" : "+v"(x0), "+v"(x1), "+v"(x2), "+v"(x3));
  return (f32x4){x0, x1, x2, x3};
}
__device__ __forceinline__ float bf2f(bf16_t v) { return __uint_as_float(((unsigned)v) << 16); }
__device__ __forceinline__ float bflo(unsigned v) { return __uint_as_float(v << 16); }
__device__ __forceinline__ float bfhi(unsigned v) { return __uint_as_float(v & 0xffff0000u); }
__device__ __forceinline__ bf16_t f2bf(float f) { return (bf16_t)(cvt_pk_bf16(f, 0.f) & 0xffffu); }
__device__ __forceinline__ float sigmoidf_(float x) { return __builtin_amdgcn_rcpf(1.f + __expf(-x)); }
__device__ __forceinline__ float siluf_(float x) { return x * __builtin_amdgcn_rcpf(1.f + __expf(-x)); }
__device__ __forceinline__ bf16x8 as_bf16x8(u32x4 v) { return __builtin_bit_cast(bf16x8, v); }
__device__ __forceinline__ int opaque_tid() { int t = threadIdx.x; asm volatile("" : "+v"(t)); return t; }
__device__ __forceinline__ int xcd_bid(int bid) { const int gpx = gridDim.x >> 3; return (bid & 7) * gpx + (bid >> 3); }
__device__ __forceinline__ int opaque_bid() { int t = blockIdx.x; asm volatile("" : "+s"(t)); return t; }
#define MFMA16(a, b, c) __builtin_amdgcn_mfma_f32_16x16x32_bf16((a), (b), (c), 0, 0, 0)

__shared__ __attribute__((aligned(16))) unsigned char smem[SMEM_BYTES + 16];

#define XB_TMO      128
#define XB_XCNT(j)  (256  + 64 * (j))
#define XB_XSUB(j)  (1280 + 64 * (j))
#define XB_XGEN(j)  (2304 + 64 * (j))
#define XB_TOP      3328
#define XB_TOPGEN   3392
#define XCD_BAR_WORDS 3456
#define XB_SPIN_CAP (1u << 18)
#define LAS __attribute__((address_space(3)))
constexpr size_t BAR_OFF = 260046848;

__device__ __forceinline__ unsigned xb_ld(unsigned* p)              { return __hip_atomic_load(p, __ATOMIC_RELAXED, __HIP_MEMORY_SCOPE_AGENT); }
__device__ __forceinline__ unsigned xb_add(unsigned* p, unsigned v) { return __hip_atomic_fetch_add(p, v, __ATOMIC_RELAXED, __HIP_MEMORY_SCOPE_AGENT); }
__device__ __forceinline__ unsigned xb_xcc_id() { return (unsigned)__builtin_amdgcn_s_getreg((3 << 11) | 20) & 0xFu; }
#define XB_SPIN(cond, bar) do { unsigned _sp = 0; while (cond) { __builtin_amdgcn_s_sleep(1); \
    if ((++_sp & 255u) == 0u) { if (xb_ld(&(bar)[XB_TMO])) break; if (_sp > XB_SPIN_CAP) { atomicAdd(&(bar)[XB_TMO], 1u); break; } } } } while (0)

struct XcdBarrier { unsigned* bar; unsigned x; volatile LAS unsigned* st; };

__device__ __forceinline__ XcdBarrier xcd_barrier_post(unsigned* bar, volatile LAS unsigned* st) {
    XcdBarrier b; b.bar = bar; b.x = xb_xcc_id(); b.st = st;
    if (threadIdx.x == 0) (void)xb_add(&bar[XB_XCNT(b.x)], 1u);
    return b;
}
__device__ __forceinline__ void xcd_barrier_complete(unsigned* bar, unsigned x, unsigned& nloc, unsigned& nx) {
    const unsigned G = gridDim.x * gridDim.y * gridDim.z;
    unsigned sum, cnt, mine, sp = 0u;
    for (;;) {
        sum = 0u; cnt = 0u; mine = 0u;
#pragma unroll
        for (unsigned j = 0; j < 16; ++j) { const unsigned c = xb_ld(&bar[XB_XCNT(j)]); sum += c; cnt += (c > 0u) ? 1u : 0u; mine = (j == x) ? c : mine; }
        if (sum == G) break;
        __builtin_amdgcn_s_sleep(1);
        if ((++sp & 255u) == 0u) { if (xb_ld(&bar[XB_TMO])) break; if (sp > XB_SPIN_CAP) { atomicAdd(&bar[XB_TMO], 1u); break; } }
    }
    nloc = mine > 0u ? mine : 1u; nx = cnt > 0u ? cnt : 1u;
}
__device__ __forceinline__ void xcd_barrier(const XcdBarrier& b) {
    asm volatile("s_waitcnt vmcnt(0)" ::: "memory");
    __syncthreads();
    if (threadIdx.x == 0) {
        unsigned* bar = b.bar;
        __builtin_amdgcn_s_waitcnt(0);
        unsigned nloc = b.st[0], nx = b.st[1];
        if (nloc == 0u) { xcd_barrier_complete(bar, b.x, nloc, nx); b.st[0] = nloc; b.st[1] = nx; }
        const unsigned old = xb_add(&bar[XB_XSUB(b.x)], 1u);
        const unsigned gen = old / nloc;
        if (old + 1u == (gen + 1u) * nloc) {
            __builtin_amdgcn_fence(__ATOMIC_RELEASE, "agent");
            asm volatile("s_waitcnt vmcnt(0)" ::: "memory");
            const unsigned og = xb_add(&bar[XB_TOP], 1u);
            const unsigned tg = og / nx;
            if (og + 1u == (tg + 1u) * nx) xb_add(&bar[XB_TOPGEN], 1u);
            else XB_SPIN(xb_ld(&bar[XB_TOPGEN]) == tg, bar);
            __builtin_amdgcn_fence(__ATOMIC_ACQUIRE, "agent");
            xb_add(&bar[XB_XGEN(b.x)], 1u);
            asm volatile("s_waitcnt vmcnt(0)" ::: "memory");
        } else {
            XB_SPIN(xb_ld(&bar[XB_XGEN(b.x)]) == gen, bar);
            __builtin_amdgcn_fence(__ATOMIC_ACQUIRE, "agent");
            asm volatile("s_waitcnt vmcnt(0)" ::: "memory");
        }
    }
    __syncthreads();
}


__device__ __forceinline__ int map_even_in(int n) { return n < 4096 ? n : (n < 5120 ? n + 16 : (n < 5136 ? n - 1024 : -1)); }
__device__ __forceinline__ int map_odd_in(int n) { return n < 768 ? n : (n < 1792 ? n + 32 : (n < 1824 ? n - 1024 : -1)); }

__device__ __forceinline__ void convert_tile(const float* __restrict__ src, int K, int Nsrc, bf16_t* __restrict__ dst,
                                             int kind, const float* __restrict__ g, int tile) {
  float* tl = (float*)smem;
  const int nkt = K >> 7;
  const int ntile = tile / nkt, ktile = tile - ntile * nkt;
  const int n0 = ntile * 64, k0 = ktile * 128;
  const int tid = opaque_tid();
  const int nl = tid & 63, kq = tid >> 6;
  const int n = n0 + nl;
  const int sc = kind == 0 ? map_even_in(n) : (kind == 1 ? map_odd_in(n) : n);
  float cs = 1.f;
  if (kind == 0 && n >= 2048 && n < 2560) cs = 0.08838834764831845f;
  if (kind == 2) cs = QSCALE_MLA;
  float v[32];
#pragma unroll
  for (int i = 0; i < 32; ++i) {
    const int kl = kq + 4 * i;
    v[i] = 0.f;
    if (sc >= 0) v[i] = src[(size_t)(k0 + kl) * Nsrc + sc];
  }
#pragma unroll
  for (int i = 0; i < 32; ++i) {
    const int kl = kq + 4 * i;
    float t = v[i] * cs;
    if (g) t *= g[k0 + kl];
    tl[kl * 65 + nl] = t;
  }
  __syncthreads();
#pragma unroll
  for (int i = 0; i < 4; ++i) {
    const int c = tid + 256 * i;
    const int nl2 = c >> 4, kc = c & 15;
    float t[8];
#pragma unroll
    for (int jj = 0; jj < 8; ++jj) t[jj] = tl[(kc * 8 + jj) * 65 + nl2];
    u32x4 pk;
    pk.x = cvt_pk_bf16(t[0], t[1]); pk.y = cvt_pk_bf16(t[2], t[3]); pk.z = cvt_pk_bf16(t[4], t[5]); pk.w = cvt_pk_bf16(t[6], t[7]);
    *(u32x4*)(dst + (size_t)(n0 + nl2) * K + k0 + kc * 8) = pk;
  }
  __syncthreads();
}

__device__ __forceinline__ void phase_prologue(const Params& p, const WS& ws) {
  for (int id = opaque_bid(); id < 2880; id += gridDim.x) {
    const int j = id / 1440; int r = id - j * 1440;
    bf16_t* wb = ws.W + (size_t)j * W_PER_J;
    if (r < 656) convert_tile(p.ab_w_in + (size_t)j * 1024 * 5136, 1024, 5136, wb + W_IN_E, 0, p.ab_norm + j * 1024, r);
    else if ((r -= 656) < 256) convert_tile(p.ab_w_out + (size_t)j * 2048 * 1024, 2048, 1024, wb + W_OUT_E, 3, nullptr, r);
    else if ((r -= 256) < 240) convert_tile(p.c_w_in + (size_t)j * 1024 * 1824, 1024, 1824, wb + W_IN_O, 1, p.c_norm + j * 1024, r);
    else if ((r -= 240) < 96) convert_tile(p.c_w_q_up + (size_t)j * 512 * 1536, 512, 1536, wb + W_Q, 2, p.c_q_norm + j * 512, r);
    else if ((r -= 96) < 64) convert_tile(p.c_w_kv_up + (size_t)j * 256 * 2048, 256, 2048, wb + W_KV, 3, p.c_kv_norm + j * 256, r);
    else { r -= 64; convert_tile(p.c_w_out + (size_t)j * 1024 * 1024, 1024, 1024, wb + W_O, 3, nullptr, r); }
  }
  const size_t gtid = (size_t)opaque_bid() * 256 + opaque_tid(), gsz = (size_t)gridDim.x * 256;
  for (size_t idx0 = gtid; idx0 < (size_t)M_ * 256; idx0 += 4 * gsz) {
    float4 v4[4];
#pragma unroll
    for (int q = 0; q < 4; ++q) {
      const size_t idx = idx0 + q * gsz;
      v4[q] = make_float4(0.f, 0.f, 0.f, 0.f);
      if (idx < (size_t)M_ * 256) {
        const int row = (int)(idx >> 8), c4 = (int)(idx & 255);
        const int b = row / T_, t = row - b * T_;
        const float* src = t < 16 ? p.meta + (size_t)t * 1024 : p.x + ((size_t)b * 2048 + (t - 16)) * 1024;
        v4[q] = *(const float4*)(src + c4 * 4);
      }
    }
#pragma unroll
    for (int q = 0; q < 4; ++q) {
      const size_t idx = idx0 + q * gsz;
      if (idx < (size_t)M_ * 256) {
        const float4 v = v4[q];
        u32x2 hi; hi.x = cvt_pk_bf16(v.x, v.y); hi.y = cvt_pk_bf16(v.z, v.w);
        u32x2 lo; lo.x = cvt_pk_bf16(v.x - bflo(hi.x), v.y - bfhi(hi.x)); lo.y = cvt_pk_bf16(v.z - bflo(hi.y), v.w - bfhi(hi.y));
        *(u32x2*)(ws.HHI + idx * 4) = hi;
        *(u32x2*)(ws.HLO + idx * 4) = lo;
      }
    }
  }
  for (size_t idx = gtid; idx < (size_t)M_ * 16; idx += gsz) {
    const int row = (int)(idx >> 4), i = (int)(idx & 15);
    const int b = row / T_, t = row - b * T_;
    const int pos = t < 16 ? t : p.positions[b * 2048 + (t - 16)] + 16;
    const float angf = (float)pos * p.inv_freq[i];
    const double rev = (double)angf * 0.15915494309189533577;
    const float fr = (float)(rev - rint(rev));
    ws.ROPE[idx] = make_float2(__builtin_amdgcn_cosf(fr), __builtin_amdgcn_sinf(fr));
  }
}

#ifndef REP_GEMM
#define REP_GEMM 1
#endif
#ifndef REP_ATTN
#define REP_ATTN 1
#endif
#ifndef REP_E2
#define REP_E2 1
#endif
enum { EPI_E1 = 0, EPI_O1 = 1, EPI_Q = 2, EPI_KV = 3, EPI_RES = 4 };

template <int EPI, int TI>
__device__ __forceinline__ void gemm_epilogue(const WS& ws, const f32x4 (&acc)[4][TI], const float (&rs)[TI], int tok0, int n0,
                                              int wm, int wn, int lr, int lq, bool dry) {
  auto tokr = [&](int ti) { return tok0 + (ti < 4 ? wn * 64 + ti * 16 : 128 + wn * 16) + lr; };
  auto okr = [&](int ti) { return ti < 4 || (wn == 0 && lr == 0); };
  const int nw = n0 + wm * 64;
  if (EPI == EPI_E1) {
    bf16_t* dst; int ld, c;
    if (n0 < 1024) { dst = ws.XA; ld = 1024; c = n0; }
    else if (n0 < 2048) { dst = ws.GA; ld = 1024; c = n0 - 1024; }
    else if (n0 < 2560) { dst = ws.Q; ld = 512; c = n0 - 2048; }
    else if (n0 < 3072) { dst = ws.K; ld = 512; c = n0 - 2560; }
    else if (n0 < 4096) { dst = ws.V; ld = 1024; c = n0 - 3072; }
    else if (n0 < 5120) { dst = ws.GB; ld = 1024; c = n0 - 4096; }
    else { dst = ws.AD; ld = 16; c = 0; }
    const bool isad = n0 >= 5120;
#pragma unroll
    for (int ni = 0; ni < 4; ++ni) {
      if (isad && (wm != 0 || ni != 0)) continue;
#pragma unroll
      for (int ti = 0; ti < TI; ++ti) {
        const f32x4 v = scale4(acc[ni][ti], rs[ti]);
        u32x2 pk; pk.x = cvt_pk_bf16(v[0], v[1]); pk.y = cvt_pk_bf16(v[2], v[3]);
        if (okr(ti)) *(u32x2*)(dst + (size_t)tokr(ti) * ld + c + wm * 64 + ni * 16 + 4 * lq) = pk;
      }
    }
  } else if (EPI == EPI_O1) {
    if (n0 < 1792) {
      bf16_t* dst; int ld, c;
      if (n0 < 512) { dst = ws.CQ; ld = 512; c = n0; }
      else if (n0 < 768) { dst = ws.CKV; ld = 256; c = n0 - 512; }
      else { dst = ws.GATE; ld = 1024; c = n0 - 768; }
#pragma unroll
      for (int ni = 0; ni < 4; ++ni)
#pragma unroll
        for (int ti = 0; ti < TI; ++ti) {
          const f32x4 v = scale4(acc[ni][ti], rs[ti]);
          u32x2 pk; pk.x = cvt_pk_bf16(v[0], v[1]); pk.y = cvt_pk_bf16(v[2], v[3]);
          if (okr(ti)) *(u32x2*)(dst + (size_t)tokr(ti) * ld + c + wm * 64 + ni * 16 + 4 * lq) = pk;
        }
    } else if (wm == 0) {
#pragma unroll
      for (int ti = 0; ti < TI; ++ti) {
        const int tok = tokr(ti);
        const f32x4 x1 = scale4(acc[0][ti], rs[ti]), x2 = scale4(acc[1][ti], rs[ti]);
        float o1[4], o2[4];
#pragma unroll
        for (int jj = 0; jj < 4; ++jj) {
          const float2 cs = ws.ROPE[(size_t)tok * 16 + 4 * lq + jj];
          o1[jj] = x1[jj] * cs.x - x2[jj] * cs.y;
          o2[jj] = x2[jj] * cs.x + x1[jj] * cs.y;
        }
        u32x2 pk; pk.x = cvt_pk_bf16(o1[0], o1[1]); pk.y = cvt_pk_bf16(o1[2], o1[3]);
        *(u32x2*)(ws.KR + (size_t)tok * 32 + 4 * lq) = pk;
        pk.x = cvt_pk_bf16(o2[0], o2[1]); pk.y = cvt_pk_bf16(o2[2], o2[3]);
        *(u32x2*)(ws.KR + (size_t)tok * 32 + 16 + 4 * lq) = pk;
      }
    }
  } else if (EPI == EPI_Q) {
#pragma unroll
    for (int ni = 0; ni < 4; ++ni)
#pragma unroll
      for (int ti = 0; ti < TI; ++ti) {
        const f32x4 v = scale4(acc[ni][ti], rs[ti]);
        u32x2 pk; pk.x = cvt_pk_bf16(v[0], v[1]); pk.y = cvt_pk_bf16(v[2], v[3]);
        if (okr(ti)) *(u32x2*)(ws.QB + (size_t)tokr(ti) * 1536 + nw + ni * 16 + 4 * lq) = pk;
      }
  } else if (EPI == EPI_KV) {
    const int hd = nw >> 7;
    const bool isv = (nw & 127) >= 64;
    if (!isv) {
#pragma unroll
      for (int ni = 0; ni < 4; ++ni)
#pragma unroll
        for (int ti = 0; ti < TI; ++ti) {
          const f32x4 v = scale4(acc[ni][ti], rs[ti]);
          u32x2 pk; pk.x = cvt_pk_bf16(v[0], v[1]); pk.y = cvt_pk_bf16(v[2], v[3]);
          if (okr(ti)) *(u32x2*)(ws.KN + (size_t)tokr(ti) * 1024 + hd * 64 + ni * 16 + 4 * lq) = pk;
        }
    } else {
#pragma unroll
      for (int ti = 0; ti < TI; ++ti) {
        const int tok = tokr(ti);
        const int b = tok / T_, t = tok - b * T_;
        bf16_t* vb = ws.VT + ((size_t)(b * 16 + hd) * 64) * TP_ + t;
#pragma unroll
        for (int ni = 0; ni < 4; ++ni) {
          const f32x4 v = scale4(acc[ni][ti], rs[ti]);
#pragma unroll
          for (int jj = 0; jj < 4; ++jj) if (okr(ti)) vb[(size_t)(ni * 16 + 4 * lq + jj) * TP_] = f2bf(v[jj]);
        }
      }
    }
  } else {
#pragma unroll
    for (int ni = 0; ni < 4; ++ni)
#pragma unroll
      for (int ti = 0; ti < TI; ++ti) {
        if (!okr(ti)) continue;
        const size_t off = (size_t)tokr(ti) * 1024 + nw + ni * 16 + 4 * lq;
        const u32x2 hi = *(const u32x2*)(ws.HHI + off), lo = *(const u32x2*)(ws.HLO + off);
        const float h0 = bflo(hi.x) + bflo(lo.x) + acc[ni][ti][0], h1 = bfhi(hi.x) + bfhi(lo.x) + acc[ni][ti][1];
        const float h2 = bflo(hi.y) + bflo(lo.y) + acc[ni][ti][2], h3 = bfhi(hi.y) + bfhi(lo.y) + acc[ni][ti][3];
        u32x2 nh; nh.x = cvt_pk_bf16(h0, h1); nh.y = cvt_pk_bf16(h2, h3);
        u32x2 nl; nl.x = cvt_pk_bf16(h0 - bflo(nh.x), h1 - bfhi(nh.x)); nl.y = cvt_pk_bf16(h2 - bflo(nh.y), h3 - bfhi(nh.y));
        if (!dry) { *(u32x2*)(ws.HHI + off) = nh; *(u32x2*)(ws.HLO + off) = nl; }
      }
  }
}

__device__ __forceinline__ float sumsq8(bf16x8 v) {
  const u32x4 u = __builtin_bit_cast(u32x4, v);
  float s = 0.f, t;
  t = bflo(u.x); s += t * t; t = bfhi(u.x); s += t * t; t = bflo(u.y); s += t * t; t = bfhi(u.y); s += t * t;
  t = bflo(u.z); s += t * t; t = bfhi(u.z); s += t * t; t = bflo(u.w); s += t * t; t = bfhi(u.w); s += t * t;
  return s;
}
__device__ __forceinline__ void tile_of(int pos, int ntn, int& mt, int& nt) {
  const int full = 128 * ntn;
  if (pos < full) { const int panel = pos / (8 * ntn); const int rem = pos - panel * 8 * ntn; nt = rem >> 3; mt = panel * 8 + (rem & 7); }
  else { mt = 128; nt = pos - full; }
}
template <bool RS, int EPI, int TI>
__device__ __forceinline__ void gemm_stream(const WS& ws, const bf16_t* A0, const bf16_t* A1, int lda, int ktsplit, int kstride,
                                            const bf16_t* __restrict__ W, int K, float invK, int ntn, int ntiles, int bid, bool dry) {
  constexpr int BM = (TI == 5) ? 129 : 128;
  constexpr int ASTG = 16384;
  unsigned char* As = smem;
  unsigned char* Bs = smem + 2 * ASTG;
  float* rsl = (float*)(smem + 65536);
  int xbase = 66048;
  asm volatile("" : "+v"(xbase));
  unsigned char* Ax0 = smem + xbase;
  const int tid = opaque_tid(), lane = tid & 63, w = tid >> 6, wm = w >> 1, wn = w & 1, lr = lane & 15, lq = lane >> 4;
  const int G = gridDim.x;
  const int nk = K >> 6;
  if (bid < ntiles) {
    const int my_tiles = (ntiles - 1 - bid) / G + 1;
    const int last_id = bid + (my_tiles - 1) * G;
    const int S = my_tiles * nk;
    f32x4 acc[4][TI];
#pragma unroll
    for (int a = 0; a < 4; ++a)
#pragma unroll
      for (int b = 0; b < TI; ++b) acc[a][b] = (f32x4){0.f, 0.f, 0.f, 0.f};
    u32x4 ra0[4], rb0[4], ra1[4], rb1[4];
    u32x4 rx0 = (u32x4){0u, 0u, 0u, 0u}, rx1 = (u32x4){0u, 0u, 0u, 0u};
    float ss[5] = {0.f, 0.f, 0.f, 0.f, 0.f};
    int l_id = bid, l_kt = 0, c_id = bid, c_kt = 0, st_kt = 0;
    const int srow = tid >> 3;
    const int soff = srow * 128 + (((tid & 7) ^ (srow & 7)) << 4);

    auto issue = [&](u32x4 (&ra)[4], u32x4 (&rb)[4], u32x4& rx) {
      const int idc = l_id < last_id ? l_id : last_id;
      int mt, nt; tile_of(idc, ntn, mt, nt);
      const bf16_t* A = (l_kt < ktsplit) ? A0 : A1;
      const int kk = (l_kt < ktsplit) ? l_kt : l_kt - ktsplit;
      const bf16_t* ap = A + (size_t)(mt * BM + srow) * lda + kk * kstride + (tid & 7) * 8;
      const bf16_t* wp = W + (size_t)(nt * 128 + srow) * K + l_kt * 64 + (tid & 7) * 8;
#pragma unroll
      for (int i = 0; i < 4; ++i) {
        ra[i] = *(const u32x4*)(ap + (size_t)i * 32 * lda);
        rb[i] = *(const u32x4*)(wp + (size_t)i * 32 * K);
      }
      if (TI == 5) { if (srow == 0) rx = *(const u32x4*)(ap + (size_t)128 * lda); }
      if (++l_kt == nk) { l_kt = 0; l_id += G; }
    };
    auto store = [&](const u32x4 (&ra)[4], const u32x4 (&rb)[4], const u32x4& rx, int buf) {
#pragma unroll
      for (int i = 0; i < 4; ++i) {
        if (RS) ss[i] += sumsq8(__builtin_bit_cast(bf16x8, ra[i]));
        *(u32x4*)(As + buf * ASTG + i * 4096 + soff) = ra[i];
        *(u32x4*)(Bs + buf * 16384 + i * 4096 + soff) = rb[i];
      }
      if (TI == 5) {
        if (RS) ss[4] += sumsq8(__builtin_bit_cast(bf16x8, rx));
        if (srow == 0) *(u32x4*)(Ax0 + buf * 128 + ((tid & 7) << 4)) = rx;
      }
      if (RS) {
        if (++st_kt == nk) {
          st_kt = 0;
#pragma unroll
          for (int i = 0; i < TI; ++i) {
            float t = ss[i];
            t += __shfl_xor(t, 1); t += __shfl_xor(t, 2); t += __shfl_xor(t, 4);
            if ((tid & 7) == 0 && i < 4) rsl[srow + 32 * i] = rsqrtf(t * invK + EPS_);
            ss[i] = 0.f;
          }
        }
      }
    };
    auto compute = [&](int buf) {
      const unsigned char* Ab = As + buf * ASTG + (wn * 64 + lr) * 128;
      const unsigned char* Ax = Ax0 + buf * 128;
      const unsigned char* Bb = Bs + buf * 16384 + (wm * 64 + lr) * 128;
#pragma unroll
      for (int ks = 0; ks < 2; ++ks) {
        if (TI == 5 && ks == 1) __builtin_amdgcn_sched_barrier(0);
        const int sw = ((ks * 4 + lq) ^ (lr & 7)) << 4;
        bf16x8 wf[4], xf[TI];
#pragma unroll
        for (int i = 0; i < 4; ++i) {
          wf[i] = *(const bf16x8*)(Bb + i * 2048 + sw);
          xf[i] = *(const bf16x8*)(Ab + i * 2048 + sw);
        }
        if (TI == 5) xf[TI - 1] = *(const bf16x8*)(Ax + ((ks * 4 + lq) << 4));
#pragma unroll
        for (int ni = 0; ni < 4; ++ni)
#pragma unroll
          for (int ti = 0; ti < TI; ++ti) acc[ni][ti] = MFMA16(wf[ni], xf[ti], acc[ni][ti]);
      }
    };
    auto tile_end = [&]() {
      float rs[TI];
#pragma unroll
      for (int ti = 0; ti < TI; ++ti) rs[ti] = 1.f;
      if (RS) {
#pragma unroll
        for (int ti = 0; ti < TI; ++ti) rs[ti] = rsl[(ti < 4 ? wn * 64 + ti * 16 : 0) + lr];
      }
      int mt, nt; tile_of(c_id, ntn, mt, nt);
      gemm_epilogue<EPI, TI>(ws, acc, rs, mt * BM, nt * 128, wm, wn, lr, lq, dry);
#pragma unroll
      for (int a = 0; a < 4; ++a)
#pragma unroll
        for (int b = 0; b < TI; ++b) acc[a][b] = (f32x4){0.f, 0.f, 0.f, 0.f};
      c_id += G;
    };

    issue(ra0, rb0, rx0);
    issue(ra1, rb1, rx1);
    store(ra0, rb0, rx0, 0);
    __syncthreads();
#pragma unroll 1
    for (int s = 0; s < S; s += 2) {
      issue(ra0, rb0, rx0);
      compute(0);
      store(ra1, rb1, rx1, 1);
      __syncthreads();
      issue(ra1, rb1, rx1);
      compute(1);
      c_kt += 2;
      if (c_kt == nk) { c_kt = 0; tile_end(); }
      store(ra0, rb0, rx0, 0);
      __syncthreads();
    }
  }
  __syncthreads();
}

__device__ __forceinline__ void gla_decay_unit(const Params& p, const WS& ws, int j, int u) {
  const int c = u % 33; const int bh = u / 33; const int hd = bh & 3, b = bh >> 2;
  bf16_t* Qs = (bf16_t*)smem;
  bf16_t* Ks = Qs + 64 * 136;
  float* ADs = (float*)(smem + 2 * 64 * 136 * 2);
  float* HT = ADs + 64 * 16;
  const int tid = opaque_tid();
  const int tbase = 64 * c - 48;
#pragma unroll
  for (int i = 0; i < 4; ++i) {
    const int ci = tid + 256 * i; const int row = ci >> 4, ch = ci & 15; const int t = tbase + row;
    u32x4 qv = (u32x4){0, 0, 0, 0}, kv = (u32x4){0, 0, 0, 0};
    if (t >= 0) {
      qv = *(const u32x4*)(ws.Q + (size_t)(b * T_ + t) * 512 + hd * 128 + ch * 8);
      kv = *(const u32x4*)(ws.K + (size_t)(b * T_ + t) * 512 + hd * 128 + ch * 8);
    }
    *(u32x4*)(Qs + row * 136 + ch * 8) = qv;
    *(u32x4*)(Ks + row * 136 + ch * 8) = kv;
    const int t2 = tbase + (ci >> 4);
    ADs[ci] = t2 >= 0 ? bf2f(ws.AD[(size_t)(b * T_ + t2) * 16 + (ci & 15)]) : 0.f;
  }
  const int d = tid & 127, half = tid >> 7;
  float aw[16];
#pragma unroll
  for (int r = 0; r < 16; ++r) aw[r] = p.ab_alpha_w[(size_t)(j * 16 + r) * 512 + hd * 128 + d];
  const float abias = p.ab_alpha_b[j * 512 + hd * 128 + d];
  __syncthreads();
  float cs[32];
  float run = 0.f;
#pragma unroll
  for (int ii = 0; ii < 32; ++ii) {
    const int row = half * 32 + ii;
    float xv = abias;
#pragma unroll
    for (int r4 = 0; r4 < 4; ++r4) {
      const float4 a4 = *(const float4*)(ADs + row * 16 + r4 * 4);
      xv += a4.x * aw[r4 * 4] + a4.y * aw[r4 * 4 + 1] + a4.z * aw[r4 * 4 + 2] + a4.w * aw[r4 * 4 + 3];
    }
    float la = (fminf(xv, 0.f) - __logf(1.f + __expf(-fabsf(xv)))) * 0.0625f;
    if (tbase + row < 0) la = 0.f;
    run += la;
    cs[ii] = run;
  }
  HT[half * 128 + d] = run;
  __syncthreads();
  const float off = half ? HT[d] : 0.f;
  const float blast = HT[d] + HT[128 + d];
#pragma unroll
  for (int ii = 0; ii < 32; ++ii) {
    const int row = half * 32 + ii;
    const float bb = cs[ii] + off;
    const float eb = __expf(bb), ebi = __expf(-bb);
    Qs[row * 136 + d] = f2bf(bf2f(Qs[row * 136 + d]) * eb);
    Ks[row * 136 + d] = f2bf(bf2f(Ks[row * 136 + d]) * ebi);
  }
  if (half == 0) ws.BL[(size_t)((b * 4 + hd) * 33 + c) * 128 + d] = __expf(blast);
  __syncthreads();
#pragma unroll
  for (int i = 0; i < 4; ++i) {
    const int ci = tid + 256 * i; const int row = ci >> 4, ch = ci & 15; const int t = tbase + row;
    if (t >= 0) {
      *(u32x4*)(ws.Q + (size_t)(b * T_ + t) * 512 + hd * 128 + ch * 8) = *(const u32x4*)(Qs + row * 136 + ch * 8);
      *(u32x4*)(ws.K + (size_t)(b * T_ + t) * 512 + hd * 128 + ch * 8) = *(const u32x4*)(Ks + row * 136 + ch * 8);
    }
  }
  __syncthreads();
}

__device__ __forceinline__ void gla_unit(const Params& p, const WS& ws, int u, bool dry = false) {
  const int sl = u & 7; const int bh = u >> 3; const int hd = bh & 3, b = bh >> 2;
  bf16_t* QDs = (bf16_t*)smem;
  bf16_t* KIs = QDs + 64 * 136;
  bf16_t* KIT = KIs + 64 * 136;
  bf16_t* VTs = KIT + 128 * 72;
  bf16_t* STs = VTs + 32 * 72;
  bf16_t* Ps = STs + 32 * 136;
  const int tid = opaque_tid(), lane = tid & 63, w = tid >> 6, lr = lane & 15, lq = lane >> 4;
  for (int i = tid; i < 32 * 136 / 2; i += 256) ((unsigned*)STs)[i] = 0u;
  f32x4 sacc[2][2];
#pragma unroll
  for (int a = 0; a < 2; ++a)
#pragma unroll
    for (int bb = 0; bb < 2; ++bb) sacc[a][bb] = (f32x4){0.f, 0.f, 0.f, 0.f};
  u32x4 qrA[4], krA[4], vrA, qrB[4], krB[4], vrB;
  float eblA[2], eblB[2];
  const float* BLp = ws.BL + (size_t)((b * 4 + hd) * 33) * 128;
  auto prefetch = [&](int c, u32x4 (&qr)[4], u32x4 (&kr)[4], u32x4& vr, float (&ebl)[2]) {
    const int tbase = 64 * c - 48;
#pragma unroll
    for (int i = 0; i < 4; ++i) {
      const int ci = tid + 256 * i; const int row = ci >> 4, ch = ci & 15; const int t = tbase + row;
      qr[i] = (u32x4){0, 0, 0, 0}; kr[i] = (u32x4){0, 0, 0, 0};
      if (t >= 0) {
        qr[i] = *(const u32x4*)(ws.Q + (size_t)(b * T_ + t) * 512 + hd * 128 + ch * 8);
        kr[i] = *(const u32x4*)(ws.K + (size_t)(b * T_ + t) * 512 + hd * 128 + ch * 8);
      }
    }
    {
      const int row = tid >> 2, ch = tid & 3; const int t = tbase + row;
      vr = (u32x4){0, 0, 0, 0};
      if (t >= 0) vr = *(const u32x4*)(ws.V + (size_t)(b * T_ + t) * 1024 + hd * 256 + sl * 32 + ch * 8);
    }
    ebl[0] = BLp[c * 128 + 16 * (2 * w) + lr];
    ebl[1] = BLp[c * 128 + 16 * (2 * w + 1) + lr];
  };
  prefetch(0, qrA, krA, vrA, eblA);
  prefetch(1, qrB, krB, vrB, eblB);
  auto body = [&](int c, u32x4 (&qr)[4], u32x4 (&kr)[4], u32x4& vr, float (&ebl)[2]) {
#pragma unroll
    for (int i = 0; i < 4; ++i) {
      const int ci = tid + 256 * i; const int row = ci >> 4, ch = ci & 15;
      *(u32x4*)(QDs + row * 136 + ch * 8) = qr[i];
      *(u32x4*)(KIs + row * 136 + ch * 8) = kr[i];
      const unsigned kk[4] = {kr[i].x, kr[i].y, kr[i].z, kr[i].w};
#pragma unroll
      for (int e = 0; e < 4; ++e) {
        KIT[(ch * 8 + 2 * e) * 72 + (row ^ ((ch & 7) << 3))] = (bf16_t)(kk[e] & 0xffffu);
        KIT[(ch * 8 + 2 * e + 1) * 72 + (row ^ ((ch & 7) << 3))] = (bf16_t)(kk[e] >> 16);
      }
    }
    {
      const int row = tid >> 2, ch = tid & 3;
      const unsigned vv[4] = {vr.x, vr.y, vr.z, vr.w};
#pragma unroll
      for (int e = 0; e < 4; ++e) {
        VTs[(ch * 8 + 2 * e) * 72 + (row ^ (ch << 3))] = (bf16_t)(vv[e] & 0xffffu);
        VTs[(ch * 8 + 2 * e + 1) * 72 + (row ^ (ch << 3))] = (bf16_t)(vv[e] >> 16);
      }
    }
    const float eb0 = ebl[0], eb1 = ebl[1];
    __syncthreads();
    if (c + 2 < 33) prefetch(c + 2, qr, kr, vr, ebl);
    bf16x8 xq[4];
#pragma unroll
    for (int ks = 0; ks < 4; ++ks) xq[ks] = *(const bf16x8*)(QDs + (16 * w + lr) * 136 + 32 * ks + 8 * lq);
    const int irow = 16 * w + lr;
#pragma unroll
    for (int mt = 0; mt < 4; ++mt) {
      u32x2 pk = (u32x2){0u, 0u};
      if (mt <= w) {
        f32x4 a = (f32x4){0.f, 0.f, 0.f, 0.f};
#pragma unroll
        for (int ks = 0; ks < 4; ++ks) {
          const bf16x8 kf = *(const bf16x8*)(KIs + (16 * mt + lr) * 136 + 32 * ks + 8 * lq);
          a = MFMA16(kf, xq[ks], a);
        }
        const int ip = 16 * mt + 4 * lq;
        const float v0 = (ip + 0 <= irow) ? a[0] : 0.f, v1 = (ip + 1 <= irow) ? a[1] : 0.f;
        const float v2 = (ip + 2 <= irow) ? a[2] : 0.f, v3 = (ip + 3 <= irow) ? a[3] : 0.f;
        pk.x = cvt_pk_bf16(v0, v1); pk.y = cvt_pk_bf16(v2, v3);
      }
      *(u32x2*)(Ps + irow * 72 + 16 * mt + 4 * lq) = pk;
    }
    __syncthreads();
    f32x4 oacc[2];
    oacc[0] = (f32x4){0.f, 0.f, 0.f, 0.f}; oacc[1] = (f32x4){0.f, 0.f, 0.f, 0.f};
#pragma unroll
    for (int ks = 0; ks < 2; ++ks) {
      if (2 * ks <= w) {
        const bf16x8 pb = *(const bf16x8*)(Ps + irow * 72 + 32 * ks + 8 * lq);
#pragma unroll
        for (int mt = 0; mt < 2; ++mt) {
          const bf16x8 vf = *(const bf16x8*)(VTs + (16 * mt + lr) * 72 + (((4 * ks + lq) ^ (((16 * mt + lr) >> 3) & 3)) << 3));
          oacc[mt] = MFMA16(vf, pb, oacc[mt]);
        }
      }
    }
#pragma unroll
    for (int ks = 0; ks < 4; ++ks)
#pragma unroll
      for (int mt = 0; mt < 2; ++mt) {
        const bf16x8 sf = *(const bf16x8*)(STs + (16 * mt + lr) * 136 + 32 * ks + 8 * lq);
        oacc[mt] = MFMA16(sf, xq[ks], oacc[mt]);
      }
    {
      const int t = 64 * c - 48 + irow;
      float sq = 0.f;
#pragma unroll
      for (int mt = 0; mt < 2; ++mt) sq += oacc[mt][0] * oacc[mt][0] + oacc[mt][1] * oacc[mt][1] + oacc[mt][2] * oacc[mt][2] + oacc[mt][3] * oacc[mt][3];
      sq += __shfl_xor(sq, 16); sq += __shfl_xor(sq, 32);
      if (t >= 0 && !dry) {
        const size_t row = (size_t)(b * T_ + t);
#pragma unroll
        for (int mt = 0; mt < 2; ++mt) {
          u32x2 pk; pk.x = cvt_pk_bf16(oacc[mt][0], oacc[mt][1]); pk.y = cvt_pk_bf16(oacc[mt][2], oacc[mt][3]);
          *(u32x2*)(ws.V + row * 1024 + hd * 256 + sl * 32 + 16 * mt + 4 * lq) = pk;
        }
        if (lq == 0) ws.SSQ[row * 32 + hd * 8 + sl] = sq;
      }
    }
    __syncthreads();
#pragma unroll
    for (int ntl = 0; ntl < 2; ++ntl) {
#pragma unroll
      for (int ks = 0; ks < 2; ++ks) {
        const bf16x8 kf = *(const bf16x8*)(KIT + (16 * (2 * w + ntl) + lr) * 72 + (((4 * ks + lq) ^ (((16 * (2 * w + ntl) + lr) >> 3) & 7)) << 3));
#pragma unroll
        for (int mt = 0; mt < 2; ++mt) {
          const bf16x8 vf = *(const bf16x8*)(VTs + (16 * mt + lr) * 72 + (((4 * ks + lq) ^ (((16 * mt + lr) >> 3) & 3)) << 3));
          sacc[mt][ntl] = MFMA16(vf, kf, sacc[mt][ntl]);
        }
      }
      const float e = ntl ? eb1 : eb0;
#pragma unroll
      for (int mt = 0; mt < 2; ++mt) {
        sacc[mt][ntl] = sacc[mt][ntl] * e;
#pragma unroll
        for (int jj = 0; jj < 4; ++jj) STs[(16 * mt + 4 * lq + jj) * 136 + 16 * (2 * w + ntl) + lr] = f2bf(sacc[mt][ntl][jj]);
      }
    }
    __syncthreads();
  };
#pragma unroll 1
  for (int c = 0; c < 33; c += 2) {
    body(c, qrA, krA, vrA, eblA);
    if (c + 1 < 33) body(c + 1, qrB, krB, vrB, eblB);
  }
}

__device__ __forceinline__ void rglru_unit(const Params& p, const WS& ws, int j, int u, bool dry = false) {
  const int jq = u & 3, g = (u >> 2) & 7, b = u >> 5;
  bf16_t* XC = (bf16_t*)smem;
  bf16_t* WG = XC + 64 * 136;
  float* AUa = (float*)(smem + 34816);
  float* AUu = AUa + 64 * 33;
  float* SEGA = AUu + 64 * 33;
  float* SEGH = SEGA + 256;
  float* CARRY = SEGH + 256;
  const int tid = opaque_tid(), lane = tid & 63, w = tid >> 6, lr = lane & 15, lq = lane >> 4;
#pragma unroll 4
  for (int i = 0; i < 32; ++i) {
    const int e = tid + 256 * i;
    const int gate = e >> 12, k = (e >> 5) & 127, n = e & 31;
    const float* gw = gate ? p.ab_gate_x_w : p.ab_gate_a_w;
    WG[(gate * 32 + n) * 136 + k] = f2bf(gw[((size_t)(j * 8 + g) * 128 + k) * 128 + 32 * jq + n]);
  }
  if (tid < 32) CARRY[tid] = 0.f;
  const int cc = tid & 15, rb = 4 * (tid >> 4);
  float cw[4][8], cb[8];
#pragma unroll
  for (int e = 0; e < 8; ++e) {
    cb[e] = p.ab_conv_b[j * 1024 + 128 * g + 8 * cc + e];
#pragma unroll
    for (int k = 0; k < 4; ++k) cw[k][e] = p.ab_conv_w[(size_t)(j * 4 + k) * 1024 + 128 * g + 8 * cc + e];
  }
  float ba[2][4], bx[2][4], sp[2][4];
#pragma unroll
  for (int mt = 0; mt < 2; ++mt)
#pragma unroll
    for (int jj = 0; jj < 4; ++jj) {
      const int ch = j * 1024 + 128 * g + 32 * jq + 16 * mt + 4 * lq + jj;
      ba[mt][jj] = p.ab_gate_a_b[ch]; bx[mt][jj] = p.ab_gate_x_b[ch];
      sp[mt][jj] = 8.f * log1pf(__expf(-p.ab_lam[ch]));
    }
  const int sc = tid & 31, ssg = tid >> 5;
  u32x4 xinA[7], xinB[7];
  bf16_t gavA[8], gavB[8];
  auto prefetch = [&](int tile, u32x4 (&xin)[7], bf16_t (&gav)[8]) {
    const int t0 = 64 * tile;
#pragma unroll
    for (int m = 0; m < 7; ++m) {
      const int tt = t0 + rb - 3 + m;
      xin[m] = (u32x4){0, 0, 0, 0};
      if (tt >= 0 && tt < T_) xin[m] = *(const u32x4*)(ws.XA + (size_t)(b * T_ + tt) * 1024 + 128 * g + 8 * cc);
    }
#pragma unroll
    for (int i = 0; i < 8; ++i) {
      const int t = t0 + 8 * ssg + i;
      gav[i] = 0;
      if (t < T_) gav[i] = ws.GA[(size_t)(b * T_ + t) * 1024 + 128 * g + 32 * jq + sc];
    }
  };
  prefetch(0, xinA, gavA);
  prefetch(1, xinB, gavB);
  __syncthreads();
  auto body = [&](int tile, u32x4 (&xin)[7], bf16_t (&gav)[8]) {
    const int t0 = 64 * tile;
#pragma unroll
    for (int r = 0; r < 4; ++r) {
      float y[8];
#pragma unroll
      for (int e = 0; e < 8; ++e) y[e] = cb[e];
#pragma unroll
      for (int k = 0; k < 4; ++k) {
        const u32x4 xv = xin[r + k];
        y[0] += cw[k][0] * bflo(xv.x); y[1] += cw[k][1] * bfhi(xv.x);
        y[2] += cw[k][2] * bflo(xv.y); y[3] += cw[k][3] * bfhi(xv.y);
        y[4] += cw[k][4] * bflo(xv.z); y[5] += cw[k][5] * bfhi(xv.z);
        y[6] += cw[k][6] * bflo(xv.w); y[7] += cw[k][7] * bfhi(xv.w);
      }
      u32x4 pk; pk.x = cvt_pk_bf16(y[0], y[1]); pk.y = cvt_pk_bf16(y[2], y[3]); pk.z = cvt_pk_bf16(y[4], y[5]); pk.w = cvt_pk_bf16(y[6], y[7]);
      *(u32x4*)(XC + (rb + r) * 136 + 8 * cc) = pk;
    }
    float gcur[8];
#pragma unroll
    for (int i = 0; i < 8; ++i) gcur[i] = bf2f(gav[i]);
    __syncthreads();
    if (tile + 2 < 33) prefetch(tile + 2, xin, gav);
    {
      f32x4 ga_[2][2];
#pragma unroll
      for (int a = 0; a < 2; ++a)
#pragma unroll
        for (int bb = 0; bb < 2; ++bb) ga_[a][bb] = (f32x4){0.f, 0.f, 0.f, 0.f};
#pragma unroll
      for (int ks = 0; ks < 4; ++ks) {
        const bf16x8 xf = *(const bf16x8*)(XC + (16 * w + lr) * 136 + 32 * ks + 8 * lq);
#pragma unroll
        for (int gate = 0; gate < 2; ++gate)
#pragma unroll
          for (int mt = 0; mt < 2; ++mt) {
            const bf16x8 wf = *(const bf16x8*)(WG + (gate * 32 + 16 * mt + lr) * 136 + 32 * ks + 8 * lq);
            ga_[gate][mt] = MFMA16(wf, xf, ga_[gate][mt]);
          }
      }
      const int tok = 16 * w + lr;
#pragma unroll
      for (int mt = 0; mt < 2; ++mt)
#pragma unroll
        for (int jj = 0; jj < 4; ++jj) {
          const int n = 16 * mt + 4 * lq + jj;
          const float xcv = bf2f(XC[tok * 136 + 32 * jq + n]);
          const float r = sigmoidf_(ga_[0][mt][jj] + ba[mt][jj]);
          const float ig = sigmoidf_(ga_[1][mt][jj] + bx[mt][jj]);
          const float la = -r * sp[mt][jj];
          const float a = __expf(la);
          const float x2 = 2.f * la;
          const float om = x2 > -0.02f ? -x2 * (1.f + 0.5f * x2 * (1.f + x2 * (1.f / 3.f))) : 1.f - a * a;
          const float mult = __builtin_amdgcn_sqrtf(fmaxf(om, 0.f));
          AUa[tok * 33 + n] = a;
          AUu[tok * 33 + n] = mult * ig * xcv;
        }
    }
    __syncthreads();
    {
      float A = 1.f, Hh = 0.f;
#pragma unroll
      for (int i = 0; i < 8; ++i) {
        const float a = AUa[(8 * ssg + i) * 33 + sc], uu = AUu[(8 * ssg + i) * 33 + sc];
        Hh = a * Hh + uu; A *= a;
      }
      SEGA[ssg * 32 + sc] = A; SEGH[ssg * 32 + sc] = Hh;
    }
    __syncthreads();
    float hin = CARRY[sc];
#pragma unroll
    for (int s2 = 0; s2 < 7; ++s2)
      if (s2 < ssg) hin = SEGA[s2 * 32 + sc] * hin + SEGH[s2 * 32 + sc];
    __syncthreads();
    {
      float h = hin;
#pragma unroll
      for (int i = 0; i < 8; ++i) {
        const float a = AUa[(8 * ssg + i) * 33 + sc], uu = AUu[(8 * ssg + i) * 33 + sc];
        h = a * h + uu;
        const int t = t0 + 8 * ssg + i;
        if (t < T_ && !dry) ws.GA[(size_t)(b * T_ + t) * 1024 + 128 * g + 32 * jq + sc] = f2bf(h * siluf_(gcur[i]));
      }
      if (ssg == 7) CARRY[sc] = h;
    }
  };
#pragma unroll 1
  for (int tile = 0; tile < 33; tile += 2) {
    body(tile, xinA, gavA);
    if (tile + 1 < 33) body(tile + 1, xinB, gavB);
  }
  __syncthreads();
}

__device__ __forceinline__ void phase_gla_norm(const Params& p, const WS& ws, int j) {
  const size_t gtid = (size_t)opaque_bid() * 256 + opaque_tid(), gsz = (size_t)gridDim.x * 256;
  const float* gn = p.ab_gla_norm + j * 256;
#pragma unroll 4
  for (size_t idx = gtid; idx < (size_t)M_ * 128; idx += gsz) {
    const size_t row = idx >> 7; const int c8 = (int)(idx & 127); const int hd = c8 >> 5; const int dv = (c8 & 31) * 8;
    const float4 s0 = *(const float4*)(ws.SSQ + row * 32 + hd * 8), s1 = *(const float4*)(ws.SSQ + row * 32 + hd * 8 + 4);
    const float ssum = (s0.x + s0.y + s0.z + s0.w) + (s1.x + s1.y + s1.z + s1.w);
    const float rstd = rsqrtf(ssum * (1.f / 256.f) + EPS_);
    const u32x4 ov = *(const u32x4*)(ws.V + row * 1024 + c8 * 8);
    const u32x4 gv = *(const u32x4*)(ws.GB + row * 1024 + c8 * 8);
    const float4 g0 = *(const float4*)(gn + dv), g1 = *(const float4*)(gn + dv + 4);
    float o[8] = {bflo(ov.x), bfhi(ov.x), bflo(ov.y), bfhi(ov.y), bflo(ov.z), bfhi(ov.z), bflo(ov.w), bfhi(ov.w)};
    const float gg[8] = {bflo(gv.x), bfhi(gv.x), bflo(gv.y), bfhi(gv.y), bflo(gv.z), bfhi(gv.z), bflo(gv.w), bfhi(gv.w)};
    const float nn[8] = {g0.x, g0.y, g0.z, g0.w, g1.x, g1.y, g1.z, g1.w};
#pragma unroll
    for (int e = 0; e < 8; ++e) o[e] = o[e] * rstd * nn[e] * siluf_(gg[e]);
    u32x4 pk; pk.x = cvt_pk_bf16(o[0], o[1]); pk.y = cvt_pk_bf16(o[2], o[3]); pk.z = cvt_pk_bf16(o[4], o[5]); pk.w = cvt_pk_bf16(o[6], o[7]);
    *(u32x4*)(ws.V + row * 1024 + c8 * 8) = pk;
  }
}

__device__ __forceinline__ void attn_unit(const WS& ws, int u, bool dry = false) {
  const int qb = 16 - (u >> 7); const int bh = u & 127; const int hd = bh & 15, b = bh >> 4;
  bf16_t* Kt = (bf16_t*)smem;
  bf16_t* Vl = Kt + 2 * 64 * 104;
  const int tid = opaque_tid(), lane = tid & 63, w = tid >> 6, lr = lane & 15, lq = lane >> 4;
  const int q0 = 128 * qb;
  int nkt = 2 * qb + 2; if (nkt > 33) nkt = 33;
  bf16x8 xq[2][3];
  int qi[2];
#pragma unroll
  for (int nt = 0; nt < 2; ++nt) {
    qi[nt] = q0 + 32 * w + 16 * nt + lr;
    const int qc = qi[nt] < T_ ? qi[nt] : T_ - 1;
#pragma unroll
    for (int ks = 0; ks < 2; ++ks)
      xq[nt][ks] = *(const bf16x8*)(ws.QB + (size_t)(b * T_ + qc) * 1536 + hd * 96 + 32 * ks + 8 * lq);
    {
      const u32x4 raw = *(const u32x4*)(ws.QB + (size_t)(b * T_ + qc) * 1536 + hd * 96 + 64 + 8 * lq);
      u32x4 oth;
      oth.x = __shfl_xor(raw.x, 32); oth.y = __shfl_xor(raw.y, 32); oth.z = __shfl_xor(raw.z, 32); oth.w = __shfl_xor(raw.w, 32);
      const float sgn = lq < 2 ? -1.f : 1.f;
      const float2* rp = ws.ROPE + (size_t)(b * T_ + qc) * 16 + 8 * (lq & 1);
      const unsigned rw[4] = {raw.x, raw.y, raw.z, raw.w}, ow[4] = {oth.x, oth.y, oth.z, oth.w};
      unsigned res[4];
#pragma unroll
      for (int e = 0; e < 4; ++e) {
        const float2 c0 = rp[2 * e], c1 = rp[2 * e + 1];
        const float r0 = bflo(rw[e]) * c0.x + sgn * bflo(ow[e]) * c0.y;
        const float r1 = bfhi(rw[e]) * c1.x + sgn * bfhi(ow[e]) * c1.y;
        res[e] = cvt_pk_bf16(r0, r1);
      }
      xq[nt][2] = as_bf16x8((u32x4){res[0], res[1], res[2], res[3]});
    }
  }
  float mrun[2] = {-INFINITY, -INFINITY}, lsum[2] = {0.f, 0.f};
  f32x4 oacc[4][2];
#pragma unroll
  for (int a = 0; a < 4; ++a)
#pragma unroll
    for (int bb = 0; bb < 2; ++bb) oacc[a][bb] = (f32x4){0.f, 0.f, 0.f, 0.f};
  u32x4 kregA[3], vregA[2], kregB[3], vregB[2];
  const bf16_t* vbase = ws.VT + ((size_t)(b * 16 + hd) * 64) * TP_;
  auto loadg = [&](int kt, u32x4 (&kreg)[3], u32x4 (&vreg)[2]) {
#pragma unroll
    for (int i = 0; i < 3; ++i) {
      const int ci = tid + 256 * i; const int key = ci / 12, ch = ci - key * 12;
      int gk = 64 * kt + key; if (gk > T_ - 1) gk = T_ - 1;
      const bf16_t* src = ch < 8 ? ws.KN + (size_t)(b * T_ + gk) * 1024 + hd * 64 + ch * 8
                                 : ws.KR + (size_t)(b * T_ + gk) * 32 + (ch - 8) * 8;
      kreg[i] = *(const u32x4*)src;
    }
#pragma unroll
    for (int i = 0; i < 2; ++i) {
      const int ci = tid + 256 * i; const int dv = ci >> 3, ch = ci & 7;
      vreg[i] = *(const u32x4*)(vbase + (size_t)dv * TP_ + 64 * kt + ch * 8);
      if (64 * kt + ch * 8 >= T_) vreg[i] = (u32x4){0u, 0u, 0u, 0u};
    }
  };
  auto stores = [&](int buf, const u32x4 (&kreg)[3], const u32x4 (&vreg)[2]) {
#pragma unroll
    for (int i = 0; i < 3; ++i) {
      const int ci = tid + 256 * i; const int key = ci / 12, ch = ci - key * 12;
      *(u32x4*)(Kt + buf * 64 * 104 + key * 104 + ch * 8) = kreg[i];
    }
#pragma unroll
    for (int i = 0; i < 2; ++i) {
      const int ci = tid + 256 * i; const int dv = ci >> 3, ch = ci & 7;
      *(u32x4*)(Vl + buf * 64 * 72 + dv * 72 + ch * 8) = vreg[i];
    }
  };
  const int nkt2 = (nkt + 1) & ~1;
  loadg(0, kregA, vregA);
  loadg(1, kregB, vregB);
  stores(0, kregA, vregA);
  __syncthreads();
  auto body = [&](int kt, int buf, u32x4 (&kreg)[3], u32x4 (&vreg)[2], const u32x4 (&kregn)[3], const u32x4 (&vregn)[2]) {
    { const int kn = kt + 2 < nkt2 ? kt + 2 : nkt2 - 1; loadg(kn, kreg, vreg); }
    const bf16_t* Kb = Kt + buf * 64 * 104;
    const bf16_t* Vb = Vl + buf * 64 * 72;
    f32x4 s[4][2];
#pragma unroll
    for (int mt = 0; mt < 4; ++mt) {
      s[mt][0] = (f32x4){0.f, 0.f, 0.f, 0.f}; s[mt][1] = (f32x4){0.f, 0.f, 0.f, 0.f};
#pragma unroll
      for (int ks = 0; ks < 3; ++ks) {
        const bf16x8 kf = *(const bf16x8*)(Kb + (16 * mt + lr) * 104 + 32 * ks + 8 * lq);
        s[mt][0] = MFMA16(kf, xq[0][ks], s[mt][0]);
        s[mt][1] = MFMA16(kf, xq[1][ks], s[mt][1]);
      }
    }
    if (kt >= 2 * qb) {
#pragma unroll
      for (int mt = 0; mt < 4; ++mt)
#pragma unroll
        for (int nt = 0; nt < 2; ++nt)
#pragma unroll
          for (int jj = 0; jj < 4; ++jj) {
            const int key = 64 * kt + 16 * mt + 4 * lq + jj;
            if (key > qi[nt]) s[mt][nt][jj] = -INFINITY;
          }
    }
    bf16x8 pf[2][2];
#pragma unroll
    for (int nt = 0; nt < 2; ++nt) {
      float mx = -INFINITY;
#pragma unroll
      for (int mt = 0; mt < 4; ++mt) mx = fmaxf(mx, fmaxf(fmaxf(s[mt][nt][0], s[mt][nt][1]), fmaxf(s[mt][nt][2], s[mt][nt][3])));
      mx = fmaxf(mx, __shfl_xor(mx, 16)); mx = fmaxf(mx, __shfl_xor(mx, 32));
      const float mnew = fmaxf(mrun[nt], mx);
      const float alpha = __builtin_amdgcn_exp2f(mrun[nt] - mnew);
      mrun[nt] = mnew;
      float ps = 0.f;
#pragma unroll
      for (int mt = 0; mt < 4; ++mt)
#pragma unroll
        for (int jj = 0; jj < 4; ++jj) { const float pv = __builtin_amdgcn_exp2f(s[mt][nt][jj] - mnew); s[mt][nt][jj] = pv; ps += pv; }
      lsum[nt] = lsum[nt] * alpha + ps;
#pragma unroll
      for (int mt = 0; mt < 4; ++mt) oacc[mt][nt] = oacc[mt][nt] * alpha;
#pragma unroll
      for (int ks = 0; ks < 2; ++ks) {
        u32x4 pk;
        pk.x = cvt_pk_bf16(s[2 * ks][nt][0], s[2 * ks][nt][1]); pk.y = cvt_pk_bf16(s[2 * ks][nt][2], s[2 * ks][nt][3]);
        pk.z = cvt_pk_bf16(s[2 * ks + 1][nt][0], s[2 * ks + 1][nt][1]); pk.w = cvt_pk_bf16(s[2 * ks + 1][nt][2], s[2 * ks + 1][nt][3]);
        pf[nt][ks] = as_bf16x8(pk);
      }
    }
#pragma unroll
    for (int mt = 0; mt < 4; ++mt)
#pragma unroll
      for (int ks = 0; ks < 2; ++ks) {
        const u32x2 lo = *(const u32x2*)(Vb + (16 * mt + lr) * 72 + 32 * ks + 4 * lq);
        const u32x2 hi = *(const u32x2*)(Vb + (16 * mt + lr) * 72 + 32 * ks + 16 + 4 * lq);
        const bf16x8 vf = as_bf16x8((u32x4){lo.x, lo.y, hi.x, hi.y});
        oacc[mt][0] = MFMA16(vf, pf[0][ks], oacc[mt][0]);
        oacc[mt][1] = MFMA16(vf, pf[1][ks], oacc[mt][1]);
      }
    stores(buf ^ 1, kregn, vregn);
    __syncthreads();
  };
#pragma unroll 1
  for (int kt = 0; kt < nkt2; kt += 2) {
    body(kt, 0, kregA, vregA, kregB, vregB);
    body(kt + 1, 1, kregB, vregB, kregA, vregA);
  }
#pragma unroll
  for (int nt = 0; nt < 2; ++nt) {
    float l = lsum[nt];
    l += __shfl_xor(l, 16); l += __shfl_xor(l, 32);
    const float inv = 1.f / l;
    if (qi[nt] < T_) {
      const size_t row = (size_t)(b * T_ + qi[nt]);
#pragma unroll
      for (int mt = 0; mt < 4; ++mt) {
        const u32x2 gv = *(const u32x2*)(ws.GATE + row * 1024 + hd * 64 + 16 * mt + 4 * lq);
        const float o0 = oacc[mt][nt][0] * inv * siluf_(bflo(gv.x)), o1 = oacc[mt][nt][1] * inv * siluf_(bfhi(gv.x));
        const float o2 = oacc[mt][nt][2] * inv * siluf_(bflo(gv.y)), o3 = oacc[mt][nt][3] * inv * siluf_(bfhi(gv.y));
        u32x2 pk; pk.x = cvt_pk_bf16(o0, o1); pk.y = cvt_pk_bf16(o2, o3);
        if (!dry) *(u32x2*)(ws.QB + row * 1536 + hd * 96 + 16 * mt + 4 * lq) = pk;
      }
    }
  }
}

__device__ __forceinline__ void phase_final(const Params& p, const WS& ws) {
  const int tidf = opaque_tid();
  const int lane = tidf & 63;
  const int gw = opaque_bid() * 4 + (tidf >> 6), nw = gridDim.x * 4;
#pragma unroll 2
  for (int r = gw; r < 8 * 2048; r += nw) {
    const int b = r >> 11, s = r & 2047;
    const size_t hoff = (size_t)(b * T_ + 16 + s) * 1024;
    float4 v[4];
    float ssum = 0.f;
#pragma unroll
    for (int i = 0; i < 4; ++i) {
      const u32x2 hi = *(const u32x2*)(ws.HHI + hoff + i * 256 + lane * 4), lo = *(const u32x2*)(ws.HLO + hoff + i * 256 + lane * 4);
      v[i] = make_float4(bflo(hi.x) + bflo(lo.x), bfhi(hi.x) + bfhi(lo.x), bflo(hi.y) + bflo(lo.y), bfhi(hi.y) + bfhi(lo.y));
      ssum += v[i].x * v[i].x + v[i].y * v[i].y + v[i].z * v[i].z + v[i].w * v[i].w;
    }
#pragma unroll
    for (int o = 1; o < 64; o <<= 1) ssum += __shfl_xor(ssum, o);
    const float rstd = rsqrtf(ssum * (1.f / 1024.f) + EPS_);
#pragma unroll
    for (int i = 0; i < 4; ++i) {
      const float4 g = *(const float4*)(p.final_norm + i * 256 + lane * 4);
      float4 o; o.x = v[i].x * rstd * g.x; o.y = v[i].y * rstd * g.y; o.z = v[i].z * rstd * g.z; o.w = v[i].w * rstd * g.w;
      *(float4*)(p.out + (size_t)r * 1024 + i * 256 + lane * 4) = o;
    }
  }
}

__global__ void __launch_bounds__(256, 2) fwd_megakernel(Params p) {
  cg::grid_group grid = cg::this_grid();
  if (p.inv_freq[0] < 0.f) grid.sync();
  volatile LAS unsigned* xst = (volatile LAS unsigned*)(smem + SMEM_BYTES);
  if (threadIdx.x == 0) { xst[0] = 0u; xst[1] = 0u; xst[2] = 0u; xst[3] = 0u; }
  __syncthreads();
  const XcdBarrier xb = xcd_barrier_post((unsigned*)(p.ws + BAR_OFF), xst);
  {
    const WS ws = make_ws(p);
    phase_prologue(p, ws);
  }
  xcd_barrier(xb);
#pragma unroll 1
  for (int layer = 0; layer < 4; ++layer) {
    const int j = layer >> 1;
    if ((layer & 1) == 0) {
      {
        const WS ws = make_ws(p);
        const bf16_t* wb = ws.W + (size_t)j * W_PER_J;
#pragma unroll 1
        for (int rep = 0; rep < REP_GEMM; ++rep)
          gemm_stream<true, EPI_E1, 4>(ws, ws.HHI, nullptr, 1024, 1 << 30, 64, wb + W_IN_E, 1024, 1.f / 1024.f, 41, 129 * 41, xcd_bid(opaque_bid()), false);
      }
      xcd_barrier(xb);
      {
        const WS ws = make_ws(p);
#pragma unroll 1
        for (int u = opaque_bid(); u < 8 * 4 * 33; u += gridDim.x) gla_decay_unit(p, ws, j, u);
      }
      xcd_barrier(xb);
      {
#pragma unroll 1
        for (int rep = 0; rep < REP_E2; ++rep)
#pragma unroll 1
        for (int u = opaque_bid(); u < 512; u += gridDim.x) {
          if (u >= 256) { const WS ws = make_ws(p); rglru_unit(p, ws, j, u - 256, rep < REP_E2 - 1); }
          else { const WS ws = make_ws(p); gla_unit(p, ws, u, rep < REP_E2 - 1); }
        }
      }
      xcd_barrier(xb);
      {
        const WS ws = make_ws(p);
        phase_gla_norm(p, ws, j);
      }
      xcd_barrier(xb);
      {
        const WS ws = make_ws(p);
        const bf16_t* wb = ws.W + (size_t)j * W_PER_J;
#pragma unroll 1
        for (int rep = 0; rep < REP_GEMM; ++rep)
          gemm_stream<false, EPI_RES, 5>(ws, ws.GA, ws.V, 1024, 16, 64, wb + W_OUT_E, 2048, 0.f, 8, 128 * 8, xcd_bid(opaque_bid()), rep < REP_GEMM - 1);
      }
      xcd_barrier(xb);
    } else {
      {
        const WS ws = make_ws(p);
        const bf16_t* wb = ws.W + (size_t)j * W_PER_J;
#pragma unroll 1
        for (int rep = 0; rep < REP_GEMM; ++rep)
          gemm_stream<true, EPI_O1, 4>(ws, ws.HHI, nullptr, 1024, 1 << 30, 64, wb + W_IN_O, 1024, 1.f / 1024.f, 15, 129 * 15, xcd_bid(opaque_bid()), false);
      }
      xcd_barrier(xb);
      {
        const WS ws = make_ws(p);
        const bf16_t* wb = ws.W + (size_t)j * W_PER_J;
#pragma unroll 1
        for (int rep = 0; rep < REP_GEMM; ++rep) {
          gemm_stream<true, EPI_Q, 4>(ws, ws.CQ, nullptr, 512, 1 << 30, 64, wb + W_Q, 512, 1.f / 512.f, 12, 129 * 12, xcd_bid(opaque_bid()), false);
          gemm_stream<true, EPI_KV, 4>(ws, ws.CKV, nullptr, 256, 1 << 30, 64, wb + W_KV, 256, 1.f / 256.f, 16, 129 * 16, xcd_bid((opaque_bid() + (int)(gridDim.x >> 1)) % (int)gridDim.x), false);
        }
      }
      xcd_barrier(xb);
      {
        const WS ws = make_ws(p);
#pragma unroll 1
        for (int rep = 0; rep < REP_ATTN; ++rep)
#pragma unroll 1
        for (int r = 0, b0 = opaque_bid(); r * (int)gridDim.x < 17 * 128; ++r) {
          const int u = r * (int)gridDim.x + ((r & 1) ? (int)gridDim.x - 1 - b0 : b0);
          if (u < 17 * 128) attn_unit(ws, u, rep < REP_ATTN - 1);
          __syncthreads();
        }
      }
      xcd_barrier(xb);
      {
        const WS ws = make_ws(p);
        const bf16_t* wb = ws.W + (size_t)j * W_PER_J;
#pragma unroll 1
        for (int rep = 0; rep < REP_GEMM; ++rep)
          gemm_stream<false, EPI_RES, 5>(ws, ws.QB, nullptr, 1536, 1 << 30, 96, wb + W_O, 1024, 0.f, 8, 128 * 8, xcd_bid(opaque_bid()), rep < REP_GEMM - 1);
      }
      xcd_barrier(xb);
    }
  }
  {
    const WS ws = make_ws(p);
    phase_final(p, ws);
  }
}

extern "C" void kernel_launch(void* const* d_in, const int* in_sizes, int n_in, void* d_out, int out_size, void* d_ws,
                              size_t ws_size, hipStream_t stream) {
  static int grid_blocks = 0;
  if (!grid_blocks) {
    int dev = 0, cus = 0, per_cu = 0;
    hipGetDevice(&dev);
    hipDeviceGetAttribute(&cus, hipDeviceAttributeMultiprocessorCount, dev);
    hipOccupancyMaxActiveBlocksPerMultiprocessor(&per_cu, fwd_megakernel, 256, 0);
    if (per_cu < 1) per_cu = 1;
    if (per_cu > 2) per_cu = 2;
    grid_blocks = cus * per_cu;
  }
  Params p{};
  p.x = (const float*)d_in[0]; p.positions = (const int*)d_in[1]; p.meta = (const float*)d_in[2];
  p.ab_norm = (const float*)d_in[3]; p.ab_w_in = (const float*)d_in[4]; p.ab_conv_w = (const float*)d_in[5];
  p.ab_conv_b = (const float*)d_in[6]; p.ab_gate_a_w = (const float*)d_in[7]; p.ab_gate_a_b = (const float*)d_in[8];
  p.ab_gate_x_w = (const float*)d_in[9]; p.ab_gate_x_b = (const float*)d_in[10]; p.ab_lam = (const float*)d_in[11];
  p.ab_alpha_w = (const float*)d_in[12]; p.ab_alpha_b = (const float*)d_in[13]; p.ab_gla_norm = (const float*)d_in[14];
  p.ab_w_out = (const float*)d_in[15]; p.c_norm = (const float*)d_in[16]; p.c_w_in = (const float*)d_in[17];
  p.c_q_norm = (const float*)d_in[18]; p.c_w_q_up = (const float*)d_in[19]; p.c_kv_norm = (const float*)d_in[20];
  p.c_w_kv_up = (const float*)d_in[21]; p.c_w_out = (const float*)d_in[22]; p.final_norm = (const float*)d_in[23];
  p.out = (float*)d_out;
  p.ws = (unsigned char*)d_ws;
  for (int i = 0; i < 16; ++i) p.inv_freq[i] = (float)pow(10000.0, -(double)i / 16.0);
  hipMemsetAsync((unsigned char*)d_ws + BAR_OFF, 0, XCD_BAR_WORDS * 4, stream);
  void* args[] = {&p};
  hipError_t e = hipLaunchCooperativeKernel((void*)fwd_megakernel, dim3(grid_blocks), dim3(256), args, 0, stream);
  if (e != hipSuccess) fprintf(stderr, "cooperative launch failed: %s (grid %d)\n", hipGetErrorString(e), grid_blocks);
}
```

```cpp
#include <hip/hip_runtime.h>
#include <hip/hip_cooperative_groups.h>
#include <cstdio>
#include <cmath>
namespace cg = cooperative_groups;

typedef unsigned short bf16_t;
typedef short bf16x8 __attribute__((ext_vector_type(8)));
typedef float f32x4 __attribute__((ext_vector_type(4)));
typedef unsigned u32x4 __attribute__((ext_vector_type(4)));
typedef unsigned u32x2 __attribute__((ext_vector_type(2)));

constexpr int T_ = 2064;
constexpr int M_ = 8 * T_;
constexpr int TP_ = 2112;
constexpr float EPS_ = 1e-6f;
constexpr int SMEM_BYTES = 75776;
constexpr float QSCALE_MLA = 0.10206207261596575f * 1.4426950408889634f;

constexpr size_t W_PER_J = 11796480;
constexpr size_t W_IN_E = 0, W_OUT_E = 5373952, W_IN_O = 7471104, W_Q = 9437184, W_KV = 10223616, W_O = 10747904;

struct Params {
  const float* x; const int* positions; const float* meta;
  const float *ab_norm, *ab_w_in, *ab_conv_w, *ab_conv_b, *ab_gate_a_w, *ab_gate_a_b, *ab_gate_x_w, *ab_gate_x_b,
      *ab_lam, *ab_alpha_w, *ab_alpha_b, *ab_gla_norm, *ab_w_out;
  const float *c_norm, *c_w_in, *c_q_norm, *c_w_q_up, *c_kv_norm, *c_w_kv_up, *c_w_out, *final_norm;
  float* out;
  unsigned char* ws;
  float inv_freq[16];
};

struct WS {
  bf16_t *HHI, *HLO; float2* ROPE;
  bf16_t *XA, *GA, *Q, *K, *V, *GB, *AD; float* SSQ; float* BL;
  bf16_t *CQ, *CKV, *GATE, *KR, *QB, *KN, *VT;
  bf16_t* W;
};

__device__ __forceinline__ unsigned char* opaque_ptr(unsigned char* q) {
  unsigned lo = (unsigned)(unsigned long long)q, hi = (unsigned)((unsigned long long)q >> 32);
  asm volatile("" : "+v"(lo), "+v"(hi));
  lo = __builtin_amdgcn_readfirstlane(lo); hi = __builtin_amdgcn_readfirstlane(hi);
  typedef __attribute__((address_space(1))) unsigned char gu8;
  return (unsigned char*)(gu8*)(((unsigned long long)hi << 32) | lo);
}
__device__ __forceinline__ WS make_ws(const Params& p) {
  WS w;
  unsigned char* b = opaque_ptr(p.ws);
  w.HHI = (bf16_t*)b; b += (size_t)M_ * 2048;
  w.HLO = (bf16_t*)b; b += (size_t)M_ * 2048;
  w.ROPE = (float2*)b; b += (size_t)M_ * 128;
  unsigned char* r = b;
  w.XA = (bf16_t*)r; r += (size_t)M_ * 2048;
  w.GA = (bf16_t*)r; r += (size_t)M_ * 2048;
  w.Q = (bf16_t*)r; r += (size_t)M_ * 1024;
  w.K = (bf16_t*)r; r += (size_t)M_ * 1024;
  w.V = (bf16_t*)r; r += (size_t)M_ * 2048;
  w.GB = (bf16_t*)r; r += (size_t)M_ * 2048;
  w.AD = (bf16_t*)r; r += (size_t)M_ * 32;
  w.SSQ = (float*)r; r += (size_t)M_ * 128;
  w.BL = (float*)r; r += (size_t)8 * 4 * 33 * 128 * 4;
  r = b;
  w.CQ = (bf16_t*)r; r += (size_t)M_ * 1024;
  w.CKV = (bf16_t*)r; r += (size_t)M_ * 512;
  w.GATE = (bf16_t*)r; r += (size_t)M_ * 2048;
  w.KR = (bf16_t*)r; r += (size_t)M_ * 64;
  w.QB = (bf16_t*)r; r += (size_t)M_ * 3072;
  w.KN = (bf16_t*)r; r += (size_t)M_ * 2048;
  w.VT = (bf16_t*)r; r += (size_t)128 * 64 * TP_ * 2;
  w.W = (bf16_t*)opaque_ptr((unsigned char*)p.out);
  return w;
}

__device__ __forceinline__ unsigned cvt_pk_bf16(float lo, float hi) {
  typedef float f32x2_t __attribute__((ext_vector_type(2)));
  typedef __bf16 bf16x2_t __attribute__((ext_vector_type(2)));
  const f32x2_t v = {lo, hi};
  const bf16x2_t r = __builtin_convertvector(v, bf16x2_t);
  return __builtin_bit_cast(unsigned, r);
}
__device__ __forceinline__ f32x4 scale4(f32x4 a, float r) {
  asm volatile("" : "+v"(r));
  float x0 = a[0] * r, x1 = a[1] * r, x2 = a[2] * r, x3 = a[3] * r;
  asm volatile("" : "+v"(x0), "+v"(x1), "+v"(x2), "+v"(x3));
  return (f32x4){x0, x1, x2, x3};
}
__device__ __forceinline__ float bf2f(bf16_t v) { return __uint_as_float(((unsigned)v) << 16); }
__device__ __forceinline__ float bflo(unsigned v) { return __uint_as_float(v << 16); }
__device__ __forceinline__ float bfhi(unsigned v) { return __uint_as_float(v & 0xffff0000u); }
__device__ __forceinline__ bf16_t f2bf(float f) { return (bf16_t)(cvt_pk_bf16(f, 0.f) & 0xffffu); }
__device__ __forceinline__ float sigmoidf_(float x) { return __builtin_amdgcn_rcpf(1.f + __expf(-x)); }
__device__ __forceinline__ float siluf_(float x) { return x * __builtin_amdgcn_rcpf(1.f + __expf(-x)); }
__device__ __forceinline__ bf16x8 as_bf16x8(u32x4 v) { return __builtin_bit_cast(bf16x8, v); }
__device__ __forceinline__ int opaque_tid() { int t = threadIdx.x; asm volatile("" : "+v"(t)); return t; }
__device__ __forceinline__ int xcd_bid(int bid) { const int gpx = gridDim.x >> 3; return (bid & 7) * gpx + (bid >> 3); }
__device__ __forceinline__ int opaque_bid() { int t = blockIdx.x; asm volatile("" : "+s"(t)); return t; }
#define MFMA16(a, b, c) __builtin_amdgcn_mfma_f32_16x16x32_bf16((a), (b), (c), 0, 0, 0)

__shared__ __attribute__((aligned(16))) unsigned char smem[SMEM_BYTES + 16];

#define XB_TMO      128
#define XB_XCNT(j)  (256  + 64 * (j))
#define XB_XSUB(j)  (1280 + 64 * (j))
#define XB_XGEN(j)  (2304 + 64 * (j))
#define XB_TOP      3328
#define XB_TOPGEN   3392
#define XCD_BAR_WORDS 3456
#define XB_SPIN_CAP (1u << 18)
#define LAS __attribute__((address_space(3)))
constexpr size_t BAR_OFF = 260046848;

__device__ __forceinline__ unsigned xb_ld(unsigned* p)              { return __hip_atomic_load(p, __ATOMIC_RELAXED, __HIP_MEMORY_SCOPE_AGENT); }
__device__ __forceinline__ unsigned xb_add(unsigned* p, unsigned v) { return __hip_atomic_fetch_add(p, v, __ATOMIC_RELAXED, __HIP_MEMORY_SCOPE_AGENT); }
__device__ __forceinline__ unsigned xb_xcc_id() { return (unsigned)__builtin_amdgcn_s_getreg((3 << 11) | 20) & 0xFu; }
#define XB_SPIN(cond, bar) do { unsigned _sp = 0; while (cond) { __builtin_amdgcn_s_sleep(1); \
    if ((++_sp & 255u) == 0u) { if (xb_ld(&(bar)[XB_TMO])) break; if (_sp > XB_SPIN_CAP) { atomicAdd(&(bar)[XB_TMO], 1u); break; } } } } while (0)

struct XcdBarrier { unsigned* bar; unsigned x; volatile LAS unsigned* st; };

__device__ __forceinline__ XcdBarrier xcd_barrier_post(unsigned* bar, volatile LAS unsigned* st) {
    XcdBarrier b; b.bar = bar; b.x = xb_xcc_id(); b.st = st;
    if (threadIdx.x == 0) (void)xb_add(&bar[XB_XCNT(b.x)], 1u);
    return b;
}
__device__ __forceinline__ void xcd_barrier_complete(unsigned* bar, unsigned x, unsigned& nloc, unsigned& nx) {
    const unsigned G = gridDim.x * gridDim.y * gridDim.z;
    unsigned sum, cnt, mine, sp = 0u;
    for (;;) {
        sum = 0u; cnt = 0u; mine = 0u;
#pragma unroll
        for (unsigned j = 0; j < 16; ++j) { const unsigned c = xb_ld(&bar[XB_XCNT(j)]); sum += c; cnt += (c > 0u) ? 1u : 0u; mine = (j == x) ? c : mine; }
        if (sum == G) break;
        __builtin_amdgcn_s_sleep(1);
        if ((++sp & 255u) == 0u) { if (xb_ld(&bar[XB_TMO])) break; if (sp > XB_SPIN_CAP) { atomicAdd(&bar[XB_TMO], 1u); break; } }
    }
    nloc = mine > 0u ? mine : 1u; nx = cnt > 0u ? cnt : 1u;
}
__device__ __forceinline__ void xcd_barrier(const XcdBarrier& b) {
    asm volatile("s_waitcnt vmcnt(0)" ::: "memory");
    __syncthreads();
    if (threadIdx.x == 0) {
        unsigned* bar = b.bar;
        __builtin_amdgcn_s_waitcnt(0);
        unsigned nloc = b.st[0], nx = b.st[1];
        if (nloc == 0u) { xcd_barrier_complete(bar, b.x, nloc, nx); b.st[0] = nloc; b.st[1] = nx; }
        const unsigned old = xb_add(&bar[XB_XSUB(b.x)], 1u);
        const unsigned gen = old / nloc;
        if (old + 1u == (gen + 1u) * nloc) {
            __builtin_amdgcn_fence(__ATOMIC_RELEASE, "agent");
            asm volatile("s_waitcnt vmcnt(0)" ::: "memory");
            const unsigned og = xb_add(&bar[XB_TOP], 1u);
            const unsigned tg = og / nx;
            if (og + 1u == (tg + 1u) * nx) xb_add(&bar[XB_TOPGEN], 1u);
            else XB_SPIN(xb_ld(&bar[XB_TOPGEN]) == tg, bar);
            __builtin_amdgcn_fence(__ATOMIC_ACQUIRE, "agent");
            xb_add(&bar[XB_XGEN(b.x)], 1u);
            asm volatile("s_waitcnt vmcnt(0)" ::: "memory");
        } else {
            XB_SPIN(xb_ld(&bar[XB_XGEN(b.x)]) == gen, bar);
            __builtin_amdgcn_fence(__ATOMIC_ACQUIRE, "agent");
            asm volatile("s_waitcnt vmcnt(0)" ::: "memory");
        }
    }
    __syncthreads();
}


__device__ __forceinline__ int map_even_in(int n) { return n < 4096 ? n : (n < 5120 ? n + 16 : (n < 5136 ? n - 1024 : -1)); }
__device__ __forceinline__ int map_odd_in(int n) { return n < 768 ? n : (n < 1792 ? n + 32 : (n < 1824 ? n - 1024 : -1)); }

__device__ __forceinline__ void convert_tile(const float* __restrict__ src, int K, int Nsrc, bf16_t* __restrict__ dst,
                                             int kind, const float* __restrict__ g, int tile) {
  float* tl = (float*)smem;
  const int nkt = K >> 7;
  const int ntile = tile / nkt, ktile = tile - ntile * nkt;
  const int n0 = ntile * 64, k0 = ktile * 128;
  const int tid = opaque_tid();
  const int nl = tid & 63, kq = tid >> 6;
  const int n = n0 + nl;
  const int sc = kind == 0 ? map_even_in(n) : (kind == 1 ? map_odd_in(n) : n);
  float cs = 1.f;
  if (kind == 0 && n >= 2048 && n < 2560) cs = 0.08838834764831845f;
  if (kind == 2) cs = QSCALE_MLA;
  float v[32];
#pragma unroll
  for (int i = 0; i < 32; ++i) {
    const int kl = kq + 4 * i;
    v[i] = 0.f;
    if (sc >= 0) v[i] = src[(size_t)(k0 + kl) * Nsrc + sc];
  }
#pragma unroll
  for (int i = 0; i < 32; ++i) {
    const int kl = kq + 4 * i;
    float t = v[i] * cs;
    if (g) t *= g[k0 + kl];
    tl[kl * 65 + nl] = t;
  }
  __syncthreads();
#pragma unroll
  for (int i = 0; i < 4; ++i) {
    const int c = tid + 256 * i;
    const int nl2 = c >> 4, kc = c & 15;
    float t[8];
#pragma unroll
    for (int jj = 0; jj < 8; ++jj) t[jj] = tl[(kc * 8 + jj) * 65 + nl2];
    u32x4 pk;
    pk.x = cvt_pk_bf16(t[0], t[1]); pk.y = cvt_pk_bf16(t[2], t[3]); pk.z = cvt_pk_bf16(t[4], t[5]); pk.w = cvt_pk_bf16(t[6], t[7]);
    *(u32x4*)(dst + (size_t)(n0 + nl2) * K + k0 + kc * 8) = pk;
  }
  __syncthreads();
}

__device__ __forceinline__ void phase_prologue(const Params& p, const WS& ws) {
  for (int id = opaque_bid(); id < 2880; id += gridDim.x) {
    const int j = id / 1440; int r = id - j * 1440;
    bf16_t* wb = ws.W + (size_t)j * W_PER_J;
    if (r < 656) convert_tile(p.ab_w_in + (size_t)j * 1024 * 5136, 1024, 5136, wb + W_IN_E, 0, p.ab_norm + j * 1024, r);
    else if ((r -= 656) < 256) convert_tile(p.ab_w_out + (size_t)j * 2048 * 1024, 2048, 1024, wb + W_OUT_E, 3, nullptr, r);
    else if ((r -= 256) < 240) convert_tile(p.c_w_in + (size_t)j * 1024 * 1824, 1024, 1824, wb + W_IN_O, 1, p.c_norm + j * 1024, r);
    else if ((r -= 240) < 96) convert_tile(p.c_w_q_up + (size_t)j * 512 * 1536, 512, 1536, wb + W_Q, 2, p.c_q_norm + j * 512, r);
    else if ((r -= 96) < 64) convert_tile(p.c_w_kv_up + (size_t)j * 256 * 2048, 256, 2048, wb + W_KV, 3, p.c_kv_norm + j * 256, r);
    else { r -= 64; convert_tile(p.c_w_out + (size_t)j * 1024 * 1024, 1024, 1024, wb + W_O, 3, nullptr, r); }
  }
  const size_t gtid = (size_t)opaque_bid() * 256 + opaque_tid(), gsz = (size_t)gridDim.x * 256;
  for (size_t idx0 = gtid; idx0 < (size_t)M_ * 256; idx0 += 4 * gsz) {
    float4 v4[4];
#pragma unroll
    for (int q = 0; q < 4; ++q) {
      const size_t idx = idx0 + q * gsz;
      v4[q] = make_float4(0.f, 0.f, 0.f, 0.f);
      if (idx < (size_t)M_ * 256) {
        const int row = (int)(idx >> 8), c4 = (int)(idx & 255);
        const int b = row / T_, t = row - b * T_;
        const float* src = t < 16 ? p.meta + (size_t)t * 1024 : p.x + ((size_t)b * 2048 + (t - 16)) * 1024;
        v4[q] = *(const float4*)(src + c4 * 4);
      }
    }
#pragma unroll
    for (int q = 0; q < 4; ++q) {
      const size_t idx = idx0 + q * gsz;
      if (idx < (size_t)M_ * 256) {
        const float4 v = v4[q];
        u32x2 hi; hi.x = cvt_pk_bf16(v.x, v.y); hi.y = cvt_pk_bf16(v.z, v.w);
        u32x2 lo; lo.x = cvt_pk_bf16(v.x - bflo(hi.x), v.y - bfhi(hi.x)); lo.y = cvt_pk_bf16(v.z - bflo(hi.y), v.w - bfhi(hi.y));
        *(u32x2*)(ws.HHI + idx * 4) = hi;
        *(u32x2*)(ws.HLO + idx * 4) = lo;
      }
    }
  }
  for (size_t idx = gtid; idx < (size_t)M_ * 16; idx += gsz) {
    const int row = (int)(idx >> 4), i = (int)(idx & 15);
    const int b = row / T_, t = row - b * T_;
    const int pos = t < 16 ? t : p.positions[b * 2048 + (t - 16)] + 16;
    const float angf = (float)pos * p.inv_freq[i];
    const double rev = (double)angf * 0.15915494309189533577;
    const float fr = (float)(rev - rint(rev));
    ws.ROPE[idx] = make_float2(__builtin_amdgcn_cosf(fr), __builtin_amdgcn_sinf(fr));
  }
}

#ifndef REP_GEMM
#define REP_GEMM 1
#endif
#ifndef REP_ATTN
#define REP_ATTN 1
#endif
#ifndef REP_E2
#define REP_E2 1
#endif
enum { EPI_E1 = 0, EPI_O1 = 1, EPI_Q = 2, EPI_KV = 3, EPI_RES = 4 };

template <int EPI, int TI>
__device__ __forceinline__ void gemm_epilogue(const WS& ws, const f32x4 (&acc)[4][TI], const float (&rs)[TI], int tok0, int n0,
                                              int wm, int wn, int lr, int lq, bool dry) {
  auto tokr = [&](int ti) { return tok0 + (ti < 4 ? wn * 64 + ti * 16 : 128 + wn * 16) + lr; };
  auto okr = [&](int ti) { return ti < 4 || (wn == 0 && lr == 0); };
  const int nw = n0 + wm * 64;
  if (EPI == EPI_E1) {
    bf16_t* dst; int ld, c;
    if (n0 < 1024) { dst = ws.XA; ld = 1024; c = n0; }
    else if (n0 < 2048) { dst = ws.GA; ld = 1024; c = n0 - 1024; }
    else if (n0 < 2560) { dst = ws.Q; ld = 512; c = n0 - 2048; }
    else if (n0 < 3072) { dst = ws.K; ld = 512; c = n0 - 2560; }
    else if (n0 < 4096) { dst = ws.V; ld = 1024; c = n0 - 3072; }
    else if (n0 < 5120) { dst = ws.GB; ld = 1024; c = n0 - 4096; }
    else { dst = ws.AD; ld = 16; c = 0; }
    const bool isad = n0 >= 5120;
#pragma unroll
    for (int ni = 0; ni < 4; ++ni) {
      if (isad && (wm != 0 || ni != 0)) continue;
#pragma unroll
      for (int ti = 0; ti < TI; ++ti) {
        const f32x4 v = scale4(acc[ni][ti], rs[ti]);
        u32x2 pk; pk.x = cvt_pk_bf16(v[0], v[1]); pk.y = cvt_pk_bf16(v[2], v[3]);
        if (okr(ti)) *(u32x2*)(dst + (size_t)tokr(ti) * ld + c + wm * 64 + ni * 16 + 4 * lq) = pk;
      }
    }
  } else if (EPI == EPI_O1) {
    if (n0 < 1792) {
      bf16_t* dst; int ld, c;
      if (n0 < 512) { dst = ws.CQ; ld = 512; c = n0; }
      else if (n0 < 768) { dst = ws.CKV; ld = 256; c = n0 - 512; }
      else { dst = ws.GATE; ld = 1024; c = n0 - 768; }
#pragma unroll
      for (int ni = 0; ni < 4; ++ni)
#pragma unroll
        for (int ti = 0; ti < TI; ++ti) {
          const f32x4 v = scale4(acc[ni][ti], rs[ti]);
          u32x2 pk; pk.x = cvt_pk_bf16(v[0], v[1]); pk.y = cvt_pk_bf16(v[2], v[3]);
          if (okr(ti)) *(u32x2*)(dst + (size_t)tokr(ti) * ld + c + wm * 64 + ni * 16 + 4 * lq) = pk;
        }
    } else if (wm == 0) {
#pragma unroll
      for (int ti = 0; ti < TI; ++ti) {
        const int tok = tokr(ti);
        const f32x4 x1 = scale4(acc[0][ti], rs[ti]), x2 = scale4(acc[1][ti], rs[ti]);
        float o1[4], o2[4];
#pragma unroll
        for (int jj = 0; jj < 4; ++jj) {
          const float2 cs = ws.ROPE[(size_t)tok * 16 + 4 * lq + jj];
          o1[jj] = x1[jj] * cs.x - x2[jj] * cs.y;
          o2[jj] = x2[jj] * cs.x + x1[jj] * cs.y;
        }
        u32x2 pk; pk.x = cvt_pk_bf16(o1[0], o1[1]); pk.y = cvt_pk_bf16(o1[2], o1[3]);
        *(u32x2*)(ws.KR + (size_t)tok * 32 + 4 * lq) = pk;
        pk.x = cvt_pk_bf16(o2[0], o2[1]); pk.y = cvt_pk_bf16(o2[2], o2[3]);
        *(u32x2*)(ws.KR + (size_t)tok * 32 + 16 + 4 * lq) = pk;
      }
    }
  } else if (EPI == EPI_Q) {
#pragma unroll
    for (int ni = 0; ni < 4; ++ni)
#pragma unroll
      for (int ti = 0; ti < TI; ++ti) {
        const f32x4 v = scale4(acc[ni][ti], rs[ti]);
        u32x2 pk; pk.x = cvt_pk_bf16(v[0], v[1]); pk.y = cvt_pk_bf16(v[2], v[3]);
        if (okr(ti)) *(u32x2*)(ws.QB + (size_t)tokr(ti) * 1536 + nw + ni * 16 + 4 * lq) = pk;
      }
  } else if (EPI == EPI_KV) {
    const int hd = nw >> 7;
    const bool isv = (nw & 127) >= 64;
    if (!isv) {
#pragma unroll
      for (int ni = 0; ni < 4; ++ni)
#pragma unroll
        for (int ti = 0; ti < TI; ++ti) {
          const f32x4 v = scale4(acc[ni][ti], rs[ti]);
          u32x2 pk; pk.x = cvt_pk_bf16(v[0], v[1]); pk.y = cvt_pk_bf16(v[2], v[3]);
          if (okr(ti)) *(u32x2*)(ws.KN + (size_t)tokr(ti) * 1024 + hd * 64 + ni * 16 + 4 * lq) = pk;
        }
    } else {
#pragma unroll
      for (int ti = 0; ti < TI; ++ti) {
        const int tok = tokr(ti);
        const int b = tok / T_, t = tok - b * T_;
        bf16_t* vb = ws.VT + ((size_t)(b * 16 + hd) * 64) * TP_ + t;
#pragma unroll
        for (int ni = 0; ni < 4; ++ni) {
          const f32x4 v = scale4(acc[ni][ti], rs[ti]);
#pragma unroll
          for (int jj = 0; jj < 4; ++jj) if (okr(ti)) vb[(size_t)(ni * 16 + 4 * lq + jj) * TP_] = f2bf(v[jj]);
        }
      }
    }
  } else {
#pragma unroll
    for (int ni = 0; ni < 4; ++ni)
#pragma unroll
      for (int ti = 0; ti < TI; ++ti) {
        if (!okr(ti)) continue;
        const size_t off = (size_t)tokr(ti) * 1024 + nw + ni * 16 + 4 * lq;
        const u32x2 hi = *(const u32x2*)(ws.HHI + off), lo = *(const u32x2*)(ws.HLO + off);
        const float h0 = bflo(hi.x) + bflo(lo.x) + acc[ni][ti][0], h1 = bfhi(hi.x) + bfhi(lo.x) + acc[ni][ti][1];
        const float h2 = bflo(hi.y) + bflo(lo.y) + acc[ni][ti][2], h3 = bfhi(hi.y) + bfhi(lo.y) + acc[ni][ti][3];
        u32x2 nh; nh.x = cvt_pk_bf16(h0, h1); nh.y = cvt_pk_bf16(h2, h3);
        u32x2 nl; nl.x = cvt_pk_bf16(h0 - bflo(nh.x), h1 - bfhi(nh.x)); nl.y = cvt_pk_bf16(h2 - bflo(nh.y), h3 - bfhi(nh.y));
        if (!dry) { *(u32x2*)(ws.HHI + off) = nh; *(u32x2*)(ws.HLO + off) = nl; }
      }
  }
}

__device__ __forceinline__ float sumsq8(bf16x8 v) {
  const u32x4 u = __builtin_bit_cast(u32x4, v);
  float s = 0.f, t;
  t = bflo(u.x); s += t * t; t = bfhi(u.x); s += t * t; t = bflo(u.y); s += t * t; t = bfhi(u.y); s += t * t;
  t = bflo(u.z); s += t * t; t = bfhi(u.z); s += t * t; t = bflo(u.w); s += t * t; t = bfhi(u.w); s += t * t;
  return s;
}
__device__ __forceinline__ void tile_of(int pos, int ntn, int& mt, int& nt) {
  const int full = 128 * ntn;
  if (pos < full) { const int panel = pos / (8 * ntn); const int rem = pos - panel * 8 * ntn; nt = rem >> 3; mt = panel * 8 + (rem & 7); }
  else { mt = 128; nt = pos - full; }
}
template <bool RS, int EPI, int TI>
__device__ __forceinline__ void gemm_stream(const WS& ws, const bf16_t* A0, const bf16_t* A1, int lda, int ktsplit, int kstride,
                                            const bf16_t* __restrict__ W, int K, float invK, int ntn, int ntiles, int bid, bool dry) {
  constexpr int BM = (TI == 5) ? 129 : 128;
  constexpr int ASTG = 16384;
  unsigned char* As = smem;
  unsigned char* Bs = smem + 2 * ASTG;
  float* rsl = (float*)(smem + 65536);
  int xbase = 66048;
  asm volatile("" : "+v"(xbase));
  unsigned char* Ax0 = smem + xbase;
  const int tid = opaque_tid(), lane = tid & 63, w = tid >> 6, wm = w >> 1, wn = w & 1, lr = lane & 15, lq = lane >> 4;
  const int G = gridDim.x;
  const int nk = K >> 6;
  if (bid < ntiles) {
    const int my_tiles = (ntiles - 1 - bid) / G + 1;
    const int last_id = bid + (my_tiles - 1) * G;
    const int S = my_tiles * nk;
    f32x4 acc[4][TI];
#pragma unroll
    for (int a = 0; a < 4; ++a)
#pragma unroll
      for (int b = 0; b < TI; ++b) acc[a][b] = (f32x4){0.f, 0.f, 0.f, 0.f};
    u32x4 ra0[4], rb0[4], ra1[4], rb1[4];
    u32x4 rx0 = (u32x4){0u, 0u, 0u, 0u}, rx1 = (u32x4){0u, 0u, 0u, 0u};
    float ss[5] = {0.f, 0.f, 0.f, 0.f, 0.f};
    int l_id = bid, l_kt = 0, c_id = bid, c_kt = 0, st_kt = 0;
    const int srow = tid >> 3;
    const int soff = srow * 128 + (((tid & 7) ^ (srow & 7)) << 4);

    auto issue = [&](u32x4 (&ra)[4], u32x4 (&rb)[4], u32x4& rx) {
      const int idc = l_id < last_id ? l_id : last_id;
      int mt, nt; tile_of(idc, ntn, mt, nt);
      const bf16_t* A = (l_kt < ktsplit) ? A0 : A1;
      const int kk = (l_kt < ktsplit) ? l_kt : l_kt - ktsplit;
      const bf16_t* ap = A + (size_t)(mt * BM + srow) * lda + kk * kstride + (tid & 7) * 8;
      const bf16_t* wp = W + (size_t)(nt * 128 + srow) * K + l_kt * 64 + (tid & 7) * 8;
#pragma unroll
      for (int i = 0; i < 4; ++i) {
        ra[i] = *(const u32x4*)(ap + (size_t)i * 32 * lda);
        rb[i] = *(const u32x4*)(wp + (size_t)i * 32 * K);
      }
      if (TI == 5) { if (srow == 0) rx = *(const u32x4*)(ap + (size_t)128 * lda); }
      if (++l_kt == nk) { l_kt = 0; l_id += G; }
    };
    auto store = [&](const u32x4 (&ra)[4], const u32x4 (&rb)[4], const u32x4& rx, int buf) {
#pragma unroll
      for (int i = 0; i < 4; ++i) {
        if (RS) ss[i] += sumsq8(__builtin_bit_cast(bf16x8, ra[i]));
        *(u32x4*)(As + buf * ASTG + i * 4096 + soff) = ra[i];
        *(u32x4*)(Bs + buf * 16384 + i * 4096 + soff) = rb[i];
      }
      if (TI == 5) {
        if (RS) ss[4] += sumsq8(__builtin_bit_cast(bf16x8, rx));
        if (srow == 0) *(u32x4*)(Ax0 + buf * 128 + ((tid & 7) << 4)) = rx;
      }
      if (RS) {
        if (++st_kt == nk) {
          st_kt = 0;
#pragma unroll
          for (int i = 0; i < TI; ++i) {
            float t = ss[i];
            t += __shfl_xor(t, 1); t += __shfl_xor(t, 2); t += __shfl_xor(t, 4);
            if ((tid & 7) == 0 && i < 4) rsl[srow + 32 * i] = rsqrtf(t * invK + EPS_);
            ss[i] = 0.f;
          }
        }
      }
    };
    auto compute = [&](int buf) {
      const unsigned char* Ab = As + buf * ASTG + (wn * 64 + lr) * 128;
      const unsigned char* Ax = Ax0 + buf * 128;
      const unsigned char* Bb = Bs + buf * 16384 + (wm * 64 + lr) * 128;
#pragma unroll
      for (int ks = 0; ks < 2; ++ks) {
        if (TI == 5 && ks == 1) __builtin_amdgcn_sched_barrier(0);
        const int sw = ((ks * 4 + lq) ^ (lr & 7)) << 4;
        bf16x8 wf[4], xf[TI];
#pragma unroll
        for (int i = 0; i < 4; ++i) {
          wf[i] = *(const bf16x8*)(Bb + i * 2048 + sw);
          xf[i] = *(const bf16x8*)(Ab + i * 2048 + sw);
        }
        if (TI == 5) xf[TI - 1] = *(const bf16x8*)(Ax + ((ks * 4 + lq) << 4));
#pragma unroll
        for (int ni = 0; ni < 4; ++ni)
#pragma unroll
          for (int ti = 0; ti < TI; ++ti) acc[ni][ti] = MFMA16(wf[ni], xf[ti], acc[ni][ti]);
      }
    };
    auto tile_end = [&]() {
      float rs[TI];
#pragma unroll
      for (int ti = 0; ti < TI; ++ti) rs[ti] = 1.f;
      if (RS) {
#pragma unroll
        for (int ti = 0; ti < TI; ++ti) rs[ti] = rsl[(ti < 4 ? wn * 64 + ti * 16 : 0) + lr];
      }
      int mt, nt; tile_of(c_id, ntn, mt, nt);
      gemm_epilogue<EPI, TI>(ws, acc, rs, mt * BM, nt * 128, wm, wn, lr, lq, dry);
#pragma unroll
      for (int a = 0; a < 4; ++a)
#pragma unroll
        for (int b = 0; b < TI; ++b) acc[a][b] = (f32x4){0.f, 0.f, 0.f, 0.f};
      c_id += G;
    };

    issue(ra0, rb0, rx0);
    issue(ra1, rb1, rx1);
    store(ra0, rb0, rx0, 0);
    __syncthreads();
#pragma unroll 1
    for (int s = 0; s < S; s += 2) {
      issue(ra0, rb0, rx0);
      compute(0);
      store(ra1, rb1, rx1, 1);
      __syncthreads();
      issue(ra1, rb1, rx1);
      compute(1);
      c_kt += 2;
      if (c_kt == nk) { c_kt = 0; tile_end(); }
      store(ra0, rb0, rx0, 0);
      __syncthreads();
    }
  }
  __syncthreads();
}

__device__ __forceinline__ void gla_decay_unit(const Params& p, const WS& ws, int j, int u) {
  const int c = u % 33; const int bh = u / 33; const int hd = bh & 3, b = bh >> 2;
  bf16_t* Qs = (bf16_t*)smem;
  bf16_t* Ks = Qs + 64 * 136;
  float* ADs = (float*)(smem + 2 * 64 * 136 * 2);
  float* HT = ADs + 64 * 16;
  const int tid = opaque_tid();
  const int tbase = 64 * c - 48;
#pragma unroll
  for (int i = 0; i < 4; ++i) {
    const int ci = tid + 256 * i; const int row = ci >> 4, ch = ci & 15; const int t = tbase + row;
    u32x4 qv = (u32x4){0, 0, 0, 0}, kv = (u32x4){0, 0, 0, 0};
    if (t >= 0) {
      qv = *(const u32x4*)(ws.Q + (size_t)(b * T_ + t) * 512 + hd * 128 + ch * 8);
      kv = *(const u32x4*)(ws.K + (size_t)(b * T_ + t) * 512 + hd * 128 + ch * 8);
    }
    *(u32x4*)(Qs + row * 136 + ch * 8) = qv;
    *(u32x4*)(Ks + row * 136 + ch * 8) = kv;
    const int t2 = tbase + (ci >> 4);
    ADs[ci] = t2 >= 0 ? bf2f(ws.AD[(size_t)(b * T_ + t2) * 16 + (ci & 15)]) : 0.f;
  }
  const int d = tid & 127, half = tid >> 7;
  float aw[16];
#pragma unroll
  for (int r = 0; r < 16; ++r) aw[r] = p.ab_alpha_w[(size_t)(j * 16 + r) * 512 + hd * 128 + d];
  const float abias = p.ab_alpha_b[j * 512 + hd * 128 + d];
  __syncthreads();
  float cs[32];
  float run = 0.f;
#pragma unroll
  for (int ii = 0; ii < 32; ++ii) {
    const int row = half * 32 + ii;
    float xv = abias;
#pragma unroll
    for (int r4 = 0; r4 < 4; ++r4) {
      const float4 a4 = *(const float4*)(ADs + row * 16 + r4 * 4);
      xv += a4.x * aw[r4 * 4] + a4.y * aw[r4 * 4 + 1] + a4.z * aw[r4 * 4 + 2] + a4.w * aw[r4 * 4 + 3];
    }
    float la = (fminf(xv, 0.f) - __logf(1.f + __expf(-fabsf(xv)))) * 0.0625f;
    if (tbase + row < 0) la = 0.f;
    run += la;
    cs[ii] = run;
  }
  HT[half * 128 + d] = run;
  __syncthreads();
  const float off = half ? HT[d] : 0.f;
  const float blast = HT[d] + HT[128 + d];
#pragma unroll
  for (int ii = 0; ii < 32; ++ii) {
    const int row = half * 32 + ii;
    const float bb = cs[ii] + off;
    const float eb = __expf(bb), ebi = __expf(-bb);
    Qs[row * 136 + d] = f2bf(bf2f(Qs[row * 136 + d]) * eb);
    Ks[row * 136 + d] = f2bf(bf2f(Ks[row * 136 + d]) * ebi);
  }
  if (half == 0) ws.BL[(size_t)((b * 4 + hd) * 33 + c) * 128 + d] = __expf(blast);
  __syncthreads();
#pragma unroll
  for (int i = 0; i < 4; ++i) {
    const int ci = tid + 256 * i; const int row = ci >> 4, ch = ci & 15; const int t = tbase + row;
    if (t >= 0) {
      *(u32x4*)(ws.Q + (size_t)(b * T_ + t) * 512 + hd * 128 + ch * 8) = *(const u32x4*)(Qs + row * 136 + ch * 8);
      *(u32x4*)(ws.K + (size_t)(b * T_ + t) * 512 + hd * 128 + ch * 8) = *(const u32x4*)(Ks + row * 136 + ch * 8);
    }
  }
  __syncthreads();
}

__device__ __forceinline__ void gla_unit(const Params& p, const WS& ws, int u, bool dry = false) {
  const int sl = u & 7; const int bh = u >> 3; const int hd = bh & 3, b = bh >> 2;
  bf16_t* QDs = (bf16_t*)smem;
  bf16_t* KIs = QDs + 64 * 136;
  bf16_t* KIT = KIs + 64 * 136;
  bf16_t* VTs = KIT + 128 * 72;
  bf16_t* STs = VTs + 32 * 72;
  bf16_t* Ps = STs + 32 * 136;
  const int tid = opaque_tid(), lane = tid & 63, w = tid >> 6, lr = lane & 15, lq = lane >> 4;
  for (int i = tid; i < 32 * 136 / 2; i += 256) ((unsigned*)STs)[i] = 0u;
  f32x4 sacc[2][2];
#pragma unroll
  for (int a = 0; a < 2; ++a)
#pragma unroll
    for (int bb = 0; bb < 2; ++bb) sacc[a][bb] = (f32x4){0.f, 0.f, 0.f, 0.f};
  u32x4 qrA[4], krA[4], vrA, qrB[4], krB[4], vrB;
  float eblA[2], eblB[2];
  const float* BLp = ws.BL + (size_t)((b * 4 + hd) * 33) * 128;
  auto prefetch = [&](int c, u32x4 (&qr)[4], u32x4 (&kr)[4], u32x4& vr, float (&ebl)[2]) {
    const int tbase = 64 * c - 48;
#pragma unroll
    for (int i = 0; i < 4; ++i) {
      const int ci = tid + 256 * i; const int row = ci >> 4, ch = ci & 15; const int t = tbase + row;
      qr[i] = (u32x4){0, 0, 0, 0}; kr[i] = (u32x4){0, 0, 0, 0};
      if (t >= 0) {
        qr[i] = *(const u32x4*)(ws.Q + (size_t)(b * T_ + t) * 512 + hd * 128 + ch * 8);
        kr[i] = *(const u32x4*)(ws.K + (size_t)(b * T_ + t) * 512 + hd * 128 + ch * 8);
      }
    }
    {
      const int row = tid >> 2, ch = tid & 3; const int t = tbase + row;
      vr = (u32x4){0, 0, 0, 0};
      if (t >= 0) vr = *(const u32x4*)(ws.V + (size_t)(b * T_ + t) * 1024 + hd * 256 + sl * 32 + ch * 8);
    }
    ebl[0] = BLp[c * 128 + 16 * (2 * w) + lr];
    ebl[1] = BLp[c * 128 + 16 * (2 * w + 1) + lr];
  };
  prefetch(0, qrA, krA, vrA, eblA);
  prefetch(1, qrB, krB, vrB, eblB);
  auto body = [&](int c, u32x4 (&qr)[4], u32x4 (&kr)[4], u32x4& vr, float (&ebl)[2]) {
#pragma unroll
    for (int i = 0; i < 4; ++i) {
      const int ci = tid + 256 * i; const int row = ci >> 4, ch = ci & 15;
      *(u32x4*)(QDs + row * 136 + ch * 8) = qr[i];
      *(u32x4*)(KIs + row * 136 + ch * 8) = kr[i];
      const unsigned kk[4] = {kr[i].x, kr[i].y, kr[i].z, kr[i].w};
#pragma unroll
      for (int e = 0; e < 4; ++e) {
        KIT[(ch * 8 + 2 * e) * 72 + (row ^ ((ch & 7) << 3))] = (bf16_t)(kk[e] & 0xffffu);
        KIT[(ch * 8 + 2 * e + 1) * 72 + (row ^ ((ch & 7) << 3))] = (bf16_t)(kk[e] >> 16);
      }
    }
    {
      const int row = tid >> 2, ch = tid & 3;
      const unsigned vv[4] = {vr.x, vr.y, vr.z, vr.w};
#pragma unroll
      for (int e = 0; e < 4; ++e) {
        VTs[(ch * 8 + 2 * e) * 72 + (row ^ (ch << 3))] = (bf16_t)(vv[e] & 0xffffu);
        VTs[(ch * 8 + 2 * e + 1) * 72 + (row ^ (ch << 3))] = (bf16_t)(vv[e] >> 16);
      }
    }
    const float eb0 = ebl[0], eb1 = ebl[1];
    __syncthreads();
    if (c + 2 < 33) prefetch(c + 2, qr, kr, vr, ebl);
    bf16x8 xq[4];
#pragma unroll
    for (int ks = 0; ks < 4; ++ks) xq[ks] = *(const bf16x8*)(QDs + (16 * w + lr) * 136 + 32 * ks + 8 * lq);
    const int irow = 16 * w + lr;
#pragma unroll
    for (int mt = 0; mt < 4; ++mt) {
      u32x2 pk = (u32x2){0u, 0u};
      if (mt <= w) {
        f32x4 a = (f32x4){0.f, 0.f, 0.f, 0.f};
#pragma unroll
        for (int ks = 0; ks < 4; ++ks) {
          const bf16x8 kf = *(const bf16x8*)(KIs + (16 * mt + lr) * 136 + 32 * ks + 8 * lq);
          a = MFMA16(kf, xq[ks], a);
        }
        const int ip = 16 * mt + 4 * lq;
        const float v0 = (ip + 0 <= irow) ? a[0] : 0.f, v1 = (ip + 1 <= irow) ? a[1] : 0.f;
        const float v2 = (ip + 2 <= irow) ? a[2] : 0.f, v3 = (ip + 3 <= irow) ? a[3] : 0.f;
        pk.x = cvt_pk_bf16(v0, v1); pk.y = cvt_pk_bf16(v2, v3);
      }
      *(u32x2*)(Ps + irow * 72 + 16 * mt + 4 * lq) = pk;
    }
    __syncthreads();
    f32x4 oacc[2];
    oacc[0] = (f32x4){0.f, 0.f, 0.f, 0.f}; oacc[1] = (f32x4){0.f, 0.f, 0.f, 0.f};
#pragma unroll
    for (int ks = 0; ks < 2; ++ks) {
      if (2 * ks <= w) {
        const bf16x8 pb = *(const bf16x8*)(Ps + irow * 72 + 32 * ks + 8 * lq);
#pragma unroll
        for (int mt = 0; mt < 2; ++mt) {
          const bf16x8 vf = *(const bf16x8*)(VTs + (16 * mt + lr) * 72 + (((4 * ks + lq) ^ (((16 * mt + lr) >> 3) & 3)) << 3));
          oacc[mt] = MFMA16(vf, pb, oacc[mt]);
        }
      }
    }
#pragma unroll
    for (int ks = 0; ks < 4; ++ks)
#pragma unroll
      for (int mt = 0; mt < 2; ++mt) {
        const bf16x8 sf = *(const bf16x8*)(STs + (16 * mt + lr) * 136 + 32 * ks + 8 * lq);
        oacc[mt] = MFMA16(sf, xq[ks], oacc[mt]);
      }
    {
      const int t = 64 * c - 48 + irow;
      float sq = 0.f;
#pragma unroll
      for (int mt = 0; mt < 2; ++mt) sq += oacc[mt][0] * oacc[mt][0] + oacc[mt][1] * oacc[mt][1] + oacc[mt][2] * oacc[mt][2] + oacc[mt][3] * oacc[mt][3];
      sq += __shfl_xor(sq, 16); sq += __shfl_xor(sq, 32);
      if (t >= 0 && !dry) {
        const size_t row = (size_t)(b * T_ + t);
#pragma unroll
        for (int mt = 0; mt < 2; ++mt) {
          u32x2 pk; pk.x = cvt_pk_bf16(oacc[mt][0], oacc[mt][1]); pk.y = cvt_pk_bf16(oacc[mt][2], oacc[mt][3]);
          *(u32x2*)(ws.V + row * 1024 + hd * 256 + sl * 32 + 16 * mt + 4 * lq) = pk;
        }
        if (lq == 0) ws.SSQ[row * 32 + hd * 8 + sl] = sq;
      }
    }
    __syncthreads();
#pragma unroll
    for (int ntl = 0; ntl < 2; ++ntl) {
#pragma unroll
      for (int ks = 0; ks < 2; ++ks) {
        const bf16x8 kf = *(const bf16x8*)(KIT + (16 * (2 * w + ntl) + lr) * 72 + (((4 * ks + lq) ^ (((16 * (2 * w + ntl) + lr) >> 3) & 7)) << 3));
#pragma unroll
        for (int mt = 0; mt < 2; ++mt) {
          const bf16x8 vf = *(const bf16x8*)(VTs + (16 * mt + lr) * 72 + (((4 * ks + lq) ^ (((16 * mt + lr) >> 3) & 3)) << 3));
          sacc[mt][ntl] = MFMA16(vf, kf, sacc[mt][ntl]);
        }
      }
      const float e = ntl ? eb1 : eb0;
#pragma unroll
      for (int mt = 0; mt < 2; ++mt) {
        sacc[mt][ntl] = scale4(sacc[mt][ntl], e);
#pragma unroll
        for (int jj = 0; jj < 4; ++jj) STs[(16 * mt + 4 * lq + jj) * 136 + 16 * (2 * w + ntl) + lr] = f2bf(sacc[mt][ntl][jj]);
      }
    }
    __syncthreads();
  };
#pragma unroll 1
  for (int c = 0; c < 33; c += 2) {
    body(c, qrA, krA, vrA, eblA);
    if (c + 1 < 33) body(c + 1, qrB, krB, vrB, eblB);
  }
}

__device__ __forceinline__ void rglru_unit(const Params& p, const WS& ws, int j, int u, bool dry = false) {
  const int jq = u & 3, g = (u >> 2) & 7, b = u >> 5;
  bf16_t* XC = (bf16_t*)smem;
  bf16_t* WG = XC + 64 * 136;
  float* AUa = (float*)(smem + 34816);
  float* AUu = AUa + 64 * 33;
  float* SEGA = AUu + 64 * 33;
  float* SEGH = SEGA + 256;
  float* CARRY = SEGH + 256;
  const int tid = opaque_tid(), lane = tid & 63, w = tid >> 6, lr = lane & 15, lq = lane >> 4;
#pragma unroll 4
  for (int i = 0; i < 32; ++i) {
    const int e = tid + 256 * i;
    const int gate = e >> 12, k = (e >> 5) & 127, n = e & 31;
    const float* gw = gate ? p.ab_gate_x_w : p.ab_gate_a_w;
    WG[(gate * 32 + n) * 136 + k] = f2bf(gw[((size_t)(j * 8 + g) * 128 + k) * 128 + 32 * jq + n]);
  }
  if (tid < 32) CARRY[tid] = 0.f;
  const int cc = tid & 15, rb = 4 * (tid >> 4);
  float cw[4][8], cb[8];
#pragma unroll
  for (int e = 0; e < 8; ++e) {
    cb[e] = p.ab_conv_b[j * 1024 + 128 * g + 8 * cc + e];
#pragma unroll
    for (int k = 0; k < 4; ++k) cw[k][e] = p.ab_conv_w[(size_t)(j * 4 + k) * 1024 + 128 * g + 8 * cc + e];
  }
  float ba[2][4], bx[2][4], sp[2][4];
#pragma unroll
  for (int mt = 0; mt < 2; ++mt)
#pragma unroll
    for (int jj = 0; jj < 4; ++jj) {
      const int ch = j * 1024 + 128 * g + 32 * jq + 16 * mt + 4 * lq + jj;
      ba[mt][jj] = p.ab_gate_a_b[ch]; bx[mt][jj] = p.ab_gate_x_b[ch];
      sp[mt][jj] = 8.f * log1pf(__expf(-p.ab_lam[ch]));
    }
  const int sc = tid & 31, ssg = tid >> 5;
  u32x4 xinA[7], xinB[7];
  bf16_t gavA[8], gavB[8];
  auto prefetch = [&](int tile, u32x4 (&xin)[7], bf16_t (&gav)[8]) {
    const int t0 = 64 * tile;
#pragma unroll
    for (int m = 0; m < 7; ++m) {
      const int tt = t0 + rb - 3 + m;
      xin[m] = (u32x4){0, 0, 0, 0};
      if (tt >= 0 && tt < T_) xin[m] = *(const u32x4*)(ws.XA + (size_t)(b * T_ + tt) * 1024 + 128 * g + 8 * cc);
    }
#pragma unroll
    for (int i = 0; i < 8; ++i) {
      const int t = t0 + 8 * ssg + i;
      gav[i] = 0;
      if (t < T_) gav[i] = ws.GA[(size_t)(b * T_ + t) * 1024 + 128 * g + 32 * jq + sc];
    }
  };
  prefetch(0, xinA, gavA);
  prefetch(1, xinB, gavB);
  __syncthreads();
  auto body = [&](int tile, u32x4 (&xin)[7], bf16_t (&gav)[8]) {
    const int t0 = 64 * tile;
#pragma unroll
    for (int r = 0; r < 4; ++r) {
      float y[8];
#pragma unroll
      for (int e = 0; e < 8; ++e) y[e] = cb[e];
#pragma unroll
      for (int k = 0; k < 4; ++k) {
        const u32x4 xv = xin[r + k];
        y[0] += cw[k][0] * bflo(xv.x); y[1] += cw[k][1] * bfhi(xv.x);
        y[2] += cw[k][2] * bflo(xv.y); y[3] += cw[k][3] * bfhi(xv.y);
        y[4] += cw[k][4] * bflo(xv.z); y[5] += cw[k][5] * bfhi(xv.z);
        y[6] += cw[k][6] * bflo(xv.w); y[7] += cw[k][7] * bfhi(xv.w);
      }
      u32x4 pk; pk.x = cvt_pk_bf16(y[0], y[1]); pk.y = cvt_pk_bf16(y[2], y[3]); pk.z = cvt_pk_bf16(y[4], y[5]); pk.w = cvt_pk_bf16(y[6], y[7]);
      *(u32x4*)(XC + (rb + r) * 136 + 8 * cc) = pk;
    }
    float gcur[8];
#pragma unroll
    for (int i = 0; i < 8; ++i) gcur[i] = bf2f(gav[i]);
    __syncthreads();
    if (tile + 2 < 33) prefetch(tile + 2, xin, gav);
    {
      f32x4 ga_[2][2];
#pragma unroll
      for (int a = 0; a < 2; ++a)
#pragma unroll
        for (int bb = 0; bb < 2; ++bb) ga_[a][bb] = (f32x4){0.f, 0.f, 0.f, 0.f};
#pragma unroll
      for (int ks = 0; ks < 4; ++ks) {
        const bf16x8 xf = *(const bf16x8*)(XC + (16 * w + lr) * 136 + 32 * ks + 8 * lq);
#pragma unroll
        for (int gate = 0; gate < 2; ++gate)
#pragma unroll
          for (int mt = 0; mt < 2; ++mt) {
            const bf16x8 wf = *(const bf16x8*)(WG + (gate * 32 + 16 * mt + lr) * 136 + 32 * ks + 8 * lq);
            ga_[gate][mt] = MFMA16(wf, xf, ga_[gate][mt]);
          }
      }
      const int tok = 16 * w + lr;
#pragma unroll
      for (int mt = 0; mt < 2; ++mt)
#pragma unroll
        for (int jj = 0; jj < 4; ++jj) {
          const int n = 16 * mt + 4 * lq + jj;
          const float xcv = bf2f(XC[tok * 136 + 32 * jq + n]);
          const float r = sigmoidf_(ga_[0][mt][jj] + ba[mt][jj]);
          const float ig = sigmoidf_(ga_[1][mt][jj] + bx[mt][jj]);
          const float la = -r * sp[mt][jj];
          const float a = __expf(la);
          const float x2 = 2.f * la;
          const float om = x2 > -0.02f ? -x2 * (1.f + 0.5f * x2 * (1.f + x2 * (1.f / 3.f))) : 1.f - a * a;
          const float mult = __builtin_amdgcn_sqrtf(fmaxf(om, 0.f));
          AUa[tok * 33 + n] = a;
          AUu[tok * 33 + n] = mult * ig * xcv;
        }
    }
    __syncthreads();
    {
      float A = 1.f, Hh = 0.f;
#pragma unroll
      for (int i = 0; i < 8; ++i) {
        const float a = AUa[(8 * ssg + i) * 33 + sc], uu = AUu[(8 * ssg + i) * 33 + sc];
        Hh = a * Hh + uu; A *= a;
      }
      SEGA[ssg * 32 + sc] = A; SEGH[ssg * 32 + sc] = Hh;
    }
    __syncthreads();
    float hin = CARRY[sc];
#pragma unroll
    for (int s2 = 0; s2 < 7; ++s2)
      if (s2 < ssg) hin = SEGA[s2 * 32 + sc] * hin + SEGH[s2 * 32 + sc];
    __syncthreads();
    {
      float h = hin;
#pragma unroll
      for (int i = 0; i < 8; ++i) {
        const float a = AUa[(8 * ssg + i) * 33 + sc], uu = AUu[(8 * ssg + i) * 33 + sc];
        h = a * h + uu;
        const int t = t0 + 8 * ssg + i;
        if (t < T_ && !dry) ws.GA[(size_t)(b * T_ + t) * 1024 + 128 * g + 32 * jq + sc] = f2bf(h * siluf_(gcur[i]));
      }
      if (ssg == 7) CARRY[sc] = h;
    }
  };
#pragma unroll 1
  for (int tile = 0; tile < 33; tile += 2) {
    body(tile, xinA, gavA);
    if (tile + 1 < 33) body(tile + 1, xinB, gavB);
  }
  __syncthreads();
}

__device__ __forceinline__ void phase_gla_norm(const Params& p, const WS& ws, int j) {
  const size_t gtid = (size_t)opaque_bid() * 256 + opaque_tid(), gsz = (size_t)gridDim.x * 256;
  const float* gn = p.ab_gla_norm + j * 256;
#pragma unroll 4
  for (size_t idx = gtid; idx < (size_t)M_ * 128; idx += gsz) {
    const size_t row = idx >> 7; const int c8 = (int)(idx & 127); const int hd = c8 >> 5; const int dv = (c8 & 31) * 8;
    const float4 s0 = *(const float4*)(ws.SSQ + row * 32 + hd * 8), s1 = *(const float4*)(ws.SSQ + row * 32 + hd * 8 + 4);
    const float ssum = (s0.x + s0.y + s0.z + s0.w) + (s1.x + s1.y + s1.z + s1.w);
    const float rstd = rsqrtf(ssum * (1.f / 256.f) + EPS_);
    const u32x4 ov = *(const u32x4*)(ws.V + row * 1024 + c8 * 8);
    const u32x4 gv = *(const u32x4*)(ws.GB + row * 1024 + c8 * 8);
    const float4 g0 = *(const float4*)(gn + dv), g1 = *(const float4*)(gn + dv + 4);
    float o[8] = {bflo(ov.x), bfhi(ov.x), bflo(ov.y), bfhi(ov.y), bflo(ov.z), bfhi(ov.z), bflo(ov.w), bfhi(ov.w)};
    const float gg[8] = {bflo(gv.x), bfhi(gv.x), bflo(gv.y), bfhi(gv.y), bflo(gv.z), bfhi(gv.z), bflo(gv.w), bfhi(gv.w)};
    const float nn[8] = {g0.x, g0.y, g0.z, g0.w, g1.x, g1.y, g1.z, g1.w};
#pragma unroll
    for (int e = 0; e < 8; ++e) o[e] = o[e] * rstd * nn[e] * siluf_(gg[e]);
    u32x4 pk; pk.x = cvt_pk_bf16(o[0], o[1]); pk.y = cvt_pk_bf16(o[2], o[3]); pk.z = cvt_pk_bf16(o[4], o[5]); pk.w = cvt_pk_bf16(o[6], o[7]);
    *(u32x4*)(ws.V + row * 1024 + c8 * 8) = pk;
  }
}

__device__ __forceinline__ void attn_unit(const WS& ws, int u, bool dry = false) {
  const int qb = 16 - (u >> 7); const int bh = u & 127; const int hd = bh & 15, b = bh >> 4;
  bf16_t* Kt = (bf16_t*)smem;
  bf16_t* Vl = Kt + 2 * 64 * 104;
  const int tid = opaque_tid(), lane = tid & 63, w = tid >> 6, lr = lane & 15, lq = lane >> 4;
  const int q0 = 128 * qb;
  int nkt = 2 * qb + 2; if (nkt > 33) nkt = 33;
  bf16x8 xq[2][3];
  int qi[2];
#pragma unroll
  for (int nt = 0; nt < 2; ++nt) {
    qi[nt] = q0 + 32 * w + 16 * nt + lr;
    const int qc = qi[nt] < T_ ? qi[nt] : T_ - 1;
#pragma unroll
    for (int ks = 0; ks < 2; ++ks)
      xq[nt][ks] = *(const bf16x8*)(ws.QB + (size_t)(b * T_ + qc) * 1536 + hd * 96 + 32 * ks + 8 * lq);
    {
      const u32x4 raw = *(const u32x4*)(ws.QB + (size_t)(b * T_ + qc) * 1536 + hd * 96 + 64 + 8 * lq);
      u32x4 oth;
      oth.x = __shfl_xor(raw.x, 32); oth.y = __shfl_xor(raw.y, 32); oth.z = __shfl_xor(raw.z, 32); oth.w = __shfl_xor(raw.w, 32);
      const float sgn = lq < 2 ? -1.f : 1.f;
      const float2* rp = ws.ROPE + (size_t)(b * T_ + qc) * 16 + 8 * (lq & 1);
      const unsigned rw[4] = {raw.x, raw.y, raw.z, raw.w}, ow[4] = {oth.x, oth.y, oth.z, oth.w};
      unsigned res[4];
#pragma unroll
      for (int e = 0; e < 4; ++e) {
        const float2 c0 = rp[2 * e], c1 = rp[2 * e + 1];
        const float r0 = bflo(rw[e]) * c0.x + sgn * bflo(ow[e]) * c0.y;
        const float r1 = bfhi(rw[e]) * c1.x + sgn * bfhi(ow[e]) * c1.y;
        res[e] = cvt_pk_bf16(r0, r1);
      }
      xq[nt][2] = as_bf16x8((u32x4){res[0], res[1], res[2], res[3]});
    }
  }
  float mrun[2] = {-INFINITY, -INFINITY}, lsum[2] = {0.f, 0.f};
  f32x4 oacc[4][2];
#pragma unroll
  for (int a = 0; a < 4; ++a)
#pragma unroll
    for (int bb = 0; bb < 2; ++bb) oacc[a][bb] = (f32x4){0.f, 0.f, 0.f, 0.f};
  u32x4 kregA[3], vregA[2], kregB[3], vregB[2];
  const bf16_t* vbase = ws.VT + ((size_t)(b * 16 + hd) * 64) * TP_;
  auto loadg = [&](int kt, u32x4 (&kreg)[3], u32x4 (&vreg)[2]) {
#pragma unroll
    for (int i = 0; i < 3; ++i) {
      const int ci = tid + 256 * i; const int key = ci / 12, ch = ci - key * 12;
      int gk = 64 * kt + key; if (gk > T_ - 1) gk = T_ - 1;
      const bf16_t* src = ch < 8 ? ws.KN + (size_t)(b * T_ + gk) * 1024 + hd * 64 + ch * 8
                                 : ws.KR + (size_t)(b * T_ + gk) * 32 + (ch - 8) * 8;
      kreg[i] = *(const u32x4*)src;
    }
#pragma unroll
    for (int i = 0; i < 2; ++i) {
      const int ci = tid + 256 * i; const int dv = ci >> 3, ch = ci & 7;
      vreg[i] = *(const u32x4*)(vbase + (size_t)dv * TP_ + 64 * kt + ch * 8);
      if (64 * kt + ch * 8 >= T_) vreg[i] = (u32x4){0u, 0u, 0u, 0u};
    }
  };
  auto stores = [&](int buf, const u32x4 (&kreg)[3], const u32x4 (&vreg)[2]) {
#pragma unroll
    for (int i = 0; i < 3; ++i) {
      const int ci = tid + 256 * i; const int key = ci / 12, ch = ci - key * 12;
      *(u32x4*)(Kt + buf * 64 * 104 + key * 104 + ch * 8) = kreg[i];
    }
#pragma unroll
    for (int i = 0; i < 2; ++i) {
      const int ci = tid + 256 * i; const int dv = ci >> 3, ch = ci & 7;
      *(u32x4*)(Vl + buf * 64 * 72 + dv * 72 + ch * 8) = vreg[i];
    }
  };
  const int nkt2 = (nkt + 1) & ~1;
  loadg(0, kregA, vregA);
  loadg(1, kregB, vregB);
  stores(0, kregA, vregA);
  __syncthreads();
  auto body = [&](int kt, int buf, u32x4 (&kreg)[3], u32x4 (&vreg)[2], const u32x4 (&kregn)[3], const u32x4 (&vregn)[2]) {
    { const int kn = kt + 2 < nkt2 ? kt + 2 : nkt2 - 1; loadg(kn, kreg, vreg); }
    const bf16_t* Kb = Kt + buf * 64 * 104;
    const bf16_t* Vb = Vl + buf * 64 * 72;
    f32x4 s[4][2];
#pragma unroll
    for (int mt = 0; mt < 4; ++mt) {
      s[mt][0] = (f32x4){0.f, 0.f, 0.f, 0.f}; s[mt][1] = (f32x4){0.f, 0.f, 0.f, 0.f};
#pragma unroll
      for (int ks = 0; ks < 3; ++ks) {
        const bf16x8 kf = *(const bf16x8*)(Kb + (16 * mt + lr) * 104 + 32 * ks + 8 * lq);
        s[mt][0] = MFMA16(kf, xq[0][ks], s[mt][0]);
        s[mt][1] = MFMA16(kf, xq[1][ks], s[mt][1]);
      }
    }
    if (kt >= 2 * qb) {
#pragma unroll
      for (int mt = 0; mt < 4; ++mt)
#pragma unroll
        for (int nt = 0; nt < 2; ++nt)
#pragma unroll
          for (int jj = 0; jj < 4; ++jj) {
            const int key = 64 * kt + 16 * mt + 4 * lq + jj;
            if (key > qi[nt]) s[mt][nt][jj] = -INFINITY;
          }
    }
    bf16x8 pf[2][2];
#pragma unroll
    for (int nt = 0; nt < 2; ++nt) {
      float mx = -INFINITY;
#pragma unroll
      for (int mt = 0; mt < 4; ++mt) mx = fmaxf(mx, fmaxf(fmaxf(s[mt][nt][0], s[mt][nt][1]), fmaxf(s[mt][nt][2], s[mt][nt][3])));
      mx = fmaxf(mx, __shfl_xor(mx, 16)); mx = fmaxf(mx, __shfl_xor(mx, 32));
      if (__builtin_amdgcn_ballot_w64(mx > mrun[nt]) != 0ull) {
        const float mnew = fmaxf(mrun[nt], mx);
        const float alpha = __builtin_amdgcn_exp2f(mrun[nt] - mnew);
        mrun[nt] = mnew;
        lsum[nt] *= alpha;
#pragma unroll
        for (int mt = 0; mt < 4; ++mt) oacc[mt][nt] = scale4(oacc[mt][nt], alpha);
      }
      const float mnew = mrun[nt];
      float ps = 0.f;
#pragma unroll
      for (int mt = 0; mt < 4; ++mt)
#pragma unroll
        for (int jj = 0; jj < 4; ++jj) { const float pv = __builtin_amdgcn_exp2f(s[mt][nt][jj] - mnew); s[mt][nt][jj] = pv; ps += pv; }
      lsum[nt] += ps;
#pragma unroll
      for (int ks = 0; ks < 2; ++ks) {
        u32x4 pk;
        pk.x = cvt_pk_bf16(s[2 * ks][nt][0], s[2 * ks][nt][1]); pk.y = cvt_pk_bf16(s[2 * ks][nt][2], s[2 * ks][nt][3]);
        pk.z = cvt_pk_bf16(s[2 * ks + 1][nt][0], s[2 * ks + 1][nt][1]); pk.w = cvt_pk_bf16(s[2 * ks + 1][nt][2], s[2 * ks + 1][nt][3]);
        pf[nt][ks] = as_bf16x8(pk);
      }
    }
#pragma unroll
    for (int mt = 0; mt < 4; ++mt)
#pragma unroll
      for (int ks = 0; ks < 2; ++ks) {
        const u32x2 lo = *(const u32x2*)(Vb + (16 * mt + lr) * 72 + 32 * ks + 4 * lq);
        const u32x2 hi = *(const u32x2*)(Vb + (16 * mt + lr) * 72 + 32 * ks + 16 + 4 * lq);
        const bf16x8 vf = as_bf16x8((u32x4){lo.x, lo.y, hi.x, hi.y});
        oacc[mt][0] = MFMA16(vf, pf[0][ks], oacc[mt][0]);
        oacc[mt][1] = MFMA16(vf, pf[1][ks], oacc[mt][1]);
      }
    stores(buf ^ 1, kregn, vregn);
    __syncthreads();
  };
#pragma unroll 1
  for (int kt = 0; kt < nkt2; kt += 2) {
    body(kt, 0, kregA, vregA, kregB, vregB);
    body(kt + 1, 1, kregB, vregB, kregA, vregA);
  }
#pragma unroll
  for (int nt = 0; nt < 2; ++nt) {
    float l = lsum[nt];
    l += __shfl_xor(l, 16); l += __shfl_xor(l, 32);
    const float inv = 1.f / l;
    if (qi[nt] < T_) {
      const size_t row = (size_t)(b * T_ + qi[nt]);
#pragma unroll
      for (int mt = 0; mt < 4; ++mt) {
        const u32x2 gv = *(const u32x2*)(ws.GATE + row * 1024 + hd * 64 + 16 * mt + 4 * lq);
        const float o0 = oacc[mt][nt][0] * inv * siluf_(bflo(gv.x)), o1 = oacc[mt][nt][1] * inv * siluf_(bfhi(gv.x));
        const float o2 = oacc[mt][nt][2] * inv * siluf_(bflo(gv.y)), o3 = oacc[mt][nt][3] * inv * siluf_(bfhi(gv.y));
        u32x2 pk; pk.x = cvt_pk_bf16(o0, o1); pk.y = cvt_pk_bf16(o2, o3);
        if (!dry) *(u32x2*)(ws.QB + row * 1536 + hd * 96 + 16 * mt + 4 * lq) = pk;
      }
    }
  }
}

__device__ __forceinline__ void phase_final(const Params& p, const WS& ws) {
  const int tidf = opaque_tid();
  const int lane = tidf & 63;
  const int gw = opaque_bid() * 4 + (tidf >> 6), nw = gridDim.x * 4;
#pragma unroll 2
  for (int r = gw; r < 8 * 2048; r += nw) {
    const int b = r >> 11, s = r & 2047;
    const size_t hoff = (size_t)(b * T_ + 16 + s) * 1024;
    float4 v[4];
    float ssum = 0.f;
#pragma unroll
    for (int i = 0; i < 4; ++i) {
      const u32x2 hi = *(const u32x2*)(ws.HHI + hoff + i * 256 + lane * 4), lo = *(const u32x2*)(ws.HLO + hoff + i * 256 + lane * 4);
      v[i] = make_float4(bflo(hi.x) + bflo(lo.x), bfhi(hi.x) + bfhi(lo.x), bflo(hi.y) + bflo(lo.y), bfhi(hi.y) + bfhi(lo.y));
      ssum += v[i].x * v[i].x + v[i].y * v[i].y + v[i].z * v[i].z + v[i].w * v[i].w;
    }
#pragma unroll
    for (int o = 1; o < 64; o <<= 1) ssum += __shfl_xor(ssum, o);
    const float rstd = rsqrtf(ssum * (1.f / 1024.f) + EPS_);
#pragma unroll
    for (int i = 0; i < 4; ++i) {
      const float4 g = *(const float4*)(p.final_norm + i * 256 + lane * 4);
      float4 o; o.x = v[i].x * rstd * g.x; o.y = v[i].y * rstd * g.y; o.z = v[i].z * rstd * g.z; o.w = v[i].w * rstd * g.w;
      *(float4*)(p.out + (size_t)r * 1024 + i * 256 + lane * 4) = o;
    }
  }
}

__global__ void __launch_bounds__(256, 2) fwd_megakernel(Params p) {
  cg::grid_group grid = cg::this_grid();
  if (p.inv_freq[0] < 0.f) grid.sync();
  volatile LAS unsigned* xst = (volatile LAS unsigned*)(smem + SMEM_BYTES);
  if (threadIdx.x == 0) { xst[0] = 0u; xst[1] = 0u; xst[2] = 0u; xst[3] = 0u; }
  __syncthreads();
  const XcdBarrier xb = xcd_barrier_post((unsigned*)(p.ws + BAR_OFF), xst);
  {
    const WS ws = make_ws(p);
    phase_prologue(p, ws);
  }
  xcd_barrier(xb);
#pragma unroll 1
  for (int layer = 0; layer < 4; ++layer) {
    const int j = layer >> 1;
    if ((layer & 1) == 0) {
      {
        const WS ws = make_ws(p);
        const bf16_t* wb = ws.W + (size_t)j * W_PER_J;
#pragma unroll 1
        for (int rep = 0; rep < REP_GEMM; ++rep)
          gemm_stream<true, EPI_E1, 4>(ws, ws.HHI, nullptr, 1024, 1 << 30, 64, wb + W_IN_E, 1024, 1.f / 1024.f, 41, 129 * 41, xcd_bid(opaque_bid()), false);
      }
      xcd_barrier(xb);
      {
        const WS ws = make_ws(p);
#pragma unroll 1
        for (int u = opaque_bid(); u < 8 * 4 * 33; u += gridDim.x) gla_decay_unit(p, ws, j, u);
      }
      xcd_barrier(xb);
      {
#pragma unroll 1
        for (int rep = 0; rep < REP_E2; ++rep)
#pragma unroll 1
        for (int u = opaque_bid(); u < 512; u += gridDim.x) {
          if (u >= 256) { const WS ws = make_ws(p); rglru_unit(p, ws, j, u - 256, rep < REP_E2 - 1); }
          else { const WS ws = make_ws(p); gla_unit(p, ws, u, rep < REP_E2 - 1); }
        }
      }
      xcd_barrier(xb);
      {
        const WS ws = make_ws(p);
        phase_gla_norm(p, ws, j);
      }
      xcd_barrier(xb);
      {
        const WS ws = make_ws(p);
        const bf16_t* wb = ws.W + (size_t)j * W_PER_J;
#pragma unroll 1
        for (int rep = 0; rep < REP_GEMM; ++rep)
          gemm_stream<false, EPI_RES, 5>(ws, ws.GA, ws.V, 1024, 16, 64, wb + W_OUT_E, 2048, 0.f, 8, 128 * 8, xcd_bid(opaque_bid()), rep < REP_GEMM - 1);
      }
      xcd_barrier(xb);
    } else {
      {
        const WS ws = make_ws(p);
        const bf16_t* wb = ws.W + (size_t)j * W_PER_J;
#pragma unroll 1
        for (int rep = 0; rep < REP_GEMM; ++rep)
          gemm_stream<true, EPI_O1, 4>(ws, ws.HHI, nullptr, 1024, 1 << 30, 64, wb + W_IN_O, 1024, 1.f / 1024.f, 15, 129 * 15, xcd_bid(opaque_bid()), false);
      }
      xcd_barrier(xb);
      {
        const WS ws = make_ws(p);
        const bf16_t* wb = ws.W + (size_t)j * W_PER_J;
#pragma unroll 1
        for (int rep = 0; rep < REP_GEMM; ++rep) {
          gemm_stream<true, EPI_Q, 4>(ws, ws.CQ, nullptr, 512, 1 << 30, 64, wb + W_Q, 512, 1.f / 512.f, 12, 129 * 12, xcd_bid(opaque_bid()), false);
          gemm_stream<true, EPI_KV, 4>(ws, ws.CKV, nullptr, 256, 1 << 30, 64, wb + W_KV, 256, 1.f / 256.f, 16, 129 * 16, xcd_bid((opaque_bid() + (int)(gridDim.x >> 1)) % (int)gridDim.x), false);
        }
      }
      xcd_barrier(xb);
      {
        const WS ws = make_ws(p);
#pragma unroll 1
        for (int rep = 0; rep < REP_ATTN; ++rep)
#pragma unroll 1
        for (int r = 0, b0 = opaque_bid(); r * (int)gridDim.x < 17 * 128; ++r) {
          const int u = r * (int)gridDim.x + ((r & 1) ? (int)gridDim.x - 1 - b0 : b0);
          if (u < 17 * 128) attn_unit(ws, u, rep < REP_ATTN - 1);
          __syncthreads();
        }
      }
      xcd_barrier(xb);
      {
        const WS ws = make_ws(p);
        const bf16_t* wb = ws.W + (size_t)j * W_PER_J;
#pragma unroll 1
        for (int rep = 0; rep < REP_GEMM; ++rep)
          gemm_stream<false, EPI_RES, 5>(ws, ws.QB, nullptr, 1536, 1 << 30, 96, wb + W_O, 1024, 0.f, 8, 128 * 8, xcd_bid(opaque_bid()), rep < REP_GEMM - 1);
      }
      xcd_barrier(xb);
    }
  }
  {
    const WS ws = make_ws(p);
    phase_final(p, ws);
  }
}

extern "C" void kernel_launch(void* const* d_in, const int* in_sizes, int n_in, void* d_out, int out_size, void* d_ws,
                              size_t ws_size, hipStream_t stream) {
  static int grid_blocks = 0;
  if (!grid_blocks) {
    int dev = 0, cus = 0, per_cu = 0;
    hipGetDevice(&dev);
    hipDeviceGetAttribute(&cus, hipDeviceAttributeMultiprocessorCount, dev);
    hipOccupancyMaxActiveBlocksPerMultiprocessor(&per_cu, fwd_megakernel, 256, 0);
    if (per_cu < 1) per_cu = 1;
    if (per_cu > 2) per_cu = 2;
    grid_blocks = cus * per_cu;
  }
  Params p{};
  p.x = (const float*)d_in[0]; p.positions = (const int*)d_in[1]; p.meta = (const float*)d_in[2];
  p.ab_norm = (const float*)d_in[3]; p.ab_w_in = (const float*)d_in[4]; p.ab_conv_w = (const float*)d_in[5];
  p.ab_conv_b = (const float*)d_in[6]; p.ab_gate_a_w = (const float*)d_in[7]; p.ab_gate_a_b = (const float*)d_in[8];
  p.ab_gate_x_w = (const float*)d_in[9]; p.ab_gate_x_b = (const float*)d_in[10]; p.ab_lam = (const float*)d_in[11];
  p.ab_alpha_w = (const float*)d_in[12]; p.ab_alpha_b = (const float*)d_in[13]; p.ab_gla_norm = (const float*)d_in[14];
  p.ab_w_out = (const float*)d_in[15]; p.c_norm = (const float*)d_in[16]; p.c_w_in = (const float*)d_in[17];
  p.c_q_norm = (const float*)d_in[18]; p.c_w_q_up = (const float*)d_in[19]; p.c_kv_norm = (const float*)d_in[20];
  p.c_w_kv_up = (const float*)d_in[21]; p.c_w_out = (const float*)d_in[22]; p.final_norm = (const float*)d_in[23];
  p.out = (float*)d_out;
  p.ws = (unsigned char*)d_ws;
  for (int i = 0; i < 16; ++i) p.inv_freq[i] = (float)pow(10000.0, -(double)i / 16.0);
  hipMemsetAsync((unsigned char*)d_ws + BAR_OFF, 0, XCD_BAR_WORDS * 4, stream);
  void* args[] = {&p};
  hipError_t e = hipLaunchCooperativeKernel((void*)fwd_megakernel, dim3(grid_blocks), dim3(256), args, 0, stream);
  if (e != hipSuccess) fprintf(stderr, "cooperative launch failed: %s (grid %d)\n", hipGetErrorString(e), grid_blocks);
}
```

```cpp
#include <hip/hip_runtime.h>
#include <hip/hip_cooperative_groups.h>
#include <cstdio>
#include <cmath>
namespace cg = cooperative_groups;

typedef unsigned short bf16_t;
typedef short bf16x8 __attribute__((ext_vector_type(8)));
typedef float f32x4 __attribute__((ext_vector_type(4)));
typedef unsigned u32x4 __attribute__((ext_vector_type(4)));
typedef unsigned u32x2 __attribute__((ext_vector_type(2)));

constexpr int T_ = 2064;
constexpr int M_ = 8 * T_;
constexpr int TP_ = 2112;
constexpr float EPS_ = 1e-6f;
constexpr int SMEM_BYTES = 75776;
constexpr float QSCALE_MLA = 0.10206207261596575f * 1.4426950408889634f;

constexpr size_t W_PER_J = 11796480;
constexpr size_t W_IN_E = 0, W_OUT_E = 5373952, W_IN_O = 7471104, W_Q = 9437184, W_KV = 10223616, W_O = 10747904;

struct Params {
  const float* x; const int* positions; const float* meta;
  const float *ab_norm, *ab_w_in, *ab_conv_w, *ab_conv_b, *ab_gate_a_w, *ab_gate_a_b, *ab_gate_x_w, *ab_gate_x_b,
      *ab_lam, *ab_alpha_w, *ab_alpha_b, *ab_gla_norm, *ab_w_out;
  const float *c_norm, *c_w_in, *c_q_norm, *c_w_q_up, *c_kv_norm, *c_w_kv_up, *c_w_out, *final_norm;
  float* out;
  unsigned char* ws;
  float inv_freq[16];
};

struct WS {
  bf16_t *HHI, *HLO; float2* ROPE;
  bf16_t *XA, *GA, *Q, *K, *V, *GB, *AD; float* SSQ; float* BL;
  bf16_t *CQ, *CKV, *GATE, *KR, *QB, *KN, *VT;
  bf16_t* W;
};

__device__ __forceinline__ unsigned char* opaque_ptr(unsigned char* q) {
  unsigned lo = (unsigned)(unsigned long long)q, hi = (unsigned)((unsigned long long)q >> 32);
  asm volatile("" : "+v"(lo), "+v"(hi));
  lo = __builtin_amdgcn_readfirstlane(lo); hi = __builtin_amdgcn_readfirstlane(hi);
  typedef __attribute__((address_space(1))) unsigned char gu8;
  return (unsigned char*)(gu8*)(((unsigned long long)hi << 32) | lo);
}
__device__ __forceinline__ WS make_ws(const Params& p) {
  WS w;
  unsigned char* b = opaque_ptr(p.ws);
  w.HHI = (bf16_t*)b; b += (size_t)M_ * 2048;
  w.HLO = (bf16_t*)b; b += (size_t)M_ * 2048;
  w.ROPE = (float2*)b; b += (size_t)M_ * 128;
  unsigned char* r = b;
  w.XA = (bf16_t*)r; r += (size_t)M_ * 2048;
  w.GA = (bf16_t*)r; r += (size_t)M_ * 2048;
  w.Q = (bf16_t*)r; r += (size_t)M_ * 1024;
  w.K = (bf16_t*)r; r += (size_t)M_ * 1024;
  w.V = (bf16_t*)r; r += (size_t)M_ * 2048;
  w.GB = (bf16_t*)r; r += (size_t)M_ * 2048;
  w.AD = (bf16_t*)r; r += (size_t)M_ * 32;
  w.SSQ = (float*)r; r += (size_t)M_ * 128;
  w.BL = (float*)r; r += (size_t)8 * 4 * 33 * 128 * 4;
  r = b;
  w.CQ = (bf16_t*)r; r += (size_t)M_ * 1024;
  w.CKV = (bf16_t*)r; r += (size_t)M_ * 512;
  w.GATE = (bf16_t*)r; r += (size_t)M_ * 2048;
  w.KR = (bf16_t*)r; r += (size_t)M_ * 64;
  w.QB = (bf16_t*)r; r += (size_t)M_ * 3072;
  w.KN = (bf16_t*)r; r += (size_t)M_ * 2048;
  w.VT = (bf16_t*)r; r += (size_t)128 * 64 * TP_ * 2;
  w.W = (bf16_t*)opaque_ptr((unsigned char*)p.out);
  return w;
}

__device__ __forceinline__ unsigned cvt_pk_bf16(float lo, float hi) {
  typedef float f32x2_t __attribute__((ext_vector_type(2)));
  typedef __bf16 bf16x2_t __attribute__((ext_vector_type(2)));
  const f32x2_t v = {lo, hi};
  const bf16x2_t r = __builtin_convertvector(v, bf16x2_t);
  return __builtin_bit_cast(unsigned, r);
}
__device__ __forceinline__ f32x4 scale4(f32x4 a, float r) {
  asm volatile("" : "+v"(r));
  float x0 = a[0] * r, x1 = a[1] * r, x2 = a[2] * r, x3 = a[3] * r;
  asm volatile("" : "+v"(x0), "+v"(x1), "+v"(x2), "+v"(x3));
  return (f32x4){x0, x1, x2, x3};
}
__device__ __forceinline__ float bf2f(bf16_t v) { return __uint_as_float(((unsigned)v) << 16); }
__device__ __forceinline__ float bflo(unsigned v) { return __uint_as_float(v << 16); }
__device__ __forceinline__ float bfhi(unsigned v) { return __uint_as_float(v & 0xffff0000u); }
__device__ __forceinline__ bf16_t f2bf(float f) { return (bf16_t)(cvt_pk_bf16(f, 0.f) & 0xffffu); }
__device__ __forceinline__ float sigmoidf_(float x) { return __builtin_amdgcn_rcpf(1.f + __expf(-x)); }
__device__ __forceinline__ float siluf_(float x) { return x * __builtin_amdgcn_rcpf(1.f + __expf(-x)); }
__device__ __forceinline__ bf16x8 as_bf16x8(u32x4 v) { return __builtin_bit_cast(bf16x8, v); }
__device__ __forceinline__ int opaque_tid() { int t = threadIdx.x; asm volatile("" : "+v"(t)); return t; }
__device__ __forceinline__ int xcd_bid(int bid) { const int gpx = gridDim.x >> 3; return (bid & 7) * gpx + (bid >> 3); }
__device__ __forceinline__ int opaque_bid() { int t = blockIdx.x; asm volatile("" : "+s"(t)); return t; }
#define MFMA16(a, b, c) __builtin_amdgcn_mfma_f32_16x16x32_bf16((a), (b), (c), 0, 0, 0)

__shared__ __attribute__((aligned(16))) unsigned char smem[SMEM_BYTES + 16];

#define XB_TMO      128
#define XB_XCNT(j)  (256  + 64 * (j))
#define XB_XSUB(j)  (1280 + 64 * (j))
#define XB_XGEN(j)  (2304 + 64 * (j))
#define XB_TOP      3328
#define XB_TOPGEN   3392
#define XCD_BAR_WORDS 3456
#define XB_SPIN_CAP (1u << 18)
#define LAS __attribute__((address_space(3)))
constexpr size_t BAR_OFF = 260046848;

__device__ __forceinline__ unsigned xb_ld(unsigned* p)              { return __hip_atomic_load(p, __ATOMIC_RELAXED, __HIP_MEMORY_SCOPE_AGENT); }
__device__ __forceinline__ unsigned xb_add(unsigned* p, unsigned v) { return __hip_atomic_fetch_add(p, v, __ATOMIC_RELAXED, __HIP_MEMORY_SCOPE_AGENT); }
__device__ __forceinline__ unsigned xb_xcc_id() { return (unsigned)__builtin_amdgcn_s_getreg((3 << 11) | 20) & 0xFu; }
#define XB_SPIN(cond, bar) do { unsigned _sp = 0; while (cond) { __builtin_amdgcn_s_sleep(1); \
    if ((++_sp & 255u) == 0u) { if (xb_ld(&(bar)[XB_TMO])) break; if (_sp > XB_SPIN_CAP) { atomicAdd(&(bar)[XB_TMO], 1u); break; } } } } while (0)

struct XcdBarrier { unsigned* bar; unsigned x; volatile LAS unsigned* st; };

__device__ __forceinline__ XcdBarrier xcd_barrier_post(unsigned* bar, volatile LAS unsigned* st) {
    XcdBarrier b; b.bar = bar; b.x = xb_xcc_id(); b.st = st;
    if (threadIdx.x == 0) (void)xb_add(&bar[XB_XCNT(b.x)], 1u);
    return b;
}
__device__ __forceinline__ void xcd_barrier_complete(unsigned* bar, unsigned x, unsigned& nloc, unsigned& nx) {
    const unsigned G = gridDim.x * gridDim.y * gridDim.z;
    unsigned sum, cnt, mine, sp = 0u;
    for (;;) {
        sum = 0u; cnt = 0u; mine = 0u;
#pragma unroll
        for (unsigned j = 0; j < 16; ++j) { const unsigned c = xb_ld(&bar[XB_XCNT(j)]); sum += c; cnt += (c > 0u) ? 1u : 0u; mine = (j == x) ? c : mine; }
        if (sum == G) break;
        __builtin_amdgcn_s_sleep(1);
        if ((++sp & 255u) == 0u) { if (xb_ld(&bar[XB_TMO])) break; if (sp > XB_SPIN_CAP) { atomicAdd(&bar[XB_TMO], 1u); break; } }
    }
    nloc = mine > 0u ? mine : 1u; nx = cnt > 0u ? cnt : 1u;
}
__device__ __forceinline__ void xcd_barrier(const XcdBarrier& b) {
    asm volatile("s_waitcnt vmcnt(0)" ::: "memory");
    __syncthreads();
    if (threadIdx.x == 0) {
        unsigned* bar = b.bar;
        __builtin_amdgcn_s_waitcnt(0);
        unsigned nloc = b.st[0], nx = b.st[1];
        if (nloc == 0u) { xcd_barrier_complete(bar, b.x, nloc, nx); b.st[0] = nloc; b.st[1] = nx; }
        const unsigned old = xb_add(&bar[XB_XSUB(b.x)], 1u);
        const unsigned gen = old / nloc;
        if (old + 1u == (gen + 1u) * nloc) {
            __builtin_amdgcn_fence(__ATOMIC_RELEASE, "agent");
            asm volatile("s_waitcnt vmcnt(0)" ::: "memory");
            const unsigned og = xb_add(&bar[XB_TOP], 1u);
            const unsigned tg = og / nx;
            if (og + 1u == (tg + 1u) * nx) xb_add(&bar[XB_TOPGEN], 1u);
            else XB_SPIN(xb_ld(&bar[XB_TOPGEN]) == tg, bar);
            __builtin_amdgcn_fence(__ATOMIC_ACQUIRE, "agent");
            xb_add(&bar[XB_XGEN(b.x)], 1u);
            asm volatile("s_waitcnt vmcnt(0)" ::: "memory");
        } else {
            XB_SPIN(xb_ld(&bar[XB_XGEN(b.x)]) == gen, bar);
            __builtin_amdgcn_fence(__ATOMIC_ACQUIRE, "agent");
            asm volatile("s_waitcnt vmcnt(0)" ::: "memory");
        }
    }
    __syncthreads();
}


__device__ __forceinline__ int map_even_in(int n) { return n < 4096 ? n : (n < 5120 ? n + 16 : (n < 5136 ? n - 1024 : -1)); }
__device__ __forceinline__ int map_odd_in(int n) { return n < 768 ? n : (n < 1792 ? n + 32 : (n < 1824 ? n - 1024 : -1)); }

__device__ __forceinline__ void convert_tile(const float* __restrict__ src, int K, int Nsrc, bf16_t* __restrict__ dst,
                                             int kind, const float* __restrict__ g, int tile) {
  float* tl = (float*)smem;
  const int nkt = K >> 7;
  const int ntile = tile / nkt, ktile = tile - ntile * nkt;
  const int n0 = ntile * 64, k0 = ktile * 128;
  const int tid = opaque_tid();
  const int nl = tid & 63, kq = tid >> 6;
  const int n = n0 + nl;
  const int sc = kind == 0 ? map_even_in(n) : (kind == 1 ? map_odd_in(n) : n);
  float cs = 1.f;
  if (kind == 0 && n >= 2048 && n < 2560) cs = 0.08838834764831845f;
  if (kind == 2) cs = QSCALE_MLA;
  float v[32];
#pragma unroll
  for (int i = 0; i < 32; ++i) {
    const int kl = kq + 4 * i;
    v[i] = 0.f;
    if (sc >= 0) v[i] = src[(size_t)(k0 + kl) * Nsrc + sc];
  }
#pragma unroll
  for (int i = 0; i < 32; ++i) {
    const int kl = kq + 4 * i;
    float t = v[i] * cs;
    if (g) t *= g[k0 + kl];
    tl[kl * 65 + nl] = t;
  }
  __syncthreads();
#pragma unroll
  for (int i = 0; i < 4; ++i) {
    const int c = tid + 256 * i;
    const int nl2 = c >> 4, kc = c & 15;
    float t[8];
#pragma unroll
    for (int jj = 0; jj < 8; ++jj) t[jj] = tl[(kc * 8 + jj) * 65 + nl2];
    u32x4 pk;
    pk.x = cvt_pk_bf16(t[0], t[1]); pk.y = cvt_pk_bf16(t[2], t[3]); pk.z = cvt_pk_bf16(t[4], t[5]); pk.w = cvt_pk_bf16(t[6], t[7]);
    *(u32x4*)(dst + (size_t)(n0 + nl2) * K + k0 + kc * 8) = pk;
  }
  __syncthreads();
}

__device__ __forceinline__ void phase_prologue(const Params& p, const WS& ws) {
  for (int id = opaque_bid(); id < 2880; id += gridDim.x) {
    const int j = id / 1440; int r = id - j * 1440;
    bf16_t* wb = ws.W + (size_t)j * W_PER_J;
    if (r < 656) convert_tile(p.ab_w_in + (size_t)j * 1024 * 5136, 1024, 5136, wb + W_IN_E, 0, p.ab_norm + j * 1024, r);
    else if ((r -= 656) < 256) convert_tile(p.ab_w_out + (size_t)j * 2048 * 1024, 2048, 1024, wb + W_OUT_E, 3, nullptr, r);
    else if ((r -= 256) < 240) convert_tile(p.c_w_in + (size_t)j * 1024 * 1824, 1024, 1824, wb + W_IN_O, 1, p.c_norm + j * 1024, r);
    else if ((r -= 240) < 96) convert_tile(p.c_w_q_up + (size_t)j * 512 * 1536, 512, 1536, wb + W_Q, 2, p.c_q_norm + j * 512, r);
    else if ((r -= 96) < 64) convert_tile(p.c_w_kv_up + (size_t)j * 256 * 2048, 256, 2048, wb + W_KV, 3, p.c_kv_norm + j * 256, r);
    else { r -= 64; convert_tile(p.c_w_out + (size_t)j * 1024 * 1024, 1024, 1024, wb + W_O, 3, nullptr, r); }
  }
  const size_t gtid = (size_t)opaque_bid() * 256 + opaque_tid(), gsz = (size_t)gridDim.x * 256;
  for (size_t idx0 = gtid; idx0 < (size_t)M_ * 256; idx0 += 4 * gsz) {
    float4 v4[4];
#pragma unroll
    for (int q = 0; q < 4; ++q) {
      const size_t idx = idx0 + q * gsz;
      v4[q] = make_float4(0.f, 0.f, 0.f, 0.f);
      if (idx < (size_t)M_ * 256) {
        const int row = (int)(idx >> 8), c4 = (int)(idx & 255);
        const int b = row / T_, t = row - b * T_;
        const float* src = t < 16 ? p.meta + (size_t)t * 1024 : p.x + ((size_t)b * 2048 + (t - 16)) * 1024;
        v4[q] = *(const float4*)(src + c4 * 4);
      }
    }
#pragma unroll
    for (int q = 0; q < 4; ++q) {
      const size_t idx = idx0 + q * gsz;
      if (idx < (size_t)M_ * 256) {
        const float4 v = v4[q];
        u32x2 hi; hi.x = cvt_pk_bf16(v.x, v.y); hi.y = cvt_pk_bf16(v.z, v.w);
        u32x2 lo; lo.x = cvt_pk_bf16(v.x - bflo(hi.x), v.y - bfhi(hi.x)); lo.y = cvt_pk_bf16(v.z - bflo(hi.y), v.w - bfhi(hi.y));
        *(u32x2*)(ws.HHI + idx * 4) = hi;
        *(u32x2*)(ws.HLO + idx * 4) = lo;
      }
    }
  }
  for (size_t idx = gtid; idx < (size_t)M_ * 16; idx += gsz) {
    const int row = (int)(idx >> 4), i = (int)(idx & 15);
    const int b = row / T_, t = row - b * T_;
    const int pos = t < 16 ? t : p.positions[b * 2048 + (t - 16)] + 16;
    const float angf = (float)pos * p.inv_freq[i];
    const double rev = (double)angf * 0.15915494309189533577;
    const float fr = (float)(rev - rint(rev));
    ws.ROPE[idx] = make_float2(__builtin_amdgcn_cosf(fr), __builtin_amdgcn_sinf(fr));
  }
}

#ifndef REP_GEMM
#define REP_GEMM 1
#endif
#ifndef REP_ATTN
#define REP_ATTN 1
#endif
#ifndef REP_E2
#define REP_E2 1
#endif
enum { EPI_E1 = 0, EPI_O1 = 1, EPI_Q = 2, EPI_KV = 3, EPI_RES = 4 };

template <int EPI, int TI>
__device__ __forceinline__ void gemm_epilogue(const WS& ws, const f32x4 (&acc)[4][TI], const float (&rs)[TI], int tok0, int n0,
                                              int wm, int wn, int lr, int lq, bool dry) {
  auto tokr = [&](int ti) { return tok0 + (ti < 4 ? wn * 64 + ti * 16 : 128 + wn * 16) + lr; };
  auto okr = [&](int ti) { return ti < 4 || (wn == 0 && lr == 0); };
  const int nw = n0 + wm * 64;
  if (EPI == EPI_E1) {
    bf16_t* dst; int ld, c;
    if (n0 < 1024) { dst = ws.XA; ld = 1024; c = n0; }
    else if (n0 < 2048) { dst = ws.GA; ld = 1024; c = n0 - 1024; }
    else if (n0 < 2560) { dst = ws.Q; ld = 512; c = n0 - 2048; }
    else if (n0 < 3072) { dst = ws.K; ld = 512; c = n0 - 2560; }
    else if (n0 < 4096) { dst = ws.V; ld = 1024; c = n0 - 3072; }
    else if (n0 < 5120) { dst = ws.GB; ld = 1024; c = n0 - 4096; }
    else { dst = ws.AD; ld = 16; c = 0; }
    const bool isad = n0 >= 5120;
#pragma unroll
    for (int ni = 0; ni < 4; ++ni) {
      if (isad && (wm != 0 || ni != 0)) continue;
#pragma unroll
      for (int ti = 0; ti < TI; ++ti) {
        const f32x4 v = scale4(acc[ni][ti], rs[ti]);
        u32x2 pk; pk.x = cvt_pk_bf16(v[0], v[1]); pk.y = cvt_pk_bf16(v[2], v[3]);
        if (okr(ti)) *(u32x2*)(dst + (size_t)tokr(ti) * ld + c + wm * 64 + ni * 16 + 4 * lq) = pk;
      }
    }
  } else if (EPI == EPI_O1) {
    if (n0 < 1792) {
      bf16_t* dst; int ld, c;
      if (n0 < 512) { dst = ws.CQ; ld = 512; c = n0; }
      else if (n0 < 768) { dst = ws.CKV; ld = 256; c = n0 - 512; }
      else { dst = ws.GATE; ld = 1024; c = n0 - 768; }
#pragma unroll
      for (int ni = 0; ni < 4; ++ni)
#pragma unroll
        for (int ti = 0; ti < TI; ++ti) {
          const f32x4 v = scale4(acc[ni][ti], rs[ti]);
          u32x2 pk; pk.x = cvt_pk_bf16(v[0], v[1]); pk.y = cvt_pk_bf16(v[2], v[3]);
          if (okr(ti)) *(u32x2*)(dst + (size_t)tokr(ti) * ld + c + wm * 64 + ni * 16 + 4 * lq) = pk;
        }
    } else if (wm == 0) {
#pragma unroll
      for (int ti = 0; ti < TI; ++ti) {
        const int tok = tokr(ti);
        const f32x4 x1 = scale4(acc[0][ti], rs[ti]), x2 = scale4(acc[1][ti], rs[ti]);
        float o1[4], o2[4];
#pragma unroll
        for (int jj = 0; jj < 4; ++jj) {
          const float2 cs = ws.ROPE[(size_t)tok * 16 + 4 * lq + jj];
          o1[jj] = x1[jj] * cs.x - x2[jj] * cs.y;
          o2[jj] = x2[jj] * cs.x + x1[jj] * cs.y;
        }
        u32x2 pk; pk.x = cvt_pk_bf16(o1[0], o1[1]); pk.y = cvt_pk_bf16(o1[2], o1[3]);
        *(u32x2*)(ws.KR + (size_t)tok * 32 + 4 * lq) = pk;
        pk.x = cvt_pk_bf16(o2[0], o2[1]); pk.y = cvt_pk_bf16(o2[2], o2[3]);
        *(u32x2*)(ws.KR + (size_t)tok * 32 + 16 + 4 * lq) = pk;
      }
    }
  } else if (EPI == EPI_Q) {
#pragma unroll
    for (int ni = 0; ni < 4; ++ni)
#pragma unroll
      for (int ti = 0; ti < TI; ++ti) {
        const f32x4 v = scale4(acc[ni][ti], rs[ti]);
        u32x2 pk; pk.x = cvt_pk_bf16(v[0], v[1]); pk.y = cvt_pk_bf16(v[2], v[3]);
        if (okr(ti)) *(u32x2*)(ws.QB + (size_t)tokr(ti) * 1536 + nw + ni * 16 + 4 * lq) = pk;
      }
  } else if (EPI == EPI_KV) {
    const int hd = nw >> 7;
    const bool isv = (nw & 127) >= 64;
    if (!isv) {
#pragma unroll
      for (int ni = 0; ni < 4; ++ni)
#pragma unroll
        for (int ti = 0; ti < TI; ++ti) {
          const f32x4 v = scale4(acc[ni][ti], rs[ti]);
          u32x2 pk; pk.x = cvt_pk_bf16(v[0], v[1]); pk.y = cvt_pk_bf16(v[2], v[3]);
          if (okr(ti)) *(u32x2*)(ws.KN + (size_t)tokr(ti) * 1024 + hd * 64 + ni * 16 + 4 * lq) = pk;
        }
    } else {
#pragma unroll
      for (int ti = 0; ti < TI; ++ti) {
        const int tok = tokr(ti);
        const int b = tok / T_, t = tok - b * T_;
        bf16_t* vb = ws.VT + ((size_t)(b * 16 + hd) * 64) * TP_ + t;
#pragma unroll
        for (int ni = 0; ni < 4; ++ni) {
          const f32x4 v = scale4(acc[ni][ti], rs[ti]);
#pragma unroll
          for (int jj = 0; jj < 4; ++jj) if (okr(ti)) vb[(size_t)(ni * 16 + 4 * lq + jj) * TP_] = f2bf(v[jj]);
        }
      }
    }
  } else {
#pragma unroll
    for (int ni = 0; ni < 4; ++ni)
#pragma unroll
      for (int ti = 0; ti < TI; ++ti) {
        if (!okr(ti)) continue;
        const size_t off = (size_t)tokr(ti) * 1024 + nw + ni * 16 + 4 * lq;
        const u32x2 hi = *(const u32x2*)(ws.HHI + off), lo = *(const u32x2*)(ws.HLO + off);
        const float h0 = bflo(hi.x) + bflo(lo.x) + acc[ni][ti][0], h1 = bfhi(hi.x) + bfhi(lo.x) + acc[ni][ti][1];
        const float h2 = bflo(hi.y) + bflo(lo.y) + acc[ni][ti][2], h3 = bfhi(hi.y) + bfhi(lo.y) + acc[ni][ti][3];
        u32x2 nh; nh.x = cvt_pk_bf16(h0, h1); nh.y = cvt_pk_bf16(h2, h3);
        u32x2 nl; nl.x = cvt_pk_bf16(h0 - bflo(nh.x), h1 - bfhi(nh.x)); nl.y = cvt_pk_bf16(h2 - bflo(nh.y), h3 - bfhi(nh.y));
        if (!dry) { *(u32x2*)(ws.HHI + off) = nh; *(u32x2*)(ws.HLO + off) = nl; }
      }
  }
}

__device__ __forceinline__ float sumsq8(bf16x8 v) {
  const u32x4 u = __builtin_bit_cast(u32x4, v);
  float s = 0.f, t;
  t = bflo(u.x); s += t * t; t = bfhi(u.x); s += t * t; t = bflo(u.y); s += t * t; t = bfhi(u.y); s += t * t;
  t = bflo(u.z); s += t * t; t = bfhi(u.z); s += t * t; t = bflo(u.w); s += t * t; t = bfhi(u.w); s += t * t;
  return s;
}
__device__ __forceinline__ void tile_of(int pos, int ntn, int& mt, int& nt) {
  const int full = 128 * ntn;
  if (pos < full) { const int panel = pos / (8 * ntn); const int rem = pos - panel * 8 * ntn; nt = rem >> 3; mt = panel * 8 + (rem & 7); }
  else { mt = 128; nt = pos - full; }
}
template <bool RS, int EPI, int TI>
__device__ __forceinline__ void gemm_stream(const WS& ws, const bf16_t* A0, const bf16_t* A1, int lda, int ktsplit, int kstride,
                                            const bf16_t* __restrict__ W, int K, float invK, int ntn, int ntiles, int bid, bool dry) {
  constexpr int BM = (TI == 5) ? 129 : 128;
  constexpr int ASTG = 16384;
  unsigned char* As = smem;
  unsigned char* Bs = smem + 2 * ASTG;
  float* rsl = (float*)(smem + 65536);
  int xbase = 66048;
  asm volatile("" : "+v"(xbase));
  unsigned char* Ax0 = smem + xbase;
  const int tid = opaque_tid(), lane = tid & 63, w = tid >> 6, wm = w >> 1, wn = w & 1, lr = lane & 15, lq = lane >> 4;
  const int G = gridDim.x;
  const int nk = K >> 6;
  if (bid < ntiles) {
    const int my_tiles = (ntiles - 1 - bid) / G + 1;
    const int last_id = bid + (my_tiles - 1) * G;
    const int S = my_tiles * nk;
    f32x4 acc[4][TI];
#pragma unroll
    for (int a = 0; a < 4; ++a)
#pragma unroll
      for (int b = 0; b < TI; ++b) acc[a][b] = (f32x4){0.f, 0.f, 0.f, 0.f};
    u32x4 ra0[4], rb0[4], ra1[4], rb1[4];
    u32x4 rx0 = (u32x4){0u, 0u, 0u, 0u}, rx1 = (u32x4){0u, 0u, 0u, 0u};
    float ss[5] = {0.f, 0.f, 0.f, 0.f, 0.f};
    int l_id = bid, l_kt = 0, c_id = bid, c_kt = 0, st_kt = 0;
    const int srow = tid >> 3;
    const int soff = srow * 128 + (((tid & 7) ^ (srow & 7)) << 4);

    auto issue = [&](u32x4 (&ra)[4], u32x4 (&rb)[4], u32x4& rx) {
      const int idc = l_id < last_id ? l_id : last_id;
      int mt, nt; tile_of(idc, ntn, mt, nt);
      const bf16_t* A = (l_kt < ktsplit) ? A0 : A1;
      const int kk = (l_kt < ktsplit) ? l_kt : l_kt - ktsplit;
      const bf16_t* ap = A + (size_t)(mt * BM + srow) * lda + kk * kstride + (tid & 7) * 8;
      const bf16_t* wp = W + (size_t)(nt * 128 + srow) * K + l_kt * 64 + (tid & 7) * 8;
#pragma unroll
      for (int i = 0; i < 4; ++i) {
        ra[i] = *(const u32x4*)(ap + (size_t)i * 32 * lda);
        rb[i] = *(const u32x4*)(wp + (size_t)i * 32 * K);
      }
      if (TI == 5) { if (srow == 0) rx = *(const u32x4*)(ap + (size_t)128 * lda); }
      if (++l_kt == nk) { l_kt = 0; l_id += G; }
    };
    auto store = [&](const u32x4 (&ra)[4], const u32x4 (&rb)[4], const u32x4& rx, int buf) {
#pragma unroll
      for (int i = 0; i < 4; ++i) {
        if (RS) ss[i] += sumsq8(__builtin_bit_cast(bf16x8, ra[i]));
        *(u32x4*)(As + buf * ASTG + i * 4096 + soff) = ra[i];
        *(u32x4*)(Bs + buf * 16384 + i * 4096 + soff) = rb[i];
      }
      if (TI == 5) {
        if (RS) ss[4] += sumsq8(__builtin_bit_cast(bf16x8, rx));
        if (srow == 0) *(u32x4*)(Ax0 + buf * 128 + ((tid & 7) << 4)) = rx;
      }
      if (RS) {
        if (++st_kt == nk) {
          st_kt = 0;
#pragma unroll
          for (int i = 0; i < TI; ++i) {
            float t = ss[i];
            t += __shfl_xor(t, 1); t += __shfl_xor(t, 2); t += __shfl_xor(t, 4);
            if ((tid & 7) == 0 && i < 4) rsl[srow + 32 * i] = rsqrtf(t * invK + EPS_);
            ss[i] = 0.f;
          }
        }
      }
    };
    auto compute = [&](int buf) {
      const unsigned char* Ab = As + buf * ASTG + (wn * 64 + lr) * 128;
      const unsigned char* Ax = Ax0 + buf * 128;
      const unsigned char* Bb = Bs + buf * 16384 + (wm * 64 + lr) * 128;
#pragma unroll
      for (int ks = 0; ks < 2; ++ks) {
        if (TI == 5 && ks == 1) __builtin_amdgcn_sched_barrier(0);
        const int sw = ((ks * 4 + lq) ^ (lr & 7)) << 4;
        bf16x8 wf[4], xf[TI];
#pragma unroll
        for (int i = 0; i < 4; ++i) {
          wf[i] = *(const bf16x8*)(Bb + i * 2048 + sw);
          xf[i] = *(const bf16x8*)(Ab + i * 2048 + sw);
        }
        if (TI == 5) xf[TI - 1] = *(const bf16x8*)(Ax + ((ks * 4 + lq) << 4));
#pragma unroll
        for (int ni = 0; ni < 4; ++ni)
#pragma unroll
          for (int ti = 0; ti < TI; ++ti) acc[ni][ti] = MFMA16(wf[ni], xf[ti], acc[ni][ti]);
      }
    };
    auto tile_end = [&]() {
      float rs[TI];
#pragma unroll
      for (int ti = 0; ti < TI; ++ti) rs[ti] = 1.f;
      if (RS) {
#pragma unroll
        for (int ti = 0; ti < TI; ++ti) rs[ti] = rsl[(ti < 4 ? wn * 64 + ti * 16 : 0) + lr];
      }
      int mt, nt; tile_of(c_id, ntn, mt, nt);
      gemm_epilogue<EPI, TI>(ws, acc, rs, mt * BM, nt * 128, wm, wn, lr, lq, dry);
#pragma unroll
      for (int a = 0; a < 4; ++a)
#pragma unroll
        for (int b = 0; b < TI; ++b) acc[a][b] = (f32x4){0.f, 0.f, 0.f, 0.f};
      c_id += G;
    };

    issue(ra0, rb0, rx0);
    issue(ra1, rb1, rx1);
    store(ra0, rb0, rx0, 0);
    __syncthreads();
#pragma unroll 1
    for (int s = 0; s < S; s += 2) {
      issue(ra0, rb0, rx0);
      compute(0);
      store(ra1, rb1, rx1, 1);
      __syncthreads();
      issue(ra1, rb1, rx1);
      compute(1);
      c_kt += 2;
      if (c_kt == nk) { c_kt = 0; tile_end(); }
      store(ra0, rb0, rx0, 0);
      __syncthreads();
    }
  }
  __syncthreads();
}

__device__ __forceinline__ void gla_decay_unit(const Params& p, const WS& ws, int j, int u) {
  const int c = u % 33; const int bh = u / 33; const int hd = bh & 3, b = bh >> 2;
  bf16_t* Qs = (bf16_t*)smem;
  bf16_t* Ks = Qs + 64 * 136;
  float* ADs = (float*)(smem + 2 * 64 * 136 * 2);
  float* HT = ADs + 64 * 16;
  const int tid = opaque_tid();
  const int tbase = 64 * c - 48;
#pragma unroll
  for (int i = 0; i < 4; ++i) {
    const int ci = tid + 256 * i; const int row = ci >> 4, ch = ci & 15; const int t = tbase + row;
    u32x4 qv = (u32x4){0, 0, 0, 0}, kv = (u32x4){0, 0, 0, 0};
    if (t >= 0) {
      qv = *(const u32x4*)(ws.Q + (size_t)(b * T_ + t) * 512 + hd * 128 + ch * 8);
      kv = *(const u32x4*)(ws.K + (size_t)(b * T_ + t) * 512 + hd * 128 + ch * 8);
    }
    *(u32x4*)(Qs + row * 136 + ch * 8) = qv;
    *(u32x4*)(Ks + row * 136 + ch * 8) = kv;
    const int t2 = tbase + (ci >> 4);
    ADs[ci] = t2 >= 0 ? bf2f(ws.AD[(size_t)(b * T_ + t2) * 16 + (ci & 15)]) : 0.f;
  }
  const int d = tid & 127, half = tid >> 7;
  float aw[16];
#pragma unroll
  for (int r = 0; r < 16; ++r) aw[r] = p.ab_alpha_w[(size_t)(j * 16 + r) * 512 + hd * 128 + d];
  const float abias = p.ab_alpha_b[j * 512 + hd * 128 + d];
  __syncthreads();
  float cs[32];
  float run = 0.f;
#pragma unroll
  for (int ii = 0; ii < 32; ++ii) {
    const int row = half * 32 + ii;
    float xv = abias;
#pragma unroll
    for (int r4 = 0; r4 < 4; ++r4) {
      const float4 a4 = *(const float4*)(ADs + row * 16 + r4 * 4);
      xv += a4.x * aw[r4 * 4] + a4.y * aw[r4 * 4 + 1] + a4.z * aw[r4 * 4 + 2] + a4.w * aw[r4 * 4 + 3];
    }
    float la = (fminf(xv, 0.f) - __logf(1.f + __expf(-fabsf(xv)))) * 0.0625f;
    if (tbase + row < 0) la = 0.f;
    run += la;
    cs[ii] = run;
  }
  HT[half * 128 + d] = run;
  __syncthreads();
  const float off = half ? HT[d] : 0.f;
  const float blast = HT[d] + HT[128 + d];
#pragma unroll
  for (int ii = 0; ii < 32; ++ii) {
    const int row = half * 32 + ii;
    const float bb = cs[ii] + off;
    const float eb = __expf(bb), ebi = __expf(-bb);
    Qs[row * 136 + d] = f2bf(bf2f(Qs[row * 136 + d]) * eb);
    Ks[row * 136 + d] = f2bf(bf2f(Ks[row * 136 + d]) * ebi);
  }
  if (half == 0) ws.BL[(size_t)((b * 4 + hd) * 33 + c) * 128 + d] = __expf(blast);
  __syncthreads();
#pragma unroll
  for (int i = 0; i < 4; ++i) {
    const int ci = tid + 256 * i; const int row = ci >> 4, ch = ci & 15; const int t = tbase + row;
    if (t >= 0) {
      *(u32x4*)(ws.Q + (size_t)(b * T_ + t) * 512 + hd * 128 + ch * 8) = *(const u32x4*)(Qs + row * 136 + ch * 8);
      *(u32x4*)(ws.K + (size_t)(b * T_ + t) * 512 + hd * 128 + ch * 8) = *(const u32x4*)(Ks + row * 136 + ch * 8);
    }
  }
  __syncthreads();
}

__device__ __forceinline__ void conv_unit(const Params& p, const WS& ws, int j, int u) {
  const int g = u & 7, b = u >> 3;
  const int tid = opaque_tid();
  const int c8 = tid & 15, seg = tid >> 4;
  const int t0 = seg * 129;
  const int cbase = 128 * g + 8 * c8;
  float cw[4][8], cb[8];
#pragma unroll
  for (int e = 0; e < 8; ++e) {
    cb[e] = p.ab_conv_b[j * 1024 + cbase + e];
#pragma unroll
    for (int k = 0; k < 4; ++k) cw[k][e] = p.ab_conv_w[(size_t)(j * 4 + k) * 1024 + cbase + e];
  }
  bf16_t* xp = ws.XA + (size_t)(b * T_) * 1024 + cbase;
  float x0[8], x1[8], x2[8];
  {
    u32x4 h[3];
#pragma unroll
    for (int m = 0; m < 3; ++m) {
      const int t = t0 - 3 + m;
      h[m] = (u32x4){0, 0, 0, 0};
      if (t >= 0) h[m] = *(const u32x4*)(xp + (size_t)t * 1024);
    }
    const u32x4 a = h[0], bq = h[1], c = h[2];
    x0[0] = bflo(a.x); x0[1] = bfhi(a.x); x0[2] = bflo(a.y); x0[3] = bfhi(a.y); x0[4] = bflo(a.z); x0[5] = bfhi(a.z); x0[6] = bflo(a.w); x0[7] = bfhi(a.w);
    x1[0] = bflo(bq.x); x1[1] = bfhi(bq.x); x1[2] = bflo(bq.y); x1[3] = bfhi(bq.y); x1[4] = bflo(bq.z); x1[5] = bfhi(bq.z); x1[6] = bflo(bq.w); x1[7] = bfhi(bq.w);
    x2[0] = bflo(c.x); x2[1] = bfhi(c.x); x2[2] = bflo(c.y); x2[3] = bfhi(c.y); x2[4] = bflo(c.z); x2[5] = bfhi(c.z); x2[6] = bflo(c.w); x2[7] = bfhi(c.w);
  }
  __syncthreads();
#pragma unroll 1
  for (int tt = 0; tt < 129; tt += 3) {
    u32x4 r[3];
#pragma unroll
    for (int m = 0; m < 3; ++m) r[m] = *(const u32x4*)(xp + (size_t)(t0 + tt + m) * 1024);
#pragma unroll
    for (int m = 0; m < 3; ++m) {
      float x3[8];
      x3[0] = bflo(r[m].x); x3[1] = bfhi(r[m].x); x3[2] = bflo(r[m].y); x3[3] = bfhi(r[m].y);
      x3[4] = bflo(r[m].z); x3[5] = bfhi(r[m].z); x3[6] = bflo(r[m].w); x3[7] = bfhi(r[m].w);
      float y[8];
#pragma unroll
      for (int e = 0; e < 8; ++e) y[e] = cb[e] + cw[0][e] * x0[e] + cw[1][e] * x1[e] + cw[2][e] * x2[e] + cw[3][e] * x3[e];
      u32x4 pk; pk.x = cvt_pk_bf16(y[0], y[1]); pk.y = cvt_pk_bf16(y[2], y[3]); pk.z = cvt_pk_bf16(y[4], y[5]); pk.w = cvt_pk_bf16(y[6], y[7]);
      *(u32x4*)(xp + (size_t)(t0 + tt + m) * 1024) = pk;
#pragma unroll
      for (int e = 0; e < 8; ++e) { x0[e] = x1[e]; x1[e] = x2[e]; x2[e] = x3[e]; }
    }
  }
  __syncthreads();
}

__device__ __forceinline__ void gla_unit(const Params& p, const WS& ws, int u, bool dry = false) {
  const int sl = u & 7; const int bh = u >> 3; const int hd = bh & 3, b = bh >> 2;
  bf16_t* QDs = (bf16_t*)smem;
  bf16_t* KIs = QDs + 64 * 136;
  bf16_t* KIT = KIs + 64 * 136;
  bf16_t* VTs = KIT + 128 * 72;
  bf16_t* STs = VTs + 32 * 72;
  bf16_t* Ps = STs + 32 * 136;
  const int tid = opaque_tid(), lane = tid & 63, w = tid >> 6, lr = lane & 15, lq = lane >> 4;
  for (int i = tid; i < 32 * 136 / 2; i += 256) ((unsigned*)STs)[i] = 0u;
  f32x4 sacc[2][2];
#pragma unroll
  for (int a = 0; a < 2; ++a)
#pragma unroll
    for (int bb = 0; bb < 2; ++bb) sacc[a][bb] = (f32x4){0.f, 0.f, 0.f, 0.f};
  u32x4 qrA[4], krA[4], vrA, qrB[4], krB[4], vrB;
  float eblA[2], eblB[2];
  const float* BLp = ws.BL + (size_t)((b * 4 + hd) * 33) * 128;
  auto prefetch = [&](int c, u32x4 (&qr)[4], u32x4 (&kr)[4], u32x4& vr, float (&ebl)[2]) {
    const int tbase = 64 * c - 48;
#pragma unroll
    for (int i = 0; i < 4; ++i) {
      const int ci = tid + 256 * i; const int row = ci >> 4, ch = ci & 15; const int t = tbase + row;
      qr[i] = (u32x4){0, 0, 0, 0}; kr[i] = (u32x4){0, 0, 0, 0};
      if (t >= 0) {
        qr[i] = *(const u32x4*)(ws.Q + (size_t)(b * T_ + t) * 512 + hd * 128 + ch * 8);
        kr[i] = *(const u32x4*)(ws.K + (size_t)(b * T_ + t) * 512 + hd * 128 + ch * 8);
      }
    }
    {
      const int row = tid >> 2, ch = tid & 3; const int t = tbase + row;
      vr = (u32x4){0, 0, 0, 0};
      if (t >= 0) vr = *(const u32x4*)(ws.V + (size_t)(b * T_ + t) * 1024 + hd * 256 + sl * 32 + ch * 8);
    }
    ebl[0] = BLp[c * 128 + 16 * (2 * w) + lr];
    ebl[1] = BLp[c * 128 + 16 * (2 * w + 1) + lr];
  };
  prefetch(0, qrA, krA, vrA, eblA);
  prefetch(1, qrB, krB, vrB, eblB);
  u32x2 opend[2]; float sqpend = 0.f; int tpend = -1;
  opend[0] = (u32x2){0u, 0u}; opend[1] = (u32x2){0u, 0u};
  auto flush_o = [&]() {
    if (tpend >= 0 && !dry) {
      const size_t row = (size_t)(b * T_ + tpend);
#pragma unroll
      for (int mt = 0; mt < 2; ++mt) *(u32x2*)(ws.V + row * 1024 + hd * 256 + sl * 32 + 16 * mt + 4 * lq) = opend[mt];
      if (lq == 0) ws.SSQ[row * 32 + hd * 8 + sl] = sqpend;
    }
  };
  auto body = [&](int c, u32x4 (&qr)[4], u32x4 (&kr)[4], u32x4& vr, float (&ebl)[2]) {
#pragma unroll
    for (int i = 0; i < 4; ++i) {
      const int ci = tid + 256 * i; const int row = ci >> 4, ch = ci & 15;
      *(u32x4*)(QDs + row * 136 + ch * 8) = qr[i];
      *(u32x4*)(KIs + row * 136 + ch * 8) = kr[i];
      const unsigned kk[4] = {kr[i].x, kr[i].y, kr[i].z, kr[i].w};
#pragma unroll
      for (int e = 0; e < 4; ++e) {
        KIT[(ch * 8 + 2 * e) * 72 + (row ^ ((ch & 7) << 3))] = (bf16_t)(kk[e] & 0xffffu);
        KIT[(ch * 8 + 2 * e + 1) * 72 + (row ^ ((ch & 7) << 3))] = (bf16_t)(kk[e] >> 16);
      }
    }
    {
      const int row = tid >> 2, ch = tid & 3;
      const unsigned vv[4] = {vr.x, vr.y, vr.z, vr.w};
#pragma unroll
      for (int e = 0; e < 4; ++e) {
        VTs[(ch * 8 + 2 * e) * 72 + (row ^ (ch << 3))] = (bf16_t)(vv[e] & 0xffffu);
        VTs[(ch * 8 + 2 * e + 1) * 72 + (row ^ (ch << 3))] = (bf16_t)(vv[e] >> 16);
      }
    }
    const float eb0 = ebl[0], eb1 = ebl[1];
    __syncthreads();
    flush_o();
    if (c + 2 < 33) prefetch(c + 2, qr, kr, vr, ebl);
    bf16x8 xq[4];
#pragma unroll
    for (int ks = 0; ks < 4; ++ks) xq[ks] = *(const bf16x8*)(QDs + (16 * w + lr) * 136 + 32 * ks + 8 * lq);
    const int irow = 16 * w + lr;
#pragma unroll
    for (int mt = 0; mt < 4; ++mt) {
      u32x2 pk = (u32x2){0u, 0u};
      if (mt <= w) {
        f32x4 a = (f32x4){0.f, 0.f, 0.f, 0.f};
#pragma unroll
        for (int ks = 0; ks < 4; ++ks) {
          const bf16x8 kf = *(const bf16x8*)(KIs + (16 * mt + lr) * 136 + 32 * ks + 8 * lq);
          a = MFMA16(kf, xq[ks], a);
        }
        const int ip = 16 * mt + 4 * lq;
        const float v0 = (ip + 0 <= irow) ? a[0] : 0.f, v1 = (ip + 1 <= irow) ? a[1] : 0.f;
        const float v2 = (ip + 2 <= irow) ? a[2] : 0.f, v3 = (ip + 3 <= irow) ? a[3] : 0.f;
        pk.x = cvt_pk_bf16(v0, v1); pk.y = cvt_pk_bf16(v2, v3);
      }
      *(u32x2*)(Ps + irow * 72 + 16 * mt + 4 * lq) = pk;
    }
    __syncthreads();
    f32x4 oacc[2];
    oacc[0] = (f32x4){0.f, 0.f, 0.f, 0.f}; oacc[1] = (f32x4){0.f, 0.f, 0.f, 0.f};
#pragma unroll
    for (int ks = 0; ks < 2; ++ks) {
      if (2 * ks <= w) {
        const bf16x8 pb = *(const bf16x8*)(Ps + irow * 72 + 32 * ks + 8 * lq);
#pragma unroll
        for (int mt = 0; mt < 2; ++mt) {
          const bf16x8 vf = *(const bf16x8*)(VTs + (16 * mt + lr) * 72 + (((4 * ks + lq) ^ (((16 * mt + lr) >> 3) & 3)) << 3));
          oacc[mt] = MFMA16(vf, pb, oacc[mt]);
        }
      }
    }
#pragma unroll
    for (int ks = 0; ks < 4; ++ks)
#pragma unroll
      for (int mt = 0; mt < 2; ++mt) {
        const bf16x8 sf = *(const bf16x8*)(STs + (16 * mt + lr) * 136 + 32 * ks + 8 * lq);
        oacc[mt] = MFMA16(sf, xq[ks], oacc[mt]);
      }
    {
      const int t = 64 * c - 48 + irow;
      float sq = 0.f;
#pragma unroll
      for (int mt = 0; mt < 2; ++mt) sq += oacc[mt][0] * oacc[mt][0] + oacc[mt][1] * oacc[mt][1] + oacc[mt][2] * oacc[mt][2] + oacc[mt][3] * oacc[mt][3];
      sq += __shfl_xor(sq, 16); sq += __shfl_xor(sq, 32);
      tpend = t;
      sqpend = sq;
#pragma unroll
      for (int mt = 0; mt < 2; ++mt) { opend[mt].x = cvt_pk_bf16(oacc[mt][0], oacc[mt][1]); opend[mt].y = cvt_pk_bf16(oacc[mt][2], oacc[mt][3]); }
    }
    __syncthreads();
#pragma unroll
    for (int ntl = 0; ntl < 2; ++ntl) {
#pragma unroll
      for (int ks = 0; ks < 2; ++ks) {
        const bf16x8 kf = *(const bf16x8*)(KIT + (16 * (2 * w + ntl) + lr) * 72 + (((4 * ks + lq) ^ (((16 * (2 * w + ntl) + lr) >> 3) & 7)) << 3));
#pragma unroll
        for (int mt = 0; mt < 2; ++mt) {
          const bf16x8 vf = *(const bf16x8*)(VTs + (16 * mt + lr) * 72 + (((4 * ks + lq) ^ (((16 * mt + lr) >> 3) & 3)) << 3));
          sacc[mt][ntl] = MFMA16(vf, kf, sacc[mt][ntl]);
        }
      }
      const float e = ntl ? eb1 : eb0;
#pragma unroll
      for (int mt = 0; mt < 2; ++mt) {
        sacc[mt][ntl] = scale4(sacc[mt][ntl], e);
#pragma unroll
        for (int jj = 0; jj < 4; ++jj) STs[(16 * mt + 4 * lq + jj) * 136 + 16 * (2 * w + ntl) + lr] = f2bf(sacc[mt][ntl][jj]);
      }
    }
    __syncthreads();
  };
#pragma unroll 1
  for (int c = 0; c < 33; c += 2) {
    body(c, qrA, krA, vrA, eblA);
    if (c + 1 < 33) body(c + 1, qrB, krB, vrB, eblB);
  }
  flush_o();
}

__device__ __forceinline__ void rglru_unit(const Params& p, const WS& ws, int j, int u, bool dry = false) {
  const int jq = u & 3, g = (u >> 2) & 7, b = u >> 5;
  bf16_t* XC = (bf16_t*)smem;
  bf16_t* WG = XC + 64 * 136;
  float* AUa = (float*)(smem + 34816);
  float* AUu = AUa + 64 * 33;
  float* SEGA = AUu + 64 * 33;
  float* SEGH = SEGA + 256;
  float* CARRY = SEGH + 256;
  const int tid = opaque_tid(), lane = tid & 63, w = tid >> 6, lr = lane & 15, lq = lane >> 4;
#pragma unroll 4
  for (int i = 0; i < 32; ++i) {
    const int e = tid + 256 * i;
    const int gate = e >> 12, k = (e >> 5) & 127, n = e & 31;
    const float* gw = gate ? p.ab_gate_x_w : p.ab_gate_a_w;
    WG[(gate * 32 + n) * 136 + k] = f2bf(gw[((size_t)(j * 8 + g) * 128 + k) * 128 + 32 * jq + n]);
  }
  if (tid < 32) CARRY[tid] = 0.f;
  float ba[2][4], bx[2][4], sp[2][4];
#pragma unroll
  for (int mt = 0; mt < 2; ++mt)
#pragma unroll
    for (int jj = 0; jj < 4; ++jj) {
      const int ch = j * 1024 + 128 * g + 32 * jq + 16 * mt + 4 * lq + jj;
      ba[mt][jj] = p.ab_gate_a_b[ch]; bx[mt][jj] = p.ab_gate_x_b[ch];
      sp[mt][jj] = 8.f * log1pf(__expf(-p.ab_lam[ch]));
    }
  const int sc = tid & 31, ssg = tid >> 5;
  u32x4 xinA[4], xinB[4];
  bf16_t gavA[8], gavB[8];
  auto prefetch = [&](int tile, u32x4 (&xin)[4], bf16_t (&gav)[8]) {
    const int t0 = 64 * tile;
#pragma unroll
    for (int i = 0; i < 4; ++i) {
      const int ci = tid + 256 * i; const int row = ci >> 4, ch = ci & 15; const int t = t0 + row;
      xin[i] = (u32x4){0, 0, 0, 0};
      if (t < T_) xin[i] = *(const u32x4*)(ws.XA + (size_t)(b * T_ + t) * 1024 + 128 * g + 8 * ch);
    }
#pragma unroll
    for (int i = 0; i < 8; ++i) {
      const int t = t0 + 8 * ssg + i;
      gav[i] = 0;
      if (t < T_) gav[i] = ws.GA[(size_t)(b * T_ + t) * 1024 + 128 * g + 32 * jq + sc];
    }
  };
  prefetch(0, xinA, gavA);
  prefetch(1, xinB, gavB);
  __syncthreads();
  bf16_t ypend[8];
  int ypend_t0 = -1;
  auto flush_y = [&]() {
    if (ypend_t0 >= 0) {
#pragma unroll
      for (int i = 0; i < 8; ++i) {
        const int t = ypend_t0 + 8 * ssg + i;
        if (t < T_ && !dry) ws.GA[(size_t)(b * T_ + t) * 1024 + 128 * g + 32 * jq + sc] = ypend[i];
      }
    }
  };
  auto body = [&](int tile, u32x4 (&xin)[4], bf16_t (&gav)[8]) {
    const int t0 = 64 * tile;
#pragma unroll
    for (int i = 0; i < 4; ++i) {
      const int ci = tid + 256 * i; const int row = ci >> 4, ch = ci & 15;
      *(u32x4*)(XC + row * 136 + 8 * ch) = xin[i];
    }
    float gcur[8];
#pragma unroll
    for (int i = 0; i < 8; ++i) gcur[i] = bf2f(gav[i]);
    __syncthreads();
    flush_y();
    if (tile + 2 < 33) prefetch(tile + 2, xin, gav);
    {
      f32x4 ga_[2][2];
#pragma unroll
      for (int a = 0; a < 2; ++a)
#pragma unroll
        for (int bb = 0; bb < 2; ++bb) ga_[a][bb] = (f32x4){0.f, 0.f, 0.f, 0.f};
#pragma unroll
      for (int ks = 0; ks < 4; ++ks) {
        const bf16x8 xf = *(const bf16x8*)(XC + (16 * w + lr) * 136 + 32 * ks + 8 * lq);
#pragma unroll
        for (int gate = 0; gate < 2; ++gate)
#pragma unroll
          for (int mt = 0; mt < 2; ++mt) {
            const bf16x8 wf = *(const bf16x8*)(WG + (gate * 32 + 16 * mt + lr) * 136 + 32 * ks + 8 * lq);
            ga_[gate][mt] = MFMA16(wf, xf, ga_[gate][mt]);
          }
      }
      const int tok = 16 * w + lr;
#pragma unroll
      for (int mt = 0; mt < 2; ++mt)
#pragma unroll
        for (int jj = 0; jj < 4; ++jj) {
          const int n = 16 * mt + 4 * lq + jj;
          const float xcv = bf2f(XC[tok * 136 + 32 * jq + n]);
          const float r = sigmoidf_(ga_[0][mt][jj] + ba[mt][jj]);
          const float ig = sigmoidf_(ga_[1][mt][jj] + bx[mt][jj]);
          const float la = -r * sp[mt][jj];
          const float a = __expf(la);
          const float x2 = 2.f * la;
          const float om = x2 > -0.02f ? -x2 * (1.f + 0.5f * x2 * (1.f + x2 * (1.f / 3.f))) : 1.f - a * a;
          const float mult = __builtin_amdgcn_sqrtf(fmaxf(om, 0.f));
          AUa[tok * 33 + n] = a;
          AUu[tok * 33 + n] = mult * ig * xcv;
        }
    }
    __syncthreads();
    {
      float A = 1.f, Hh = 0.f;
#pragma unroll
      for (int i = 0; i < 8; ++i) {
        const float a = AUa[(8 * ssg + i) * 33 + sc], uu = AUu[(8 * ssg + i) * 33 + sc];
        Hh = a * Hh + uu; A *= a;
      }
      SEGA[ssg * 32 + sc] = A; SEGH[ssg * 32 + sc] = Hh;
    }
    __syncthreads();
    float hin = CARRY[sc];
#pragma unroll
    for (int s2 = 0; s2 < 7; ++s2)
      if (s2 < ssg) hin = SEGA[s2 * 32 + sc] * hin + SEGH[s2 * 32 + sc];
    __syncthreads();
    {
      float h = hin;
#pragma unroll
      for (int i = 0; i < 8; ++i) {
        const float a = AUa[(8 * ssg + i) * 33 + sc], uu = AUu[(8 * ssg + i) * 33 + sc];
        h = a * h + uu;
        const int t = t0 + 8 * ssg + i;
        ypend[i] = f2bf(h * siluf_(gcur[i]));
      }
      if (ssg == 7) CARRY[sc] = h;
      ypend_t0 = t0;
    }
  };
#pragma unroll 1
  for (int tile = 0; tile < 33; tile += 2) {
    body(tile, xinA, gavA);
    if (tile + 1 < 33) body(tile + 1, xinB, gavB);
  }
  flush_y();
  __syncthreads();
}

__device__ __forceinline__ void phase_gla_norm(const Params& p, const WS& ws, int j) {
  const size_t gtid = (size_t)opaque_bid() * 256 + opaque_tid(), gsz = (size_t)gridDim.x * 256;
  const float* gn = p.ab_gla_norm + j * 256;
#pragma unroll 4
  for (size_t idx = gtid; idx < (size_t)M_ * 128; idx += gsz) {
    const size_t row = idx >> 7; const int c8 = (int)(idx & 127); const int hd = c8 >> 5; const int dv = (c8 & 31) * 8;
    const float4 s0 = *(const float4*)(ws.SSQ + row * 32 + hd * 8), s1 = *(const float4*)(ws.SSQ + row * 32 + hd * 8 + 4);
    const float ssum = (s0.x + s0.y + s0.z + s0.w) + (s1.x + s1.y + s1.z + s1.w);
    const float rstd = rsqrtf(ssum * (1.f / 256.f) + EPS_);
    const u32x4 ov = *(const u32x4*)(ws.V + row * 1024 + c8 * 8);
    const u32x4 gv = *(const u32x4*)(ws.GB + row * 1024 + c8 * 8);
    const float4 g0 = *(const float4*)(gn + dv), g1 = *(const float4*)(gn + dv + 4);
    float o[8] = {bflo(ov.x), bfhi(ov.x), bflo(ov.y), bfhi(ov.y), bflo(ov.z), bfhi(ov.z), bflo(ov.w), bfhi(ov.w)};
    const float gg[8] = {bflo(gv.x), bfhi(gv.x), bflo(gv.y), bfhi(gv.y), bflo(gv.z), bfhi(gv.z), bflo(gv.w), bfhi(gv.w)};
    const float nn[8] = {g0.x, g0.y, g0.z, g0.w, g1.x, g1.y, g1.z, g1.w};
#pragma unroll
    for (int e = 0; e < 8; ++e) o[e] = o[e] * rstd * nn[e] * siluf_(gg[e]);
    u32x4 pk; pk.x = cvt_pk_bf16(o[0], o[1]); pk.y = cvt_pk_bf16(o[2], o[3]); pk.z = cvt_pk_bf16(o[4], o[5]); pk.w = cvt_pk_bf16(o[6], o[7]);
    *(u32x4*)(ws.V + row * 1024 + c8 * 8) = pk;
  }
}

__device__ __forceinline__ void attn_unit(const WS& ws, int u, bool dry = false) {
  const int qb = 16 - (u >> 7); const int bh = u & 127; const int hd = bh & 15, b = bh >> 4;
  bf16_t* Kt = (bf16_t*)smem;
  bf16_t* Vl = Kt + 2 * 64 * 104;
  const int tid = opaque_tid(), lane = tid & 63, w = tid >> 6, lr = lane & 15, lq = lane >> 4;
  const int q0 = 128 * qb;
  int nkt = 2 * qb + 2; if (nkt > 33) nkt = 33;
  bf16x8 xq[2][3];
  int qi[2];
#pragma unroll
  for (int nt = 0; nt < 2; ++nt) {
    qi[nt] = q0 + 32 * w + 16 * nt + lr;
    const int qc = qi[nt] < T_ ? qi[nt] : T_ - 1;
#pragma unroll
    for (int ks = 0; ks < 2; ++ks)
      xq[nt][ks] = *(const bf16x8*)(ws.QB + (size_t)(b * T_ + qc) * 1536 + hd * 96 + 32 * ks + 8 * lq);
    {
      const u32x4 raw = *(const u32x4*)(ws.QB + (size_t)(b * T_ + qc) * 1536 + hd * 96 + 64 + 8 * lq);
      u32x4 oth;
      oth.x = __shfl_xor(raw.x, 32); oth.y = __shfl_xor(raw.y, 32); oth.z = __shfl_xor(raw.z, 32); oth.w = __shfl_xor(raw.w, 32);
      const float sgn = lq < 2 ? -1.f : 1.f;
      const float2* rp = ws.ROPE + (size_t)(b * T_ + qc) * 16 + 8 * (lq & 1);
      const unsigned rw[4] = {raw.x, raw.y, raw.z, raw.w}, ow[4] = {oth.x, oth.y, oth.z, oth.w};
      unsigned res[4];
#pragma unroll
      for (int e = 0; e < 4; ++e) {
        const float2 c0 = rp[2 * e], c1 = rp[2 * e + 1];
        const float r0 = bflo(rw[e]) * c0.x + sgn * bflo(ow[e]) * c0.y;
        const float r1 = bfhi(rw[e]) * c1.x + sgn * bfhi(ow[e]) * c1.y;
        res[e] = cvt_pk_bf16(r0, r1);
      }
      xq[nt][2] = as_bf16x8((u32x4){res[0], res[1], res[2], res[3]});
    }
  }
  float mrun[2] = {-INFINITY, -INFINITY}, lsum[2] = {0.f, 0.f};
  f32x4 oacc[4][2];
#pragma unroll
  for (int a = 0; a < 4; ++a)
#pragma unroll
    for (int bb = 0; bb < 2; ++bb) oacc[a][bb] = (f32x4){0.f, 0.f, 0.f, 0.f};
  u32x4 kregA[3], vregA[2], kregB[3], vregB[2];
  const bf16_t* vbase = ws.VT + ((size_t)(b * 16 + hd) * 64) * TP_;
  auto loadg = [&](int kt, u32x4 (&kreg)[3], u32x4 (&vreg)[2]) {
#pragma unroll
    for (int i = 0; i < 3; ++i) {
      const int ci = tid + 256 * i; const int key = ci / 12, ch = ci - key * 12;
      int gk = 64 * kt + key; if (gk > T_ - 1) gk = T_ - 1;
      const bf16_t* src = ch < 8 ? ws.KN + (size_t)(b * T_ + gk) * 1024 + hd * 64 + ch * 8
                                 : ws.KR + (size_t)(b * T_ + gk) * 32 + (ch - 8) * 8;
      kreg[i] = *(const u32x4*)src;
    }
#pragma unroll
    for (int i = 0; i < 2; ++i) {
      const int ci = tid + 256 * i; const int dv = ci >> 3, ch = ci & 7;
      vreg[i] = *(const u32x4*)(vbase + (size_t)dv * TP_ + 64 * kt + ch * 8);
      if (64 * kt + ch * 8 >= T_) vreg[i] = (u32x4){0u, 0u, 0u, 0u};
    }
  };
  auto stores = [&](int buf, const u32x4 (&kreg)[3], const u32x4 (&vreg)[2]) {
#pragma unroll
    for (int i = 0; i < 3; ++i) {
      const int ci = tid + 256 * i; const int key = ci / 12, ch = ci - key * 12;
      *(u32x4*)(Kt + buf * 64 * 104 + key * 104 + ch * 8) = kreg[i];
    }
#pragma unroll
    for (int i = 0; i < 2; ++i) {
      const int ci = tid + 256 * i; const int dv = ci >> 3, ch = ci & 7;
      *(u32x4*)(Vl + buf * 64 * 72 + dv * 72 + ch * 8) = vreg[i];
    }
  };
  const int nkt2 = (nkt + 1) & ~1;
  loadg(0, kregA, vregA);
  loadg(1, kregB, vregB);
  stores(0, kregA, vregA);
  __syncthreads();
  auto body = [&](int kt, int buf, u32x4 (&kreg)[3], u32x4 (&vreg)[2], const u32x4 (&kregn)[3], const u32x4 (&vregn)[2]) {
    { const int kn = kt + 2 < nkt2 ? kt + 2 : nkt2 - 1; loadg(kn, kreg, vreg); }
    const bf16_t* Kb = Kt + buf * 64 * 104;
    const bf16_t* Vb = Vl + buf * 64 * 72;
    f32x4 s[4][2];
#pragma unroll
    for (int mt = 0; mt < 4; ++mt) {
      s[mt][0] = (f32x4){0.f, 0.f, 0.f, 0.f}; s[mt][1] = (f32x4){0.f, 0.f, 0.f, 0.f};
#pragma unroll
      for (int ks = 0; ks < 3; ++ks) {
        const bf16x8 kf = *(const bf16x8*)(Kb + (16 * mt + lr) * 104 + 32 * ks + 8 * lq);
        s[mt][0] = MFMA16(kf, xq[0][ks], s[mt][0]);
        s[mt][1] = MFMA16(kf, xq[1][ks], s[mt][1]);
      }
    }
    if (kt >= 2 * qb) {
#pragma unroll
      for (int mt = 0; mt < 4; ++mt)
#pragma unroll
        for (int nt = 0; nt < 2; ++nt)
#pragma unroll
          for (int jj = 0; jj < 4; ++jj) {
            const int key = 64 * kt + 16 * mt + 4 * lq + jj;
            if (key > qi[nt]) s[mt][nt][jj] = -INFINITY;
          }
    }
    bf16x8 pf[2][2];
#pragma unroll
    for (int nt = 0; nt < 2; ++nt) {
      float mx = -INFINITY;
#pragma unroll
      for (int mt = 0; mt < 4; ++mt) mx = fmaxf(mx, fmaxf(fmaxf(s[mt][nt][0], s[mt][nt][1]), fmaxf(s[mt][nt][2], s[mt][nt][3])));
      mx = fmaxf(mx, __shfl_xor(mx, 16)); mx = fmaxf(mx, __shfl_xor(mx, 32));
      if (__builtin_amdgcn_ballot_w64(mx > mrun[nt]) != 0ull) {
        const float mnew = fmaxf(mrun[nt], mx);
        const float alpha = __builtin_amdgcn_exp2f(mrun[nt] - mnew);
        mrun[nt] = mnew;
        lsum[nt] *= alpha;
#pragma unroll
        for (int mt = 0; mt < 4; ++mt) oacc[mt][nt] = scale4(oacc[mt][nt], alpha);
      }
      const float mnew = mrun[nt];
      float ps = 0.f;
#pragma unroll
      for (int mt = 0; mt < 4; ++mt)
#pragma unroll
        for (int jj = 0; jj < 4; ++jj) { const float pv = __builtin_amdgcn_exp2f(s[mt][nt][jj] - mnew); s[mt][nt][jj] = pv; ps += pv; }
      lsum[nt] += ps;
#pragma unroll
      for (int ks = 0; ks < 2; ++ks) {
        u32x4 pk;
        pk.x = cvt_pk_bf16(s[2 * ks][nt][0], s[2 * ks][nt][1]); pk.y = cvt_pk_bf16(s[2 * ks][nt][2], s[2 * ks][nt][3]);
        pk.z = cvt_pk_bf16(s[2 * ks + 1][nt][0], s[2 * ks + 1][nt][1]); pk.w = cvt_pk_bf16(s[2 * ks + 1][nt][2], s[2 * ks + 1][nt][3]);
        pf[nt][ks] = as_bf16x8(pk);
      }
    }
#pragma unroll
    for (int mt = 0; mt < 4; ++mt)
#pragma unroll
      for (int ks = 0; ks < 2; ++ks) {
        const u32x2 lo = *(const u32x2*)(Vb + (16 * mt + lr) * 72 + 32 * ks + 4 * lq);
        const u32x2 hi = *(const u32x2*)(Vb + (16 * mt + lr) * 72 + 32 * ks + 16 + 4 * lq);
        const bf16x8 vf = as_bf16x8((u32x4){lo.x, lo.y, hi.x, hi.y});
        oacc[mt][0] = MFMA16(vf, pf[0][ks], oacc[mt][0]);
        oacc[mt][1] = MFMA16(vf, pf[1][ks], oacc[mt][1]);
      }
    stores(buf ^ 1, kregn, vregn);
    __syncthreads();
  };
#pragma unroll 1
  for (int kt = 0; kt < nkt2; kt += 2) {
    body(kt, 0, kregA, vregA, kregB, vregB);
    body(kt + 1, 1, kregB, vregB, kregA, vregA);
  }
#pragma unroll
  for (int nt = 0; nt < 2; ++nt) {
    float l = lsum[nt];
    l += __shfl_xor(l, 16); l += __shfl_xor(l, 32);
    const float inv = 1.f / l;
    if (qi[nt] < T_) {
      const size_t row = (size_t)(b * T_ + qi[nt]);
#pragma unroll
      for (int mt = 0; mt < 4; ++mt) {
        const u32x2 gv = *(const u32x2*)(ws.GATE + row * 1024 + hd * 64 + 16 * mt + 4 * lq);
        const float o0 = oacc[mt][nt][0] * inv * siluf_(bflo(gv.x)), o1 = oacc[mt][nt][1] * inv * siluf_(bfhi(gv.x));
        const float o2 = oacc[mt][nt][2] * inv * siluf_(bflo(gv.y)), o3 = oacc[mt][nt][3] * inv * siluf_(bfhi(gv.y));
        u32x2 pk; pk.x = cvt_pk_bf16(o0, o1); pk.y = cvt_pk_bf16(o2, o3);
        if (!dry) *(u32x2*)(ws.QB + row * 1536 + hd * 96 + 16 * mt + 4 * lq) = pk;
      }
    }
  }
}

__device__ __forceinline__ void phase_final(const Params& p, const WS& ws) {
  const int tidf = opaque_tid();
  const int lane = tidf & 63;
  const int gw = opaque_bid() * 4 + (tidf >> 6), nw = gridDim.x * 4;
#pragma unroll 2
  for (int r = gw; r < 8 * 2048; r += nw) {
    const int b = r >> 11, s = r & 2047;
    const size_t hoff = (size_t)(b * T_ + 16 + s) * 1024;
    float4 v[4];
    float ssum = 0.f;
#pragma unroll
    for (int i = 0; i < 4; ++i) {
      const u32x2 hi = *(const u32x2*)(ws.HHI + hoff + i * 256 + lane * 4), lo = *(const u32x2*)(ws.HLO + hoff + i * 256 + lane * 4);
      v[i] = make_float4(bflo(hi.x) + bflo(lo.x), bfhi(hi.x) + bfhi(lo.x), bflo(hi.y) + bflo(lo.y), bfhi(hi.y) + bfhi(lo.y));
      ssum += v[i].x * v[i].x + v[i].y * v[i].y + v[i].z * v[i].z + v[i].w * v[i].w;
    }
#pragma unroll
    for (int o = 1; o < 64; o <<= 1) ssum += __shfl_xor(ssum, o);
    const float rstd = rsqrtf(ssum * (1.f / 1024.f) + EPS_);
#pragma unroll
    for (int i = 0; i < 4; ++i) {
      const float4 g = *(const float4*)(p.final_norm + i * 256 + lane * 4);
      float4 o; o.x = v[i].x * rstd * g.x; o.y = v[i].y * rstd * g.y; o.z = v[i].z * rstd * g.z; o.w = v[i].w * rstd * g.w;
      *(float4*)(p.out + (size_t)r * 1024 + i * 256 + lane * 4) = o;
    }
  }
}

__global__ void __launch_bounds__(256, 2) fwd_megakernel(Params p) {
  cg::grid_group grid = cg::this_grid();
  if (p.inv_freq[0] < 0.f) grid.sync();
  volatile LAS unsigned* xst = (volatile LAS unsigned*)(smem + SMEM_BYTES);
  if (threadIdx.x == 0) { xst[0] = 0u; xst[1] = 0u; xst[2] = 0u; xst[3] = 0u; }
  __syncthreads();
  const XcdBarrier xb = xcd_barrier_post((unsigned*)(p.ws + BAR_OFF), xst);
  {
    const WS ws = make_ws(p);
    phase_prologue(p, ws);
  }
  xcd_barrier(xb);
#pragma unroll 1
  for (int layer = 0; layer < 4; ++layer) {
    const int j = layer >> 1;
    if ((layer & 1) == 0) {
      {
        const WS ws = make_ws(p);
        const bf16_t* wb = ws.W + (size_t)j * W_PER_J;
#pragma unroll 1
        for (int rep = 0; rep < REP_GEMM; ++rep)
          gemm_stream<true, EPI_E1, 4>(ws, ws.HHI, nullptr, 1024, 1 << 30, 64, wb + W_IN_E, 1024, 1.f / 1024.f, 41, 129 * 41, xcd_bid(opaque_bid()), false);
      }
      xcd_barrier(xb);
      {
        const WS ws = make_ws(p);
#pragma unroll 1
        for (int u = opaque_bid(); u < 8 * 4 * 33 + 64; u += gridDim.x) {
          if (u < 64) conv_unit(p, ws, j, u); else gla_decay_unit(p, ws, j, u - 64);
        }
      }
      xcd_barrier(xb);
      {
#pragma unroll 1
        for (int rep = 0; rep < REP_E2; ++rep)
#pragma unroll 1
        for (int u = opaque_bid(); u < 512; u += gridDim.x) {
          if (u >= 256) { const WS ws = make_ws(p); rglru_unit(p, ws, j, u - 256, rep < REP_E2 - 1); }
          else { const WS ws = make_ws(p); gla_unit(p, ws, u, rep < REP_E2 - 1); }
        }
      }
      xcd_barrier(xb);
      {
        const WS ws = make_ws(p);
        phase_gla_norm(p, ws, j);
      }
      xcd_barrier(xb);
      {
        const WS ws = make_ws(p);
        const bf16_t* wb = ws.W + (size_t)j * W_PER_J;
#pragma unroll 1
        for (int rep = 0; rep < REP_GEMM; ++rep)
          gemm_stream<false, EPI_RES, 5>(ws, ws.GA, ws.V, 1024, 16, 64, wb + W_OUT_E, 2048, 0.f, 8, 128 * 8, xcd_bid(opaque_bid()), rep < REP_GEMM - 1);
      }
      xcd_barrier(xb);
    } else {
      {
        const WS ws = make_ws(p);
        const bf16_t* wb = ws.W + (size_t)j * W_PER_J;
#pragma unroll 1
        for (int rep = 0; rep < REP_GEMM; ++rep)
          gemm_stream<true, EPI_O1, 4>(ws, ws.HHI, nullptr, 1024, 1 << 30, 64, wb + W_IN_O, 1024, 1.f / 1024.f, 15, 129 * 15, xcd_bid(opaque_bid()), false);
      }
      xcd_barrier(xb);
      {
        const WS ws = make_ws(p);
        const bf16_t* wb = ws.W + (size_t)j * W_PER_J;
#pragma unroll 1
        for (int rep = 0; rep < REP_GEMM; ++rep) {
          gemm_stream<true, EPI_Q, 4>(ws, ws.CQ, nullptr, 512, 1 << 30, 64, wb + W_Q, 512, 1.f / 512.f, 12, 129 * 12, xcd_bid(opaque_bid()), false);
          gemm_stream<true, EPI_KV, 4>(ws, ws.CKV, nullptr, 256, 1 << 30, 64, wb + W_KV, 256, 1.f / 256.f, 16, 129 * 16, xcd_bid((opaque_bid() + (int)(gridDim.x >> 1)) % (int)gridDim.x), false);
        }
      }
      xcd_barrier(xb);
      {
        const WS ws = make_ws(p);
#pragma unroll 1
        for (int rep = 0; rep < REP_ATTN; ++rep)
#pragma unroll 1
        for (int r = 0, b0 = opaque_bid(); r * (int)gridDim.x < 17 * 128; ++r) {
          const int u = r * (int)gridDim.x + ((r & 1) ? (int)gridDim.x - 1 - b0 : b0);
          if (u < 17 * 128) attn_unit(ws, u, rep < REP_ATTN - 1);
          __syncthreads();
        }
      }
      xcd_barrier(xb);
      {
        const WS ws = make_ws(p);
        const bf16_t* wb = ws.W + (size_t)j * W_PER_J;
#pragma unroll 1
        for (int rep = 0; rep < REP_GEMM; ++rep)
          gemm_stream<false, EPI_RES, 5>(ws, ws.QB, nullptr, 1536, 1 << 30, 96, wb + W_O, 1024, 0.f, 8, 128 * 8, xcd_bid(opaque_bid()), rep < REP_GEMM - 1);
      }
      xcd_barrier(xb);
    }
  }
  {
    const WS ws = make_ws(p);
    phase_final(p, ws);
  }
}

extern "C" void kernel_launch(void* const* d_in, const int* in_sizes, int n_in, void* d_out, int out_size, void* d_ws,
                              size_t ws_size, hipStream_t stream) {
  static int grid_blocks = 0;
  if (!grid_blocks) {
    int dev = 0, cus = 0, per_cu = 0;
    hipGetDevice(&dev);
    hipDeviceGetAttribute(&cus, hipDeviceAttributeMultiprocessorCount, dev);
    hipOccupancyMaxActiveBlocksPerMultiprocessor(&per_cu, fwd_megakernel, 256, 0);
    if (per_cu < 1) per_cu = 1;
    if (per_cu > 2) per_cu = 2;
    grid_blocks = cus * per_cu;
  }
  Params p{};
  p.x = (const float*)d_in[0]; p.positions = (const int*)d_in[1]; p.meta = (const float*)d_in[2];
  p.ab_norm = (const float*)d_in[3]; p.ab_w_in = (const float*)d_in[4]; p.ab_conv_w = (const float*)d_in[5];
  p.ab_conv_b = (const float*)d_in[6]; p.ab_gate_a_w = (const float*)d_in[7]; p.ab_gate_a_b = (const float*)d_in[8];
  p.ab_gate_x_w = (const float*)d_in[9]; p.ab_gate_x_b = (const float*)d_in[10]; p.ab_lam = (const float*)d_in[11];
  p.ab_alpha_w = (const float*)d_in[12]; p.ab_alpha_b = (const float*)d_in[13]; p.ab_gla_norm = (const float*)d_in[14];
  p.ab_w_out = (const float*)d_in[15]; p.c_norm = (const float*)d_in[16]; p.c_w_in = (const float*)d_in[17];
  p.c_q_norm = (const float*)d_in[18]; p.c_w_q_up = (const float*)d_in[19]; p.c_kv_norm = (const float*)d_in[20];
  p.c_w_kv_up = (const float*)d_in[21]; p.c_w_out = (const float*)d_in[22]; p.final_norm = (const float*)d_in[23];
  p.out = (float*)d_out;
  p.ws = (unsigned char*)d_ws;
  for (int i = 0; i < 16; ++i) p.inv_freq[i] = (float)pow(10000.0, -(double)i / 16.0);
  hipMemsetAsync((unsigned char*)d_ws + BAR_OFF, 0, XCD_BAR_WORDS * 4, stream);
  void* args[] = {&p};
  hipError_t e = hipLaunchCooperativeKernel((void*)fwd_megakernel, dim3(grid_blocks), dim3(256), args, 0, stream);
  if (e != hipSuccess) fprintf(stderr, "cooperative launch failed: %s (grid %d)\n", hipGetErrorString(e), grid_blocks);
}
```

```cpp
#include <hip/hip_runtime.h>
#include <hip/hip_cooperative_groups.h>
#include <cstdio>
#include <cmath>
namespace cg = cooperative_groups;

typedef unsigned short bf16_t;
typedef short bf16x8 __attribute__((ext_vector_type(8)));
typedef float f32x4 __attribute__((ext_vector_type(4)));
typedef unsigned u32x4 __attribute__((ext_vector_type(4)));
typedef unsigned u32x2 __attribute__((ext_vector_type(2)));

constexpr int T_ = 2064;
constexpr int M_ = 8 * T_;
constexpr int TP_ = 2112;
constexpr float EPS_ = 1e-6f;
constexpr int SMEM_BYTES = 75776;
constexpr float QSCALE_MLA = 0.10206207261596575f * 1.4426950408889634f;

constexpr size_t W_PER_J = 11796480;
constexpr size_t W_IN_E = 0, W_OUT_E = 5373952, W_IN_O = 7471104, W_Q = 9437184, W_KV = 10223616, W_O = 10747904;

struct Params {
  const float* x; const int* positions; const float* meta;
  const float *ab_norm, *ab_w_in, *ab_conv_w, *ab_conv_b, *ab_gate_a_w, *ab_gate_a_b, *ab_gate_x_w, *ab_gate_x_b,
      *ab_lam, *ab_alpha_w, *ab_alpha_b, *ab_gla_norm, *ab_w_out;
  const float *c_norm, *c_w_in, *c_q_norm, *c_w_q_up, *c_kv_norm, *c_w_kv_up, *c_w_out, *final_norm;
  float* out;
  unsigned char* ws;
  float inv_freq[16];
};

struct WS {
  bf16_t *HHI, *HLO; float2* ROPE;
  bf16_t *XA, *GA, *Q, *K, *V, *GB, *AD; float* SSQ; float* BL;
  bf16_t *CQ, *CKV, *GATE, *KR, *QB, *KN, *VT;
  bf16_t* W;
};

__device__ __forceinline__ unsigned char* opaque_ptr(unsigned char* q) {
  unsigned lo = (unsigned)(unsigned long long)q, hi = (unsigned)((unsigned long long)q >> 32);
  asm volatile("" : "+v"(lo), "+v"(hi));
  lo = __builtin_amdgcn_readfirstlane(lo); hi = __builtin_amdgcn_readfirstlane(hi);
  typedef __attribute__((address_space(1))) unsigned char gu8;
  return (unsigned char*)(gu8*)(((unsigned long long)hi << 32) | lo);
}
__device__ __forceinline__ WS make_ws(const Params& p) {
  WS w;
  unsigned char* b = opaque_ptr(p.ws);
  w.HHI = (bf16_t*)b; b += (size_t)M_ * 2048;
  w.HLO = (bf16_t*)b; b += (size_t)M_ * 2048;
  w.ROPE = (float2*)b; b += (size_t)M_ * 128;
  unsigned char* r = b;
  w.XA = (bf16_t*)r; r += (size_t)M_ * 2048;
  w.GA = (bf16_t*)r; r += (size_t)M_ * 2048;
  w.Q = (bf16_t*)r; r += (size_t)M_ * 1024;
  w.K = (bf16_t*)r; r += (size_t)M_ * 1024;
  w.V = (bf16_t*)r; r += (size_t)M_ * 2048;
  w.GB = (bf16_t*)r; r += (size_t)M_ * 2048;
  w.AD = (bf16_t*)r; r += (size_t)M_ * 32;
  w.SSQ = (float*)r; r += (size_t)M_ * 128;
  w.BL = (float*)r; r += (size_t)8 * 4 * 33 * 128 * 4;
  r = b;
  w.CQ = (bf16_t*)r; r += (size_t)M_ * 1024;
  w.CKV = (bf16_t*)r; r += (size_t)M_ * 512;
  w.GATE = (bf16_t*)r; r += (size_t)M_ * 2048;
  w.KR = (bf16_t*)r; r += (size_t)M_ * 64;
  w.QB = (bf16_t*)r; r += (size_t)M_ * 3072;
  w.KN = (bf16_t*)r; r += (size_t)M_ * 2048;
  w.VT = (bf16_t*)r; r += (size_t)128 * 64 * TP_ * 2;
  w.W = (bf16_t*)opaque_ptr((unsigned char*)p.out);
  return w;
}

__device__ __forceinline__ unsigned cvt_pk_bf16(float lo, float hi) {
  typedef float f32x2_t __attribute__((ext_vector_type(2)));
  typedef __bf16 bf16x2_t __attribute__((ext_vector_type(2)));
  const f32x2_t v = {lo, hi};
  const bf16x2_t r = __builtin_convertvector(v, bf16x2_t);
  return __builtin_bit_cast(unsigned, r);
}
__device__ __forceinline__ f32x4 scale4(f32x4 a, float r) {
  asm volatile("" : "+v"(r));
  float x0 = a[0] * r, x1 = a[1] * r, x2 = a[2] * r, x3 = a[3] * r;
  asm volatile("" : "+v"(x0), "+v"(x1), "+v"(x2), "+v"(x3));
  return (f32x4){x0, x1, x2, x3};
}
__device__ __forceinline__ float bf2f(bf16_t v) { return __uint_as_float(((unsigned)v) << 16); }
__device__ __forceinline__ float bflo(unsigned v) { return __uint_as_float(v << 16); }
__device__ __forceinline__ float bfhi(unsigned v) { return __uint_as_float(v & 0xffff0000u); }
__device__ __forceinline__ bf16_t f2bf(float f) { return (bf16_t)(cvt_pk_bf16(f, 0.f) & 0xffffu); }
__device__ __forceinline__ float sigmoidf_(float x) { return __builtin_amdgcn_rcpf(1.f + __expf(-x)); }
__device__ __forceinline__ float siluf_(float x) { return x * __builtin_amdgcn_rcpf(1.f + __expf(-x)); }
__device__ __forceinline__ bf16x8 as_bf16x8(u32x4 v) { return __builtin_bit_cast(bf16x8, v); }
__device__ __forceinline__ int half_id() { return __builtin_amdgcn_readfirstlane((int)(threadIdx.x >> 8)); }
__device__ __forceinline__ int opaque_tid() { int t = threadIdx.x & 255; asm volatile("" : "+v"(t)); return t; }
__device__ __forceinline__ int opaque_tid512() { int t = threadIdx.x; asm volatile("" : "+v"(t)); return t; }
__device__ __forceinline__ int xcd_bid(int bid) { const int gpx = gridDim.x >> 3; return (bid & 7) * gpx + (bid >> 3); }
__device__ __forceinline__ int opaque_bid() { int t = blockIdx.x * 2 + half_id(); asm volatile("" : "+s"(t)); return t; }
__device__ __forceinline__ int opaque_rbid() { int t = blockIdx.x; asm volatile("" : "+s"(t)); return t; }
#define NVB ((int)gridDim.x * 2)
#define MFMA16(a, b, c) __builtin_amdgcn_mfma_f32_16x16x32_bf16((a), (b), (c), 0, 0, 0)

__shared__ __attribute__((aligned(16))) unsigned char smem_all[2 * SMEM_BYTES + 16];
#define smem (smem_all + half_id() * SMEM_BYTES)

#define XB_TMO      128
#define XB_XCNT(j)  (256  + 64 * (j))
#define XB_XSUB(j)  (1280 + 64 * (j))
#define XB_XGEN(j)  (2304 + 64 * (j))
#define XB_TOP      3328
#define XB_TOPGEN   3392
#define XCD_BAR_WORDS 3456
#define XB_SPIN_CAP (1u << 18)
#define LAS __attribute__((address_space(3)))
constexpr size_t BAR_OFF = 260046848;

__device__ __forceinline__ unsigned xb_ld(unsigned* p)              { return __hip_atomic_load(p, __ATOMIC_RELAXED, __HIP_MEMORY_SCOPE_AGENT); }
__device__ __forceinline__ unsigned xb_add(unsigned* p, unsigned v) { return __hip_atomic_fetch_add(p, v, __ATOMIC_RELAXED, __HIP_MEMORY_SCOPE_AGENT); }
__device__ __forceinline__ unsigned xb_xcc_id() { return (unsigned)__builtin_amdgcn_s_getreg((3 << 11) | 20) & 0xFu; }
#define XB_SPIN(cond, bar) do { unsigned _sp = 0; while (cond) { __builtin_amdgcn_s_sleep(1); \
    if ((++_sp & 255u) == 0u) { if (xb_ld(&(bar)[XB_TMO])) break; if (_sp > XB_SPIN_CAP) { atomicAdd(&(bar)[XB_TMO], 1u); break; } } } } while (0)

struct XcdBarrier { unsigned* bar; unsigned x; volatile LAS unsigned* st; };

__device__ __forceinline__ XcdBarrier xcd_barrier_post(unsigned* bar, volatile LAS unsigned* st) {
    XcdBarrier b; b.bar = bar; b.x = xb_xcc_id(); b.st = st;
    if (threadIdx.x == 0) (void)xb_add(&bar[XB_XCNT(b.x)], 1u);
    return b;
}
__device__ __forceinline__ void xcd_barrier_complete(unsigned* bar, unsigned x, unsigned& nloc, unsigned& nx) {
    const unsigned G = gridDim.x * gridDim.y * gridDim.z;
    unsigned sum, cnt, mine, sp = 0u;
    for (;;) {
        sum = 0u; cnt = 0u; mine = 0u;
#pragma unroll
        for (unsigned j = 0; j < 16; ++j) { const unsigned c = xb_ld(&bar[XB_XCNT(j)]); sum += c; cnt += (c > 0u) ? 1u : 0u; mine = (j == x) ? c : mine; }
        if (sum == G) break;
        __builtin_amdgcn_s_sleep(1);
        if ((++sp & 255u) == 0u) { if (xb_ld(&bar[XB_TMO])) break; if (sp > XB_SPIN_CAP) { atomicAdd(&bar[XB_TMO], 1u); break; } }
    }
    nloc = mine > 0u ? mine : 1u; nx = cnt > 0u ? cnt : 1u;
}
__device__ __forceinline__ void xcd_barrier(const XcdBarrier& b) {
    asm volatile("s_waitcnt vmcnt(0)" ::: "memory");
    __syncthreads();
    if (threadIdx.x == 0) {
        unsigned* bar = b.bar;
        __builtin_amdgcn_s_waitcnt(0);
        unsigned nloc = b.st[0], nx = b.st[1];
        if (nloc == 0u) { xcd_barrier_complete(bar, b.x, nloc, nx); b.st[0] = nloc; b.st[1] = nx; }
        const unsigned old = xb_add(&bar[XB_XSUB(b.x)], 1u);
        const unsigned gen = old / nloc;
        if (old + 1u == (gen + 1u) * nloc) {
            __builtin_amdgcn_fence(__ATOMIC_RELEASE, "agent");
            asm volatile("s_waitcnt vmcnt(0)" ::: "memory");
            const unsigned og = xb_add(&bar[XB_TOP], 1u);
            const unsigned tg = og / nx;
            if (og + 1u == (tg + 1u) * nx) xb_add(&bar[XB_TOPGEN], 1u);
            else XB_SPIN(xb_ld(&bar[XB_TOPGEN]) == tg, bar);
            __builtin_amdgcn_fence(__ATOMIC_ACQUIRE, "agent");
            xb_add(&bar[XB_XGEN(b.x)], 1u);
            asm volatile("s_waitcnt vmcnt(0)" ::: "memory");
        } else {
            XB_SPIN(xb_ld(&bar[XB_XGEN(b.x)]) == gen, bar);
            __builtin_amdgcn_fence(__ATOMIC_ACQUIRE, "agent");
            asm volatile("s_waitcnt vmcnt(0)" ::: "memory");
        }
    }
    __syncthreads();
}


__device__ __forceinline__ int map_even_in(int n) { return n < 4096 ? n : (n < 5120 ? n + 16 : (n < 5136 ? n - 1024 : -1)); }
__device__ __forceinline__ int map_odd_in(int n) { return n < 768 ? n : (n < 1792 ? n + 32 : (n < 1824 ? n - 1024 : -1)); }

__device__ __forceinline__ void convert_tile(const float* __restrict__ src, int K, int Nsrc, bf16_t* __restrict__ dst,
                                             int kind, const float* __restrict__ g, int tile) {
  float* tl = (float*)smem;
  const int nkt = K >> 7;
  const int ntile = tile / nkt, ktile = tile - ntile * nkt;
  const int n0 = ntile * 64, k0 = ktile * 128;
  const int tid = opaque_tid();
  const int nl = tid & 63, kq = tid >> 6;
  const int n = n0 + nl;
  const int sc = kind == 0 ? map_even_in(n) : (kind == 1 ? map_odd_in(n) : n);
  float cs = 1.f;
  if (kind == 0 && n >= 2048 && n < 2560) cs = 0.08838834764831845f;
  if (kind == 2) cs = QSCALE_MLA;
  float v[32];
#pragma unroll
  for (int i = 0; i < 32; ++i) {
    const int kl = kq + 4 * i;
    v[i] = 0.f;
    if (sc >= 0) v[i] = src[(size_t)(k0 + kl) * Nsrc + sc];
  }
#pragma unroll
  for (int i = 0; i < 32; ++i) {
    const int kl = kq + 4 * i;
    float t = v[i] * cs;
    if (g) t *= g[k0 + kl];
    tl[kl * 65 + nl] = t;
  }
  __syncthreads();
#pragma unroll
  for (int i = 0; i < 4; ++i) {
    const int c = tid + 256 * i;
    const int nl2 = c >> 4, kc = c & 15;
    float t[8];
#pragma unroll
    for (int jj = 0; jj < 8; ++jj) t[jj] = tl[(kc * 8 + jj) * 65 + nl2];
    u32x4 pk;
    pk.x = cvt_pk_bf16(t[0], t[1]); pk.y = cvt_pk_bf16(t[2], t[3]); pk.z = cvt_pk_bf16(t[4], t[5]); pk.w = cvt_pk_bf16(t[6], t[7]);
    *(u32x4*)(dst + (size_t)(n0 + nl2) * K + k0 + kc * 8) = pk;
  }
  __syncthreads();
}

__device__ __forceinline__ void phase_prologue(const Params& p, const WS& ws) {
  for (int id = opaque_bid(); id < 2880; id += NVB) {
    const int j = id / 1440; int r = id - j * 1440;
    bf16_t* wb = ws.W + (size_t)j * W_PER_J;
    if (r < 656) convert_tile(p.ab_w_in + (size_t)j * 1024 * 5136, 1024, 5136, wb + W_IN_E, 0, p.ab_norm + j * 1024, r);
    else if ((r -= 656) < 256) convert_tile(p.ab_w_out + (size_t)j * 2048 * 1024, 2048, 1024, wb + W_OUT_E, 3, nullptr, r);
    else if ((r -= 256) < 240) convert_tile(p.c_w_in + (size_t)j * 1024 * 1824, 1024, 1824, wb + W_IN_O, 1, p.c_norm + j * 1024, r);
    else if ((r -= 240) < 96) convert_tile(p.c_w_q_up + (size_t)j * 512 * 1536, 512, 1536, wb + W_Q, 2, p.c_q_norm + j * 512, r);
    else if ((r -= 96) < 64) convert_tile(p.c_w_kv_up + (size_t)j * 256 * 2048, 256, 2048, wb + W_KV, 3, p.c_kv_norm + j * 256, r);
    else { r -= 64; convert_tile(p.c_w_out + (size_t)j * 1024 * 1024, 1024, 1024, wb + W_O, 3, nullptr, r); }
  }
  const size_t gtid = (size_t)opaque_bid() * 256 + opaque_tid(), gsz = (size_t)NVB * 256;
  for (size_t idx0 = gtid; idx0 < (size_t)M_ * 256; idx0 += 4 * gsz) {
    float4 v4[4];
#pragma unroll
    for (int q = 0; q < 4; ++q) {
      const size_t idx = idx0 + q * gsz;
      v4[q] = make_float4(0.f, 0.f, 0.f, 0.f);
      if (idx < (size_t)M_ * 256) {
        const int row = (int)(idx >> 8), c4 = (int)(idx & 255);
        const int b = row / T_, t = row - b * T_;
        const float* src = t < 16 ? p.meta + (size_t)t * 1024 : p.x + ((size_t)b * 2048 + (t - 16)) * 1024;
        v4[q] = *(const float4*)(src + c4 * 4);
      }
    }
#pragma unroll
    for (int q = 0; q < 4; ++q) {
      const size_t idx = idx0 + q * gsz;
      if (idx < (size_t)M_ * 256) {
        const float4 v = v4[q];
        u32x2 hi; hi.x = cvt_pk_bf16(v.x, v.y); hi.y = cvt_pk_bf16(v.z, v.w);
        u32x2 lo; lo.x = cvt_pk_bf16(v.x - bflo(hi.x), v.y - bfhi(hi.x)); lo.y = cvt_pk_bf16(v.z - bflo(hi.y), v.w - bfhi(hi.y));
        *(u32x2*)(ws.HHI + idx * 4) = hi;
        *(u32x2*)(ws.HLO + idx * 4) = lo;
      }
    }
  }
  for (size_t idx = gtid; idx < (size_t)M_ * 16; idx += gsz) {
    const int row = (int)(idx >> 4), i = (int)(idx & 15);
    const int b = row / T_, t = row - b * T_;
    const int pos = t < 16 ? t : p.positions[b * 2048 + (t - 16)] + 16;
    const float angf = (float)pos * p.inv_freq[i];
    const double rev = (double)angf * 0.15915494309189533577;
    const float fr = (float)(rev - rint(rev));
    ws.ROPE[idx] = make_float2(__builtin_amdgcn_cosf(fr), __builtin_amdgcn_sinf(fr));
  }
}

#ifndef REP_GEMM
#define REP_GEMM 1
#endif
#ifndef REP_ATTN
#define REP_ATTN 1
#endif
#ifndef REP_E2
#define REP_E2 1
#endif
enum { EPI_E1 = 0, EPI_O1 = 1, EPI_Q = 2, EPI_KV = 3, EPI_RES = 4 };

template <int EPI, int TI>
__device__ __forceinline__ void gemm_epilogue(const WS& ws, const f32x4 (&acc)[4][TI], const float (&rs)[TI], int tok0, int n0,
                                              int wm, int wn, int lr, int lq, bool dry) {
  auto tokr = [&](int ti) { return tok0 + (ti < 4 ? wn * 64 + ti * 16 : 128 + wn * 16) + lr; };
  auto okr = [&](int ti) { return ti < 4 || (wn == 0 && lr == 0); };
  const int nw = n0 + wm * 64;
  if (EPI == EPI_E1) {
    bf16_t* dst; int ld, c;
    if (n0 < 1024) { dst = ws.XA; ld = 1024; c = n0; }
    else if (n0 < 2048) { dst = ws.GA; ld = 1024; c = n0 - 1024; }
    else if (n0 < 2560) { dst = ws.Q; ld = 512; c = n0 - 2048; }
    else if (n0 < 3072) { dst = ws.K; ld = 512; c = n0 - 2560; }
    else if (n0 < 4096) { dst = ws.V; ld = 1024; c = n0 - 3072; }
    else if (n0 < 5120) { dst = ws.GB; ld = 1024; c = n0 - 4096; }
    else { dst = ws.AD; ld = 16; c = 0; }
    const bool isad = n0 >= 5120;
#pragma unroll
    for (int ni = 0; ni < 4; ++ni) {
      if (isad && (wm != 0 || ni != 0)) continue;
#pragma unroll
      for (int ti = 0; ti < TI; ++ti) {
        const f32x4 v = scale4(acc[ni][ti], rs[ti]);
        u32x2 pk; pk.x = cvt_pk_bf16(v[0], v[1]); pk.y = cvt_pk_bf16(v[2], v[3]);
        if (okr(ti)) *(u32x2*)(dst + (size_t)tokr(ti) * ld + c + wm * 64 + ni * 16 + 4 * lq) = pk;
      }
    }
  } else if (EPI == EPI_O1) {
    if (n0 < 1792) {
      bf16_t* dst; int ld, c;
      if (n0 < 512) { dst = ws.CQ; ld = 512; c = n0; }
      else if (n0 < 768) { dst = ws.CKV; ld = 256; c = n0 - 512; }
      else { dst = ws.GATE; ld = 1024; c = n0 - 768; }
#pragma unroll
      for (int ni = 0; ni < 4; ++ni)
#pragma unroll
        for (int ti = 0; ti < TI; ++ti) {
          const f32x4 v = scale4(acc[ni][ti], rs[ti]);
          u32x2 pk; pk.x = cvt_pk_bf16(v[0], v[1]); pk.y = cvt_pk_bf16(v[2], v[3]);
          if (okr(ti)) *(u32x2*)(dst + (size_t)tokr(ti) * ld + c + wm * 64 + ni * 16 + 4 * lq) = pk;
        }
    } else if (wm == 0) {
#pragma unroll
      for (int ti = 0; ti < TI; ++ti) {
        const int tok = tokr(ti);
        const f32x4 x1 = scale4(acc[0][ti], rs[ti]), x2 = scale4(acc[1][ti], rs[ti]);
        float o1[4], o2[4];
#pragma unroll
        for (int jj = 0; jj < 4; ++jj) {
          const float2 cs = ws.ROPE[(size_t)tok * 16 + 4 * lq + jj];
          o1[jj] = x1[jj] * cs.x - x2[jj] * cs.y;
          o2[jj] = x2[jj] * cs.x + x1[jj] * cs.y;
        }
        u32x2 pk; pk.x = cvt_pk_bf16(o1[0], o1[1]); pk.y = cvt_pk_bf16(o1[2], o1[3]);
        *(u32x2*)(ws.KR + (size_t)tok * 32 + 4 * lq) = pk;
        pk.x = cvt_pk_bf16(o2[0], o2[1]); pk.y = cvt_pk_bf16(o2[2], o2[3]);
        *(u32x2*)(ws.KR + (size_t)tok * 32 + 16 + 4 * lq) = pk;
      }
    }
  } else if (EPI == EPI_Q) {
#pragma unroll
    for (int ni = 0; ni < 4; ++ni)
#pragma unroll
      for (int ti = 0; ti < TI; ++ti) {
        const f32x4 v = scale4(acc[ni][ti], rs[ti]);
        u32x2 pk; pk.x = cvt_pk_bf16(v[0], v[1]); pk.y = cvt_pk_bf16(v[2], v[3]);
        if (okr(ti)) *(u32x2*)(ws.QB + (size_t)tokr(ti) * 1536 + nw + ni * 16 + 4 * lq) = pk;
      }
  } else if (EPI == EPI_KV) {
    const int hd = nw >> 7;
    const bool isv = (nw & 127) >= 64;
    if (!isv) {
#pragma unroll
      for (int ni = 0; ni < 4; ++ni)
#pragma unroll
        for (int ti = 0; ti < TI; ++ti) {
          const f32x4 v = scale4(acc[ni][ti], rs[ti]);
          u32x2 pk; pk.x = cvt_pk_bf16(v[0], v[1]); pk.y = cvt_pk_bf16(v[2], v[3]);
          if (okr(ti)) *(u32x2*)(ws.KN + (size_t)tokr(ti) * 1024 + hd * 64 + ni * 16 + 4 * lq) = pk;
        }
    } else {
#pragma unroll
      for (int ti = 0; ti < TI; ++ti) {
        const int tok = tokr(ti);
        const int b = tok / T_, t = tok - b * T_;
        bf16_t* vb = ws.VT + ((size_t)(b * 16 + hd) * 64) * TP_ + t;
#pragma unroll
        for (int ni = 0; ni < 4; ++ni) {
          const f32x4 v = scale4(acc[ni][ti], rs[ti]);
#pragma unroll
          for (int jj = 0; jj < 4; ++jj) if (okr(ti)) vb[(size_t)(ni * 16 + 4 * lq + jj) * TP_] = f2bf(v[jj]);
        }
      }
    }
  } else {
#pragma unroll
    for (int ni = 0; ni < 4; ++ni)
#pragma unroll
      for (int ti = 0; ti < TI; ++ti) {
        if (!okr(ti)) continue;
        const size_t off = (size_t)tokr(ti) * 1024 + nw + ni * 16 + 4 * lq;
        const u32x2 hi = *(const u32x2*)(ws.HHI + off), lo = *(const u32x2*)(ws.HLO + off);
        const float h0 = bflo(hi.x) + bflo(lo.x) + acc[ni][ti][0], h1 = bfhi(hi.x) + bfhi(lo.x) + acc[ni][ti][1];
        const float h2 = bflo(hi.y) + bflo(lo.y) + acc[ni][ti][2], h3 = bfhi(hi.y) + bfhi(lo.y) + acc[ni][ti][3];
        u32x2 nh; nh.x = cvt_pk_bf16(h0, h1); nh.y = cvt_pk_bf16(h2, h3);
        u32x2 nl; nl.x = cvt_pk_bf16(h0 - bflo(nh.x), h1 - bfhi(nh.x)); nl.y = cvt_pk_bf16(h2 - bflo(nh.y), h3 - bfhi(nh.y));
        if (!dry) { *(u32x2*)(ws.HHI + off) = nh; *(u32x2*)(ws.HLO + off) = nl; }
      }
  }
}

__device__ __forceinline__ float sumsq8(bf16x8 v) {
  const u32x4 u = __builtin_bit_cast(u32x4, v);
  float s = 0.f, t;
  t = bflo(u.x); s += t * t; t = bfhi(u.x); s += t * t; t = bflo(u.y); s += t * t; t = bfhi(u.y); s += t * t;
  t = bflo(u.z); s += t * t; t = bfhi(u.z); s += t * t; t = bflo(u.w); s += t * t; t = bfhi(u.w); s += t * t;
  return s;
}
__device__ __forceinline__ void tile_of(int pos, int ntn, int& mt, int& nt) {
  const int full = 64 * ntn;
  if (pos < full) { const int panel = pos / (8 * ntn); const int rem = pos - panel * 8 * ntn; nt = rem >> 3; mt = panel * 8 + (rem & 7); }
  else { mt = 64; nt = pos - full; }
}
template <int EPI>
__device__ __forceinline__ void gemm_wide(const WS& ws, const bf16_t* A, int lda, const bf16_t* __restrict__ W, int K, float invK,
                                          int ntn, int ntiles, int bid) {
  unsigned char* As = smem_all + half_id() * 32768;
  unsigned char* Bs = smem_all + 65536;
  float* rsl = (float*)(smem_all + 131072 + half_id() * 1024);
  const int tid = opaque_tid(), lane = tid & 63, w = tid >> 6, wm = w >> 1, wn = w & 1, lr = lane & 15, lq = lane >> 4;
  const int tid5 = opaque_tid512(), hh = half_id();
  const int G = gridDim.x;
  const int nk = K >> 6;
  if (bid < ntiles) {
    const int my_tiles = (ntiles - 1 - bid) / G + 1;
    const int last_id = bid + (my_tiles - 1) * G;
    const int S = my_tiles * nk;
    f32x4 accA[4][4], accB[4][4];
#pragma unroll
    for (int a = 0; a < 4; ++a)
#pragma unroll
      for (int b = 0; b < 4; ++b) { accA[a][b] = (f32x4){0.f, 0.f, 0.f, 0.f}; accB[a][b] = (f32x4){0.f, 0.f, 0.f, 0.f}; }
    u32x4 ra[4], rb[4];
    float ss[4] = {0.f, 0.f, 0.f, 0.f};
    int l_id = bid, l_kt = 0, c_id = bid, c_kt = 0, st_kt = 0;
    const int srow = tid >> 3;
    const int soff = srow * 128 + (((tid & 7) ^ (srow & 7)) << 4);
    const int wrow = tid5 >> 3;
    const int woff = wrow * 128 + (((tid5 & 7) ^ (wrow & 7)) << 4);
    auto issue = [&]() {
      const int idc = l_id < last_id ? l_id : last_id;
      int mt, nt; tile_of(idc, ntn, mt, nt);
      const int arow = mt * 256 + hh * 128 + srow;
      const bf16_t* akb = A + l_kt * 64 + (tid & 7) * 8;
      const bf16_t* wp = W + (size_t)(nt * 256 + wrow) * K + l_kt * 64 + (tid5 & 7) * 8;
#pragma unroll
      for (int i = 0; i < 4; ++i) {
        int r = arow + 32 * i; r = r < M_ ? r : M_ - 1;
        ra[i] = *(const u32x4*)(akb + (size_t)r * lda);
        rb[i] = *(const u32x4*)(wp + (size_t)i * 64 * K);
      }
      if (++l_kt == nk) { l_kt = 0; l_id += G; }
    };
    auto store = [&](int buf) {
#pragma unroll
      for (int i = 0; i < 4; ++i) {
        ss[i] += sumsq8(__builtin_bit_cast(bf16x8, ra[i]));
        *(u32x4*)(As + buf * 16384 + i * 4096 + soff) = ra[i];
        *(u32x4*)(Bs + buf * 32768 + i * 8192 + woff) = rb[i];
      }
      if (++st_kt == nk) {
        st_kt = 0;
#pragma unroll
        for (int i = 0; i < 4; ++i) {
          float t = ss[i];
          t += __shfl_xor(t, 1); t += __shfl_xor(t, 2); t += __shfl_xor(t, 4);
          if ((tid & 7) == 0) rsl[srow + 32 * i] = rsqrtf(t * invK + EPS_);
          ss[i] = 0.f;
        }
      }
    };
    auto compute = [&](int buf) {
      const unsigned char* Ab = As + buf * 16384 + (wn * 64 + lr) * 128;
      const unsigned char* Bb = Bs + buf * 32768 + (wm * 64 + lr) * 128;
#pragma unroll
      for (int ks = 0; ks < 2; ++ks) {
        const int sw = ((ks * 4 + lq) ^ (lr & 7)) << 4;
        bf16x8 xf[4], wf[4];
#pragma unroll
        for (int i = 0; i < 4; ++i) { xf[i] = *(const bf16x8*)(Ab + i * 2048 + sw); wf[i] = *(const bf16x8*)(Bb + i * 2048 + sw); }
#pragma unroll
        for (int ni = 0; ni < 4; ++ni)
#pragma unroll
          for (int ti = 0; ti < 4; ++ti) accA[ni][ti] = MFMA16(wf[ni], xf[ti], accA[ni][ti]);
#pragma unroll
        for (int i = 0; i < 4; ++i) wf[i] = *(const bf16x8*)(Bb + 16384 + i * 2048 + sw);
#pragma unroll
        for (int ni = 0; ni < 4; ++ni)
#pragma unroll
          for (int ti = 0; ti < 4; ++ti) accB[ni][ti] = MFMA16(wf[ni], xf[ti], accB[ni][ti]);
      }
    };
    auto tile_end = [&]() {
      float rs[4];
#pragma unroll
      for (int ti = 0; ti < 4; ++ti) rs[ti] = rsl[wn * 64 + ti * 16 + lr];
      int mt, nt; tile_of(c_id, ntn, mt, nt);
      const int tokb = mt * 256 + hh * 128;
      if (tokb < M_) {
        gemm_epilogue<EPI, 4>(ws, accA, rs, tokb, nt * 256, wm, wn, lr, lq, false);
        if (nt * 256 + 128 < 5248) gemm_epilogue<EPI, 4>(ws, accB, rs, tokb, nt * 256 + 128, wm, wn, lr, lq, false);
      }
#pragma unroll
      for (int a = 0; a < 4; ++a)
#pragma unroll
        for (int b = 0; b < 4; ++b) { accA[a][b] = (f32x4){0.f, 0.f, 0.f, 0.f}; accB[a][b] = (f32x4){0.f, 0.f, 0.f, 0.f}; }
      c_id += G;
    };
    issue();
    store(0);
    __syncthreads();
#pragma unroll 1
    for (int s = 0; s < S; ++s) {
      issue();
      compute(s & 1);
      if (++c_kt == nk) { c_kt = 0; tile_end(); }
      store((s + 1) & 1);
      __syncthreads();
    }
  }
  __syncthreads();
}

__device__ __forceinline__ void rem_tile(int pos, int& mt, int& nt) { if (pos < 65) { mt = pos; nt = 40; } else { mt = 64; nt = pos - 65; } }
template <bool RS, int EPI, int TI, int TMAP = 0>
__device__ __forceinline__ void gemm_stream(const WS& ws, const bf16_t* A0, const bf16_t* A1, int lda, int ktsplit, int kstride,
                                            const bf16_t* __restrict__ W, int K, float invK, int ntn, int ntiles, int bid, bool dry) {
  constexpr int BMH = (TI == 5) ? 129 : 128;
  constexpr int ASTG = 16384;
  unsigned char* As = smem;
  unsigned char* Bs = smem_all + 2 * ASTG;
  float* rsl = (float*)(smem + 65536);
  int xbase = 66048;
  asm volatile("" : "+v"(xbase));
  unsigned char* Ax0 = smem + xbase;
  const int tid = opaque_tid(), lane = tid & 63, w = tid >> 6, wm = w >> 1, wn = w & 1, lr = lane & 15, lq = lane >> 4;
  const int tid5 = opaque_tid512(), hh = half_id();
  const int G = gridDim.x;
  const int nk = K >> 6;
  if (bid < ntiles) {
    const int my_tiles = (ntiles - 1 - bid) / G + 1;
    const int last_id = bid + (my_tiles - 1) * G;
    const int S = my_tiles * nk;
    f32x4 acc[4][TI];
#pragma unroll
    for (int a = 0; a < 4; ++a)
#pragma unroll
      for (int b = 0; b < TI; ++b) acc[a][b] = (f32x4){0.f, 0.f, 0.f, 0.f};
    u32x4 ra0[4], rb0[2], ra1[4], rb1[2];
    u32x4 rx0 = (u32x4){0u, 0u, 0u, 0u}, rx1 = (u32x4){0u, 0u, 0u, 0u};
    float ss[5] = {0.f, 0.f, 0.f, 0.f, 0.f};
    int l_id = bid, l_kt = 0, c_id = bid, c_kt = 0, st_kt = 0;
    const int srow = tid >> 3;
    const int soff = srow * 128 + (((tid & 7) ^ (srow & 7)) << 4);

    const int wrow = tid5 >> 3;
    const int woff = wrow * 128 + (((tid5 & 7) ^ (wrow & 7)) << 4);
    auto issue = [&](u32x4 (&ra)[4], u32x4 (&rb)[2], u32x4& rx) {
      const int idc = l_id < last_id ? l_id : last_id;
      int mt, nt; if (TMAP == 1) rem_tile(idc, mt, nt); else tile_of(idc, ntn, mt, nt);
      const bf16_t* A = (l_kt < ktsplit) ? A0 : A1;
      const int kk = (l_kt < ktsplit) ? l_kt : l_kt - ktsplit;
      const int arow = mt * 2 * BMH + hh * BMH + srow;
      const bf16_t* akb = A + kk * kstride + (tid & 7) * 8;
      const bf16_t* wp = W + (size_t)(nt * 128 + wrow) * K + l_kt * 64 + (tid5 & 7) * 8;
#pragma unroll
      for (int i = 0; i < 4; ++i) {
        int r = arow + 32 * i; r = r < M_ ? r : M_ - 1;
        ra[i] = *(const u32x4*)(akb + (size_t)r * lda);
      }
#pragma unroll
      for (int i = 0; i < 2; ++i) rb[i] = *(const u32x4*)(wp + (size_t)i * 64 * K);
      if (TI == 5) { if (srow == 0) rx = *(const u32x4*)(akb + (size_t)(arow + 128) * lda); }
      if (++l_kt == nk) { l_kt = 0; l_id += G; }
    };
    auto store = [&](const u32x4 (&ra)[4], const u32x4 (&rb)[2], const u32x4& rx, int buf) {
#pragma unroll
      for (int i = 0; i < 4; ++i) {
        if (RS) ss[i] += sumsq8(__builtin_bit_cast(bf16x8, ra[i]));
        *(u32x4*)(As + buf * ASTG + i * 4096 + soff) = ra[i];
      }
#pragma unroll
      for (int i = 0; i < 2; ++i) *(u32x4*)(Bs + buf * 16384 + i * 8192 + woff) = rb[i];
      if (TI == 5) {
        if (RS) ss[4] += sumsq8(__builtin_bit_cast(bf16x8, rx));
        if (srow == 0) *(u32x4*)(Ax0 + buf * 128 + ((tid & 7) << 4)) = rx;
      }
      if (RS) {
        if (++st_kt == nk) {
          st_kt = 0;
#pragma unroll
          for (int i = 0; i < TI; ++i) {
            float t = ss[i];
            t += __shfl_xor(t, 1); t += __shfl_xor(t, 2); t += __shfl_xor(t, 4);
            if ((tid & 7) == 0 && i < 4) rsl[srow + 32 * i] = rsqrtf(t * invK + EPS_);
            ss[i] = 0.f;
          }
        }
      }
    };
    auto compute = [&](int buf) {
      const unsigned char* Ab = As + buf * ASTG + (wn * 64 + lr) * 128;
      const unsigned char* Ax = Ax0 + buf * 128;
      const unsigned char* Bb = Bs + buf * 16384 + (wm * 64 + lr) * 128;
#pragma unroll
      for (int ks = 0; ks < 2; ++ks) {
        if (TI == 5 && ks == 1) __builtin_amdgcn_sched_barrier(0);
        const int sw = ((ks * 4 + lq) ^ (lr & 7)) << 4;
        bf16x8 wf[4], xf[TI];
#pragma unroll
        for (int i = 0; i < 4; ++i) {
          wf[i] = *(const bf16x8*)(Bb + i * 2048 + sw);
          xf[i] = *(const bf16x8*)(Ab + i * 2048 + sw);
        }
        if (TI == 5) xf[TI - 1] = *(const bf16x8*)(Ax + ((ks * 4 + lq) << 4));
#pragma unroll
        for (int ni = 0; ni < 4; ++ni)
#pragma unroll
          for (int ti = 0; ti < TI; ++ti) acc[ni][ti] = MFMA16(wf[ni], xf[ti], acc[ni][ti]);
      }
    };
    auto tile_end = [&]() {
      float rs[TI];
#pragma unroll
      for (int ti = 0; ti < TI; ++ti) rs[ti] = 1.f;
      if (RS) {
#pragma unroll
        for (int ti = 0; ti < TI; ++ti) rs[ti] = rsl[(ti < 4 ? wn * 64 + ti * 16 : 0) + lr];
      }
      int mt, nt; if (TMAP == 1) rem_tile(c_id, mt, nt); else tile_of(c_id, ntn, mt, nt);
      const int tokb = mt * 2 * BMH + hh * BMH;
      if (tokb < M_) gemm_epilogue<EPI, TI>(ws, acc, rs, tokb, nt * 128, wm, wn, lr, lq, dry);
#pragma unroll
      for (int a = 0; a < 4; ++a)
#pragma unroll
        for (int b = 0; b < TI; ++b) acc[a][b] = (f32x4){0.f, 0.f, 0.f, 0.f};
      c_id += G;
    };

    issue(ra0, rb0, rx0);
    issue(ra1, rb1, rx1);
    store(ra0, rb0, rx0, 0);
    __syncthreads();
#pragma unroll 1
    for (int s = 0; s < S; s += 2) {
      issue(ra0, rb0, rx0);
      compute(0);
      store(ra1, rb1, rx1, 1);
      __syncthreads();
      issue(ra1, rb1, rx1);
      compute(1);
      c_kt += 2;
      if (c_kt == nk) { c_kt = 0; tile_end(); }
      store(ra0, rb0, rx0, 0);
      __syncthreads();
    }
  }
  __syncthreads();
}

__device__ __forceinline__ void gla_decay_unit(const Params& p, const WS& ws, int j, int u) {
  const int c = u % 33; const int bh = u / 33; const int hd = bh & 3, b = bh >> 2;
  bf16_t* Qs = (bf16_t*)smem;
  bf16_t* Ks = Qs + 64 * 136;
  float* ADs = (float*)(smem + 2 * 64 * 136 * 2);
  float* HT = ADs + 64 * 16;
  const int tid = opaque_tid();
  const int tbase = 64 * c - 48;
#pragma unroll
  for (int i = 0; i < 4; ++i) {
    const int ci = tid + 256 * i; const int row = ci >> 4, ch = ci & 15; const int t = tbase + row;
    u32x4 qv = (u32x4){0, 0, 0, 0}, kv = (u32x4){0, 0, 0, 0};
    if (t >= 0) {
      qv = *(const u32x4*)(ws.Q + (size_t)(b * T_ + t) * 512 + hd * 128 + ch * 8);
      kv = *(const u32x4*)(ws.K + (size_t)(b * T_ + t) * 512 + hd * 128 + ch * 8);
    }
    *(u32x4*)(Qs + row * 136 + ch * 8) = qv;
    *(u32x4*)(Ks + row * 136 + ch * 8) = kv;
    const int t2 = tbase + (ci >> 4);
    ADs[ci] = t2 >= 0 ? bf2f(ws.AD[(size_t)(b * T_ + t2) * 16 + (ci & 15)]) : 0.f;
  }
  const int d = tid & 127, half = tid >> 7;
  float aw[16];
#pragma unroll
  for (int r = 0; r < 16; ++r) aw[r] = p.ab_alpha_w[(size_t)(j * 16 + r) * 512 + hd * 128 + d];
  const float abias = p.ab_alpha_b[j * 512 + hd * 128 + d];
  __syncthreads();
  float cs[32];
  float run = 0.f;
#pragma unroll
  for (int ii = 0; ii < 32; ++ii) {
    const int row = half * 32 + ii;
    float xv = abias;
#pragma unroll
    for (int r4 = 0; r4 < 4; ++r4) {
      const float4 a4 = *(const float4*)(ADs + row * 16 + r4 * 4);
      xv += a4.x * aw[r4 * 4] + a4.y * aw[r4 * 4 + 1] + a4.z * aw[r4 * 4 + 2] + a4.w * aw[r4 * 4 + 3];
    }
    float la = (fminf(xv, 0.f) - __logf(1.f + __expf(-fabsf(xv)))) * 0.0625f;
    if (tbase + row < 0) la = 0.f;
    run += la;
    cs[ii] = run;
  }
  HT[half * 128 + d] = run;
  __syncthreads();
  const float off = half ? HT[d] : 0.f;
  const float blast = HT[d] + HT[128 + d];
#pragma unroll
  for (int ii = 0; ii < 32; ++ii) {
    const int row = half * 32 + ii;
    const float bb = cs[ii] + off;
    const float eb = __expf(bb), ebi = __expf(-bb);
    Qs[row * 136 + d] = f2bf(bf2f(Qs[row * 136 + d]) * eb);
    Ks[row * 136 + d] = f2bf(bf2f(Ks[row * 136 + d]) * ebi);
  }
  if (half == 0) ws.BL[(size_t)((b * 4 + hd) * 33 + c) * 128 + d] = __expf(blast);
  __syncthreads();
#pragma unroll
  for (int i = 0; i < 4; ++i) {
    const int ci = tid + 256 * i; const int row = ci >> 4, ch = ci & 15; const int t = tbase + row;
    if (t >= 0) {
      *(u32x4*)(ws.Q + (size_t)(b * T_ + t) * 512 + hd * 128 + ch * 8) = *(const u32x4*)(Qs + row * 136 + ch * 8);
      *(u32x4*)(ws.K + (size_t)(b * T_ + t) * 512 + hd * 128 + ch * 8) = *(const u32x4*)(Ks + row * 136 + ch * 8);
    }
  }
  __syncthreads();
}

__device__ __forceinline__ void conv_unit(const Params& p, const WS& ws, int j, int u) {
  const int g = u & 7, b = u >> 3;
  const int tid = opaque_tid();
  const int c8 = tid & 15, seg = tid >> 4;
  const int t0 = seg * 129;
  const int cbase = 128 * g + 8 * c8;
  float cw[4][8], cb[8];
#pragma unroll
  for (int e = 0; e < 8; ++e) {
    cb[e] = p.ab_conv_b[j * 1024 + cbase + e];
#pragma unroll
    for (int k = 0; k < 4; ++k) cw[k][e] = p.ab_conv_w[(size_t)(j * 4 + k) * 1024 + cbase + e];
  }
  bf16_t* xp = ws.XA + (size_t)(b * T_) * 1024 + cbase;
  float x0[8], x1[8], x2[8];
  {
    u32x4 h[3];
#pragma unroll
    for (int m = 0; m < 3; ++m) {
      const int t = t0 - 3 + m;
      h[m] = (u32x4){0, 0, 0, 0};
      if (t >= 0) h[m] = *(const u32x4*)(xp + (size_t)t * 1024);
    }
    const u32x4 a = h[0], bq = h[1], c = h[2];
    x0[0] = bflo(a.x); x0[1] = bfhi(a.x); x0[2] = bflo(a.y); x0[3] = bfhi(a.y); x0[4] = bflo(a.z); x0[5] = bfhi(a.z); x0[6] = bflo(a.w); x0[7] = bfhi(a.w);
    x1[0] = bflo(bq.x); x1[1] = bfhi(bq.x); x1[2] = bflo(bq.y); x1[3] = bfhi(bq.y); x1[4] = bflo(bq.z); x1[5] = bfhi(bq.z); x1[6] = bflo(bq.w); x1[7] = bfhi(bq.w);
    x2[0] = bflo(c.x); x2[1] = bfhi(c.x); x2[2] = bflo(c.y); x2[3] = bfhi(c.y); x2[4] = bflo(c.z); x2[5] = bfhi(c.z); x2[6] = bflo(c.w); x2[7] = bfhi(c.w);
  }
  __syncthreads();
#pragma unroll 1
  for (int tt = 0; tt < 129; tt += 3) {
    u32x4 r[3];
#pragma unroll
    for (int m = 0; m < 3; ++m) r[m] = *(const u32x4*)(xp + (size_t)(t0 + tt + m) * 1024);
#pragma unroll
    for (int m = 0; m < 3; ++m) {
      float x3[8];
      x3[0] = bflo(r[m].x); x3[1] = bfhi(r[m].x); x3[2] = bflo(r[m].y); x3[3] = bfhi(r[m].y);
      x3[4] = bflo(r[m].z); x3[5] = bfhi(r[m].z); x3[6] = bflo(r[m].w); x3[7] = bfhi(r[m].w);
      float y[8];
#pragma unroll
      for (int e = 0; e < 8; ++e) y[e] = cb[e] + cw[0][e] * x0[e] + cw[1][e] * x1[e] + cw[2][e] * x2[e] + cw[3][e] * x3[e];
      u32x4 pk; pk.x = cvt_pk_bf16(y[0], y[1]); pk.y = cvt_pk_bf16(y[2], y[3]); pk.z = cvt_pk_bf16(y[4], y[5]); pk.w = cvt_pk_bf16(y[6], y[7]);
      *(u32x4*)(xp + (size_t)(t0 + tt + m) * 1024) = pk;
#pragma unroll
      for (int e = 0; e < 8; ++e) { x0[e] = x1[e]; x1[e] = x2[e]; x2[e] = x3[e]; }
    }
  }
  __syncthreads();
}

__device__ __forceinline__ void gla_unit(const Params& p, const WS& ws, int u, bool dry = false) {
  const int sl = u & 7; const int bh = u >> 3; const int hd = bh & 3, b = bh >> 2;
  bf16_t* QDs = (bf16_t*)smem;
  bf16_t* KIs = QDs + 64 * 136;
  bf16_t* KIT = KIs + 64 * 136;
  bf16_t* VTs = KIT + 128 * 72;
  bf16_t* STs = VTs + 32 * 72;
  bf16_t* Ps = STs + 32 * 136;
  const int tid = opaque_tid(), lane = tid & 63, w = tid >> 6, lr = lane & 15, lq = lane >> 4;
  for (int i = tid; i < 32 * 136 / 2; i += 256) ((unsigned*)STs)[i] = 0u;
  f32x4 sacc[2][2];
#pragma unroll
  for (int a = 0; a < 2; ++a)
#pragma unroll
    for (int bb = 0; bb < 2; ++bb) sacc[a][bb] = (f32x4){0.f, 0.f, 0.f, 0.f};
  u32x4 qrA[4], krA[4], vrA, qrB[4], krB[4], vrB;
  float eblA[2], eblB[2];
  const float* BLp = ws.BL + (size_t)((b * 4 + hd) * 33) * 128;
  auto prefetch = [&](int c, u32x4 (&qr)[4], u32x4 (&kr)[4], u32x4& vr, float (&ebl)[2]) {
    const int tbase = 64 * c - 48;
#pragma unroll
    for (int i = 0; i < 4; ++i) {
      const int ci = tid + 256 * i; const int row = ci >> 4, ch = ci & 15; const int t = tbase + row;
      qr[i] = (u32x4){0, 0, 0, 0}; kr[i] = (u32x4){0, 0, 0, 0};
      if (t >= 0) {
        qr[i] = *(const u32x4*)(ws.Q + (size_t)(b * T_ + t) * 512 + hd * 128 + ch * 8);
        kr[i] = *(const u32x4*)(ws.K + (size_t)(b * T_ + t) * 512 + hd * 128 + ch * 8);
      }
    }
    {
      const int row = tid >> 2, ch = tid & 3; const int t = tbase + row;
      vr = (u32x4){0, 0, 0, 0};
      if (t >= 0) vr = *(const u32x4*)(ws.V + (size_t)(b * T_ + t) * 1024 + hd * 256 + sl * 32 + ch * 8);
    }
    ebl[0] = BLp[c * 128 + 16 * (2 * w) + lr];
    ebl[1] = BLp[c * 128 + 16 * (2 * w + 1) + lr];
  };
  prefetch(0, qrA, krA, vrA, eblA);
  prefetch(1, qrB, krB, vrB, eblB);
  __syncthreads();
  u32x2 opend[2]; float sqpend = 0.f; int tpend = -1;
  opend[0] = (u32x2){0u, 0u}; opend[1] = (u32x2){0u, 0u};
  auto flush_o = [&]() {
    if (tpend >= 0 && !dry) {
      const size_t row = (size_t)(b * T_ + tpend);
#pragma unroll
      for (int mt = 0; mt < 2; ++mt) *(u32x2*)(ws.V + row * 1024 + hd * 256 + sl * 32 + 16 * mt + 4 * lq) = opend[mt];
      if (lq == 0) ws.SSQ[row * 32 + hd * 8 + sl] = sqpend;
    }
  };
  auto body = [&](int c, u32x4 (&qr)[4], u32x4 (&kr)[4], u32x4& vr, float (&ebl)[2]) {
#pragma unroll
    for (int i = 0; i < 4; ++i) {
      const int ci = tid + 256 * i; const int row = ci >> 4, ch = ci & 15;
      *(u32x4*)(QDs + row * 136 + ch * 8) = qr[i];
      *(u32x4*)(KIs + row * 136 + ch * 8) = kr[i];
      const unsigned kk[4] = {kr[i].x, kr[i].y, kr[i].z, kr[i].w};
#pragma unroll
      for (int e = 0; e < 4; ++e) {
        KIT[(ch * 8 + 2 * e) * 72 + (row ^ ((ch & 7) << 3))] = (bf16_t)(kk[e] & 0xffffu);
        KIT[(ch * 8 + 2 * e + 1) * 72 + (row ^ ((ch & 7) << 3))] = (bf16_t)(kk[e] >> 16);
      }
    }
    {
      const int row = tid >> 2, ch = tid & 3;
      const unsigned vv[4] = {vr.x, vr.y, vr.z, vr.w};
#pragma unroll
      for (int e = 0; e < 4; ++e) {
        VTs[(ch * 8 + 2 * e) * 72 + (row ^ (ch << 3))] = (bf16_t)(vv[e] & 0xffffu);
        VTs[(ch * 8 + 2 * e + 1) * 72 + (row ^ (ch << 3))] = (bf16_t)(vv[e] >> 16);
      }
    }
    const float eb0 = ebl[0], eb1 = ebl[1];
    __syncthreads();
    flush_o();
    if (c + 2 < 33) prefetch(c + 2, qr, kr, vr, ebl);
    bf16x8 xq[4];
#pragma unroll
    for (int ks = 0; ks < 4; ++ks) xq[ks] = *(const bf16x8*)(QDs + (16 * w + lr) * 136 + 32 * ks + 8 * lq);
    const int irow = 16 * w + lr;
#pragma unroll
    for (int mt = 0; mt < 4; ++mt) {
      u32x2 pk = (u32x2){0u, 0u};
      if (mt <= w) {
        f32x4 a = (f32x4){0.f, 0.f, 0.f, 0.f};
#pragma unroll
        for (int ks = 0; ks < 4; ++ks) {
          const bf16x8 kf = *(const bf16x8*)(KIs + (16 * mt + lr) * 136 + 32 * ks + 8 * lq);
          a = MFMA16(kf, xq[ks], a);
        }
        const int ip = 16 * mt + 4 * lq;
        const float v0 = (ip + 0 <= irow) ? a[0] : 0.f, v1 = (ip + 1 <= irow) ? a[1] : 0.f;
        const float v2 = (ip + 2 <= irow) ? a[2] : 0.f, v3 = (ip + 3 <= irow) ? a[3] : 0.f;
        pk.x = cvt_pk_bf16(v0, v1); pk.y = cvt_pk_bf16(v2, v3);
      }
      *(u32x2*)(Ps + irow * 72 + 16 * mt + 4 * lq) = pk;
    }
    __syncthreads();
    f32x4 oacc[2];
    oacc[0] = (f32x4){0.f, 0.f, 0.f, 0.f}; oacc[1] = (f32x4){0.f, 0.f, 0.f, 0.f};
#pragma unroll
    for (int ks = 0; ks < 2; ++ks) {
      if (2 * ks <= w) {
        const bf16x8 pb = *(const bf16x8*)(Ps + irow * 72 + 32 * ks + 8 * lq);
#pragma unroll
        for (int mt = 0; mt < 2; ++mt) {
          const bf16x8 vf = *(const bf16x8*)(VTs + (16 * mt + lr) * 72 + (((4 * ks + lq) ^ (((16 * mt + lr) >> 3) & 3)) << 3));
          oacc[mt] = MFMA16(vf, pb, oacc[mt]);
        }
      }
    }
#pragma unroll
    for (int ks = 0; ks < 4; ++ks)
#pragma unroll
      for (int mt = 0; mt < 2; ++mt) {
        const bf16x8 sf = *(const bf16x8*)(STs + (16 * mt + lr) * 136 + 32 * ks + 8 * lq);
        oacc[mt] = MFMA16(sf, xq[ks], oacc[mt]);
      }
    {
      const int t = 64 * c - 48 + irow;
      float sq = 0.f;
#pragma unroll
      for (int mt = 0; mt < 2; ++mt) sq += oacc[mt][0] * oacc[mt][0] + oacc[mt][1] * oacc[mt][1] + oacc[mt][2] * oacc[mt][2] + oacc[mt][3] * oacc[mt][3];
      sq += __shfl_xor(sq, 16); sq += __shfl_xor(sq, 32);
      tpend = t;
      sqpend = sq;
#pragma unroll
      for (int mt = 0; mt < 2; ++mt) { opend[mt].x = cvt_pk_bf16(oacc[mt][0], oacc[mt][1]); opend[mt].y = cvt_pk_bf16(oacc[mt][2], oacc[mt][3]); }
    }
    __syncthreads();
#pragma unroll
    for (int ntl = 0; ntl < 2; ++ntl) {
#pragma unroll
      for (int ks = 0; ks < 2; ++ks) {
        const bf16x8 kf = *(const bf16x8*)(KIT + (16 * (2 * w + ntl) + lr) * 72 + (((4 * ks + lq) ^ (((16 * (2 * w + ntl) + lr) >> 3) & 7)) << 3));
#pragma unroll
        for (int mt = 0; mt < 2; ++mt) {
          const bf16x8 vf = *(const bf16x8*)(VTs + (16 * mt + lr) * 72 + (((4 * ks + lq) ^ (((16 * mt + lr) >> 3) & 3)) << 3));
          sacc[mt][ntl] = MFMA16(vf, kf, sacc[mt][ntl]);
        }
      }
      const float e = ntl ? eb1 : eb0;
#pragma unroll
      for (int mt = 0; mt < 2; ++mt) {
        sacc[mt][ntl] = scale4(sacc[mt][ntl], e);
#pragma unroll
        for (int jj = 0; jj < 4; ++jj) STs[(16 * mt + 4 * lq + jj) * 136 + 16 * (2 * w + ntl) + lr] = f2bf(sacc[mt][ntl][jj]);
      }
    }
    __syncthreads();
  };
#pragma unroll 1
  for (int c = 0; c < 33; c += 2) {
    body(c, qrA, krA, vrA, eblA);
    if (c + 1 < 33) body(c + 1, qrB, krB, vrB, eblB);
  }
  flush_o();
  __syncthreads();
}

__device__ __forceinline__ void rglru_unit(const Params& p, const WS& ws, int j, int u, bool dry = false) {
  const int jq = u & 3, g = (u >> 2) & 7, b = u >> 5;
  bf16_t* XC = (bf16_t*)smem;
  bf16_t* WG = XC + 64 * 136;
  float* AUa = (float*)(smem + 34816);
  float* AUu = AUa + 64 * 33;
  float* SEGA = AUu + 64 * 33;
  float* SEGH = SEGA + 256;
  float* CARRY = SEGH + 256;
  const int tid = opaque_tid(), lane = tid & 63, w = tid >> 6, lr = lane & 15, lq = lane >> 4;
#pragma unroll 4
  for (int i = 0; i < 32; ++i) {
    const int e = tid + 256 * i;
    const int gate = e >> 12, k = (e >> 5) & 127, n = e & 31;
    const float* gw = gate ? p.ab_gate_x_w : p.ab_gate_a_w;
    WG[(gate * 32 + n) * 136 + k] = f2bf(gw[((size_t)(j * 8 + g) * 128 + k) * 128 + 32 * jq + n]);
  }
  if (tid < 32) CARRY[tid] = 0.f;
  float ba[2][4], bx[2][4], sp[2][4];
#pragma unroll
  for (int mt = 0; mt < 2; ++mt)
#pragma unroll
    for (int jj = 0; jj < 4; ++jj) {
      const int ch = j * 1024 + 128 * g + 32 * jq + 16 * mt + 4 * lq + jj;
      ba[mt][jj] = p.ab_gate_a_b[ch]; bx[mt][jj] = p.ab_gate_x_b[ch];
      sp[mt][jj] = 8.f * log1pf(__expf(-p.ab_lam[ch]));
    }
  const int sc = tid & 31, ssg = tid >> 5;
  u32x4 xinA[4], xinB[4];
  bf16_t gavA[8], gavB[8];
  auto prefetch = [&](int tile, u32x4 (&xin)[4], bf16_t (&gav)[8]) {
    const int t0 = 64 * tile;
#pragma unroll
    for (int i = 0; i < 4; ++i) {
      const int ci = tid + 256 * i; const int row = ci >> 4, ch = ci & 15; const int t = t0 + row;
      xin[i] = (u32x4){0, 0, 0, 0};
      if (t < T_) xin[i] = *(const u32x4*)(ws.XA + (size_t)(b * T_ + t) * 1024 + 128 * g + 8 * ch);
    }
#pragma unroll
    for (int i = 0; i < 8; ++i) {
      const int t = t0 + 8 * ssg + i;
      gav[i] = 0;
      if (t < T_) gav[i] = ws.GA[(size_t)(b * T_ + t) * 1024 + 128 * g + 32 * jq + sc];
    }
  };
  prefetch(0, xinA, gavA);
  prefetch(1, xinB, gavB);
  __syncthreads();
  bf16_t ypend[8];
  int ypend_t0 = -1;
  auto flush_y = [&]() {
    if (ypend_t0 >= 0) {
#pragma unroll
      for (int i = 0; i < 8; ++i) {
        const int t = ypend_t0 + 8 * ssg + i;
        if (t < T_ && !dry) ws.GA[(size_t)(b * T_ + t) * 1024 + 128 * g + 32 * jq + sc] = ypend[i];
      }
    }
  };
  auto body = [&](int tile, u32x4 (&xin)[4], bf16_t (&gav)[8]) {
    const int t0 = 64 * tile;
#pragma unroll
    for (int i = 0; i < 4; ++i) {
      const int ci = tid + 256 * i; const int row = ci >> 4, ch = ci & 15;
      *(u32x4*)(XC + row * 136 + 8 * ch) = xin[i];
    }
    float gcur[8];
#pragma unroll
    for (int i = 0; i < 8; ++i) gcur[i] = bf2f(gav[i]);
    __syncthreads();
    flush_y();
    if (tile + 2 < 33) prefetch(tile + 2, xin, gav);
    {
      f32x4 ga_[2][2];
#pragma unroll
      for (int a = 0; a < 2; ++a)
#pragma unroll
        for (int bb = 0; bb < 2; ++bb) ga_[a][bb] = (f32x4){0.f, 0.f, 0.f, 0.f};
#pragma unroll
      for (int ks = 0; ks < 4; ++ks) {
        const bf16x8 xf = *(const bf16x8*)(XC + (16 * w + lr) * 136 + 32 * ks + 8 * lq);
#pragma unroll
        for (int gate = 0; gate < 2; ++gate)
#pragma unroll
          for (int mt = 0; mt < 2; ++mt) {
            const bf16x8 wf = *(const bf16x8*)(WG + (gate * 32 + 16 * mt + lr) * 136 + 32 * ks + 8 * lq);
            ga_[gate][mt] = MFMA16(wf, xf, ga_[gate][mt]);
          }
      }
      const int tok = 16 * w + lr;
#pragma unroll
      for (int mt = 0; mt < 2; ++mt)
#pragma unroll
        for (int jj = 0; jj < 4; ++jj) {
          const int n = 16 * mt + 4 * lq + jj;
          const float xcv = bf2f(XC[tok * 136 + 32 * jq + n]);
          const float r = sigmoidf_(ga_[0][mt][jj] + ba[mt][jj]);
          const float ig = sigmoidf_(ga_[1][mt][jj] + bx[mt][jj]);
          const float la = -r * sp[mt][jj];
          const float a = __expf(la);
          const float x2 = 2.f * la;
          const float om = x2 > -0.02f ? -x2 * (1.f + 0.5f * x2 * (1.f + x2 * (1.f / 3.f))) : 1.f - a * a;
          const float mult = __builtin_amdgcn_sqrtf(fmaxf(om, 0.f));
          AUa[tok * 33 + n] = a;
          AUu[tok * 33 + n] = mult * ig * xcv;
        }
    }
    __syncthreads();
    {
      float A = 1.f, Hh = 0.f;
#pragma unroll
      for (int i = 0; i < 8; ++i) {
        const float a = AUa[(8 * ssg + i) * 33 + sc], uu = AUu[(8 * ssg + i) * 33 + sc];
        Hh = a * Hh + uu; A *= a;
      }
      SEGA[ssg * 32 + sc] = A; SEGH[ssg * 32 + sc] = Hh;
    }
    __syncthreads();
    float hin = CARRY[sc];
#pragma unroll
    for (int s2 = 0; s2 < 7; ++s2)
      if (s2 < ssg) hin = SEGA[s2 * 32 + sc] * hin + SEGH[s2 * 32 + sc];
    __syncthreads();
    {
      float h = hin;
#pragma unroll
      for (int i = 0; i < 8; ++i) {
        const float a = AUa[(8 * ssg + i) * 33 + sc], uu = AUu[(8 * ssg + i) * 33 + sc];
        h = a * h + uu;
        const int t = t0 + 8 * ssg + i;
        ypend[i] = f2bf(h * siluf_(gcur[i]));
      }
      if (ssg == 7) CARRY[sc] = h;
      ypend_t0 = t0;
    }
  };
#pragma unroll 1
  for (int tile = 0; tile < 33; tile += 2) {
    body(tile, xinA, gavA);
    if (tile + 1 < 33) body(tile + 1, xinB, gavB);
  }
  flush_y();
  __syncthreads();
}

__device__ __forceinline__ void phase_gla_norm(const Params& p, const WS& ws, int j) {
  const size_t gtid = (size_t)opaque_bid() * 256 + opaque_tid(), gsz = (size_t)NVB * 256;
  const float* gn = p.ab_gla_norm + j * 256;
#pragma unroll 4
  for (size_t idx = gtid; idx < (size_t)M_ * 128; idx += gsz) {
    const size_t row = idx >> 7; const int c8 = (int)(idx & 127); const int hd = c8 >> 5; const int dv = (c8 & 31) * 8;
    const float4 s0 = *(const float4*)(ws.SSQ + row * 32 + hd * 8), s1 = *(const float4*)(ws.SSQ + row * 32 + hd * 8 + 4);
    const float ssum = (s0.x + s0.y + s0.z + s0.w) + (s1.x + s1.y + s1.z + s1.w);
    const float rstd = rsqrtf(ssum * (1.f / 256.f) + EPS_);
    const u32x4 ov = *(const u32x4*)(ws.V + row * 1024 + c8 * 8);
    const u32x4 gv = *(const u32x4*)(ws.GB + row * 1024 + c8 * 8);
    const float4 g0 = *(const float4*)(gn + dv), g1 = *(const float4*)(gn + dv + 4);
    float o[8] = {bflo(ov.x), bfhi(ov.x), bflo(ov.y), bfhi(ov.y), bflo(ov.z), bfhi(ov.z), bflo(ov.w), bfhi(ov.w)};
    const float gg[8] = {bflo(gv.x), bfhi(gv.x), bflo(gv.y), bfhi(gv.y), bflo(gv.z), bfhi(gv.z), bflo(gv.w), bfhi(gv.w)};
    const float nn[8] = {g0.x, g0.y, g0.z, g0.w, g1.x, g1.y, g1.z, g1.w};
#pragma unroll
    for (int e = 0; e < 8; ++e) o[e] = o[e] * rstd * nn[e] * siluf_(gg[e]);
    u32x4 pk; pk.x = cvt_pk_bf16(o[0], o[1]); pk.y = cvt_pk_bf16(o[2], o[3]); pk.z = cvt_pk_bf16(o[4], o[5]); pk.w = cvt_pk_bf16(o[6], o[7]);
    *(u32x4*)(ws.V + row * 1024 + c8 * 8) = pk;
  }
}

__device__ __forceinline__ void attn_unit(const WS& ws, int u, bool dry = false) {
  const int qb = 16 - (u >> 7); const int bh = u & 127; const int hd = bh & 15, b = bh >> 4;
  bf16_t* Kt = (bf16_t*)smem;
  bf16_t* Vl = Kt + 2 * 64 * 104;
  const int tid = opaque_tid(), lane = tid & 63, w = tid >> 6, lr = lane & 15, lq = lane >> 4;
  const int q0 = 128 * qb;
  int nkt = 2 * qb + 2; if (nkt > 33) nkt = 33;
  bf16x8 xq[2][3];
  int qi[2];
#pragma unroll
  for (int nt = 0; nt < 2; ++nt) {
    qi[nt] = q0 + 32 * w + 16 * nt + lr;
    const int qc = qi[nt] < T_ ? qi[nt] : T_ - 1;
#pragma unroll
    for (int ks = 0; ks < 2; ++ks)
      xq[nt][ks] = *(const bf16x8*)(ws.QB + (size_t)(b * T_ + qc) * 1536 + hd * 96 + 32 * ks + 8 * lq);
    {
      const u32x4 raw = *(const u32x4*)(ws.QB + (size_t)(b * T_ + qc) * 1536 + hd * 96 + 64 + 8 * lq);
      u32x4 oth;
      oth.x = __shfl_xor(raw.x, 32); oth.y = __shfl_xor(raw.y, 32); oth.z = __shfl_xor(raw.z, 32); oth.w = __shfl_xor(raw.w, 32);
      const float sgn = lq < 2 ? -1.f : 1.f;
      const float2* rp = ws.ROPE + (size_t)(b * T_ + qc) * 16 + 8 * (lq & 1);
      const unsigned rw[4] = {raw.x, raw.y, raw.z, raw.w}, ow[4] = {oth.x, oth.y, oth.z, oth.w};
      unsigned res[4];
#pragma unroll
      for (int e = 0; e < 4; ++e) {
        const float2 c0 = rp[2 * e], c1 = rp[2 * e + 1];
        const float r0 = bflo(rw[e]) * c0.x + sgn * bflo(ow[e]) * c0.y;
        const float r1 = bfhi(rw[e]) * c1.x + sgn * bfhi(ow[e]) * c1.y;
        res[e] = cvt_pk_bf16(r0, r1);
      }
      xq[nt][2] = as_bf16x8((u32x4){res[0], res[1], res[2], res[3]});
    }
  }
  float mrun[2] = {-INFINITY, -INFINITY}, lsum[2] = {0.f, 0.f};
  f32x4 oacc[4][2];
#pragma unroll
  for (int a = 0; a < 4; ++a)
#pragma unroll
    for (int bb = 0; bb < 2; ++bb) oacc[a][bb] = (f32x4){0.f, 0.f, 0.f, 0.f};
  u32x4 kregA[3], vregA[2], kregB[3], vregB[2];
  const bf16_t* vbase = ws.VT + ((size_t)(b * 16 + hd) * 64) * TP_;
  auto loadg = [&](int kt, u32x4 (&kreg)[3], u32x4 (&vreg)[2]) {
#pragma unroll
    for (int i = 0; i < 3; ++i) {
      const int ci = tid + 256 * i; const int key = ci / 12, ch = ci - key * 12;
      int gk = 64 * kt + key; if (gk > T_ - 1) gk = T_ - 1;
      const bf16_t* src = ch < 8 ? ws.KN + (size_t)(b * T_ + gk) * 1024 + hd * 64 + ch * 8
                                 : ws.KR + (size_t)(b * T_ + gk) * 32 + (ch - 8) * 8;
      kreg[i] = *(const u32x4*)src;
    }
#pragma unroll
    for (int i = 0; i < 2; ++i) {
      const int ci = tid + 256 * i; const int dv = ci >> 3, ch = ci & 7;
      vreg[i] = *(const u32x4*)(vbase + (size_t)dv * TP_ + 64 * kt + ch * 8);
      if (64 * kt + ch * 8 >= T_) vreg[i] = (u32x4){0u, 0u, 0u, 0u};
    }
  };
  auto stores = [&](int buf, const u32x4 (&kreg)[3], const u32x4 (&vreg)[2]) {
#pragma unroll
    for (int i = 0; i < 3; ++i) {
      const int ci = tid + 256 * i; const int key = ci / 12, ch = ci - key * 12;
      *(u32x4*)(Kt + buf * 64 * 104 + key * 104 + ch * 8) = kreg[i];
    }
#pragma unroll
    for (int i = 0; i < 2; ++i) {
      const int ci = tid + 256 * i; const int dv = ci >> 3, ch = ci & 7;
      *(u32x4*)(Vl + buf * 64 * 72 + dv * 72 + ch * 8) = vreg[i];
    }
  };
  const int nkt2 = (nkt + 1) & ~1;
  loadg(0, kregA, vregA);
  loadg(1, kregB, vregB);
  stores(0, kregA, vregA);
  __syncthreads();
  auto body = [&](int kt, int buf, u32x4 (&kreg)[3], u32x4 (&vreg)[2], const u32x4 (&kregn)[3], const u32x4 (&vregn)[2]) {
    { const int kn = kt + 2 < nkt2 ? kt + 2 : nkt2 - 1; loadg(kn, kreg, vreg); }
    const bf16_t* Kb = Kt + buf * 64 * 104;
    const bf16_t* Vb = Vl + buf * 64 * 72;
    f32x4 s[4][2];
#pragma unroll
    for (int mt = 0; mt < 4; ++mt) {
      s[mt][0] = (f32x4){0.f, 0.f, 0.f, 0.f}; s[mt][1] = (f32x4){0.f, 0.f, 0.f, 0.f};
#pragma unroll
      for (int ks = 0; ks < 3; ++ks) {
        const bf16x8 kf = *(const bf16x8*)(Kb + (16 * mt + lr) * 104 + 32 * ks + 8 * lq);
        s[mt][0] = MFMA16(kf, xq[0][ks], s[mt][0]);
        s[mt][1] = MFMA16(kf, xq[1][ks], s[mt][1]);
      }
    }
    if (kt >= 2 * qb) {
#pragma unroll
      for (int mt = 0; mt < 4; ++mt)
#pragma unroll
        for (int nt = 0; nt < 2; ++nt)
#pragma unroll
          for (int jj = 0; jj < 4; ++jj) {
            const int key = 64 * kt + 16 * mt + 4 * lq + jj;
            if (key > qi[nt]) s[mt][nt][jj] = -INFINITY;
          }
    }
    bf16x8 pf[2][2];
#pragma unroll
    for (int nt = 0; nt < 2; ++nt) {
      float mx = -INFINITY;
#pragma unroll
      for (int mt = 0; mt < 4; ++mt) mx = fmaxf(mx, fmaxf(fmaxf(s[mt][nt][0], s[mt][nt][1]), fmaxf(s[mt][nt][2], s[mt][nt][3])));
      mx = fmaxf(mx, __shfl_xor(mx, 16)); mx = fmaxf(mx, __shfl_xor(mx, 32));
      if (__builtin_amdgcn_ballot_w64(mx > mrun[nt]) != 0ull) {
        const float mnew = fmaxf(mrun[nt], mx);
        const float alpha = __builtin_amdgcn_exp2f(mrun[nt] - mnew);
        mrun[nt] = mnew;
        lsum[nt] *= alpha;
#pragma unroll
        for (int mt = 0; mt < 4; ++mt) oacc[mt][nt] = scale4(oacc[mt][nt], alpha);
      }
      const float mnew = mrun[nt];
      float ps = 0.f;
#pragma unroll
      for (int mt = 0; mt < 4; ++mt)
#pragma unroll
        for (int jj = 0; jj < 4; ++jj) { const float pv = __builtin_amdgcn_exp2f(s[mt][nt][jj] - mnew); s[mt][nt][jj] = pv; ps += pv; }
      lsum[nt] += ps;
#pragma unroll
      for (int ks = 0; ks < 2; ++ks) {
        u32x4 pk;
        pk.x = cvt_pk_bf16(s[2 * ks][nt][0], s[2 * ks][nt][1]); pk.y = cvt_pk_bf16(s[2 * ks][nt][2], s[2 * ks][nt][3]);
        pk.z = cvt_pk_bf16(s[2 * ks + 1][nt][0], s[2 * ks + 1][nt][1]); pk.w = cvt_pk_bf16(s[2 * ks + 1][nt][2], s[2 * ks + 1][nt][3]);
        pf[nt][ks] = as_bf16x8(pk);
      }
    }
#pragma unroll
    for (int mt = 0; mt < 4; ++mt)
#pragma unroll
      for (int ks = 0; ks < 2; ++ks) {
        const u32x2 lo = *(const u32x2*)(Vb + (16 * mt + lr) * 72 + 32 * ks + 4 * lq);
        const u32x2 hi = *(const u32x2*)(Vb + (16 * mt + lr) * 72 + 32 * ks + 16 + 4 * lq);
        const bf16x8 vf = as_bf16x8((u32x4){lo.x, lo.y, hi.x, hi.y});
        oacc[mt][0] = MFMA16(vf, pf[0][ks], oacc[mt][0]);
        oacc[mt][1] = MFMA16(vf, pf[1][ks], oacc[mt][1]);
      }
    stores(buf ^ 1, kregn, vregn);
    __syncthreads();
  };
#pragma unroll 1
  for (int kt = 0; kt < nkt2; kt += 2) {
    body(kt, 0, kregA, vregA, kregB, vregB);
    body(kt + 1, 1, kregB, vregB, kregA, vregA);
  }
#pragma unroll
  for (int nt = 0; nt < 2; ++nt) {
    float l = lsum[nt];
    l += __shfl_xor(l, 16); l += __shfl_xor(l, 32);
    const float inv = 1.f / l;
    if (qi[nt] < T_) {
      const size_t row = (size_t)(b * T_ + qi[nt]);
#pragma unroll
      for (int mt = 0; mt < 4; ++mt) {
        const u32x2 gv = *(const u32x2*)(ws.GATE + row * 1024 + hd * 64 + 16 * mt + 4 * lq);
        const float o0 = oacc[mt][nt][0] * inv * siluf_(bflo(gv.x)), o1 = oacc[mt][nt][1] * inv * siluf_(bfhi(gv.x));
        const float o2 = oacc[mt][nt][2] * inv * siluf_(bflo(gv.y)), o3 = oacc[mt][nt][3] * inv * siluf_(bfhi(gv.y));
        u32x2 pk; pk.x = cvt_pk_bf16(o0, o1); pk.y = cvt_pk_bf16(o2, o3);
        if (!dry) *(u32x2*)(ws.QB + row * 1536 + hd * 96 + 16 * mt + 4 * lq) = pk;
      }
    }
  }
}

__device__ __forceinline__ void phase_final(const Params& p, const WS& ws) {
  const int tidf = opaque_tid();
  const int lane = tidf & 63;
  const int gw = opaque_bid() * 4 + (tidf >> 6), nw = NVB * 4;
#pragma unroll 2
  for (int r = gw; r < 8 * 2048; r += nw) {
    const int b = r >> 11, s = r & 2047;
    const size_t hoff = (size_t)(b * T_ + 16 + s) * 1024;
    float4 v[4];
    float ssum = 0.f;
#pragma unroll
    for (int i = 0; i < 4; ++i) {
      const u32x2 hi = *(const u32x2*)(ws.HHI + hoff + i * 256 + lane * 4), lo = *(const u32x2*)(ws.HLO + hoff + i * 256 + lane * 4);
      v[i] = make_float4(bflo(hi.x) + bflo(lo.x), bfhi(hi.x) + bfhi(lo.x), bflo(hi.y) + bflo(lo.y), bfhi(hi.y) + bfhi(lo.y));
      ssum += v[i].x * v[i].x + v[i].y * v[i].y + v[i].z * v[i].z + v[i].w * v[i].w;
    }
#pragma unroll
    for (int o = 1; o < 64; o <<= 1) ssum += __shfl_xor(ssum, o);
    const float rstd = rsqrtf(ssum * (1.f / 1024.f) + EPS_);
#pragma unroll
    for (int i = 0; i < 4; ++i) {
      const float4 g = *(const float4*)(p.final_norm + i * 256 + lane * 4);
      float4 o; o.x = v[i].x * rstd * g.x; o.y = v[i].y * rstd * g.y; o.z = v[i].z * rstd * g.z; o.w = v[i].w * rstd * g.w;
      *(float4*)(p.out + (size_t)r * 1024 + i * 256 + lane * 4) = o;
    }
  }
}

__global__ void __launch_bounds__(512, 2) fwd_megakernel(Params p) {
  cg::grid_group grid = cg::this_grid();
  if (p.inv_freq[0] < 0.f) grid.sync();
  volatile LAS unsigned* xst = (volatile LAS unsigned*)(smem_all + 2 * SMEM_BYTES);
  if (threadIdx.x == 0) { xst[0] = 0u; xst[1] = 0u; xst[2] = 0u; xst[3] = 0u; }
  __syncthreads();
  const XcdBarrier xb = xcd_barrier_post((unsigned*)(p.ws + BAR_OFF), xst);
  {
    const WS ws = make_ws(p);
    phase_prologue(p, ws);
  }
  xcd_barrier(xb);
#pragma unroll 1
  for (int layer = 0; layer < 4; ++layer) {
    const int j = layer >> 1;
    if ((layer & 1) == 0) {
      {
        const WS ws = make_ws(p);
        const bf16_t* wb = ws.W + (size_t)j * W_PER_J;
#pragma unroll 1
        for (int rep = 0; rep < REP_GEMM; ++rep)
          { gemm_wide<EPI_E1>(ws, ws.HHI, 1024, wb + W_IN_E, 1024, 1.f / 1024.f, 20, 64 * 20, xcd_bid(opaque_rbid()));
            gemm_stream<true, EPI_E1, 4, 1>(ws, ws.HHI, nullptr, 1024, 1 << 30, 64, wb + W_IN_E, 1024, 1.f / 1024.f, 41, 105, opaque_rbid(), false); }
      }
      xcd_barrier(xb);
      {
        const WS ws = make_ws(p);
#pragma unroll 1
        for (int u = opaque_bid(); u < 8 * 4 * 33 + 64; u += NVB) {
          if (u < 64) conv_unit(p, ws, j, u); else gla_decay_unit(p, ws, j, u - 64);
        }
      }
      xcd_barrier(xb);
      {
#pragma unroll 1
        for (int rep = 0; rep < REP_E2; ++rep)
#pragma unroll 1
        for (int u = opaque_bid(); u < 512; u += NVB) {
          if (u & 1) { const WS ws = make_ws(p); rglru_unit(p, ws, j, u >> 1, rep < REP_E2 - 1); }
          else { const WS ws = make_ws(p); gla_unit(p, ws, u >> 1, rep < REP_E2 - 1); }
        }
      }
      xcd_barrier(xb);
      {
        const WS ws = make_ws(p);
        phase_gla_norm(p, ws, j);
      }
      xcd_barrier(xb);
      {
        const WS ws = make_ws(p);
        const bf16_t* wb = ws.W + (size_t)j * W_PER_J;
#pragma unroll 1
        for (int rep = 0; rep < REP_GEMM; ++rep)
          gemm_stream<false, EPI_RES, 5>(ws, ws.GA, ws.V, 1024, 16, 64, wb + W_OUT_E, 2048, 0.f, 8, 64 * 8, xcd_bid(opaque_rbid()), rep < REP_GEMM - 1);
      }
      xcd_barrier(xb);
    } else {
      {
        const WS ws = make_ws(p);
        const bf16_t* wb = ws.W + (size_t)j * W_PER_J;
#pragma unroll 1
        for (int rep = 0; rep < REP_GEMM; ++rep)
          gemm_stream<true, EPI_O1, 4>(ws, ws.HHI, nullptr, 1024, 1 << 30, 64, wb + W_IN_O, 1024, 1.f / 1024.f, 15, 65 * 15, xcd_bid(opaque_rbid()), false);
      }
      xcd_barrier(xb);
      {
        const WS ws = make_ws(p);
        const bf16_t* wb = ws.W + (size_t)j * W_PER_J;
#pragma unroll 1
        for (int rep = 0; rep < REP_GEMM; ++rep) {
          gemm_stream<true, EPI_Q, 4>(ws, ws.CQ, nullptr, 512, 1 << 30, 64, wb + W_Q, 512, 1.f / 512.f, 12, 65 * 12, xcd_bid(opaque_rbid()), false);
          gemm_stream<true, EPI_KV, 4>(ws, ws.CKV, nullptr, 256, 1 << 30, 64, wb + W_KV, 256, 1.f / 256.f, 16, 65 * 16, xcd_bid((opaque_rbid() + (int)(gridDim.x >> 1)) % (int)gridDim.x), false);
        }
      }
      xcd_barrier(xb);
      {
        const WS ws = make_ws(p);
#pragma unroll 1
        for (int rep = 0; rep < REP_ATTN; ++rep)
#pragma unroll 1
        for (int r = 0, b0 = opaque_bid(); r * NVB < 17 * 128; ++r) {
          const int u = r * NVB + ((r & 1) ? NVB - 1 - b0 : b0);
          if (u < 17 * 128) attn_unit(ws, u, rep < REP_ATTN - 1);
          __syncthreads();
        }
      }
      xcd_barrier(xb);
      {
        const WS ws = make_ws(p);
        const bf16_t* wb = ws.W + (size_t)j * W_PER_J;
#pragma unroll 1
        for (int rep = 0; rep < REP_GEMM; ++rep)
          gemm_stream<false, EPI_RES, 5>(ws, ws.QB, nullptr, 1536, 1 << 30, 96, wb + W_O, 1024, 0.f, 8, 64 * 8, xcd_bid(opaque_rbid()), rep < REP_GEMM - 1);
      }
      xcd_barrier(xb);
    }
  }
  {
    const WS ws = make_ws(p);
    phase_final(p, ws);
  }
}

extern "C" void kernel_launch(void* const* d_in, const int* in_sizes, int n_in, void* d_out, int out_size, void* d_ws,
                              size_t ws_size, hipStream_t stream) {
  static int grid_blocks = 0;
  if (!grid_blocks) {
    int dev = 0, cus = 0, per_cu = 0;
    hipGetDevice(&dev);
    hipDeviceGetAttribute(&cus, hipDeviceAttributeMultiprocessorCount, dev);
    hipOccupancyMaxActiveBlocksPerMultiprocessor(&per_cu, fwd_megakernel, 512, 0);
    per_cu = 1;
    grid_blocks = cus * per_cu;
  }
  Params p{};
  p.x = (const float*)d_in[0]; p.positions = (const int*)d_in[1]; p.meta = (const float*)d_in[2];
  p.ab_norm = (const float*)d_in[3]; p.ab_w_in = (const float*)d_in[4]; p.ab_conv_w = (const float*)d_in[5];
  p.ab_conv_b = (const float*)d_in[6]; p.ab_gate_a_w = (const float*)d_in[7]; p.ab_gate_a_b = (const float*)d_in[8];
  p.ab_gate_x_w = (const float*)d_in[9]; p.ab_gate_x_b = (const float*)d_in[10]; p.ab_lam = (const float*)d_in[11];
  p.ab_alpha_w = (const float*)d_in[12]; p.ab_alpha_b = (const float*)d_in[13]; p.ab_gla_norm = (const float*)d_in[14];
  p.ab_w_out = (const float*)d_in[15]; p.c_norm = (const float*)d_in[16]; p.c_w_in = (const float*)d_in[17];
  p.c_q_norm = (const float*)d_in[18]; p.c_w_q_up = (const float*)d_in[19]; p.c_kv_norm = (const float*)d_in[20];
  p.c_w_kv_up = (const float*)d_in[21]; p.c_w_out = (const float*)d_in[22]; p.final_norm = (const float*)d_in[23];
  p.out = (float*)d_out;
  p.ws = (unsigned char*)d_ws;
  for (int i = 0; i < 16; ++i) p.inv_freq[i] = (float)pow(10000.0, -(double)i / 16.0);
  hipMemsetAsync((unsigned char*)d_ws + BAR_OFF, 0, XCD_BAR_WORDS * 4, stream);
  void* args[] = {&p};
  hipError_t e = hipLaunchCooperativeKernel((void*)fwd_megakernel, dim3(grid_blocks), dim3(512), args, 0, stream);
  if (e != hipSuccess) fprintf(stderr, "cooperative launch failed: %s (grid %d)\n", hipGetErrorString(e), grid_blocks);
}
```

```cpp
#include <hip/hip_runtime.h>
#include <hip/hip_cooperative_groups.h>
#include <cstdio>
#include <cmath>
namespace cg = cooperative_groups;

typedef unsigned short bf16_t;
typedef short bf16x8 __attribute__((ext_vector_type(8)));
typedef float f32x4 __attribute__((ext_vector_type(4)));
typedef unsigned u32x4 __attribute__((ext_vector_type(4)));
typedef unsigned u32x2 __attribute__((ext_vector_type(2)));

constexpr int T_ = 2064;
constexpr int M_ = 8 * T_;
constexpr int TP_ = 2112;
constexpr float EPS_ = 1e-6f;
constexpr int SMEM_BYTES = 75776;
constexpr float QSCALE_MLA = 0.10206207261596575f * 1.4426950408889634f;

constexpr size_t W_PER_J = 11796480;
constexpr size_t W_IN_E = 0, W_OUT_E = 5373952, W_IN_O = 7471104, W_Q = 9437184, W_KV = 10223616, W_O = 10747904;

struct Params {
  const float* x; const int* positions; const float* meta;
  const float *ab_norm, *ab_w_in, *ab_conv_w, *ab_conv_b, *ab_gate_a_w, *ab_gate_a_b, *ab_gate_x_w, *ab_gate_x_b,
      *ab_lam, *ab_alpha_w, *ab_alpha_b, *ab_gla_norm, *ab_w_out;
  const float *c_norm, *c_w_in, *c_q_norm, *c_w_q_up, *c_kv_norm, *c_w_kv_up, *c_w_out, *final_norm;
  float* out;
  unsigned char* ws;
  float inv_freq[16];
};

struct WS {
  bf16_t *HHI, *HLO; float2* ROPE;
  bf16_t *XA, *GA, *Q, *K, *V, *GB, *AD; float* SSQ; float* BL;
  bf16_t *CQ, *CKV, *GATE, *KR, *QB, *KN, *VT;
  bf16_t* W;
};

__device__ __forceinline__ unsigned char* opaque_ptr(unsigned char* q) {
  unsigned lo = (unsigned)(unsigned long long)q, hi = (unsigned)((unsigned long long)q >> 32);
  asm volatile("" : "+v"(lo), "+v"(hi));
  lo = __builtin_amdgcn_readfirstlane(lo); hi = __builtin_amdgcn_readfirstlane(hi);
  typedef __attribute__((address_space(1))) unsigned char gu8;
  return (unsigned char*)(gu8*)(((unsigned long long)hi << 32) | lo);
}
__device__ __forceinline__ WS make_ws(const Params& p) {
  WS w;
  unsigned char* b = opaque_ptr(p.ws);
  w.HHI = (bf16_t*)b; b += (size_t)M_ * 2048;
  w.HLO = (bf16_t*)b; b += (size_t)M_ * 2048;
  w.ROPE = (float2*)b; b += (size_t)M_ * 128;
  unsigned char* r = b;
  w.XA = (bf16_t*)r; r += (size_t)M_ * 2048;
  w.GA = (bf16_t*)r; r += (size_t)M_ * 2048;
  w.Q = (bf16_t*)r; r += (size_t)M_ * 1024;
  w.K = (bf16_t*)r; r += (size_t)M_ * 1024;
  w.V = (bf16_t*)r; r += (size_t)M_ * 2048;
  w.GB = (bf16_t*)r; r += (size_t)M_ * 2048;
  w.AD = (bf16_t*)r; r += (size_t)M_ * 32;
  w.SSQ = (float*)r; r += (size_t)M_ * 128;
  w.BL = (float*)r; r += (size_t)8 * 4 * 33 * 128 * 4;
  r = b;
  w.CQ = (bf16_t*)r; r += (size_t)M_ * 1024;
  w.CKV = (bf16_t*)r; r += (size_t)M_ * 512;
  w.GATE = (bf16_t*)r; r += (size_t)M_ * 2048;
  w.KR = (bf16_t*)r; r += (size_t)M_ * 64;
  w.QB = (bf16_t*)r; r += (size_t)M_ * 3072;
  w.KN = (bf16_t*)r; r += (size_t)M_ * 2048;
  w.VT = (bf16_t*)r; r += (size_t)128 * 64 * TP_ * 2;
  w.W = (bf16_t*)opaque_ptr((unsigned char*)p.out);
  return w;
}

__device__ __forceinline__ unsigned cvt_pk_bf16(float lo, float hi) {
  typedef float f32x2_t __attribute__((ext_vector_type(2)));
  typedef __bf16 bf16x2_t __attribute__((ext_vector_type(2)));
  const f32x2_t v = {lo, hi};
  const bf16x2_t r = __builtin_convertvector(v, bf16x2_t);
  return __builtin_bit_cast(unsigned, r);
}
__device__ __forceinline__ f32x4 scale4(f32x4 a, float r) {
  asm volatile("" : "+v"(r));
  float x0 = a[0] * r, x1 = a[1] * r, x2 = a[2] * r, x3 = a[3] * r;
  asm volatile("" : "+v"(x0), "+v"(x1), "+v"(x2), "+v"(x3));
  return (f32x4){x0, x1, x2, x3};
}
__device__ __forceinline__ float bf2f(bf16_t v) { return __uint_as_float(((unsigned)v) << 16); }
__device__ __forceinline__ float bflo(unsigned v) { return __uint_as_float(v << 16); }
__device__ __forceinline__ float bfhi(unsigned v) { return __uint_as_float(v & 0xffff0000u); }
__device__ __forceinline__ bf16_t f2bf(float f) { return (bf16_t)(cvt_pk_bf16(f, 0.f) & 0xffffu); }
__device__ __forceinline__ float sigmoidf_(float x) { return __builtin_amdgcn_rcpf(1.f + __expf(-x)); }
__device__ __forceinline__ float siluf_(float x) { return x * __builtin_amdgcn_rcpf(1.f + __expf(-x)); }
__device__ __forceinline__ bf16x8 as_bf16x8(u32x4 v) { return __builtin_bit_cast(bf16x8, v); }
__device__ __forceinline__ int half_id() { return __builtin_amdgcn_readfirstlane((int)(threadIdx.x >> 8)); }
__device__ __forceinline__ int opaque_tid() { int t = threadIdx.x & 255; asm volatile("" : "+v"(t)); return t; }
__device__ __forceinline__ int opaque_tid512() { int t = threadIdx.x; asm volatile("" : "+v"(t)); return t; }
__device__ __forceinline__ int xcd_bid(int bid) { const int gpx = gridDim.x >> 3; return (bid & 7) * gpx + (bid >> 3); }
__device__ __forceinline__ int opaque_bid() { int t = blockIdx.x * 2 + half_id(); asm volatile("" : "+s"(t)); return t; }
__device__ __forceinline__ int opaque_rbid() { int t = blockIdx.x; asm volatile("" : "+s"(t)); return t; }
#define NVB ((int)gridDim.x * 2)
#define MFMA16(a, b, c) __builtin_amdgcn_mfma_f32_16x16x32_bf16((a), (b), (c), 0, 0, 0)

__shared__ __attribute__((aligned(16))) unsigned char smem_all[2 * SMEM_BYTES + 16];
#define smem (smem_all + half_id() * SMEM_BYTES)

#define XB_TMO      128
#define XB_XCNT(j)  (256  + 64 * (j))
#define XB_XSUB(j)  (1280 + 64 * (j))
#define XB_XGEN(j)  (2304 + 64 * (j))
#define XB_TOP      3328
#define XB_TOPGEN   3392
#define XCD_BAR_WORDS 3456
#define XB_SPIN_CAP (1u << 18)
#define LAS __attribute__((address_space(3)))
constexpr size_t BAR_OFF = 260046848;

__device__ __forceinline__ unsigned xb_ld(unsigned* p)              { return __hip_atomic_load(p, __ATOMIC_RELAXED, __HIP_MEMORY_SCOPE_AGENT); }
__device__ __forceinline__ unsigned xb_add(unsigned* p, unsigned v) { return __hip_atomic_fetch_add(p, v, __ATOMIC_RELAXED, __HIP_MEMORY_SCOPE_AGENT); }
__device__ __forceinline__ unsigned xb_xcc_id() { return (unsigned)__builtin_amdgcn_s_getreg((3 << 11) | 20) & 0xFu; }
#define XB_SPIN(cond, bar) do { unsigned _sp = 0; while (cond) { __builtin_amdgcn_s_sleep(1); \
    if ((++_sp & 255u) == 0u) { if (xb_ld(&(bar)[XB_TMO])) break; if (_sp > XB_SPIN_CAP) { atomicAdd(&(bar)[XB_TMO], 1u); break; } } } } while (0)

struct XcdBarrier { unsigned* bar; unsigned x; volatile LAS unsigned* st; };

__device__ __forceinline__ XcdBarrier xcd_barrier_post(unsigned* bar, volatile LAS unsigned* st) {
    XcdBarrier b; b.bar = bar; b.x = xb_xcc_id(); b.st = st;
    if (threadIdx.x == 0) (void)xb_add(&bar[XB_XCNT(b.x)], 1u);
    return b;
}
__device__ __forceinline__ void xcd_barrier_complete(unsigned* bar, unsigned x, unsigned& nloc, unsigned& nx) {
    const unsigned G = gridDim.x * gridDim.y * gridDim.z;
    unsigned sum, cnt, mine, sp = 0u;
    for (;;) {
        sum = 0u; cnt = 0u; mine = 0u;
#pragma unroll
        for (unsigned j = 0; j < 16; ++j) { const unsigned c = xb_ld(&bar[XB_XCNT(j)]); sum += c; cnt += (c > 0u) ? 1u : 0u; mine = (j == x) ? c : mine; }
        if (sum == G) break;
        __builtin_amdgcn_s_sleep(1);
        if ((++sp & 255u) == 0u) { if (xb_ld(&bar[XB_TMO])) break; if (sp > XB_SPIN_CAP) { atomicAdd(&bar[XB_TMO], 1u); break; } }
    }
    nloc = mine > 0u ? mine : 1u; nx = cnt > 0u ? cnt : 1u;
}
__device__ __forceinline__ void xcd_barrier(const XcdBarrier& b) {
    asm volatile("s_waitcnt vmcnt(0)" ::: "memory");
    __syncthreads();
    if (threadIdx.x == 0) {
        unsigned* bar = b.bar;
        __builtin_amdgcn_s_waitcnt(0);
        unsigned nloc = b.st[0], nx = b.st[1];
        if (nloc == 0u) { xcd_barrier_complete(bar, b.x, nloc, nx); b.st[0] = nloc; b.st[1] = nx; }
        const unsigned old = xb_add(&bar[XB_XSUB(b.x)], 1u);
        const unsigned gen = old / nloc;
        if (old + 1u == (gen + 1u) * nloc) {
            __builtin_amdgcn_fence(__ATOMIC_RELEASE, "agent");
            asm volatile("s_waitcnt vmcnt(0)" ::: "memory");
            const unsigned og = xb_add(&bar[XB_TOP], 1u);
            const unsigned tg = og / nx;
            if (og + 1u == (tg + 1u) * nx) xb_add(&bar[XB_TOPGEN], 1u);
            else XB_SPIN(xb_ld(&bar[XB_TOPGEN]) == tg, bar);
            __builtin_amdgcn_fence(__ATOMIC_ACQUIRE, "agent");
            xb_add(&bar[XB_XGEN(b.x)], 1u);
            asm volatile("s_waitcnt vmcnt(0)" ::: "memory");
        } else {
            XB_SPIN(xb_ld(&bar[XB_XGEN(b.x)]) == gen, bar);
            __builtin_amdgcn_fence(__ATOMIC_ACQUIRE, "agent");
            asm volatile("s_waitcnt vmcnt(0)" ::: "memory");
        }
    }
    __syncthreads();
}


__device__ __forceinline__ int map_even_in(int n) { return n < 4096 ? n : (n < 5120 ? n + 16 : (n < 5136 ? n - 1024 : -1)); }
__device__ __forceinline__ int map_odd_in(int n) { return n < 768 ? n : (n < 1792 ? n + 32 : (n < 1824 ? n - 1024 : -1)); }

__device__ __forceinline__ void convert_tile(const float* __restrict__ src, int K, int Nsrc, bf16_t* __restrict__ dst,
                                             int kind, const float* __restrict__ g, int tile) {
  float* tl = (float*)smem;
  const int nkt = K >> 7;
  const int ntile = tile / nkt, ktile = tile - ntile * nkt;
  const int n0 = ntile * 64, k0 = ktile * 128;
  const int tid = opaque_tid();
  const int nl = tid & 63, kq = tid >> 6;
  const int n = n0 + nl;
  const int sc = kind == 0 ? map_even_in(n) : (kind == 1 ? map_odd_in(n) : n);
  float cs = 1.f;
  if (kind == 0 && n >= 2048 && n < 2560) cs = 0.08838834764831845f;
  if (kind == 2) cs = QSCALE_MLA;
  float v[32];
#pragma unroll
  for (int i = 0; i < 32; ++i) {
    const int kl = kq + 4 * i;
    v[i] = 0.f;
    if (sc >= 0) v[i] = src[(size_t)(k0 + kl) * Nsrc + sc];
  }
#pragma unroll
  for (int i = 0; i < 32; ++i) {
    const int kl = kq + 4 * i;
    float t = v[i] * cs;
    if (g) t *= g[k0 + kl];
    tl[kl * 65 + nl] = t;
  }
  __syncthreads();
#pragma unroll
  for (int i = 0; i < 4; ++i) {
    const int c = tid + 256 * i;
    const int nl2 = c >> 4, kc = c & 15;
    float t[8];
#pragma unroll
    for (int jj = 0; jj < 8; ++jj) t[jj] = tl[(kc * 8 + jj) * 65 + nl2];
    u32x4 pk;
    pk.x = cvt_pk_bf16(t[0], t[1]); pk.y = cvt_pk_bf16(t[2], t[3]); pk.z = cvt_pk_bf16(t[4], t[5]); pk.w = cvt_pk_bf16(t[6], t[7]);
    *(u32x4*)(dst + (size_t)(n0 + nl2) * K + k0 + kc * 8) = pk;
  }
  __syncthreads();
}

__device__ __forceinline__ void phase_prologue(const Params& p, const WS& ws) {
  for (int id = opaque_bid(); id < 2880; id += NVB) {
    const int j = id / 1440; int r = id - j * 1440;
    bf16_t* wb = ws.W + (size_t)j * W_PER_J;
    if (r < 656) convert_tile(p.ab_w_in + (size_t)j * 1024 * 5136, 1024, 5136, wb + W_IN_E, 0, p.ab_norm + j * 1024, r);
    else if ((r -= 656) < 256) convert_tile(p.ab_w_out + (size_t)j * 2048 * 1024, 2048, 1024, wb + W_OUT_E, 3, nullptr, r);
    else if ((r -= 256) < 240) convert_tile(p.c_w_in + (size_t)j * 1024 * 1824, 1024, 1824, wb + W_IN_O, 1, p.c_norm + j * 1024, r);
    else if ((r -= 240) < 96) convert_tile(p.c_w_q_up + (size_t)j * 512 * 1536, 512, 1536, wb + W_Q, 2, p.c_q_norm + j * 512, r);
    else if ((r -= 96) < 64) convert_tile(p.c_w_kv_up + (size_t)j * 256 * 2048, 256, 2048, wb + W_KV, 3, p.c_kv_norm + j * 256, r);
    else { r -= 64; convert_tile(p.c_w_out + (size_t)j * 1024 * 1024, 1024, 1024, wb + W_O, 3, nullptr, r); }
  }
  const size_t gtid = (size_t)opaque_bid() * 256 + opaque_tid(), gsz = (size_t)NVB * 256;
  for (size_t idx0 = gtid; idx0 < (size_t)M_ * 256; idx0 += 4 * gsz) {
    float4 v4[4];
#pragma unroll
    for (int q = 0; q < 4; ++q) {
      const size_t idx = idx0 + q * gsz;
      v4[q] = make_float4(0.f, 0.f, 0.f, 0.f);
      if (idx < (size_t)M_ * 256) {
        const int row = (int)(idx >> 8), c4 = (int)(idx & 255);
        const int b = row / T_, t = row - b * T_;
        const float* src = t < 16 ? p.meta + (size_t)t * 1024 : p.x + ((size_t)b * 2048 + (t - 16)) * 1024;
        v4[q] = *(const float4*)(src + c4 * 4);
      }
    }
#pragma unroll
    for (int q = 0; q < 4; ++q) {
      const size_t idx = idx0 + q * gsz;
      if (idx < (size_t)M_ * 256) {
        const float4 v = v4[q];
        u32x2 hi; hi.x = cvt_pk_bf16(v.x, v.y); hi.y = cvt_pk_bf16(v.z, v.w);
        u32x2 lo; lo.x = cvt_pk_bf16(v.x - bflo(hi.x), v.y - bfhi(hi.x)); lo.y = cvt_pk_bf16(v.z - bflo(hi.y), v.w - bfhi(hi.y));
        *(u32x2*)(ws.HHI + idx * 4) = hi;
        *(u32x2*)(ws.HLO + idx * 4) = lo;
      }
    }
  }
  for (size_t idx = gtid; idx < (size_t)M_ * 16; idx += gsz) {
    const int row = (int)(idx >> 4), i = (int)(idx & 15);
    const int b = row / T_, t = row - b * T_;
    const int pos = t < 16 ? t : p.positions[b * 2048 + (t - 16)] + 16;
    const float angf = (float)pos * p.inv_freq[i];
    const double rev = (double)angf * 0.15915494309189533577;
    const float fr = (float)(rev - rint(rev));
    ws.ROPE[idx] = make_float2(__builtin_amdgcn_cosf(fr), __builtin_amdgcn_sinf(fr));
  }
}

#ifndef REP_GEMM
#define REP_GEMM 1
#endif
#ifndef REP_ATTN
#define REP_ATTN 1
#endif
#ifndef REP_E2
#define REP_E2 1
#endif
enum { EPI_E1 = 0, EPI_O1 = 1, EPI_Q = 2, EPI_KV = 3, EPI_RES = 4 };

template <int EPI, int TI>
__device__ __forceinline__ void gemm_epilogue(const WS& ws, const f32x4 (&acc)[4][TI], const float (&rs)[TI], int tok0, int n0,
                                              int wm, int wn, int lr, int lq, bool dry) {
  auto tokr = [&](int ti) { return tok0 + (ti < 4 ? wn * 64 + ti * 16 : 128 + wn * 16) + lr; };
  auto okr = [&](int ti) { return ti < 4 || (wn == 0 && lr == 0); };
  const int nw = n0 + wm * 64;
  if (EPI == EPI_E1) {
    bf16_t* dst; int ld, c;
    if (n0 < 1024) { dst = ws.XA; ld = 1024; c = n0; }
    else if (n0 < 2048) { dst = ws.GA; ld = 1024; c = n0 - 1024; }
    else if (n0 < 2560) { dst = ws.Q; ld = 512; c = n0 - 2048; }
    else if (n0 < 3072) { dst = ws.K; ld = 512; c = n0 - 2560; }
    else if (n0 < 4096) { dst = ws.V; ld = 1024; c = n0 - 3072; }
    else if (n0 < 5120) { dst = ws.GB; ld = 1024; c = n0 - 4096; }
    else { dst = ws.AD; ld = 16; c = 0; }
    const bool isad = n0 >= 5120;
#pragma unroll
    for (int ni = 0; ni < 4; ++ni) {
      if (isad && (wm != 0 || ni != 0)) continue;
#pragma unroll
      for (int ti = 0; ti < TI; ++ti) {
        const f32x4 v = scale4(acc[ni][ti], rs[ti]);
        u32x2 pk; pk.x = cvt_pk_bf16(v[0], v[1]); pk.y = cvt_pk_bf16(v[2], v[3]);
        if (okr(ti)) *(u32x2*)(dst + (size_t)tokr(ti) * ld + c + wm * 64 + ni * 16 + 4 * lq) = pk;
      }
    }
  } else if (EPI == EPI_O1) {
    if (n0 < 1792) {
      bf16_t* dst; int ld, c;
      if (n0 < 512) { dst = ws.CQ; ld = 512; c = n0; }
      else if (n0 < 768) { dst = ws.CKV; ld = 256; c = n0 - 512; }
      else { dst = ws.GATE; ld = 1024; c = n0 - 768; }
#pragma unroll
      for (int ni = 0; ni < 4; ++ni)
#pragma unroll
        for (int ti = 0; ti < TI; ++ti) {
          const f32x4 v = scale4(acc[ni][ti], rs[ti]);
          u32x2 pk; pk.x = cvt_pk_bf16(v[0], v[1]); pk.y = cvt_pk_bf16(v[2], v[3]);
          if (okr(ti)) *(u32x2*)(dst + (size_t)tokr(ti) * ld + c + wm * 64 + ni * 16 + 4 * lq) = pk;
        }
    } else if (wm == 0) {
#pragma unroll
      for (int ti = 0; ti < TI; ++ti) {
        const int tok = tokr(ti);
        const f32x4 x1 = scale4(acc[0][ti], rs[ti]), x2 = scale4(acc[1][ti], rs[ti]);
        float o1[4], o2[4];
#pragma unroll
        for (int jj = 0; jj < 4; ++jj) {
          const float2 cs = ws.ROPE[(size_t)tok * 16 + 4 * lq + jj];
          o1[jj] = x1[jj] * cs.x - x2[jj] * cs.y;
          o2[jj] = x2[jj] * cs.x + x1[jj] * cs.y;
        }
        u32x2 pk; pk.x = cvt_pk_bf16(o1[0], o1[1]); pk.y = cvt_pk_bf16(o1[2], o1[3]);
        *(u32x2*)(ws.KR + (size_t)tok * 32 + 4 * lq) = pk;
        pk.x = cvt_pk_bf16(o2[0], o2[1]); pk.y = cvt_pk_bf16(o2[2], o2[3]);
        *(u32x2*)(ws.KR + (size_t)tok * 32 + 16 + 4 * lq) = pk;
      }
    }
  } else if (EPI == EPI_Q) {
#pragma unroll
    for (int ni = 0; ni < 4; ++ni)
#pragma unroll
      for (int ti = 0; ti < TI; ++ti) {
        const f32x4 v = scale4(acc[ni][ti], rs[ti]);
        u32x2 pk; pk.x = cvt_pk_bf16(v[0], v[1]); pk.y = cvt_pk_bf16(v[2], v[3]);
        if (okr(ti)) *(u32x2*)(ws.QB + (size_t)tokr(ti) * 1536 + nw + ni * 16 + 4 * lq) = pk;
      }
  } else if (EPI == EPI_KV) {
    const int hd = nw >> 7;
    const bool isv = (nw & 127) >= 64;
    if (!isv) {
#pragma unroll
      for (int ni = 0; ni < 4; ++ni)
#pragma unroll
        for (int ti = 0; ti < TI; ++ti) {
          const f32x4 v = scale4(acc[ni][ti], rs[ti]);
          u32x2 pk; pk.x = cvt_pk_bf16(v[0], v[1]); pk.y = cvt_pk_bf16(v[2], v[3]);
          if (okr(ti)) *(u32x2*)(ws.KN + (size_t)tokr(ti) * 1024 + hd * 64 + ni * 16 + 4 * lq) = pk;
        }
    } else {
#pragma unroll
      for (int ti = 0; ti < TI; ++ti) {
        const int tok = tokr(ti);
        const int b = tok / T_, t = tok - b * T_;
        bf16_t* vb = ws.VT + ((size_t)(b * 16 + hd) * 64) * TP_ + t;
#pragma unroll
        for (int ni = 0; ni < 4; ++ni) {
          const f32x4 v = scale4(acc[ni][ti], rs[ti]);
#pragma unroll
          for (int jj = 0; jj < 4; ++jj) if (okr(ti)) vb[(size_t)(ni * 16 + 4 * lq + jj) * TP_] = f2bf(v[jj]);
        }
      }
    }
  } else {
#pragma unroll
    for (int ni = 0; ni < 4; ++ni)
#pragma unroll
      for (int ti = 0; ti < TI; ++ti) {
        if (!okr(ti)) continue;
        const size_t off = (size_t)tokr(ti) * 1024 + nw + ni * 16 + 4 * lq;
        const u32x2 hi = *(const u32x2*)(ws.HHI + off), lo = *(const u32x2*)(ws.HLO + off);
        const float h0 = bflo(hi.x) + bflo(lo.x) + acc[ni][ti][0], h1 = bfhi(hi.x) + bfhi(lo.x) + acc[ni][ti][1];
        const float h2 = bflo(hi.y) + bflo(lo.y) + acc[ni][ti][2], h3 = bfhi(hi.y) + bfhi(lo.y) + acc[ni][ti][3];
        u32x2 nh; nh.x = cvt_pk_bf16(h0, h1); nh.y = cvt_pk_bf16(h2, h3);
        u32x2 nl; nl.x = cvt_pk_bf16(h0 - bflo(nh.x), h1 - bfhi(nh.x)); nl.y = cvt_pk_bf16(h2 - bflo(nh.y), h3 - bfhi(nh.y));
        if (!dry) { *(u32x2*)(ws.HHI + off) = nh; *(u32x2*)(ws.HLO + off) = nl; }
      }
  }
}

__device__ __forceinline__ float sumsq8(bf16x8 v) {
  const u32x4 u = __builtin_bit_cast(u32x4, v);
  float s = 0.f, t;
  t = bflo(u.x); s += t * t; t = bfhi(u.x); s += t * t; t = bflo(u.y); s += t * t; t = bfhi(u.y); s += t * t;
  t = bflo(u.z); s += t * t; t = bfhi(u.z); s += t * t; t = bflo(u.w); s += t * t; t = bfhi(u.w); s += t * t;
  return s;
}
__device__ __forceinline__ void tile_of(int pos, int ntn, int& mt, int& nt) {
  const int full = 64 * ntn;
  if (pos < full) { const int panel = pos / (8 * ntn); const int rem = pos - panel * 8 * ntn; nt = rem >> 3; mt = panel * 8 + (rem & 7); }
  else { mt = 64; nt = pos - full; }
}
template <int EPI>
__device__ __forceinline__ void gemm_wide(const WS& ws, const bf16_t* A, int lda, const bf16_t* __restrict__ W, int K, float invK,
                                          int ntn, int ntiles, int bid) {
  unsigned char* As = smem_all + half_id() * 32768;
  unsigned char* Bs = smem_all + 65536;
  float* rsl = (float*)(smem_all + 131072 + half_id() * 1024);
  const int tid = opaque_tid(), lane = tid & 63, w = tid >> 6, wm = w >> 1, wn = w & 1, lr = lane & 15, lq = lane >> 4;
  const int tid5 = opaque_tid512(), hh = half_id();
  const int G = gridDim.x;
  const int nk = K >> 6;
  if (bid < ntiles) {
    const int my_tiles = (ntiles - 1 - bid) / G + 1;
    const int last_id = bid + (my_tiles - 1) * G;
    const int S = my_tiles * nk;
    f32x4 accA[4][4], accB[4][4];
#pragma unroll
    for (int a = 0; a < 4; ++a)
#pragma unroll
      for (int b = 0; b < 4; ++b) { accA[a][b] = (f32x4){0.f, 0.f, 0.f, 0.f}; accB[a][b] = (f32x4){0.f, 0.f, 0.f, 0.f}; }
    u32x4 ra[4], rb[4];
    float ss[4] = {0.f, 0.f, 0.f, 0.f};
    int l_id = bid, l_kt = 0, c_id = bid, c_kt = 0, st_kt = 0;
    const int srow = tid >> 3;
    const int soff = srow * 128 + (((tid & 7) ^ (srow & 7)) << 4);
    const int wrow = tid5 >> 3;
    const int woff = wrow * 128 + (((tid5 & 7) ^ (wrow & 7)) << 4);
    auto issue = [&]() {
      const int idc = l_id < last_id ? l_id : last_id;
      int mt, nt; tile_of(idc, ntn, mt, nt);
      const int arow = mt * 256 + hh * 128 + srow;
      const bf16_t* akb = A + l_kt * 64 + (tid & 7) * 8;
      const bf16_t* wp = W + (size_t)(nt * 256 + wrow) * K + l_kt * 64 + (tid5 & 7) * 8;
#pragma unroll
      for (int i = 0; i < 4; ++i) {
        int r = arow + 32 * i; r = r < M_ ? r : M_ - 1;
        ra[i] = *(const u32x4*)(akb + (size_t)r * lda);
        rb[i] = *(const u32x4*)(wp + (size_t)i * 64 * K);
      }
      if (++l_kt == nk) { l_kt = 0; l_id += G; }
    };
    auto store = [&](int buf) {
#pragma unroll
      for (int i = 0; i < 4; ++i) {
        ss[i] += sumsq8(__builtin_bit_cast(bf16x8, ra[i]));
        *(u32x4*)(As + buf * 16384 + i * 4096 + soff) = ra[i];
        *(u32x4*)(Bs + buf * 32768 + i * 8192 + woff) = rb[i];
      }
      if (++st_kt == nk) {
        st_kt = 0;
#pragma unroll
        for (int i = 0; i < 4; ++i) {
          float t = ss[i];
          t += __shfl_xor(t, 1); t += __shfl_xor(t, 2); t += __shfl_xor(t, 4);
          if ((tid & 7) == 0) rsl[srow + 32 * i] = rsqrtf(t * invK + EPS_);
          ss[i] = 0.f;
        }
      }
    };
    auto compute = [&](int buf) {
      const unsigned char* Ab = As + buf * 16384 + (wn * 64 + lr) * 128;
      const unsigned char* Bb = Bs + buf * 32768 + (wm * 64 + lr) * 128;
#pragma unroll
      for (int ks = 0; ks < 2; ++ks) {
        const int sw = ((ks * 4 + lq) ^ (lr & 7)) << 4;
        bf16x8 xf[4], wf[4];
#pragma unroll
        for (int i = 0; i < 4; ++i) { xf[i] = *(const bf16x8*)(Ab + i * 2048 + sw); wf[i] = *(const bf16x8*)(Bb + i * 2048 + sw); }
#pragma unroll
        for (int ni = 0; ni < 4; ++ni)
#pragma unroll
          for (int ti = 0; ti < 4; ++ti) accA[ni][ti] = MFMA16(wf[ni], xf[ti], accA[ni][ti]);
#pragma unroll
        for (int i = 0; i < 4; ++i) wf[i] = *(const bf16x8*)(Bb + 16384 + i * 2048 + sw);
#pragma unroll
        for (int ni = 0; ni < 4; ++ni)
#pragma unroll
          for (int ti = 0; ti < 4; ++ti) accB[ni][ti] = MFMA16(wf[ni], xf[ti], accB[ni][ti]);
      }
    };
    auto tile_end = [&]() {
      float rs[4];
#pragma unroll
      for (int ti = 0; ti < 4; ++ti) rs[ti] = rsl[wn * 64 + ti * 16 + lr];
      int mt, nt; tile_of(c_id, ntn, mt, nt);
      const int tokb = mt * 256 + hh * 128;
      if (tokb < M_) {
        gemm_epilogue<EPI, 4>(ws, accA, rs, tokb, nt * 256, wm, wn, lr, lq, false);
        if (nt * 256 + 128 < 5248) gemm_epilogue<EPI, 4>(ws, accB, rs, tokb, nt * 256 + 128, wm, wn, lr, lq, false);
      }
#pragma unroll
      for (int a = 0; a < 4; ++a)
#pragma unroll
        for (int b = 0; b < 4; ++b) { accA[a][b] = (f32x4){0.f, 0.f, 0.f, 0.f}; accB[a][b] = (f32x4){0.f, 0.f, 0.f, 0.f}; }
      c_id += G;
    };
    issue();
    store(0);
    __syncthreads();
#pragma unroll 1
    for (int s = 0; s < S; ++s) {
      issue();
      compute(s & 1);
      if (++c_kt == nk) { c_kt = 0; tile_end(); }
      store((s + 1) & 1);
      __syncthreads();
    }
  }
  __syncthreads();
}

__device__ __forceinline__ void gemm_rem_splitk(const WS& ws, const bf16_t* A, const bf16_t* __restrict__ W, int bid) {
  unsigned char* As = smem;
  unsigned char* Bs = smem + 32768;
  float* xacc = (float*)(smem_all + SMEM_BYTES);
  float* xss = (float*)(smem_all + SMEM_BYTES + 65536);
  float* rsl = (float*)(smem_all + 65536);
  const int tid = opaque_tid(), lane = tid & 63, w = tid >> 6, wm = w >> 1, wn = w & 1, lr = lane & 15, lq = lane >> 4;
  const int hh = half_id();
  if (bid < 169) {
    int rt, nt;
    if (bid < 129) { rt = bid; nt = 40; } else { rt = 128; nt = bid - 129; }
    f32x4 acc[4][4];
#pragma unroll
    for (int a = 0; a < 4; ++a)
#pragma unroll
      for (int b = 0; b < 4; ++b) acc[a][b] = (f32x4){0.f, 0.f, 0.f, 0.f};
    u32x4 ra[4], rb[4];
    float ss[4] = {0.f, 0.f, 0.f, 0.f};
    const int srow = tid >> 3;
    const int soff = srow * 128 + (((tid & 7) ^ (srow & 7)) << 4);
    const bf16_t* ap = A + (size_t)(rt * 128 + srow) * 1024 + hh * 512 + (tid & 7) * 8;
    const bf16_t* wp = W + (size_t)(nt * 128 + srow) * 1024 + hh * 512 + (tid & 7) * 8;
    auto issue = [&](int kt) {
#pragma unroll
      for (int i = 0; i < 4; ++i) {
        ra[i] = *(const u32x4*)(ap + (size_t)i * 32 * 1024 + kt * 64);
        rb[i] = *(const u32x4*)(wp + (size_t)i * 32 * 1024 + kt * 64);
      }
    };
    auto store = [&](int buf) {
#pragma unroll
      for (int i = 0; i < 4; ++i) {
        ss[i] += sumsq8(__builtin_bit_cast(bf16x8, ra[i]));
        *(u32x4*)(As + buf * 16384 + i * 4096 + soff) = ra[i];
        *(u32x4*)(Bs + buf * 16384 + i * 4096 + soff) = rb[i];
      }
    };
    issue(0);
    store(0);
    __syncthreads();
#pragma unroll 1
    for (int kt = 0; kt < 8; ++kt) {
      const int buf = kt & 1;
      if (kt + 1 < 8) issue(kt + 1);
      const unsigned char* Ab = As + buf * 16384 + (wn * 64 + lr) * 128;
      const unsigned char* Bb = Bs + buf * 16384 + (wm * 64 + lr) * 128;
#pragma unroll
      for (int ks = 0; ks < 2; ++ks) {
        const int sw = ((ks * 4 + lq) ^ (lr & 7)) << 4;
        bf16x8 wf[4], xf[4];
#pragma unroll
        for (int i = 0; i < 4; ++i) { wf[i] = *(const bf16x8*)(Bb + i * 2048 + sw); xf[i] = *(const bf16x8*)(Ab + i * 2048 + sw); }
#pragma unroll
        for (int ni = 0; ni < 4; ++ni)
#pragma unroll
          for (int ti = 0; ti < 4; ++ti) acc[ni][ti] = MFMA16(wf[ni], xf[ti], acc[ni][ti]);
      }
      if (kt + 1 < 8) store(buf ^ 1);
      __syncthreads();
    }
#pragma unroll
    for (int i = 0; i < 4; ++i) {
      float t = ss[i];
      t += __shfl_xor(t, 1); t += __shfl_xor(t, 2); t += __shfl_xor(t, 4);
      if ((tid & 7) == 0) { if (hh) xss[srow + 32 * i] = t; else rsl[srow + 32 * i] = t; }
    }
    if (hh) {
#pragma unroll
      for (int a = 0; a < 4; ++a)
#pragma unroll
        for (int b = 0; b < 4; ++b)
#pragma unroll
          for (int e = 0; e < 4; ++e) xacc[((a * 4 + b) * 4 + e) * 256 + tid] = acc[a][b][e];
    }
    __syncthreads();
    if (!hh) {
#pragma unroll
      for (int a = 0; a < 4; ++a)
#pragma unroll
        for (int b = 0; b < 4; ++b)
#pragma unroll
          for (int e = 0; e < 4; ++e) acc[a][b][e] += xacc[((a * 4 + b) * 4 + e) * 256 + tid];
      float rs[4];
#pragma unroll
      for (int ti = 0; ti < 4; ++ti) {
        const int r = wn * 64 + ti * 16 + lr;
        rs[ti] = rsqrtf((rsl[r] + xss[r]) * (1.f / 1024.f) + EPS_);
      }
      gemm_epilogue<EPI_E1, 4>(ws, acc, rs, rt * 128, nt * 128, wm, wn, lr, lq, false);
    }
  }
  __syncthreads();
}

__device__ __forceinline__ void rem_tile(int pos, int& mt, int& nt) { if (pos < 65) { mt = pos; nt = 40; } else { mt = 64; nt = pos - 65; } }
template <bool RS, int EPI, int TI, int TMAP = 0>
__device__ __forceinline__ void gemm_stream(const WS& ws, const bf16_t* A0, const bf16_t* A1, int lda, int ktsplit, int kstride,
                                            const bf16_t* __restrict__ W, int K, float invK, int ntn, int ntiles, int bid, bool dry) {
  constexpr int BMH = (TI == 5) ? 129 : 128;
  constexpr int ASTG = 16384;
  unsigned char* As = smem;
  unsigned char* Bs = smem_all + 2 * ASTG;
  float* rsl = (float*)(smem + 65536);
  int xbase = 66048;
  asm volatile("" : "+v"(xbase));
  unsigned char* Ax0 = smem + xbase;
  const int tid = opaque_tid(), lane = tid & 63, w = tid >> 6, wm = w >> 1, wn = w & 1, lr = lane & 15, lq = lane >> 4;
  const int tid5 = opaque_tid512(), hh = half_id();
  const int G = gridDim.x;
  const int nk = K >> 6;
  if (bid < ntiles) {
    const int my_tiles = (ntiles - 1 - bid) / G + 1;
    const int last_id = bid + (my_tiles - 1) * G;
    const int S = my_tiles * nk;
    f32x4 acc[4][TI];
#pragma unroll
    for (int a = 0; a < 4; ++a)
#pragma unroll
      for (int b = 0; b < TI; ++b) acc[a][b] = (f32x4){0.f, 0.f, 0.f, 0.f};
    u32x4 ra0[4], rb0[2], ra1[4], rb1[2];
    u32x4 rx0 = (u32x4){0u, 0u, 0u, 0u}, rx1 = (u32x4){0u, 0u, 0u, 0u};
    float ss[5] = {0.f, 0.f, 0.f, 0.f, 0.f};
    int l_id = bid, l_kt = 0, c_id = bid, c_kt = 0, st_kt = 0;
    const int srow = tid >> 3;
    const int soff = srow * 128 + (((tid & 7) ^ (srow & 7)) << 4);

    const int wrow = tid5 >> 3;
    const int woff = wrow * 128 + (((tid5 & 7) ^ (wrow & 7)) << 4);
    auto issue = [&](u32x4 (&ra)[4], u32x4 (&rb)[2], u32x4& rx) {
      const int idc = l_id < last_id ? l_id : last_id;
      int mt, nt; if (TMAP == 1) rem_tile(idc, mt, nt); else tile_of(idc, ntn, mt, nt);
      const bf16_t* A = (l_kt < ktsplit) ? A0 : A1;
      const int kk = (l_kt < ktsplit) ? l_kt : l_kt - ktsplit;
      const int arow = mt * 2 * BMH + hh * BMH + srow;
      const bf16_t* akb = A + kk * kstride + (tid & 7) * 8;
      const bf16_t* wp = W + (size_t)(nt * 128 + wrow) * K + l_kt * 64 + (tid5 & 7) * 8;
#pragma unroll
      for (int i = 0; i < 4; ++i) {
        int r = arow + 32 * i; r = r < M_ ? r : M_ - 1;
        ra[i] = *(const u32x4*)(akb + (size_t)r * lda);
      }
#pragma unroll
      for (int i = 0; i < 2; ++i) rb[i] = *(const u32x4*)(wp + (size_t)i * 64 * K);
      if (TI == 5) { if (srow == 0) rx = *(const u32x4*)(akb + (size_t)(arow + 128) * lda); }
      if (++l_kt == nk) { l_kt = 0; l_id += G; }
    };
    auto store = [&](const u32x4 (&ra)[4], const u32x4 (&rb)[2], const u32x4& rx, int buf) {
#pragma unroll
      for (int i = 0; i < 4; ++i) {
        if (RS) ss[i] += sumsq8(__builtin_bit_cast(bf16x8, ra[i]));
        *(u32x4*)(As + buf * ASTG + i * 4096 + soff) = ra[i];
      }
#pragma unroll
      for (int i = 0; i < 2; ++i) *(u32x4*)(Bs + buf * 16384 + i * 8192 + woff) = rb[i];
      if (TI == 5) {
        if (RS) ss[4] += sumsq8(__builtin_bit_cast(bf16x8, rx));
        if (srow == 0) *(u32x4*)(Ax0 + buf * 128 + ((tid & 7) << 4)) = rx;
      }
      if (RS) {
        if (++st_kt == nk) {
          st_kt = 0;
#pragma unroll
          for (int i = 0; i < TI; ++i) {
            float t = ss[i];
            t += __shfl_xor(t, 1); t += __shfl_xor(t, 2); t += __shfl_xor(t, 4);
            if ((tid & 7) == 0 && i < 4) rsl[srow + 32 * i] = rsqrtf(t * invK + EPS_);
            ss[i] = 0.f;
          }
        }
      }
    };
    auto compute = [&](int buf) {
      const unsigned char* Ab = As + buf * ASTG + (wn * 64 + lr) * 128;
      const unsigned char* Ax = Ax0 + buf * 128;
      const unsigned char* Bb = Bs + buf * 16384 + (wm * 64 + lr) * 128;
#pragma unroll
      for (int ks = 0; ks < 2; ++ks) {
        if (TI == 5 && ks == 1) __builtin_amdgcn_sched_barrier(0);
        const int sw = ((ks * 4 + lq) ^ (lr & 7)) << 4;
        bf16x8 wf[4], xf[TI];
#pragma unroll
        for (int i = 0; i < 4; ++i) {
          wf[i] = *(const bf16x8*)(Bb + i * 2048 + sw);
          xf[i] = *(const bf16x8*)(Ab + i * 2048 + sw);
        }
        if (TI == 5) xf[TI - 1] = *(const bf16x8*)(Ax + ((ks * 4 + lq) << 4));
#pragma unroll
        for (int ni = 0; ni < 4; ++ni)
#pragma unroll
          for (int ti = 0; ti < TI; ++ti) acc[ni][ti] = MFMA16(wf[ni], xf[ti], acc[ni][ti]);
      }
    };
    auto tile_end = [&]() {
      float rs[TI];
#pragma unroll
      for (int ti = 0; ti < TI; ++ti) rs[ti] = 1.f;
      if (RS) {
#pragma unroll
        for (int ti = 0; ti < TI; ++ti) rs[ti] = rsl[(ti < 4 ? wn * 64 + ti * 16 : 0) + lr];
      }
      int mt, nt; if (TMAP == 1) rem_tile(c_id, mt, nt); else tile_of(c_id, ntn, mt, nt);
      const int tokb = mt * 2 * BMH + hh * BMH;
      if (tokb < M_) gemm_epilogue<EPI, TI>(ws, acc, rs, tokb, nt * 128, wm, wn, lr, lq, dry);
#pragma unroll
      for (int a = 0; a < 4; ++a)
#pragma unroll
        for (int b = 0; b < TI; ++b) acc[a][b] = (f32x4){0.f, 0.f, 0.f, 0.f};
      c_id += G;
    };

    issue(ra0, rb0, rx0);
    issue(ra1, rb1, rx1);
    store(ra0, rb0, rx0, 0);
    __syncthreads();
#pragma unroll 1
    for (int s = 0; s < S; s += 2) {
      issue(ra0, rb0, rx0);
      compute(0);
      store(ra1, rb1, rx1, 1);
      __syncthreads();
      issue(ra1, rb1, rx1);
      compute(1);
      c_kt += 2;
      if (c_kt == nk) { c_kt = 0; tile_end(); }
      store(ra0, rb0, rx0, 0);
      __syncthreads();
    }
  }
  __syncthreads();
}

__device__ __forceinline__ void gla_decay_unit(const Params& p, const WS& ws, int j, int u) {
  const int c = u % 33; const int bh = u / 33; const int hd = bh & 3, b = bh >> 2;
  bf16_t* Qs = (bf16_t*)smem;
  bf16_t* Ks = Qs + 64 * 136;
  float* ADs = (float*)(smem + 2 * 64 * 136 * 2);
  float* HT = ADs + 64 * 16;
  const int tid = opaque_tid();
  const int tbase = 64 * c - 48;
#pragma unroll
  for (int i = 0; i < 4; ++i) {
    const int ci = tid + 256 * i; const int row = ci >> 4, ch = ci & 15; const int t = tbase + row;
    u32x4 qv = (u32x4){0, 0, 0, 0}, kv = (u32x4){0, 0, 0, 0};
    if (t >= 0) {
      qv = *(const u32x4*)(ws.Q + (size_t)(b * T_ + t) * 512 + hd * 128 + ch * 8);
      kv = *(const u32x4*)(ws.K + (size_t)(b * T_ + t) * 512 + hd * 128 + ch * 8);
    }
    *(u32x4*)(Qs + row * 136 + ch * 8) = qv;
    *(u32x4*)(Ks + row * 136 + ch * 8) = kv;
    const int t2 = tbase + (ci >> 4);
    ADs[ci] = t2 >= 0 ? bf2f(ws.AD[(size_t)(b * T_ + t2) * 16 + (ci & 15)]) : 0.f;
  }
  const int d = tid & 127, half = tid >> 7;
  float aw[16];
#pragma unroll
  for (int r = 0; r < 16; ++r) aw[r] = p.ab_alpha_w[(size_t)(j * 16 + r) * 512 + hd * 128 + d];
  const float abias = p.ab_alpha_b[j * 512 + hd * 128 + d];
  __syncthreads();
  float cs[32];
  float run = 0.f;
#pragma unroll
  for (int ii = 0; ii < 32; ++ii) {
    const int row = half * 32 + ii;
    float xv = abias;
#pragma unroll
    for (int r4 = 0; r4 < 4; ++r4) {
      const float4 a4 = *(const float4*)(ADs + row * 16 + r4 * 4);
      xv += a4.x * aw[r4 * 4] + a4.y * aw[r4 * 4 + 1] + a4.z * aw[r4 * 4 + 2] + a4.w * aw[r4 * 4 + 3];
    }
    float la = (fminf(xv, 0.f) - __logf(1.f + __expf(-fabsf(xv)))) * 0.0625f;
    if (tbase + row < 0) la = 0.f;
    run += la;
    cs[ii] = run;
  }
  HT[half * 128 + d] = run;
  __syncthreads();
  const float off = half ? HT[d] : 0.f;
  const float blast = HT[d] + HT[128 + d];
#pragma unroll
  for (int ii = 0; ii < 32; ++ii) {
    const int row = half * 32 + ii;
    const float bb = cs[ii] + off;
    const float eb = __expf(bb), ebi = __expf(-bb);
    Qs[row * 136 + d] = f2bf(bf2f(Qs[row * 136 + d]) * eb);
    Ks[row * 136 + d] = f2bf(bf2f(Ks[row * 136 + d]) * ebi);
  }
  if (half == 0) ws.BL[(size_t)((b * 4 + hd) * 33 + c) * 128 + d] = __expf(blast);
  __syncthreads();
#pragma unroll
  for (int i = 0; i < 4; ++i) {
    const int ci = tid + 256 * i; const int row = ci >> 4, ch = ci & 15; const int t = tbase + row;
    if (t >= 0) {
      *(u32x4*)(ws.Q + (size_t)(b * T_ + t) * 512 + hd * 128 + ch * 8) = *(const u32x4*)(Qs + row * 136 + ch * 8);
      *(u32x4*)(ws.K + (size_t)(b * T_ + t) * 512 + hd * 128 + ch * 8) = *(const u32x4*)(Ks + row * 136 + ch * 8);
    }
  }
  __syncthreads();
}

__device__ __forceinline__ void conv_unit(const Params& p, const WS& ws, int j, int u) {
  const int g = u & 7, b = u >> 3;
  const int tid = opaque_tid();
  const int c8 = tid & 15, seg = tid >> 4;
  const int t0 = seg * 129;
  const int cbase = 128 * g + 8 * c8;
  float cw[4][8], cb[8];
#pragma unroll
  for (int e = 0; e < 8; ++e) {
    cb[e] = p.ab_conv_b[j * 1024 + cbase + e];
#pragma unroll
    for (int k = 0; k < 4; ++k) cw[k][e] = p.ab_conv_w[(size_t)(j * 4 + k) * 1024 + cbase + e];
  }
  bf16_t* xp = ws.XA + (size_t)(b * T_) * 1024 + cbase;
  float x0[8], x1[8], x2[8];
  {
    u32x4 h[3];
#pragma unroll
    for (int m = 0; m < 3; ++m) {
      const int t = t0 - 3 + m;
      h[m] = (u32x4){0, 0, 0, 0};
      if (t >= 0) h[m] = *(const u32x4*)(xp + (size_t)t * 1024);
    }
    const u32x4 a = h[0], bq = h[1], c = h[2];
    x0[0] = bflo(a.x); x0[1] = bfhi(a.x); x0[2] = bflo(a.y); x0[3] = bfhi(a.y); x0[4] = bflo(a.z); x0[5] = bfhi(a.z); x0[6] = bflo(a.w); x0[7] = bfhi(a.w);
    x1[0] = bflo(bq.x); x1[1] = bfhi(bq.x); x1[2] = bflo(bq.y); x1[3] = bfhi(bq.y); x1[4] = bflo(bq.z); x1[5] = bfhi(bq.z); x1[6] = bflo(bq.w); x1[7] = bfhi(bq.w);
    x2[0] = bflo(c.x); x2[1] = bfhi(c.x); x2[2] = bflo(c.y); x2[3] = bfhi(c.y); x2[4] = bflo(c.z); x2[5] = bfhi(c.z); x2[6] = bflo(c.w); x2[7] = bfhi(c.w);
  }
  __syncthreads();
#pragma unroll 1
  for (int tt = 0; tt < 129; tt += 3) {
    u32x4 r[3];
#pragma unroll
    for (int m = 0; m < 3; ++m) r[m] = *(const u32x4*)(xp + (size_t)(t0 + tt + m) * 1024);
#pragma unroll
    for (int m = 0; m < 3; ++m) {
      float x3[8];
      x3[0] = bflo(r[m].x); x3[1] = bfhi(r[m].x); x3[2] = bflo(r[m].y); x3[3] = bfhi(r[m].y);
      x3[4] = bflo(r[m].z); x3[5] = bfhi(r[m].z); x3[6] = bflo(r[m].w); x3[7] = bfhi(r[m].w);
      float y[8];
#pragma unroll
      for (int e = 0; e < 8; ++e) y[e] = cb[e] + cw[0][e] * x0[e] + cw[1][e] * x1[e] + cw[2][e] * x2[e] + cw[3][e] * x3[e];
      u32x4 pk; pk.x = cvt_pk_bf16(y[0], y[1]); pk.y = cvt_pk_bf16(y[2], y[3]); pk.z = cvt_pk_bf16(y[4], y[5]); pk.w = cvt_pk_bf16(y[6], y[7]);
      *(u32x4*)(xp + (size_t)(t0 + tt + m) * 1024) = pk;
#pragma unroll
      for (int e = 0; e < 8; ++e) { x0[e] = x1[e]; x1[e] = x2[e]; x2[e] = x3[e]; }
    }
  }
  __syncthreads();
}

__device__ __forceinline__ void gla_unit(const Params& p, const WS& ws, int u, bool dry = false) {
  const int sl = u & 7; const int bh = u >> 3; const int hd = bh & 3, b = bh >> 2;
  bf16_t* QDs = (bf16_t*)smem;
  bf16_t* KIs = QDs + 64 * 136;
  bf16_t* KIT = KIs + 64 * 136;
  bf16_t* VTs = KIT + 128 * 72;
  bf16_t* STs = VTs + 32 * 72;
  bf16_t* Ps = STs + 32 * 136;
  const int tid = opaque_tid(), lane = tid & 63, w = tid >> 6, lr = lane & 15, lq = lane >> 4;
  for (int i = tid; i < 32 * 136 / 2; i += 256) ((unsigned*)STs)[i] = 0u;
  f32x4 sacc[2][2];
#pragma unroll
  for (int a = 0; a < 2; ++a)
#pragma unroll
    for (int bb = 0; bb < 2; ++bb) sacc[a][bb] = (f32x4){0.f, 0.f, 0.f, 0.f};
  u32x4 qrA[4], krA[4], vrA, qrB[4], krB[4], vrB;
  float eblA[2], eblB[2];
  const float* BLp = ws.BL + (size_t)((b * 4 + hd) * 33) * 128;
  auto prefetch = [&](int c, u32x4 (&qr)[4], u32x4 (&kr)[4], u32x4& vr, float (&ebl)[2]) {
    const int tbase = 64 * c - 48;
#pragma unroll
    for (int i = 0; i < 4; ++i) {
      const int ci = tid + 256 * i; const int row = ci >> 4, ch = ci & 15; const int t = tbase + row;
      qr[i] = (u32x4){0, 0, 0, 0}; kr[i] = (u32x4){0, 0, 0, 0};
      if (t >= 0) {
        qr[i] = *(const u32x4*)(ws.Q + (size_t)(b * T_ + t) * 512 + hd * 128 + ch * 8);
        kr[i] = *(const u32x4*)(ws.K + (size_t)(b * T_ + t) * 512 + hd * 128 + ch * 8);
      }
    }
    {
      const int row = tid >> 2, ch = tid & 3; const int t = tbase + row;
      vr = (u32x4){0, 0, 0, 0};
      if (t >= 0) vr = *(const u32x4*)(ws.V + (size_t)(b * T_ + t) * 1024 + hd * 256 + sl * 32 + ch * 8);
    }
    ebl[0] = BLp[c * 128 + 16 * (2 * w) + lr];
    ebl[1] = BLp[c * 128 + 16 * (2 * w + 1) + lr];
  };
  prefetch(0, qrA, krA, vrA, eblA);
  prefetch(1, qrB, krB, vrB, eblB);
  __syncthreads();
  u32x2 opend[2]; float sqpend = 0.f; int tpend = -1;
  opend[0] = (u32x2){0u, 0u}; opend[1] = (u32x2){0u, 0u};
  auto flush_o = [&]() {
    if (tpend >= 0 && !dry) {
      const size_t row = (size_t)(b * T_ + tpend);
#pragma unroll
      for (int mt = 0; mt < 2; ++mt) *(u32x2*)(ws.V + row * 1024 + hd * 256 + sl * 32 + 16 * mt + 4 * lq) = opend[mt];
      if (lq == 0) ws.SSQ[row * 32 + hd * 8 + sl] = sqpend;
    }
  };
  auto body = [&](int c, u32x4 (&qr)[4], u32x4 (&kr)[4], u32x4& vr, float (&ebl)[2]) {
#pragma unroll
    for (int i = 0; i < 4; ++i) {
      const int ci = tid + 256 * i; const int row = ci >> 4, ch = ci & 15;
      *(u32x4*)(QDs + row * 136 + ch * 8) = qr[i];
      *(u32x4*)(KIs + row * 136 + ch * 8) = kr[i];
      const unsigned kk[4] = {kr[i].x, kr[i].y, kr[i].z, kr[i].w};
#pragma unroll
      for (int e = 0; e < 4; ++e) {
        KIT[(ch * 8 + 2 * e) * 72 + (row ^ ((ch & 7) << 3))] = (bf16_t)(kk[e] & 0xffffu);
        KIT[(ch * 8 + 2 * e + 1) * 72 + (row ^ ((ch & 7) << 3))] = (bf16_t)(kk[e] >> 16);
      }
    }
    {
      const int row = tid >> 2, ch = tid & 3;
      const unsigned vv[4] = {vr.x, vr.y, vr.z, vr.w};
#pragma unroll
      for (int e = 0; e < 4; ++e) {
        VTs[(ch * 8 + 2 * e) * 72 + (row ^ (ch << 3))] = (bf16_t)(vv[e] & 0xffffu);
        VTs[(ch * 8 + 2 * e + 1) * 72 + (row ^ (ch << 3))] = (bf16_t)(vv[e] >> 16);
      }
    }
    const float eb0 = ebl[0], eb1 = ebl[1];
    __syncthreads();
    flush_o();
    if (c + 2 < 33) prefetch(c + 2, qr, kr, vr, ebl);
    bf16x8 xq[4];
#pragma unroll
    for (int ks = 0; ks < 4; ++ks) xq[ks] = *(const bf16x8*)(QDs + (16 * w + lr) * 136 + 32 * ks + 8 * lq);
    const int irow = 16 * w + lr;
#pragma unroll
    for (int mt = 0; mt < 4; ++mt) {
      u32x2 pk = (u32x2){0u, 0u};
      if (mt <= w) {
        f32x4 a = (f32x4){0.f, 0.f, 0.f, 0.f};
#pragma unroll
        for (int ks = 0; ks < 4; ++ks) {
          const bf16x8 kf = *(const bf16x8*)(KIs + (16 * mt + lr) * 136 + 32 * ks + 8 * lq);
          a = MFMA16(kf, xq[ks], a);
        }
        const int ip = 16 * mt + 4 * lq;
        const float v0 = (ip + 0 <= irow) ? a[0] : 0.f, v1 = (ip + 1 <= irow) ? a[1] : 0.f;
        const float v2 = (ip + 2 <= irow) ? a[2] : 0.f, v3 = (ip + 3 <= irow) ? a[3] : 0.f;
        pk.x = cvt_pk_bf16(v0, v1); pk.y = cvt_pk_bf16(v2, v3);
      }
      *(u32x2*)(Ps + irow * 72 + 16 * mt + 4 * lq) = pk;
    }
    __syncthreads();
    f32x4 oacc[2];
    oacc[0] = (f32x4){0.f, 0.f, 0.f, 0.f}; oacc[1] = (f32x4){0.f, 0.f, 0.f, 0.f};
#pragma unroll
    for (int ks = 0; ks < 2; ++ks) {
      if (2 * ks <= w) {
        const bf16x8 pb = *(const bf16x8*)(Ps + irow * 72 + 32 * ks + 8 * lq);
#pragma unroll
        for (int mt = 0; mt < 2; ++mt) {
          const bf16x8 vf = *(const bf16x8*)(VTs + (16 * mt + lr) * 72 + (((4 * ks + lq) ^ (((16 * mt + lr) >> 3) & 3)) << 3));
          oacc[mt] = MFMA16(vf, pb, oacc[mt]);
        }
      }
    }
#pragma unroll
    for (int ks = 0; ks < 4; ++ks)
#pragma unroll
      for (int mt = 0; mt < 2; ++mt) {
        const bf16x8 sf = *(const bf16x8*)(STs + (16 * mt + lr) * 136 + 32 * ks + 8 * lq);
        oacc[mt] = MFMA16(sf, xq[ks], oacc[mt]);
      }
    {
      const int t = 64 * c - 48 + irow;
      float sq = 0.f;
#pragma unroll
      for (int mt = 0; mt < 2; ++mt) sq += oacc[mt][0] * oacc[mt][0] + oacc[mt][1] * oacc[mt][1] + oacc[mt][2] * oacc[mt][2] + oacc[mt][3] * oacc[mt][3];
      sq += __shfl_xor(sq, 16); sq += __shfl_xor(sq, 32);
      tpend = t;
      sqpend = sq;
#pragma unroll
      for (int mt = 0; mt < 2; ++mt) { opend[mt].x = cvt_pk_bf16(oacc[mt][0], oacc[mt][1]); opend[mt].y = cvt_pk_bf16(oacc[mt][2], oacc[mt][3]); }
    }
    __syncthreads();
#pragma unroll
    for (int ntl = 0; ntl < 2; ++ntl) {
#pragma unroll
      for (int ks = 0; ks < 2; ++ks) {
        const bf16x8 kf = *(const bf16x8*)(KIT + (16 * (2 * w + ntl) + lr) * 72 + (((4 * ks + lq) ^ (((16 * (2 * w + ntl) + lr) >> 3) & 7)) << 3));
#pragma unroll
        for (int mt = 0; mt < 2; ++mt) {
          const bf16x8 vf = *(const bf16x8*)(VTs + (16 * mt + lr) * 72 + (((4 * ks + lq) ^ (((16 * mt + lr) >> 3) & 3)) << 3));
          sacc[mt][ntl] = MFMA16(vf, kf, sacc[mt][ntl]);
        }
      }
      const float e = ntl ? eb1 : eb0;
#pragma unroll
      for (int mt = 0; mt < 2; ++mt) {
        sacc[mt][ntl] = scale4(sacc[mt][ntl], e);
#pragma unroll
        for (int jj = 0; jj < 4; ++jj) STs[(16 * mt + 4 * lq + jj) * 136 + 16 * (2 * w + ntl) + lr] = f2bf(sacc[mt][ntl][jj]);
      }
    }
    __syncthreads();
  };
#pragma unroll 1
  for (int c = 0; c < 33; c += 2) {
    body(c, qrA, krA, vrA, eblA);
    if (c + 1 < 33) body(c + 1, qrB, krB, vrB, eblB);
  }
  flush_o();
  __syncthreads();
}

__device__ __forceinline__ void rglru_unit(const Params& p, const WS& ws, int j, int u, bool dry = false) {
  const int jq = u & 3, g = (u >> 2) & 7, b = u >> 5;
  bf16_t* XC = (bf16_t*)smem;
  bf16_t* WG = XC + 64 * 136;
  float* AUa = (float*)(smem + 34816);
  float* AUu = AUa + 64 * 33;
  float* SEGA = AUu + 64 * 33;
  float* SEGH = SEGA + 256;
  float* CARRY = SEGH + 256;
  const int tid = opaque_tid(), lane = tid & 63, w = tid >> 6, lr = lane & 15, lq = lane >> 4;
#pragma unroll 4
  for (int i = 0; i < 32; ++i) {
    const int e = tid + 256 * i;
    const int gate = e >> 12, k = (e >> 5) & 127, n = e & 31;
    const float* gw = gate ? p.ab_gate_x_w : p.ab_gate_a_w;
    WG[(gate * 32 + n) * 136 + k] = f2bf(gw[((size_t)(j * 8 + g) * 128 + k) * 128 + 32 * jq + n]);
  }
  if (tid < 32) CARRY[tid] = 0.f;
  float ba[2][4], bx[2][4], sp[2][4];
#pragma unroll
  for (int mt = 0; mt < 2; ++mt)
#pragma unroll
    for (int jj = 0; jj < 4; ++jj) {
      const int ch = j * 1024 + 128 * g + 32 * jq + 16 * mt + 4 * lq + jj;
      ba[mt][jj] = p.ab_gate_a_b[ch]; bx[mt][jj] = p.ab_gate_x_b[ch];
      sp[mt][jj] = 8.f * log1pf(__expf(-p.ab_lam[ch]));
    }
  const int sc = tid & 31, ssg = tid >> 5;
  u32x4 xinA[4], xinB[4];
  bf16_t gavA[8], gavB[8];
  auto prefetch = [&](int tile, u32x4 (&xin)[4], bf16_t (&gav)[8]) {
    const int t0 = 64 * tile;
#pragma unroll
    for (int i = 0; i < 4; ++i) {
      const int ci = tid + 256 * i; const int row = ci >> 4, ch = ci & 15; const int t = t0 + row;
      xin[i] = (u32x4){0, 0, 0, 0};
      if (t < T_) xin[i] = *(const u32x4*)(ws.XA + (size_t)(b * T_ + t) * 1024 + 128 * g + 8 * ch);
    }
#pragma unroll
    for (int i = 0; i < 8; ++i) {
      const int t = t0 + 8 * ssg + i;
      gav[i] = 0;
      if (t < T_) gav[i] = ws.GA[(size_t)(b * T_ + t) * 1024 + 128 * g + 32 * jq + sc];
    }
  };
  prefetch(0, xinA, gavA);
  prefetch(1, xinB, gavB);
  __syncthreads();
  bf16_t ypend[8];
  int ypend_t0 = -1;
  auto flush_y = [&]() {
    if (ypend_t0 >= 0) {
#pragma unroll
      for (int i = 0; i < 8; ++i) {
        const int t = ypend_t0 + 8 * ssg + i;
        if (t < T_ && !dry) ws.GA[(size_t)(b * T_ + t) * 1024 + 128 * g + 32 * jq + sc] = ypend[i];
      }
    }
  };
  auto body = [&](int tile, u32x4 (&xin)[4], bf16_t (&gav)[8]) {
    const int t0 = 64 * tile;
#pragma unroll
    for (int i = 0; i < 4; ++i) {
      const int ci = tid + 256 * i; const int row = ci >> 4, ch = ci & 15;
      *(u32x4*)(XC + row * 136 + 8 * ch) = xin[i];
    }
    float gcur[8];
#pragma unroll
    for (int i = 0; i < 8; ++i) gcur[i] = bf2f(gav[i]);
    __syncthreads();
    flush_y();
    if (tile + 2 < 33) prefetch(tile + 2, xin, gav);
    {
      f32x4 ga_[2][2];
#pragma unroll
      for (int a = 0; a < 2; ++a)
#pragma unroll
        for (int bb = 0; bb < 2; ++bb) ga_[a][bb] = (f32x4){0.f, 0.f, 0.f, 0.f};
#pragma unroll
      for (int ks = 0; ks < 4; ++ks) {
        const bf16x8 xf = *(const bf16x8*)(XC + (16 * w + lr) * 136 + 32 * ks + 8 * lq);
#pragma unroll
        for (int gate = 0; gate < 2; ++gate)
#pragma unroll
          for (int mt = 0; mt < 2; ++mt) {
            const bf16x8 wf = *(const bf16x8*)(WG + (gate * 32 + 16 * mt + lr) * 136 + 32 * ks + 8 * lq);
            ga_[gate][mt] = MFMA16(wf, xf, ga_[gate][mt]);
          }
      }
      const int tok = 16 * w + lr;
#pragma unroll
      for (int mt = 0; mt < 2; ++mt)
#pragma unroll
        for (int jj = 0; jj < 4; ++jj) {
          const int n = 16 * mt + 4 * lq + jj;
          const float xcv = bf2f(XC[tok * 136 + 32 * jq + n]);
          const float r = sigmoidf_(ga_[0][mt][jj] + ba[mt][jj]);
          const float ig = sigmoidf_(ga_[1][mt][jj] + bx[mt][jj]);
          const float la = -r * sp[mt][jj];
          const float a = __expf(la);
          const float x2 = 2.f * la;
          const float om = x2 > -0.02f ? -x2 * (1.f + 0.5f * x2 * (1.f + x2 * (1.f / 3.f))) : 1.f - a * a;
          const float mult = __builtin_amdgcn_sqrtf(fmaxf(om, 0.f));
          AUa[tok * 33 + n] = a;
          AUu[tok * 33 + n] = mult * ig * xcv;
        }
    }
    __syncthreads();
    {
      float A = 1.f, Hh = 0.f;
#pragma unroll
      for (int i = 0; i < 8; ++i) {
        const float a = AUa[(8 * ssg + i) * 33 + sc], uu = AUu[(8 * ssg + i) * 33 + sc];
        Hh = a * Hh + uu; A *= a;
      }
      SEGA[ssg * 32 + sc] = A; SEGH[ssg * 32 + sc] = Hh;
    }
    __syncthreads();
    float hin = CARRY[sc];
#pragma unroll
    for (int s2 = 0; s2 < 7; ++s2)
      if (s2 < ssg) hin = SEGA[s2 * 32 + sc] * hin + SEGH[s2 * 32 + sc];
    __syncthreads();
    {
      float h = hin;
#pragma unroll
      for (int i = 0; i < 8; ++i) {
        const float a = AUa[(8 * ssg + i) * 33 + sc], uu = AUu[(8 * ssg + i) * 33 + sc];
        h = a * h + uu;
        const int t = t0 + 8 * ssg + i;
        ypend[i] = f2bf(h * siluf_(gcur[i]));
      }
      if (ssg == 7) CARRY[sc] = h;
      ypend_t0 = t0;
    }
  };
#pragma unroll 1
  for (int tile = 0; tile < 33; tile += 2) {
    body(tile, xinA, gavA);
    if (tile + 1 < 33) body(tile + 1, xinB, gavB);
  }
  flush_y();
  __syncthreads();
}

__device__ __forceinline__ void phase_gla_norm(const Params& p, const WS& ws, int j) {
  const size_t gtid = (size_t)opaque_bid() * 256 + opaque_tid(), gsz = (size_t)NVB * 256;
  const float* gn = p.ab_gla_norm + j * 256;
#pragma unroll 4
  for (size_t idx = gtid; idx < (size_t)M_ * 128; idx += gsz) {
    const size_t row = idx >> 7; const int c8 = (int)(idx & 127); const int hd = c8 >> 5; const int dv = (c8 & 31) * 8;
    const float4 s0 = *(const float4*)(ws.SSQ + row * 32 + hd * 8), s1 = *(const float4*)(ws.SSQ + row * 32 + hd * 8 + 4);
    const float ssum = (s0.x + s0.y + s0.z + s0.w) + (s1.x + s1.y + s1.z + s1.w);
    const float rstd = rsqrtf(ssum * (1.f / 256.f) + EPS_);
    const u32x4 ov = *(const u32x4*)(ws.V + row * 1024 + c8 * 8);
    const u32x4 gv = *(const u32x4*)(ws.GB + row * 1024 + c8 * 8);
    const float4 g0 = *(const float4*)(gn + dv), g1 = *(const float4*)(gn + dv + 4);
    float o[8] = {bflo(ov.x), bfhi(ov.x), bflo(ov.y), bfhi(ov.y), bflo(ov.z), bfhi(ov.z), bflo(ov.w), bfhi(ov.w)};
    const float gg[8] = {bflo(gv.x), bfhi(gv.x), bflo(gv.y), bfhi(gv.y), bflo(gv.z), bfhi(gv.z), bflo(gv.w), bfhi(gv.w)};
    const float nn[8] = {g0.x, g0.y, g0.z, g0.w, g1.x, g1.y, g1.z, g1.w};
#pragma unroll
    for (int e = 0; e < 8; ++e) o[e] = o[e] * rstd * nn[e] * siluf_(gg[e]);
    u32x4 pk; pk.x = cvt_pk_bf16(o[0], o[1]); pk.y = cvt_pk_bf16(o[2], o[3]); pk.z = cvt_pk_bf16(o[4], o[5]); pk.w = cvt_pk_bf16(o[6], o[7]);
    *(u32x4*)(ws.V + row * 1024 + c8 * 8) = pk;
  }
}

__device__ __forceinline__ void attn_unit(const WS& ws, int u, bool dry = false) {
  const int qb = 16 - (u >> 7); const int bh = u & 127; const int hd = bh & 15, b = bh >> 4;
  bf16_t* Kt = (bf16_t*)smem;
  bf16_t* Vl = Kt + 2 * 64 * 104;
  const int tid = opaque_tid(), lane = tid & 63, w = tid >> 6, lr = lane & 15, lq = lane >> 4;
  const int q0 = 128 * qb;
  int nkt = 2 * qb + 2; if (nkt > 33) nkt = 33;
  bf16x8 xq[2][3];
  int qi[2];
#pragma unroll
  for (int nt = 0; nt < 2; ++nt) {
    qi[nt] = q0 + 32 * w + 16 * nt + lr;
    const int qc = qi[nt] < T_ ? qi[nt] : T_ - 1;
#pragma unroll
    for (int ks = 0; ks < 2; ++ks)
      xq[nt][ks] = *(const bf16x8*)(ws.QB + (size_t)(b * T_ + qc) * 1536 + hd * 96 + 32 * ks + 8 * lq);
    {
      const u32x4 raw = *(const u32x4*)(ws.QB + (size_t)(b * T_ + qc) * 1536 + hd * 96 + 64 + 8 * lq);
      u32x4 oth;
      oth.x = __shfl_xor(raw.x, 32); oth.y = __shfl_xor(raw.y, 32); oth.z = __shfl_xor(raw.z, 32); oth.w = __shfl_xor(raw.w, 32);
      const float sgn = lq < 2 ? -1.f : 1.f;
      const float2* rp = ws.ROPE + (size_t)(b * T_ + qc) * 16 + 8 * (lq & 1);
      const unsigned rw[4] = {raw.x, raw.y, raw.z, raw.w}, ow[4] = {oth.x, oth.y, oth.z, oth.w};
      unsigned res[4];
#pragma unroll
      for (int e = 0; e < 4; ++e) {
        const float2 c0 = rp[2 * e], c1 = rp[2 * e + 1];
        const float r0 = bflo(rw[e]) * c0.x + sgn * bflo(ow[e]) * c0.y;
        const float r1 = bfhi(rw[e]) * c1.x + sgn * bfhi(ow[e]) * c1.y;
        res[e] = cvt_pk_bf16(r0, r1);
      }
      xq[nt][2] = as_bf16x8((u32x4){res[0], res[1], res[2], res[3]});
    }
  }
  float mrun[2] = {-INFINITY, -INFINITY}, lsum[2] = {0.f, 0.f};
  f32x4 oacc[4][2];
#pragma unroll
  for (int a = 0; a < 4; ++a)
#pragma unroll
    for (int bb = 0; bb < 2; ++bb) oacc[a][bb] = (f32x4){0.f, 0.f, 0.f, 0.f};
  u32x4 kregA[3], vregA[2], kregB[3], vregB[2];
  const bf16_t* vbase = ws.VT + ((size_t)(b * 16 + hd) * 64) * TP_;
  auto loadg = [&](int kt, u32x4 (&kreg)[3], u32x4 (&vreg)[2]) {
#pragma unroll
    for (int i = 0; i < 3; ++i) {
      const int ci = tid + 256 * i; const int key = ci / 12, ch = ci - key * 12;
      int gk = 64 * kt + key; if (gk > T_ - 1) gk = T_ - 1;
      const bf16_t* src = ch < 8 ? ws.KN + (size_t)(b * T_ + gk) * 1024 + hd * 64 + ch * 8
                                 : ws.KR + (size_t)(b * T_ + gk) * 32 + (ch - 8) * 8;
      kreg[i] = *(const u32x4*)src;
    }
#pragma unroll
    for (int i = 0; i < 2; ++i) {
      const int ci = tid + 256 * i; const int dv = ci >> 3, ch = ci & 7;
      vreg[i] = *(const u32x4*)(vbase + (size_t)dv * TP_ + 64 * kt + ch * 8);
      if (64 * kt + ch * 8 >= T_) vreg[i] = (u32x4){0u, 0u, 0u, 0u};
    }
  };
  auto stores = [&](int buf, const u32x4 (&kreg)[3], const u32x4 (&vreg)[2]) {
#pragma unroll
    for (int i = 0; i < 3; ++i) {
      const int ci = tid + 256 * i; const int key = ci / 12, ch = ci - key * 12;
      *(u32x4*)(Kt + buf * 64 * 104 + key * 104 + ch * 8) = kreg[i];
    }
#pragma unroll
    for (int i = 0; i < 2; ++i) {
      const int ci = tid + 256 * i; const int dv = ci >> 3, ch = ci & 7;
      *(u32x4*)(Vl + buf * 64 * 72 + dv * 72 + ch * 8) = vreg[i];
    }
  };
  const int nkt2 = (nkt + 1) & ~1;
  loadg(0, kregA, vregA);
  loadg(1, kregB, vregB);
  stores(0, kregA, vregA);
  __syncthreads();
  auto body = [&](int kt, int buf, u32x4 (&kreg)[3], u32x4 (&vreg)[2], const u32x4 (&kregn)[3], const u32x4 (&vregn)[2]) {
    { const int kn = kt + 2 < nkt2 ? kt + 2 : nkt2 - 1; loadg(kn, kreg, vreg); }
    const bf16_t* Kb = Kt + buf * 64 * 104;
    const bf16_t* Vb = Vl + buf * 64 * 72;
    f32x4 s[4][2];
#pragma unroll
    for (int mt = 0; mt < 4; ++mt) {
      s[mt][0] = (f32x4){0.f, 0.f, 0.f, 0.f}; s[mt][1] = (f32x4){0.f, 0.f, 0.f, 0.f};
#pragma unroll
      for (int ks = 0; ks < 3; ++ks) {
        const bf16x8 kf = *(const bf16x8*)(Kb + (16 * mt + lr) * 104 + 32 * ks + 8 * lq);
        s[mt][0] = MFMA16(kf, xq[0][ks], s[mt][0]);
        s[mt][1] = MFMA16(kf, xq[1][ks], s[mt][1]);
      }
    }
    if (kt >= 2 * qb) {
#pragma unroll
      for (int mt = 0; mt < 4; ++mt)
#pragma unroll
        for (int nt = 0; nt < 2; ++nt)
#pragma unroll
          for (int jj = 0; jj < 4; ++jj) {
            const int key = 64 * kt + 16 * mt + 4 * lq + jj;
            if (key > qi[nt]) s[mt][nt][jj] = -INFINITY;
          }
    }
    bf16x8 pf[2][2];
#pragma unroll
    for (int nt = 0; nt < 2; ++nt) {
      float mx = -INFINITY;
#pragma unroll
      for (int mt = 0; mt < 4; ++mt) mx = fmaxf(mx, fmaxf(fmaxf(s[mt][nt][0], s[mt][nt][1]), fmaxf(s[mt][nt][2], s[mt][nt][3])));
      mx = fmaxf(mx, __shfl_xor(mx, 16)); mx = fmaxf(mx, __shfl_xor(mx, 32));
      if (__builtin_amdgcn_ballot_w64(mx > mrun[nt]) != 0ull) {
        const float mnew = fmaxf(mrun[nt], mx);
        const float alpha = __builtin_amdgcn_exp2f(mrun[nt] - mnew);
        mrun[nt] = mnew;
        lsum[nt] *= alpha;
#pragma unroll
        for (int mt = 0; mt < 4; ++mt) oacc[mt][nt] = scale4(oacc[mt][nt], alpha);
      }
      const float mnew = mrun[nt];
      float ps = 0.f;
#pragma unroll
      for (int mt = 0; mt < 4; ++mt)
#pragma unroll
        for (int jj = 0; jj < 4; ++jj) { const float pv = __builtin_amdgcn_exp2f(s[mt][nt][jj] - mnew); s[mt][nt][jj] = pv; ps += pv; }
      lsum[nt] += ps;
#pragma unroll
      for (int ks = 0; ks < 2; ++ks) {
        u32x4 pk;
        pk.x = cvt_pk_bf16(s[2 * ks][nt][0], s[2 * ks][nt][1]); pk.y = cvt_pk_bf16(s[2 * ks][nt][2], s[2 * ks][nt][3]);
        pk.z = cvt_pk_bf16(s[2 * ks + 1][nt][0], s[2 * ks + 1][nt][1]); pk.w = cvt_pk_bf16(s[2 * ks + 1][nt][2], s[2 * ks + 1][nt][3]);
        pf[nt][ks] = as_bf16x8(pk);
      }
    }
#pragma unroll
    for (int mt = 0; mt < 4; ++mt)
#pragma unroll
      for (int ks = 0; ks < 2; ++ks) {
        const u32x2 lo = *(const u32x2*)(Vb + (16 * mt + lr) * 72 + 32 * ks + 4 * lq);
        const u32x2 hi = *(const u32x2*)(Vb + (16 * mt + lr) * 72 + 32 * ks + 16 + 4 * lq);
        const bf16x8 vf = as_bf16x8((u32x4){lo.x, lo.y, hi.x, hi.y});
        oacc[mt][0] = MFMA16(vf, pf[0][ks], oacc[mt][0]);
        oacc[mt][1] = MFMA16(vf, pf[1][ks], oacc[mt][1]);
      }
    stores(buf ^ 1, kregn, vregn);
    __syncthreads();
  };
#pragma unroll 1
  for (int kt = 0; kt < nkt2; kt += 2) {
    body(kt, 0, kregA, vregA, kregB, vregB);
    body(kt + 1, 1, kregB, vregB, kregA, vregA);
  }
#pragma unroll
  for (int nt = 0; nt < 2; ++nt) {
    float l = lsum[nt];
    l += __shfl_xor(l, 16); l += __shfl_xor(l, 32);
    const float inv = 1.f / l;
    if (qi[nt] < T_) {
      const size_t row = (size_t)(b * T_ + qi[nt]);
#pragma unroll
      for (int mt = 0; mt < 4; ++mt) {
        const u32x2 gv = *(const u32x2*)(ws.GATE + row * 1024 + hd * 64 + 16 * mt + 4 * lq);
        const float o0 = oacc[mt][nt][0] * inv * siluf_(bflo(gv.x)), o1 = oacc[mt][nt][1] * inv * siluf_(bfhi(gv.x));
        const float o2 = oacc[mt][nt][2] * inv * siluf_(bflo(gv.y)), o3 = oacc[mt][nt][3] * inv * siluf_(bfhi(gv.y));
        u32x2 pk; pk.x = cvt_pk_bf16(o0, o1); pk.y = cvt_pk_bf16(o2, o3);
        if (!dry) *(u32x2*)(ws.QB + row * 1536 + hd * 96 + 16 * mt + 4 * lq) = pk;
      }
    }
  }
}

__device__ __forceinline__ void phase_final(const Params& p, const WS& ws) {
  const int tidf = opaque_tid();
  const int lane = tidf & 63;
  const int gw = opaque_bid() * 4 + (tidf >> 6), nw = NVB * 4;
#pragma unroll 2
  for (int r = gw; r < 8 * 2048; r += nw) {
    const int b = r >> 11, s = r & 2047;
    const size_t hoff = (size_t)(b * T_ + 16 + s) * 1024;
    float4 v[4];
    float ssum = 0.f;
#pragma unroll
    for (int i = 0; i < 4; ++i) {
      const u32x2 hi = *(const u32x2*)(ws.HHI + hoff + i * 256 + lane * 4), lo = *(const u32x2*)(ws.HLO + hoff + i * 256 + lane * 4);
      v[i] = make_float4(bflo(hi.x) + bflo(lo.x), bfhi(hi.x) + bfhi(lo.x), bflo(hi.y) + bflo(lo.y), bfhi(hi.y) + bfhi(lo.y));
      ssum += v[i].x * v[i].x + v[i].y * v[i].y + v[i].z * v[i].z + v[i].w * v[i].w;
    }
#pragma unroll
    for (int o = 1; o < 64; o <<= 1) ssum += __shfl_xor(ssum, o);
    const float rstd = rsqrtf(ssum * (1.f / 1024.f) + EPS_);
#pragma unroll
    for (int i = 0; i < 4; ++i) {
      const float4 g = *(const float4*)(p.final_norm + i * 256 + lane * 4);
      float4 o; o.x = v[i].x * rstd * g.x; o.y = v[i].y * rstd * g.y; o.z = v[i].z * rstd * g.z; o.w = v[i].w * rstd * g.w;
      *(float4*)(p.out + (size_t)r * 1024 + i * 256 + lane * 4) = o;
    }
  }
}

__global__ void __launch_bounds__(512, 2) fwd_megakernel(Params p) {
  cg::grid_group grid = cg::this_grid();
  if (p.inv_freq[0] < 0.f) grid.sync();
  volatile LAS unsigned* xst = (volatile LAS unsigned*)(smem_all + 2 * SMEM_BYTES);
  if (threadIdx.x == 0) { xst[0] = 0u; xst[1] = 0u; xst[2] = 0u; xst[3] = 0u; }
  __syncthreads();
  const XcdBarrier xb = xcd_barrier_post((unsigned*)(p.ws + BAR_OFF), xst);
  {
    const WS ws = make_ws(p);
    phase_prologue(p, ws);
  }
  xcd_barrier(xb);
#pragma unroll 1
  for (int layer = 0; layer < 4; ++layer) {
    const int j = layer >> 1;
    if ((layer & 1) == 0) {
      {
        const WS ws = make_ws(p);
        const bf16_t* wb = ws.W + (size_t)j * W_PER_J;
#pragma unroll 1
        for (int rep = 0; rep < REP_GEMM; ++rep)
          { gemm_wide<EPI_E1>(ws, ws.HHI, 1024, wb + W_IN_E, 1024, 1.f / 1024.f, 20, 64 * 20, xcd_bid(opaque_rbid()));
            gemm_rem_splitk(ws, ws.HHI, wb + W_IN_E, opaque_rbid()); }
      }
      xcd_barrier(xb);
      {
        const WS ws = make_ws(p);
#pragma unroll 1
        for (int u = opaque_bid(); u < 8 * 4 * 33 + 64; u += NVB) {
          if (u < 64) conv_unit(p, ws, j, u); else gla_decay_unit(p, ws, j, u - 64);
        }
      }
      xcd_barrier(xb);
      {
#pragma unroll 1
        for (int rep = 0; rep < REP_E2; ++rep)
#pragma unroll 1
        for (int u = opaque_bid(); u < 512; u += NVB) {
          if (u & 1) { const WS ws = make_ws(p); rglru_unit(p, ws, j, u >> 1, rep < REP_E2 - 1); }
          else { const WS ws = make_ws(p); gla_unit(p, ws, u >> 1, rep < REP_E2 - 1); }
        }
      }
      xcd_barrier(xb);
      {
        const WS ws = make_ws(p);
        phase_gla_norm(p, ws, j);
      }
      xcd_barrier(xb);
      {
        const WS ws = make_ws(p);
        const bf16_t* wb = ws.W + (size_t)j * W_PER_J;
#pragma unroll 1
        for (int rep = 0; rep < REP_GEMM; ++rep)
          gemm_stream<false, EPI_RES, 5>(ws, ws.GA, ws.V, 1024, 16, 64, wb + W_OUT_E, 2048, 0.f, 8, 64 * 8, xcd_bid(opaque_rbid()), rep < REP_GEMM - 1);
      }
      xcd_barrier(xb);
    } else {
      {
        const WS ws = make_ws(p);
        const bf16_t* wb = ws.W + (size_t)j * W_PER_J;
#pragma unroll 1
        for (int rep = 0; rep < REP_GEMM; ++rep)
          gemm_stream<true, EPI_O1, 4>(ws, ws.HHI, nullptr, 1024, 1 << 30, 64, wb + W_IN_O, 1024, 1.f / 1024.f, 15, 65 * 15, xcd_bid(opaque_rbid()), false);
      }
      xcd_barrier(xb);
      {
        const WS ws = make_ws(p);
        const bf16_t* wb = ws.W + (size_t)j * W_PER_J;
#pragma unroll 1
        for (int rep = 0; rep < REP_GEMM; ++rep) {
          gemm_stream<true, EPI_Q, 4>(ws, ws.CQ, nullptr, 512, 1 << 30, 64, wb + W_Q, 512, 1.f / 512.f, 12, 65 * 12, xcd_bid(opaque_rbid()), false);
          gemm_stream<true, EPI_KV, 4>(ws, ws.CKV, nullptr, 256, 1 << 30, 64, wb + W_KV, 256, 1.f / 256.f, 16, 65 * 16, xcd_bid((opaque_rbid() + (int)(gridDim.x >> 1)) % (int)gridDim.x), false);
        }
      }
      xcd_barrier(xb);
      {
        const WS ws = make_ws(p);
#pragma unroll 1
        for (int rep = 0; rep < REP_ATTN; ++rep)
#pragma unroll 1
        for (int r = 0, b0 = opaque_bid(); r * NVB < 17 * 128; ++r) {
          const int u = r * NVB + ((r & 1) ? NVB - 1 - b0 : b0);
          if (u < 17 * 128) attn_unit(ws, u, rep < REP_ATTN - 1);
          __syncthreads();
        }
      }
      xcd_barrier(xb);
      {
        const WS ws = make_ws(p);
        const bf16_t* wb = ws.W + (size_t)j * W_PER_J;
#pragma unroll 1
        for (int rep = 0; rep < REP_GEMM; ++rep)
          gemm_stream<false, EPI_RES, 5>(ws, ws.QB, nullptr, 1536, 1 << 30, 96, wb + W_O, 1024, 0.f, 8, 64 * 8, xcd_bid(opaque_rbid()), rep < REP_GEMM - 1);
      }
      xcd_barrier(xb);
    }
  }
  {
    const WS ws = make_ws(p);
    phase_final(p, ws);
  }
}

extern "C" void kernel_launch(void* const* d_in, const int* in_sizes, int n_in, void* d_out, int out_size, void* d_ws,
                              size_t ws_size, hipStream_t stream) {
  static int grid_blocks = 0;
  if (!grid_blocks) {
    int dev = 0, cus = 0, per_cu = 0;
    hipGetDevice(&dev);
    hipDeviceGetAttribute(&cus, hipDeviceAttributeMultiprocessorCount, dev);
    hipOccupancyMaxActiveBlocksPerMultiprocessor(&per_cu, fwd_megakernel, 512, 0);
    per_cu = 1;
    grid_blocks = cus * per_cu;
  }
  Params p{};
  p.x = (const float*)d_in[0]; p.positions = (const int*)d_in[1]; p.meta = (const float*)d_in[2];
  p.ab_norm = (const float*)d_in[3]; p.ab_w_in = (const float*)d_in[4]; p.ab_conv_w = (const float*)d_in[5];
  p.ab_conv_b = (const float*)d_in[6]; p.ab_gate_a_w = (const float*)d_in[7]; p.ab_gate_a_b = (const float*)d_in[8];
  p.ab_gate_x_w = (const float*)d_in[9]; p.ab_gate_x_b = (const float*)d_in[10]; p.ab_lam = (const float*)d_in[11];
  p.ab_alpha_w = (const float*)d_in[12]; p.ab_alpha_b = (const float*)d_in[13]; p.ab_gla_norm = (const float*)d_in[14];
  p.ab_w_out = (const float*)d_in[15]; p.c_norm = (const float*)d_in[16]; p.c_w_in = (const float*)d_in[17];
  p.c_q_norm = (const float*)d_in[18]; p.c_w_q_up = (const float*)d_in[19]; p.c_kv_norm = (const float*)d_in[20];
  p.c_w_kv_up = (const float*)d_in[21]; p.c_w_out = (const float*)d_in[22]; p.final_norm = (const float*)d_in[23];
  p.out = (float*)d_out;
  p.ws = (unsigned char*)d_ws;
  for (int i = 0; i < 16; ++i) p.inv_freq[i] = (float)pow(10000.0, -(double)i / 16.0);
  hipMemsetAsync((unsigned char*)d_ws + BAR_OFF, 0, XCD_BAR_WORDS * 4, stream);
  void* args[] = {&p};
  hipError_t e = hipLaunchCooperativeKernel((void*)fwd_megakernel, dim3(grid_blocks), dim3(512), args, 0, stream);
  if (e != hipSuccess) fprintf(stderr, "cooperative launch failed: %s (grid %d)\n", hipGetErrorString(e), grid_blocks);
}
```

```cpp
#include <hip/hip_runtime.h>
#include <hip/hip_cooperative_groups.h>
#include <cstdio>
#include <cmath>
namespace cg = cooperative_groups;

typedef unsigned short bf16_t;
typedef short bf16x8 __attribute__((ext_vector_type(8)));
typedef float f32x4 __attribute__((ext_vector_type(4)));
typedef unsigned u32x4 __attribute__((ext_vector_type(4)));
typedef unsigned u32x2 __attribute__((ext_vector_type(2)));

constexpr int T_ = 2064;
constexpr int M_ = 8 * T_;
constexpr int TP_ = 2112;
constexpr float EPS_ = 1e-6f;
constexpr int SMEM_BYTES = 75776;
constexpr float QSCALE_MLA = 0.10206207261596575f * 1.4426950408889634f;

constexpr size_t W_PER_J = 11796480;
constexpr size_t W_IN_E = 0, W_OUT_E = 5373952, W_IN_O = 7471104, W_Q = 9437184, W_KV = 10223616, W_O = 10747904;

struct Params {
  const float* x; const int* positions; const float* meta;
  const float *ab_norm, *ab_w_in, *ab_conv_w, *ab_conv_b, *ab_gate_a_w, *ab_gate_a_b, *ab_gate_x_w, *ab_gate_x_b,
      *ab_lam, *ab_alpha_w, *ab_alpha_b, *ab_gla_norm, *ab_w_out;
  const float *c_norm, *c_w_in, *c_q_norm, *c_w_q_up, *c_kv_norm, *c_w_kv_up, *c_w_out, *final_norm;
  float* out;
  unsigned char* ws;
  float inv_freq[16];
};

struct WS {
  bf16_t *HHI, *HLO; float2* ROPE;
  bf16_t *XA, *GA, *Q, *K, *V, *GB, *AD; float* SSQ; float* BL;
  bf16_t *CQ, *CKV, *GATE, *KR, *QB, *KN, *VT;
  bf16_t* W;
};

__device__ __forceinline__ unsigned char* opaque_ptr(unsigned char* q) {
  unsigned lo = (unsigned)(unsigned long long)q, hi = (unsigned)((unsigned long long)q >> 32);
  asm volatile("" : "+v"(lo), "+v"(hi));
  lo = __builtin_amdgcn_readfirstlane(lo); hi = __builtin_amdgcn_readfirstlane(hi);
  typedef __attribute__((address_space(1))) unsigned char gu8;
  return (unsigned char*)(gu8*)(((unsigned long long)hi << 32) | lo);
}
__device__ __forceinline__ WS make_ws(const Params& p) {
  WS w;
  unsigned char* b = opaque_ptr(p.ws);
  w.HHI = (bf16_t*)b; b += (size_t)M_ * 2048;
  w.HLO = (bf16_t*)b; b += (size_t)M_ * 2048;
  w.ROPE = (float2*)b; b += (size_t)M_ * 128;
  unsigned char* r = b;
  w.XA = (bf16_t*)r; r += (size_t)M_ * 2048;
  w.GA = (bf16_t*)r; r += (size_t)M_ * 2048;
  w.Q = (bf16_t*)r; r += (size_t)M_ * 1024;
  w.K = (bf16_t*)r; r += (size_t)M_ * 1024;
  w.V = (bf16_t*)r; r += (size_t)M_ * 2048;
  w.GB = (bf16_t*)r; r += (size_t)M_ * 2048;
  w.AD = (bf16_t*)r; r += (size_t)M_ * 32;
  w.SSQ = (float*)r; r += (size_t)M_ * 128;
  w.BL = (float*)r; r += (size_t)8 * 4 * 33 * 128 * 4;
  r = b;
  w.CQ = (bf16_t*)r; r += (size_t)M_ * 1024;
  w.CKV = (bf16_t*)r; r += (size_t)M_ * 512;
  w.GATE = (bf16_t*)r; r += (size_t)M_ * 2048;
  w.KR = (bf16_t*)r; r += (size_t)M_ * 64;
  w.QB = (bf16_t*)r; r += (size_t)M_ * 3072;
  w.KN = (bf16_t*)r; r += (size_t)M_ * 2048;
  w.VT = (bf16_t*)r; r += (size_t)128 * 64 * TP_ * 2;
  w.W = (bf16_t*)opaque_ptr((unsigned char*)p.out);
  return w;
}

__device__ __forceinline__ unsigned cvt_pk_bf16(float lo, float hi) {
  typedef float f32x2_t __attribute__((ext_vector_type(2)));
  typedef __bf16 bf16x2_t __attribute__((ext_vector_type(2)));
  const f32x2_t v = {lo, hi};
  const bf16x2_t r = __builtin_convertvector(v, bf16x2_t);
  return __builtin_bit_cast(unsigned, r);
}
__device__ __forceinline__ f32x4 scale4(f32x4 a, float r) {
  asm volatile("" : "+v"(r));
  float x0 = a[0] * r, x1 = a[1] * r, x2 = a[2] * r, x3 = a[3] * r;
  asm volatile("" : "+v"(x0), "+v"(x1), "+v"(x2), "+v"(x3));
  return (f32x4){x0, x1, x2, x3};
}
__device__ __forceinline__ float bf2f(bf16_t v) { return __uint_as_float(((unsigned)v) << 16); }
__device__ __forceinline__ float bflo(unsigned v) { return __uint_as_float(v << 16); }
__device__ __forceinline__ float bfhi(unsigned v) { return __uint_as_float(v & 0xffff0000u); }
__device__ __forceinline__ bf16_t f2bf(float f) { return (bf16_t)(cvt_pk_bf16(f, 0.f) & 0xffffu); }
__device__ __forceinline__ float sigmoidf_(float x) { return __builtin_amdgcn_rcpf(1.f + __expf(-x)); }
__device__ __forceinline__ float siluf_(float x) { return x * __builtin_amdgcn_rcpf(1.f + __expf(-x)); }
__device__ __forceinline__ bf16x8 as_bf16x8(u32x4 v) { return __builtin_bit_cast(bf16x8, v); }
__device__ __forceinline__ int half_id() { return __builtin_amdgcn_readfirstlane((int)(threadIdx.x >> 8)); }
__device__ __forceinline__ int opaque_tid() { int t = threadIdx.x & 255; asm volatile("" : "+v"(t)); return t; }
__device__ __forceinline__ int opaque_tid512() { int t = threadIdx.x; asm volatile("" : "+v"(t)); return t; }
__device__ __forceinline__ int xcd_bid(int bid) { const int gpx = gridDim.x >> 3; return (bid & 7) * gpx + (bid >> 3); }
__device__ __forceinline__ int opaque_bid() { int t = blockIdx.x * 2 + half_id(); asm volatile("" : "+s"(t)); return t; }
__device__ __forceinline__ int opaque_rbid() { int t = blockIdx.x; asm volatile("" : "+s"(t)); return t; }
#define NVB ((int)gridDim.x * 2)
#define MFMA16(a, b, c) __builtin_amdgcn_mfma_f32_16x16x32_bf16((a), (b), (c), 0, 0, 0)

__shared__ __attribute__((aligned(16))) unsigned char smem_all[2 * SMEM_BYTES + 16];
#define smem (smem_all + half_id() * SMEM_BYTES)

#define XB_TMO      128
#define XB_XCNT(j)  (256  + 64 * (j))
#define XB_XSUB(j)  (1280 + 64 * (j))
#define XB_XGEN(j)  (2304 + 64 * (j))
#define XB_TOP      3328
#define XB_TOPGEN   3392
#define XCD_BAR_WORDS 3456
#define XB_SPIN_CAP (1u << 18)
#define LAS __attribute__((address_space(3)))
constexpr size_t BAR_OFF = 260046848;

__device__ __forceinline__ unsigned xb_ld(unsigned* p)              { return __hip_atomic_load(p, __ATOMIC_RELAXED, __HIP_MEMORY_SCOPE_AGENT); }
__device__ __forceinline__ unsigned xb_add(unsigned* p, unsigned v) { return __hip_atomic_fetch_add(p, v, __ATOMIC_RELAXED, __HIP_MEMORY_SCOPE_AGENT); }
__device__ __forceinline__ unsigned xb_xcc_id() { return (unsigned)__builtin_amdgcn_s_getreg((3 << 11) | 20) & 0xFu; }
#define XB_SPIN(cond, bar) do { unsigned _sp = 0; while (cond) { __builtin_amdgcn_s_sleep(1); \
    if ((++_sp & 255u) == 0u) { if (xb_ld(&(bar)[XB_TMO])) break; if (_sp > XB_SPIN_CAP) { atomicAdd(&(bar)[XB_TMO], 1u); break; } } } } while (0)

struct XcdBarrier { unsigned* bar; unsigned x; volatile LAS unsigned* st; };

__device__ __forceinline__ XcdBarrier xcd_barrier_post(unsigned* bar, volatile LAS unsigned* st) {
    XcdBarrier b; b.bar = bar; b.x = xb_xcc_id(); b.st = st;
    if (threadIdx.x == 0) (void)xb_add(&bar[XB_XCNT(b.x)], 1u);
    return b;
}
__device__ __forceinline__ void xcd_barrier_complete(unsigned* bar, unsigned x, unsigned& nloc, unsigned& nx) {
    const unsigned G = gridDim.x * gridDim.y * gridDim.z;
    unsigned sum, cnt, mine, sp = 0u;
    for (;;) {
        sum = 0u; cnt = 0u; mine = 0u;
#pragma unroll
        for (unsigned j = 0; j < 16; ++j) { const unsigned c = xb_ld(&bar[XB_XCNT(j)]); sum += c; cnt += (c > 0u) ? 1u : 0u; mine = (j == x) ? c : mine; }
        if (sum == G) break;
        __builtin_amdgcn_s_sleep(1);
        if ((++sp & 255u) == 0u) { if (xb_ld(&bar[XB_TMO])) break; if (sp > XB_SPIN_CAP) { atomicAdd(&bar[XB_TMO], 1u); break; } }
    }
    nloc = mine > 0u ? mine : 1u; nx = cnt > 0u ? cnt : 1u;
}
__device__ __forceinline__ void xcd_barrier(const XcdBarrier& b) {
    asm volatile("s_waitcnt vmcnt(0)" ::: "memory");
    __syncthreads();
    if (threadIdx.x == 0) {
        unsigned* bar = b.bar;
        __builtin_amdgcn_s_waitcnt(0);
        unsigned nloc = b.st[0], nx = b.st[1];
        if (nloc == 0u) { xcd_barrier_complete(bar, b.x, nloc, nx); b.st[0] = nloc; b.st[1] = nx; }
        const unsigned old = xb_add(&bar[XB_XSUB(b.x)], 1u);
        const unsigned gen = old / nloc;
        if (old + 1u == (gen + 1u) * nloc) {
            __builtin_amdgcn_fence(__ATOMIC_RELEASE, "agent");
            asm volatile("s_waitcnt vmcnt(0)" ::: "memory");
            const unsigned og = xb_add(&bar[XB_TOP], 1u);
            const unsigned tg = og / nx;
            if (og + 1u == (tg + 1u) * nx) xb_add(&bar[XB_TOPGEN], 1u);
            else XB_SPIN(xb_ld(&bar[XB_TOPGEN]) == tg, bar);
            __builtin_amdgcn_fence(__ATOMIC_ACQUIRE, "agent");
            xb_add(&bar[XB_XGEN(b.x)], 1u);
            asm volatile("s_waitcnt vmcnt(0)" ::: "memory");
        } else {
            XB_SPIN(xb_ld(&bar[XB_XGEN(b.x)]) == gen, bar);
            __builtin_amdgcn_fence(__ATOMIC_ACQUIRE, "agent");
            asm volatile("s_waitcnt vmcnt(0)" ::: "memory");
        }
    }
    __syncthreads();
}


__device__ __forceinline__ int map_even_in(int n) { return n < 4096 ? n : (n < 5120 ? n + 16 : (n < 5136 ? n - 1024 : -1)); }
__device__ __forceinline__ int map_odd_in(int n) { return n < 768 ? n : (n < 1792 ? n + 32 : (n < 1824 ? n - 1024 : -1)); }

__device__ __forceinline__ void convert_tile(const float* __restrict__ src, int K, int Nsrc, bf16_t* __restrict__ dst,
                                             int kind, const float* __restrict__ g, int tile) {
  float* tl = (float*)smem;
  const int nkt = K >> 7;
  const int ntile = tile / nkt, ktile = tile - ntile * nkt;
  const int n0 = ntile * 64, k0 = ktile * 128;
  const int tid = opaque_tid();
  const int nl = tid & 63, kq = tid >> 6;
  const int n = n0 + nl;
  const int sc = kind == 0 ? map_even_in(n) : (kind == 1 ? map_odd_in(n) : n);
  float cs = 1.f;
  if (kind == 0 && n >= 2048 && n < 2560) cs = 0.08838834764831845f;
  if (kind == 2) cs = QSCALE_MLA;
  float v[32];
#pragma unroll
  for (int i = 0; i < 32; ++i) {
    const int kl = kq + 4 * i;
    v[i] = 0.f;
    if (sc >= 0) v[i] = src[(size_t)(k0 + kl) * Nsrc + sc];
  }
#pragma unroll
  for (int i = 0; i < 32; ++i) {
    const int kl = kq + 4 * i;
    float t = v[i] * cs;
    if (g) t *= g[k0 + kl];
    tl[kl * 65 + nl] = t;
  }
  __syncthreads();
#pragma unroll
  for (int i = 0; i < 4; ++i) {
    const int c = tid + 256 * i;
    const int nl2 = c >> 4, kc = c & 15;
    float t[8];
#pragma unroll
    for (int jj = 0; jj < 8; ++jj) t[jj] = tl[(kc * 8 + jj) * 65 + nl2];
    u32x4 pk;
    pk.x = cvt_pk_bf16(t[0], t[1]); pk.y = cvt_pk_bf16(t[2], t[3]); pk.z = cvt_pk_bf16(t[4], t[5]); pk.w = cvt_pk_bf16(t[6], t[7]);
    *(u32x4*)(dst + (size_t)(n0 + nl2) * K + k0 + kc * 8) = pk;
  }
  __syncthreads();
}

__device__ __forceinline__ void phase_prologue(const Params& p, const WS& ws) {
  for (int id = opaque_bid(); id < 2880; id += NVB) {
    const int j = id / 1440; int r = id - j * 1440;
    bf16_t* wb = ws.W + (size_t)j * W_PER_J;
    if (r < 656) convert_tile(p.ab_w_in + (size_t)j * 1024 * 5136, 1024, 5136, wb + W_IN_E, 0, p.ab_norm + j * 1024, r);
    else if ((r -= 656) < 256) convert_tile(p.ab_w_out + (size_t)j * 2048 * 1024, 2048, 1024, wb + W_OUT_E, 3, nullptr, r);
    else if ((r -= 256) < 240) convert_tile(p.c_w_in + (size_t)j * 1024 * 1824, 1024, 1824, wb + W_IN_O, 1, p.c_norm + j * 1024, r);
    else if ((r -= 240) < 96) convert_tile(p.c_w_q_up + (size_t)j * 512 * 1536, 512, 1536, wb + W_Q, 2, p.c_q_norm + j * 512, r);
    else if ((r -= 96) < 64) convert_tile(p.c_w_kv_up + (size_t)j * 256 * 2048, 256, 2048, wb + W_KV, 3, p.c_kv_norm + j * 256, r);
    else { r -= 64; convert_tile(p.c_w_out + (size_t)j * 1024 * 1024, 1024, 1024, wb + W_O, 3, nullptr, r); }
  }
  const size_t gtid = (size_t)opaque_bid() * 256 + opaque_tid(), gsz = (size_t)NVB * 256;
  for (size_t idx0 = gtid; idx0 < (size_t)M_ * 256; idx0 += 8 * gsz) {
    float4 v4[8];
#pragma unroll
    for (int q = 0; q < 8; ++q) {
      const size_t idx = idx0 + q * gsz;
      v4[q] = make_float4(0.f, 0.f, 0.f, 0.f);
      if (idx < (size_t)M_ * 256) {
        const int row = (int)(idx >> 8), c4 = (int)(idx & 255);
        const int b = row / T_, t = row - b * T_;
        const float* src = t < 16 ? p.meta + (size_t)t * 1024 : p.x + ((size_t)b * 2048 + (t - 16)) * 1024;
        v4[q] = *(const float4*)(src + c4 * 4);
      }
    }
#pragma unroll
    for (int q = 0; q < 8; ++q) {
      const size_t idx = idx0 + q * gsz;
      if (idx < (size_t)M_ * 256) {
        const float4 v = v4[q];
        u32x2 hi; hi.x = cvt_pk_bf16(v.x, v.y); hi.y = cvt_pk_bf16(v.z, v.w);
        u32x2 lo; lo.x = cvt_pk_bf16(v.x - bflo(hi.x), v.y - bfhi(hi.x)); lo.y = cvt_pk_bf16(v.z - bflo(hi.y), v.w - bfhi(hi.y));
        *(u32x2*)(ws.HHI + idx * 4) = hi;
        *(u32x2*)(ws.HLO + idx * 4) = lo;
      }
    }
  }
  for (size_t idx = gtid; idx < (size_t)M_ * 16; idx += gsz) {
    const int row = (int)(idx >> 4), i = (int)(idx & 15);
    const int b = row / T_, t = row - b * T_;
    const int pos = t < 16 ? t : p.positions[b * 2048 + (t - 16)] + 16;
    const float angf = (float)pos * p.inv_freq[i];
    const double rev = (double)angf * 0.15915494309189533577;
    const float fr = (float)(rev - rint(rev));
    ws.ROPE[idx] = make_float2(__builtin_amdgcn_cosf(fr), __builtin_amdgcn_sinf(fr));
  }
}

#ifndef REP_GEMM
#define REP_GEMM 1
#endif
#ifndef REP_ATTN
#define REP_ATTN 1
#endif
#ifndef REP_E2
#define REP_E2 1
#endif
enum { EPI_E1 = 0, EPI_O1 = 1, EPI_Q = 2, EPI_KV = 3, EPI_RES = 4 };

template <int EPI, int TI>
__device__ __forceinline__ void gemm_epilogue(const WS& ws, const f32x4 (&acc)[4][TI], const float (&rs)[TI], int tok0, int n0,
                                              int wm, int wn, int lr, int lq, bool dry) {
  auto tokr = [&](int ti) { return tok0 + (ti < 4 ? wn * 64 + ti * 16 : 128 + wn * 16) + lr; };
  auto okr = [&](int ti) { return ti < 4 || (wn == 0 && lr == 0); };
  const int nw = n0 + wm * 64;
  if (EPI == EPI_E1) {
    bf16_t* dst; int ld, c;
    if (n0 < 1024) { dst = ws.XA; ld = 1024; c = n0; }
    else if (n0 < 2048) { dst = ws.GA; ld = 1024; c = n0 - 1024; }
    else if (n0 < 2560) { dst = ws.Q; ld = 512; c = n0 - 2048; }
    else if (n0 < 3072) { dst = ws.K; ld = 512; c = n0 - 2560; }
    else if (n0 < 4096) { dst = ws.V; ld = 1024; c = n0 - 3072; }
    else if (n0 < 5120) { dst = ws.GB; ld = 1024; c = n0 - 4096; }
    else { dst = ws.AD; ld = 16; c = 0; }
    const bool isad = n0 >= 5120;
#pragma unroll
    for (int ni = 0; ni < 4; ++ni) {
      if (isad && (wm != 0 || ni != 0)) continue;
#pragma unroll
      for (int ti = 0; ti < TI; ++ti) {
        const f32x4 v = scale4(acc[ni][ti], rs[ti]);
        u32x2 pk; pk.x = cvt_pk_bf16(v[0], v[1]); pk.y = cvt_pk_bf16(v[2], v[3]);
        if (okr(ti)) *(u32x2*)(dst + (size_t)tokr(ti) * ld + c + wm * 64 + ni * 16 + 4 * lq) = pk;
      }
    }
  } else if (EPI == EPI_O1) {
    if (n0 < 1792) {
      bf16_t* dst; int ld, c;
      if (n0 < 512) { dst = ws.CQ; ld = 512; c = n0; }
      else if (n0 < 768) { dst = ws.CKV; ld = 256; c = n0 - 512; }
      else { dst = ws.GATE; ld = 1024; c = n0 - 768; }
#pragma unroll
      for (int ni = 0; ni < 4; ++ni)
#pragma unroll
        for (int ti = 0; ti < TI; ++ti) {
          const f32x4 v = scale4(acc[ni][ti], rs[ti]);
          u32x2 pk; pk.x = cvt_pk_bf16(v[0], v[1]); pk.y = cvt_pk_bf16(v[2], v[3]);
          if (okr(ti)) *(u32x2*)(dst + (size_t)tokr(ti) * ld + c + wm * 64 + ni * 16 + 4 * lq) = pk;
        }
    } else if (wm == 0) {
#pragma unroll
      for (int ti = 0; ti < TI; ++ti) {
        const int tok = tokr(ti);
        const f32x4 x1 = scale4(acc[0][ti], rs[ti]), x2 = scale4(acc[1][ti], rs[ti]);
        float o1[4], o2[4];
#pragma unroll
        for (int jj = 0; jj < 4; ++jj) {
          const float2 cs = ws.ROPE[(size_t)tok * 16 + 4 * lq + jj];
          o1[jj] = x1[jj] * cs.x - x2[jj] * cs.y;
          o2[jj] = x2[jj] * cs.x + x1[jj] * cs.y;
        }
        u32x2 pk; pk.x = cvt_pk_bf16(o1[0], o1[1]); pk.y = cvt_pk_bf16(o1[2], o1[3]);
        *(u32x2*)(ws.KR + (size_t)tok * 32 + 4 * lq) = pk;
        pk.x = cvt_pk_bf16(o2[0], o2[1]); pk.y = cvt_pk_bf16(o2[2], o2[3]);
        *(u32x2*)(ws.KR + (size_t)tok * 32 + 16 + 4 * lq) = pk;
      }
    }
  } else if (EPI == EPI_Q) {
#pragma unroll
    for (int ni = 0; ni < 4; ++ni)
#pragma unroll
      for (int ti = 0; ti < TI; ++ti) {
        const f32x4 v = scale4(acc[ni][ti], rs[ti]);
        u32x2 pk; pk.x = cvt_pk_bf16(v[0], v[1]); pk.y = cvt_pk_bf16(v[2], v[3]);
        if (okr(ti)) *(u32x2*)(ws.QB + (size_t)tokr(ti) * 1536 + nw + ni * 16 + 4 * lq) = pk;
      }
  } else if (EPI == EPI_KV) {
    const int hd = nw >> 7;
    const bool isv = (nw & 127) >= 64;
    if (!isv) {
#pragma unroll
      for (int ni = 0; ni < 4; ++ni)
#pragma unroll
        for (int ti = 0; ti < TI; ++ti) {
          const f32x4 v = scale4(acc[ni][ti], rs[ti]);
          u32x2 pk; pk.x = cvt_pk_bf16(v[0], v[1]); pk.y = cvt_pk_bf16(v[2], v[3]);
          if (okr(ti)) *(u32x2*)(ws.KN + (size_t)tokr(ti) * 1024 + hd * 64 + ni * 16 + 4 * lq) = pk;
        }
    } else {
#pragma unroll
      for (int ti = 0; ti < TI; ++ti) {
        const int tok = tokr(ti);
        const int b = tok / T_, t = tok - b * T_;
        bf16_t* vb = ws.VT + ((size_t)(b * 16 + hd) * 64) * TP_ + t;
#pragma unroll
        for (int ni = 0; ni < 4; ++ni) {
          const f32x4 v = scale4(acc[ni][ti], rs[ti]);
#pragma unroll
          for (int jj = 0; jj < 4; ++jj) if (okr(ti)) vb[(size_t)(ni * 16 + 4 * lq + jj) * TP_] = f2bf(v[jj]);
        }
      }
    }
  } else {
#pragma unroll
    for (int ni = 0; ni < 4; ++ni)
#pragma unroll
      for (int ti = 0; ti < TI; ++ti) {
        if (!okr(ti)) continue;
        const size_t off = (size_t)tokr(ti) * 1024 + nw + ni * 16 + 4 * lq;
        const u32x2 hi = *(const u32x2*)(ws.HHI + off), lo = *(const u32x2*)(ws.HLO + off);
        const float h0 = bflo(hi.x) + bflo(lo.x) + acc[ni][ti][0], h1 = bfhi(hi.x) + bfhi(lo.x) + acc[ni][ti][1];
        const float h2 = bflo(hi.y) + bflo(lo.y) + acc[ni][ti][2], h3 = bfhi(hi.y) + bfhi(lo.y) + acc[ni][ti][3];
        u32x2 nh; nh.x = cvt_pk_bf16(h0, h1); nh.y = cvt_pk_bf16(h2, h3);
        u32x2 nl; nl.x = cvt_pk_bf16(h0 - bflo(nh.x), h1 - bfhi(nh.x)); nl.y = cvt_pk_bf16(h2 - bflo(nh.y), h3 - bfhi(nh.y));
        if (!dry) { *(u32x2*)(ws.HHI + off) = nh; *(u32x2*)(ws.HLO + off) = nl; }
      }
  }
}

__device__ __forceinline__ float sumsq8(bf16x8 v) {
  const u32x4 u = __builtin_bit_cast(u32x4, v);
  float s = 0.f, t;
  t = bflo(u.x); s += t * t; t = bfhi(u.x); s += t * t; t = bflo(u.y); s += t * t; t = bfhi(u.y); s += t * t;
  t = bflo(u.z); s += t * t; t = bfhi(u.z); s += t * t; t = bflo(u.w); s += t * t; t = bfhi(u.w); s += t * t;
  return s;
}
__device__ __forceinline__ void tile_of(int pos, int ntn, int& mt, int& nt) {
  const int full = 64 * ntn;
  if (pos < full) { const int panel = pos / (8 * ntn); const int rem = pos - panel * 8 * ntn; nt = rem >> 3; mt = panel * 8 + (rem & 7); }
  else { mt = 64; nt = pos - full; }
}
template <int EPI>
__device__ __forceinline__ void gemm_wide(const WS& ws, const bf16_t* A, int lda, const bf16_t* __restrict__ W, int K, float invK,
                                          int ntn, int ntiles, int bid) {
  unsigned char* As = smem_all + half_id() * 32768;
  unsigned char* Bs = smem_all + 65536;
  float* rsl = (float*)(smem_all + 131072 + half_id() * 1024);
  const int tid = opaque_tid(), lane = tid & 63, w = tid >> 6, wm = w >> 1, wn = w & 1, lr = lane & 15, lq = lane >> 4;
  const int tid5 = opaque_tid512(), hh = half_id();
  const int G = gridDim.x;
  const int nk = K >> 6;
  if (bid < ntiles) {
    const int my_tiles = (ntiles - 1 - bid) / G + 1;
    const int last_id = bid + (my_tiles - 1) * G;
    const int S = my_tiles * nk;
    f32x4 accA[4][4], accB[4][4];
#pragma unroll
    for (int a = 0; a < 4; ++a)
#pragma unroll
      for (int b = 0; b < 4; ++b) { accA[a][b] = (f32x4){0.f, 0.f, 0.f, 0.f}; accB[a][b] = (f32x4){0.f, 0.f, 0.f, 0.f}; }
    u32x4 ra[4], rb[4];
    float ss[4] = {0.f, 0.f, 0.f, 0.f};
    int l_id = bid, l_kt = 0, c_id = bid, c_kt = 0, st_kt = 0;
    const int srow = tid >> 3;
    const int soff = srow * 128 + (((tid & 7) ^ (srow & 7)) << 4);
    const int wrow = tid5 >> 3;
    const int woff = wrow * 128 + (((tid5 & 7) ^ (wrow & 7)) << 4);
    auto issue = [&]() {
      const int idc = l_id < last_id ? l_id : last_id;
      int mt, nt; tile_of(idc, ntn, mt, nt);
      const int arow = mt * 256 + hh * 128 + srow;
      const bf16_t* akb = A + l_kt * 64 + (tid & 7) * 8;
      const bf16_t* wp = W + (size_t)(nt * 256 + wrow) * K + l_kt * 64 + (tid5 & 7) * 8;
#pragma unroll
      for (int i = 0; i < 4; ++i) {
        int r = arow + 32 * i; r = r < M_ ? r : M_ - 1;
        ra[i] = *(const u32x4*)(akb + (size_t)r * lda);
        rb[i] = *(const u32x4*)(wp + (size_t)i * 64 * K);
      }
      if (++l_kt == nk) { l_kt = 0; l_id += G; }
    };
    auto store = [&](int buf) {
#pragma unroll
      for (int i = 0; i < 4; ++i) {
        ss[i] += sumsq8(__builtin_bit_cast(bf16x8, ra[i]));
        *(u32x4*)(As + buf * 16384 + i * 4096 + soff) = ra[i];
        *(u32x4*)(Bs + buf * 32768 + i * 8192 + woff) = rb[i];
      }
      if (++st_kt == nk) {
        st_kt = 0;
#pragma unroll
        for (int i = 0; i < 4; ++i) {
          float t = ss[i];
          t += __shfl_xor(t, 1); t += __shfl_xor(t, 2); t += __shfl_xor(t, 4);
          if ((tid & 7) == 0) rsl[srow + 32 * i] = rsqrtf(t * invK + EPS_);
          ss[i] = 0.f;
        }
      }
    };
    auto compute = [&](int buf) {
      const unsigned char* Ab = As + buf * 16384 + (wn * 64 + lr) * 128;
      const unsigned char* Bb = Bs + buf * 32768 + (wm * 64 + lr) * 128;
#pragma unroll
      for (int ks = 0; ks < 2; ++ks) {
        const int sw = ((ks * 4 + lq) ^ (lr & 7)) << 4;
        bf16x8 xf[4], wf[4];
#pragma unroll
        for (int i = 0; i < 4; ++i) { xf[i] = *(const bf16x8*)(Ab + i * 2048 + sw); wf[i] = *(const bf16x8*)(Bb + i * 2048 + sw); }
#pragma unroll
        for (int ni = 0; ni < 4; ++ni)
#pragma unroll
          for (int ti = 0; ti < 4; ++ti) accA[ni][ti] = MFMA16(wf[ni], xf[ti], accA[ni][ti]);
#pragma unroll
        for (int i = 0; i < 4; ++i) wf[i] = *(const bf16x8*)(Bb + 16384 + i * 2048 + sw);
#pragma unroll
        for (int ni = 0; ni < 4; ++ni)
#pragma unroll
          for (int ti = 0; ti < 4; ++ti) accB[ni][ti] = MFMA16(wf[ni], xf[ti], accB[ni][ti]);
      }
    };
    auto tile_end = [&]() {
      float rs[4];
#pragma unroll
      for (int ti = 0; ti < 4; ++ti) rs[ti] = rsl[wn * 64 + ti * 16 + lr];
      int mt, nt; tile_of(c_id, ntn, mt, nt);
      const int tokb = mt * 256 + hh * 128;
      if (tokb < M_) {
        gemm_epilogue<EPI, 4>(ws, accA, rs, tokb, nt * 256, wm, wn, lr, lq, false);
        if (nt * 256 + 128 < 5248) gemm_epilogue<EPI, 4>(ws, accB, rs, tokb, nt * 256 + 128, wm, wn, lr, lq, false);
      }
#pragma unroll
      for (int a = 0; a < 4; ++a)
#pragma unroll
        for (int b = 0; b < 4; ++b) { accA[a][b] = (f32x4){0.f, 0.f, 0.f, 0.f}; accB[a][b] = (f32x4){0.f, 0.f, 0.f, 0.f}; }
      c_id += G;
    };
    issue();
    store(0);
    __syncthreads();
#pragma unroll 1
    for (int s = 0; s < S; ++s) {
      issue();
      compute(s & 1);
      if (++c_kt == nk) { c_kt = 0; tile_end(); }
      store((s + 1) & 1);
      __syncthreads();
    }
  }
  __syncthreads();
}

__device__ __forceinline__ void gemm_rem_splitk(const WS& ws, const bf16_t* A, const bf16_t* __restrict__ W, int bid) {
  unsigned char* As = smem;
  unsigned char* Bs = smem + 32768;
  float* xacc = (float*)(smem_all + SMEM_BYTES);
  float* xss = (float*)(smem_all + SMEM_BYTES + 65536);
  float* rsl = (float*)(smem_all + 65536);
  const int tid = opaque_tid(), lane = tid & 63, w = tid >> 6, wm = w >> 1, wn = w & 1, lr = lane & 15, lq = lane >> 4;
  const int hh = half_id();
  if (bid < 169) {
    int rt, nt;
    if (bid < 129) { rt = bid; nt = 40; } else { rt = 128; nt = bid - 129; }
    f32x4 acc[4][4];
#pragma unroll
    for (int a = 0; a < 4; ++a)
#pragma unroll
      for (int b = 0; b < 4; ++b) acc[a][b] = (f32x4){0.f, 0.f, 0.f, 0.f};
    u32x4 ra[4], rb[4];
    float ss[4] = {0.f, 0.f, 0.f, 0.f};
    const int srow = tid >> 3;
    const int soff = srow * 128 + (((tid & 7) ^ (srow & 7)) << 4);
    const bf16_t* ap = A + (size_t)(rt * 128 + srow) * 1024 + hh * 512 + (tid & 7) * 8;
    const bf16_t* wp = W + (size_t)(nt * 128 + srow) * 1024 + hh * 512 + (tid & 7) * 8;
    auto issue = [&](int kt) {
#pragma unroll
      for (int i = 0; i < 4; ++i) {
        ra[i] = *(const u32x4*)(ap + (size_t)i * 32 * 1024 + kt * 64);
        rb[i] = *(const u32x4*)(wp + (size_t)i * 32 * 1024 + kt * 64);
      }
    };
    auto store = [&](int buf) {
#pragma unroll
      for (int i = 0; i < 4; ++i) {
        ss[i] += sumsq8(__builtin_bit_cast(bf16x8, ra[i]));
        *(u32x4*)(As + buf * 16384 + i * 4096 + soff) = ra[i];
        *(u32x4*)(Bs + buf * 16384 + i * 4096 + soff) = rb[i];
      }
    };
    issue(0);
    store(0);
    __syncthreads();
#pragma unroll 1
    for (int kt = 0; kt < 8; ++kt) {
      const int buf = kt & 1;
      if (kt + 1 < 8) issue(kt + 1);
      const unsigned char* Ab = As + buf * 16384 + (wn * 64 + lr) * 128;
      const unsigned char* Bb = Bs + buf * 16384 + (wm * 64 + lr) * 128;
#pragma unroll
      for (int ks = 0; ks < 2; ++ks) {
        const int sw = ((ks * 4 + lq) ^ (lr & 7)) << 4;
        bf16x8 wf[4], xf[4];
#pragma unroll
        for (int i = 0; i < 4; ++i) { wf[i] = *(const bf16x8*)(Bb + i * 2048 + sw); xf[i] = *(const bf16x8*)(Ab + i * 2048 + sw); }
#pragma unroll
        for (int ni = 0; ni < 4; ++ni)
#pragma unroll
          for (int ti = 0; ti < 4; ++ti) acc[ni][ti] = MFMA16(wf[ni], xf[ti], acc[ni][ti]);
      }
      if (kt + 1 < 8) store(buf ^ 1);
      __syncthreads();
    }
#pragma unroll
    for (int i = 0; i < 4; ++i) {
      float t = ss[i];
      t += __shfl_xor(t, 1); t += __shfl_xor(t, 2); t += __shfl_xor(t, 4);
      if ((tid & 7) == 0) { if (hh) xss[srow + 32 * i] = t; else rsl[srow + 32 * i] = t; }
    }
    if (hh) {
#pragma unroll
      for (int a = 0; a < 4; ++a)
#pragma unroll
        for (int b = 0; b < 4; ++b)
#pragma unroll
          for (int e = 0; e < 4; ++e) xacc[((a * 4 + b) * 4 + e) * 256 + tid] = acc[a][b][e];
    }
    __syncthreads();
    if (!hh) {
#pragma unroll
      for (int a = 0; a < 4; ++a)
#pragma unroll
        for (int b = 0; b < 4; ++b)
#pragma unroll
          for (int e = 0; e < 4; ++e) acc[a][b][e] += xacc[((a * 4 + b) * 4 + e) * 256 + tid];
      float rs[4];
#pragma unroll
      for (int ti = 0; ti < 4; ++ti) {
        const int r = wn * 64 + ti * 16 + lr;
        rs[ti] = rsqrtf((rsl[r] + xss[r]) * (1.f / 1024.f) + EPS_);
      }
      gemm_epilogue<EPI_E1, 4>(ws, acc, rs, rt * 128, nt * 128, wm, wn, lr, lq, false);
    }
  }
  __syncthreads();
}

__device__ __forceinline__ void rem_tile(int pos, int& mt, int& nt) { if (pos < 65) { mt = pos; nt = 40; } else { mt = 64; nt = pos - 65; } }
template <bool RS, int EPI, int TI, int TMAP = 0>
__device__ __forceinline__ void gemm_stream(const WS& ws, const bf16_t* A0, const bf16_t* A1, int lda, int ktsplit, int kstride,
                                            const bf16_t* __restrict__ W, int K, float invK, int ntn, int ntiles, int bid, bool dry) {
  constexpr int BMH = (TI == 5) ? 129 : 128;
  constexpr int ASTG = 16384;
  unsigned char* As = smem;
  unsigned char* Bs = smem_all + 2 * ASTG;
  float* rsl = (float*)(smem + 65536);
  int xbase = 66048;
  asm volatile("" : "+v"(xbase));
  unsigned char* Ax0 = smem + xbase;
  const int tid = opaque_tid(), lane = tid & 63, w = tid >> 6, wm = w >> 1, wn = w & 1, lr = lane & 15, lq = lane >> 4;
  const int tid5 = opaque_tid512(), hh = half_id();
  const int G = gridDim.x;
  const int nk = K >> 6;
  if (bid < ntiles) {
    const int my_tiles = (ntiles - 1 - bid) / G + 1;
    const int last_id = bid + (my_tiles - 1) * G;
    const int S = my_tiles * nk;
    f32x4 acc[4][TI];
#pragma unroll
    for (int a = 0; a < 4; ++a)
#pragma unroll
      for (int b = 0; b < TI; ++b) acc[a][b] = (f32x4){0.f, 0.f, 0.f, 0.f};
    u32x4 ra0[4], rb0[2], ra1[4], rb1[2];
    u32x4 rx0 = (u32x4){0u, 0u, 0u, 0u}, rx1 = (u32x4){0u, 0u, 0u, 0u};
    float ss[5] = {0.f, 0.f, 0.f, 0.f, 0.f};
    int l_id = bid, l_kt = 0, c_id = bid, c_kt = 0, st_kt = 0;
    const int srow = tid >> 3;
    const int soff = srow * 128 + (((tid & 7) ^ (srow & 7)) << 4);

    const int wrow = tid5 >> 3;
    const int woff = wrow * 128 + (((tid5 & 7) ^ (wrow & 7)) << 4);
    auto issue = [&](u32x4 (&ra)[4], u32x4 (&rb)[2], u32x4& rx) {
      const int idc = l_id < last_id ? l_id : last_id;
      int mt, nt; if (TMAP == 1) rem_tile(idc, mt, nt); else tile_of(idc, ntn, mt, nt);
      const bf16_t* A = (l_kt < ktsplit) ? A0 : A1;
      const int kk = (l_kt < ktsplit) ? l_kt : l_kt - ktsplit;
      const int arow = mt * 2 * BMH + hh * BMH + srow;
      const bf16_t* akb = A + kk * kstride + (tid & 7) * 8;
      const bf16_t* wp = W + (size_t)(nt * 128 + wrow) * K + l_kt * 64 + (tid5 & 7) * 8;
#pragma unroll
      for (int i = 0; i < 4; ++i) {
        int r = arow + 32 * i; r = r < M_ ? r : M_ - 1;
        ra[i] = *(const u32x4*)(akb + (size_t)r * lda);
      }
#pragma unroll
      for (int i = 0; i < 2; ++i) rb[i] = *(const u32x4*)(wp + (size_t)i * 64 * K);
      if (TI == 5) { if (srow == 0) rx = *(const u32x4*)(akb + (size_t)(arow + 128) * lda); }
      if (++l_kt == nk) { l_kt = 0; l_id += G; }
    };
    auto store = [&](const u32x4 (&ra)[4], const u32x4 (&rb)[2], const u32x4& rx, int buf) {
#pragma unroll
      for (int i = 0; i < 4; ++i) {
        if (RS) ss[i] += sumsq8(__builtin_bit_cast(bf16x8, ra[i]));
        *(u32x4*)(As + buf * ASTG + i * 4096 + soff) = ra[i];
      }
#pragma unroll
      for (int i = 0; i < 2; ++i) *(u32x4*)(Bs + buf * 16384 + i * 8192 + woff) = rb[i];
      if (TI == 5) {
        if (RS) ss[4] += sumsq8(__builtin_bit_cast(bf16x8, rx));
        if (srow == 0) *(u32x4*)(Ax0 + buf * 128 + ((tid & 7) << 4)) = rx;
      }
      if (RS) {
        if (++st_kt == nk) {
          st_kt = 0;
#pragma unroll
          for (int i = 0; i < TI; ++i) {
            float t = ss[i];
            t += __shfl_xor(t, 1); t += __shfl_xor(t, 2); t += __shfl_xor(t, 4);
            if ((tid & 7) == 0 && i < 4) rsl[srow + 32 * i] = rsqrtf(t * invK + EPS_);
            ss[i] = 0.f;
          }
        }
      }
    };
    auto compute = [&](int buf) {
      const unsigned char* Ab = As + buf * ASTG + (wn * 64 + lr) * 128;
      const unsigned char* Ax = Ax0 + buf * 128;
      const unsigned char* Bb = Bs + buf * 16384 + (wm * 64 + lr) * 128;
#pragma unroll
      for (int ks = 0; ks < 2; ++ks) {
        if (TI == 5 && ks == 1) __builtin_amdgcn_sched_barrier(0);
        const int sw = ((ks * 4 + lq) ^ (lr & 7)) << 4;
        bf16x8 wf[4], xf[TI];
#pragma unroll
        for (int i = 0; i < 4; ++i) {
          wf[i] = *(const bf16x8*)(Bb + i * 2048 + sw);
          xf[i] = *(const bf16x8*)(Ab + i * 2048 + sw);
        }
        if (TI == 5) xf[TI - 1] = *(const bf16x8*)(Ax + ((ks * 4 + lq) << 4));
#pragma unroll
        for (int ni = 0; ni < 4; ++ni)
#pragma unroll
          for (int ti = 0; ti < TI; ++ti) acc[ni][ti] = MFMA16(wf[ni], xf[ti], acc[ni][ti]);
      }
    };
    auto tile_end = [&]() {
      float rs[TI];
#pragma unroll
      for (int ti = 0; ti < TI; ++ti) rs[ti] = 1.f;
      if (RS) {
#pragma unroll
        for (int ti = 0; ti < TI; ++ti) rs[ti] = rsl[(ti < 4 ? wn * 64 + ti * 16 : 0) + lr];
      }
      int mt, nt; if (TMAP == 1) rem_tile(c_id, mt, nt); else tile_of(c_id, ntn, mt, nt);
      const int tokb = mt * 2 * BMH + hh * BMH;
      if (tokb < M_) gemm_epilogue<EPI, TI>(ws, acc, rs, tokb, nt * 128, wm, wn, lr, lq, dry);
#pragma unroll
      for (int a = 0; a < 4; ++a)
#pragma unroll
        for (int b = 0; b < TI; ++b) acc[a][b] = (f32x4){0.f, 0.f, 0.f, 0.f};
      c_id += G;
    };

    issue(ra0, rb0, rx0);
    issue(ra1, rb1, rx1);
    store(ra0, rb0, rx0, 0);
    __syncthreads();
#pragma unroll 1
    for (int s = 0; s < S; s += 2) {
      issue(ra0, rb0, rx0);
      compute(0);
      store(ra1, rb1, rx1, 1);
      __syncthreads();
      issue(ra1, rb1, rx1);
      compute(1);
      c_kt += 2;
      if (c_kt == nk) { c_kt = 0; tile_end(); }
      store(ra0, rb0, rx0, 0);
      __syncthreads();
    }
  }
  __syncthreads();
}

__device__ __forceinline__ void gla_decay_unit(const Params& p, const WS& ws, int j, int u) {
  const int c = u % 33; const int bh = u / 33; const int hd = bh & 3, b = bh >> 2;
  bf16_t* Qs = (bf16_t*)smem;
  bf16_t* Ks = Qs + 64 * 136;
  float* ADs = (float*)(smem + 2 * 64 * 136 * 2);
  float* HT = ADs + 64 * 16;
  const int tid = opaque_tid();
  const int tbase = 64 * c - 48;
#pragma unroll
  for (int i = 0; i < 4; ++i) {
    const int ci = tid + 256 * i; const int row = ci >> 4, ch = ci & 15; const int t = tbase + row;
    u32x4 qv = (u32x4){0, 0, 0, 0}, kv = (u32x4){0, 0, 0, 0};
    if (t >= 0) {
      qv = *(const u32x4*)(ws.Q + (size_t)(b * T_ + t) * 512 + hd * 128 + ch * 8);
      kv = *(const u32x4*)(ws.K + (size_t)(b * T_ + t) * 512 + hd * 128 + ch * 8);
    }
    *(u32x4*)(Qs + row * 136 + ch * 8) = qv;
    *(u32x4*)(Ks + row * 136 + ch * 8) = kv;
    const int t2 = tbase + (ci >> 4);
    ADs[ci] = t2 >= 0 ? bf2f(ws.AD[(size_t)(b * T_ + t2) * 16 + (ci & 15)]) : 0.f;
  }
  const int d = tid & 127, half = tid >> 7;
  float aw[16];
#pragma unroll
  for (int r = 0; r < 16; ++r) aw[r] = p.ab_alpha_w[(size_t)(j * 16 + r) * 512 + hd * 128 + d];
  const float abias = p.ab_alpha_b[j * 512 + hd * 128 + d];
  __syncthreads();
  float cs[32];
  float run = 0.f;
#pragma unroll
  for (int ii = 0; ii < 32; ++ii) {
    const int row = half * 32 + ii;
    float xv = abias;
#pragma unroll
    for (int r4 = 0; r4 < 4; ++r4) {
      const float4 a4 = *(const float4*)(ADs + row * 16 + r4 * 4);
      xv += a4.x * aw[r4 * 4] + a4.y * aw[r4 * 4 + 1] + a4.z * aw[r4 * 4 + 2] + a4.w * aw[r4 * 4 + 3];
    }
    float la = (fminf(xv, 0.f) - __logf(1.f + __expf(-fabsf(xv)))) * 0.0625f;
    if (tbase + row < 0) la = 0.f;
    run += la;
    cs[ii] = run;
  }
  HT[half * 128 + d] = run;
  __syncthreads();
  const float off = half ? HT[d] : 0.f;
  const float blast = HT[d] + HT[128 + d];
#pragma unroll
  for (int ii = 0; ii < 32; ++ii) {
    const int row = half * 32 + ii;
    const float bb = cs[ii] + off;
    const float eb = __expf(bb), ebi = __expf(-bb);
    Qs[row * 136 + d] = f2bf(bf2f(Qs[row * 136 + d]) * eb);
    Ks[row * 136 + d] = f2bf(bf2f(Ks[row * 136 + d]) * ebi);
  }
  if (half == 0) ws.BL[(size_t)((b * 4 + hd) * 33 + c) * 128 + d] = __expf(blast);
  __syncthreads();
#pragma unroll
  for (int i = 0; i < 4; ++i) {
    const int ci = tid + 256 * i; const int row = ci >> 4, ch = ci & 15; const int t = tbase + row;
    if (t >= 0) {
      *(u32x4*)(ws.Q + (size_t)(b * T_ + t) * 512 + hd * 128 + ch * 8) = *(const u32x4*)(Qs + row * 136 + ch * 8);
      *(u32x4*)(ws.K + (size_t)(b * T_ + t) * 512 + hd * 128 + ch * 8) = *(const u32x4*)(Ks + row * 136 + ch * 8);
    }
  }
  __syncthreads();
}

__device__ __forceinline__ void conv_unit(const Params& p, const WS& ws, int j, int u) {
  const int g = u & 7, b = u >> 3;
  const int tid = opaque_tid();
  const int c8 = tid & 15, seg = tid >> 4;
  const int t0 = seg * 129;
  const int cbase = 128 * g + 8 * c8;
  float cw[4][8], cb[8];
#pragma unroll
  for (int e = 0; e < 8; ++e) {
    cb[e] = p.ab_conv_b[j * 1024 + cbase + e];
#pragma unroll
    for (int k = 0; k < 4; ++k) cw[k][e] = p.ab_conv_w[(size_t)(j * 4 + k) * 1024 + cbase + e];
  }
  bf16_t* xp = ws.XA + (size_t)(b * T_) * 1024 + cbase;
  float x0[8], x1[8], x2[8];
  {
    u32x4 h[3];
#pragma unroll
    for (int m = 0; m < 3; ++m) {
      const int t = t0 - 3 + m;
      h[m] = (u32x4){0, 0, 0, 0};
      if (t >= 0) h[m] = *(const u32x4*)(xp + (size_t)t * 1024);
    }
    const u32x4 a = h[0], bq = h[1], c = h[2];
    x0[0] = bflo(a.x); x0[1] = bfhi(a.x); x0[2] = bflo(a.y); x0[3] = bfhi(a.y); x0[4] = bflo(a.z); x0[5] = bfhi(a.z); x0[6] = bflo(a.w); x0[7] = bfhi(a.w);
    x1[0] = bflo(bq.x); x1[1] = bfhi(bq.x); x1[2] = bflo(bq.y); x1[3] = bfhi(bq.y); x1[4] = bflo(bq.z); x1[5] = bfhi(bq.z); x1[6] = bflo(bq.w); x1[7] = bfhi(bq.w);
    x2[0] = bflo(c.x); x2[1] = bfhi(c.x); x2[2] = bflo(c.y); x2[3] = bfhi(c.y); x2[4] = bflo(c.z); x2[5] = bfhi(c.z); x2[6] = bflo(c.w); x2[7] = bfhi(c.w);
  }
  __syncthreads();
#pragma unroll 1
  for (int tt = 0; tt < 129; tt += 3) {
    u32x4 r[3];
#pragma unroll
    for (int m = 0; m < 3; ++m) r[m] = *(const u32x4*)(xp + (size_t)(t0 + tt + m) * 1024);
#pragma unroll
    for (int m = 0; m < 3; ++m) {
      float x3[8];
      x3[0] = bflo(r[m].x); x3[1] = bfhi(r[m].x); x3[2] = bflo(r[m].y); x3[3] = bfhi(r[m].y);
      x3[4] = bflo(r[m].z); x3[5] = bfhi(r[m].z); x3[6] = bflo(r[m].w); x3[7] = bfhi(r[m].w);
      float y[8];
#pragma unroll
      for (int e = 0; e < 8; ++e) y[e] = cb[e] + cw[0][e] * x0[e] + cw[1][e] * x1[e] + cw[2][e] * x2[e] + cw[3][e] * x3[e];
      u32x4 pk; pk.x = cvt_pk_bf16(y[0], y[1]); pk.y = cvt_pk_bf16(y[2], y[3]); pk.z = cvt_pk_bf16(y[4], y[5]); pk.w = cvt_pk_bf16(y[6], y[7]);
      *(u32x4*)(xp + (size_t)(t0 + tt + m) * 1024) = pk;
#pragma unroll
      for (int e = 0; e < 8; ++e) { x0[e] = x1[e]; x1[e] = x2[e]; x2[e] = x3[e]; }
    }
  }
  __syncthreads();
}

__device__ __forceinline__ void gla_unit(const Params& p, const WS& ws, int u, bool dry = false) {
  const int sl = u & 7; const int bh = u >> 3; const int hd = bh & 3, b = bh >> 2;
  bf16_t* QDs = (bf16_t*)smem;
  bf16_t* KIs = QDs + 64 * 136;
  bf16_t* KIT = KIs + 64 * 136;
  bf16_t* VTs = KIT + 128 * 72;
  bf16_t* STs = VTs + 32 * 72;
  bf16_t* Ps = STs + 32 * 136;
  const int tid = opaque_tid(), lane = tid & 63, w = tid >> 6, lr = lane & 15, lq = lane >> 4;
  for (int i = tid; i < 32 * 136 / 2; i += 256) ((unsigned*)STs)[i] = 0u;
  f32x4 sacc[2][2];
#pragma unroll
  for (int a = 0; a < 2; ++a)
#pragma unroll
    for (int bb = 0; bb < 2; ++bb) sacc[a][bb] = (f32x4){0.f, 0.f, 0.f, 0.f};
  u32x4 qrA[4], krA[4], vrA, qrB[4], krB[4], vrB;
  float eblA[2], eblB[2];
  const float* BLp = ws.BL + (size_t)((b * 4 + hd) * 33) * 128;
  auto prefetch = [&](int c, u32x4 (&qr)[4], u32x4 (&kr)[4], u32x4& vr, float (&ebl)[2]) {
    const int tbase = 64 * c - 48;
#pragma unroll
    for (int i = 0; i < 4; ++i) {
      const int ci = tid + 256 * i; const int row = ci >> 4, ch = ci & 15; const int t = tbase + row;
      qr[i] = (u32x4){0, 0, 0, 0}; kr[i] = (u32x4){0, 0, 0, 0};
      if (t >= 0) {
        qr[i] = *(const u32x4*)(ws.Q + (size_t)(b * T_ + t) * 512 + hd * 128 + ch * 8);
        kr[i] = *(const u32x4*)(ws.K + (size_t)(b * T_ + t) * 512 + hd * 128 + ch * 8);
      }
    }
    {
      const int row = tid >> 2, ch = tid & 3; const int t = tbase + row;
      vr = (u32x4){0, 0, 0, 0};
      if (t >= 0) vr = *(const u32x4*)(ws.V + (size_t)(b * T_ + t) * 1024 + hd * 256 + sl * 32 + ch * 8);
    }
    ebl[0] = BLp[c * 128 + 16 * (2 * w) + lr];
    ebl[1] = BLp[c * 128 + 16 * (2 * w + 1) + lr];
  };
  prefetch(0, qrA, krA, vrA, eblA);
  prefetch(1, qrB, krB, vrB, eblB);
  __syncthreads();
  u32x2 opend[2]; float sqpend = 0.f; int tpend = -1;
  opend[0] = (u32x2){0u, 0u}; opend[1] = (u32x2){0u, 0u};
  auto flush_o = [&]() {
    if (tpend >= 0 && !dry) {
      const size_t row = (size_t)(b * T_ + tpend);
#pragma unroll
      for (int mt = 0; mt < 2; ++mt) *(u32x2*)(ws.V + row * 1024 + hd * 256 + sl * 32 + 16 * mt + 4 * lq) = opend[mt];
      if (lq == 0) ws.SSQ[row * 32 + hd * 8 + sl] = sqpend;
    }
  };
  auto body = [&](int c, u32x4 (&qr)[4], u32x4 (&kr)[4], u32x4& vr, float (&ebl)[2]) {
#pragma unroll
    for (int i = 0; i < 4; ++i) {
      const int ci = tid + 256 * i; const int row = ci >> 4, ch = ci & 15;
      *(u32x4*)(QDs + row * 136 + ch * 8) = qr[i];
      *(u32x4*)(KIs + row * 136 + ch * 8) = kr[i];
      const unsigned kk[4] = {kr[i].x, kr[i].y, kr[i].z, kr[i].w};
#pragma unroll
      for (int e = 0; e < 4; ++e) {
        KIT[(ch * 8 + 2 * e) * 72 + (row ^ ((ch & 7) << 3))] = (bf16_t)(kk[e] & 0xffffu);
        KIT[(ch * 8 + 2 * e + 1) * 72 + (row ^ ((ch & 7) << 3))] = (bf16_t)(kk[e] >> 16);
      }
    }
    {
      const int row = tid >> 2, ch = tid & 3;
      const unsigned vv[4] = {vr.x, vr.y, vr.z, vr.w};
#pragma unroll
      for (int e = 0; e < 4; ++e) {
        VTs[(ch * 8 + 2 * e) * 72 + (row ^ (ch << 3))] = (bf16_t)(vv[e] & 0xffffu);
        VTs[(ch * 8 + 2 * e + 1) * 72 + (row ^ (ch << 3))] = (bf16_t)(vv[e] >> 16);
      }
    }
    const float eb0 = ebl[0], eb1 = ebl[1];
    __syncthreads();
    flush_o();
    if (c + 2 < 33) prefetch(c + 2, qr, kr, vr, ebl);
    bf16x8 xq[4];
#pragma unroll
    for (int ks = 0; ks < 4; ++ks) xq[ks] = *(const bf16x8*)(QDs + (16 * w + lr) * 136 + 32 * ks + 8 * lq);
    const int irow = 16 * w + lr;
#pragma unroll
    for (int mt = 0; mt < 4; ++mt) {
      u32x2 pk = (u32x2){0u, 0u};
      if (mt <= w) {
        f32x4 a = (f32x4){0.f, 0.f, 0.f, 0.f};
#pragma unroll
        for (int ks = 0; ks < 4; ++ks) {
          const bf16x8 kf = *(const bf16x8*)(KIs + (16 * mt + lr) * 136 + 32 * ks + 8 * lq);
          a = MFMA16(kf, xq[ks], a);
        }
        const int ip = 16 * mt + 4 * lq;
        const float v0 = (ip + 0 <= irow) ? a[0] : 0.f, v1 = (ip + 1 <= irow) ? a[1] : 0.f;
        const float v2 = (ip + 2 <= irow) ? a[2] : 0.f, v3 = (ip + 3 <= irow) ? a[3] : 0.f;
        pk.x = cvt_pk_bf16(v0, v1); pk.y = cvt_pk_bf16(v2, v3);
      }
      *(u32x2*)(Ps + irow * 72 + 16 * mt + 4 * lq) = pk;
    }
    __syncthreads();
    f32x4 oacc[2];
    oacc[0] = (f32x4){0.f, 0.f, 0.f, 0.f}; oacc[1] = (f32x4){0.f, 0.f, 0.f, 0.f};
#pragma unroll
    for (int ks = 0; ks < 2; ++ks) {
      if (2 * ks <= w) {
        const bf16x8 pb = *(const bf16x8*)(Ps + irow * 72 + 32 * ks + 8 * lq);
#pragma unroll
        for (int mt = 0; mt < 2; ++mt) {
          const bf16x8 vf = *(const bf16x8*)(VTs + (16 * mt + lr) * 72 + (((4 * ks + lq) ^ (((16 * mt + lr) >> 3) & 3)) << 3));
          oacc[mt] = MFMA16(vf, pb, oacc[mt]);
        }
      }
    }
#pragma unroll
    for (int ks = 0; ks < 4; ++ks)
#pragma unroll
      for (int mt = 0; mt < 2; ++mt) {
        const bf16x8 sf = *(const bf16x8*)(STs + (16 * mt + lr) * 136 + 32 * ks + 8 * lq);
        oacc[mt] = MFMA16(sf, xq[ks], oacc[mt]);
      }
    {
      const int t = 64 * c - 48 + irow;
      float sq = 0.f;
#pragma unroll
      for (int mt = 0; mt < 2; ++mt) sq += oacc[mt][0] * oacc[mt][0] + oacc[mt][1] * oacc[mt][1] + oacc[mt][2] * oacc[mt][2] + oacc[mt][3] * oacc[mt][3];
      sq += __shfl_xor(sq, 16); sq += __shfl_xor(sq, 32);
      tpend = t;
      sqpend = sq;
#pragma unroll
      for (int mt = 0; mt < 2; ++mt) { opend[mt].x = cvt_pk_bf16(oacc[mt][0], oacc[mt][1]); opend[mt].y = cvt_pk_bf16(oacc[mt][2], oacc[mt][3]); }
    }
    __syncthreads();
#pragma unroll
    for (int ntl = 0; ntl < 2; ++ntl) {
#pragma unroll
      for (int ks = 0; ks < 2; ++ks) {
        const bf16x8 kf = *(const bf16x8*)(KIT + (16 * (2 * w + ntl) + lr) * 72 + (((4 * ks + lq) ^ (((16 * (2 * w + ntl) + lr) >> 3) & 7)) << 3));
#pragma unroll
        for (int mt = 0; mt < 2; ++mt) {
          const bf16x8 vf = *(const bf16x8*)(VTs + (16 * mt + lr) * 72 + (((4 * ks + lq) ^ (((16 * mt + lr) >> 3) & 3)) << 3));
          sacc[mt][ntl] = MFMA16(vf, kf, sacc[mt][ntl]);
        }
      }
      const float e = ntl ? eb1 : eb0;
#pragma unroll
      for (int mt = 0; mt < 2; ++mt) {
        sacc[mt][ntl] = scale4(sacc[mt][ntl], e);
#pragma unroll
        for (int jj = 0; jj < 4; ++jj) STs[(16 * mt + 4 * lq + jj) * 136 + 16 * (2 * w + ntl) + lr] = f2bf(sacc[mt][ntl][jj]);
      }
    }
    __syncthreads();
  };
#pragma unroll 1
  for (int c = 0; c < 33; c += 2) {
    body(c, qrA, krA, vrA, eblA);
    if (c + 1 < 33) body(c + 1, qrB, krB, vrB, eblB);
  }
  flush_o();
  __syncthreads();
}

__device__ __forceinline__ void rglru_unit(const Params& p, const WS& ws, int j, int u, bool dry = false) {
  const int jq = u & 3, g = (u >> 2) & 7, b = u >> 5;
  bf16_t* XC = (bf16_t*)smem;
  bf16_t* WG = XC + 64 * 136;
  float* AUa = (float*)(smem + 34816);
  float* AUu = AUa + 64 * 33;
  float* SEGA = AUu + 64 * 33;
  float* SEGH = SEGA + 256;
  float* CARRY = SEGH + 256;
  const int tid = opaque_tid(), lane = tid & 63, w = tid >> 6, lr = lane & 15, lq = lane >> 4;
#pragma unroll 4
  for (int i = 0; i < 32; ++i) {
    const int e = tid + 256 * i;
    const int gate = e >> 12, k = (e >> 5) & 127, n = e & 31;
    const float* gw = gate ? p.ab_gate_x_w : p.ab_gate_a_w;
    WG[(gate * 32 + n) * 136 + k] = f2bf(gw[((size_t)(j * 8 + g) * 128 + k) * 128 + 32 * jq + n]);
  }
  if (tid < 32) CARRY[tid] = 0.f;
  float ba[2][4], bx[2][4], sp[2][4];
#pragma unroll
  for (int mt = 0; mt < 2; ++mt)
#pragma unroll
    for (int jj = 0; jj < 4; ++jj) {
      const int ch = j * 1024 + 128 * g + 32 * jq + 16 * mt + 4 * lq + jj;
      ba[mt][jj] = p.ab_gate_a_b[ch]; bx[mt][jj] = p.ab_gate_x_b[ch];
      sp[mt][jj] = 8.f * log1pf(__expf(-p.ab_lam[ch]));
    }
  const int sc = tid & 31, ssg = tid >> 5;
  u32x4 xinA[4], xinB[4];
  bf16_t gavA[8], gavB[8];
  auto prefetch = [&](int tile, u32x4 (&xin)[4], bf16_t (&gav)[8]) {
    const int t0 = 64 * tile;
#pragma unroll
    for (int i = 0; i < 4; ++i) {
      const int ci = tid + 256 * i; const int row = ci >> 4, ch = ci & 15; const int t = t0 + row;
      xin[i] = (u32x4){0, 0, 0, 0};
      if (t < T_) xin[i] = *(const u32x4*)(ws.XA + (size_t)(b * T_ + t) * 1024 + 128 * g + 8 * ch);
    }
#pragma unroll
    for (int i = 0; i < 8; ++i) {
      const int t = t0 + 8 * ssg + i;
      gav[i] = 0;
      if (t < T_) gav[i] = ws.GA[(size_t)(b * T_ + t) * 1024 + 128 * g + 32 * jq + sc];
    }
  };
  prefetch(0, xinA, gavA);
  prefetch(1, xinB, gavB);
  __syncthreads();
  bf16_t ypend[8];
  int ypend_t0 = -1;
  auto flush_y = [&]() {
    if (ypend_t0 >= 0) {
#pragma unroll
      for (int i = 0; i < 8; ++i) {
        const int t = ypend_t0 + 8 * ssg + i;
        if (t < T_ && !dry) ws.GA[(size_t)(b * T_ + t) * 1024 + 128 * g + 32 * jq + sc] = ypend[i];
      }
    }
  };
  auto body = [&](int tile, u32x4 (&xin)[4], bf16_t (&gav)[8]) {
    const int t0 = 64 * tile;
#pragma unroll
    for (int i = 0; i < 4; ++i) {
      const int ci = tid + 256 * i; const int row = ci >> 4, ch = ci & 15;
      *(u32x4*)(XC + row * 136 + 8 * ch) = xin[i];
    }
    float gcur[8];
#pragma unroll
    for (int i = 0; i < 8; ++i) gcur[i] = bf2f(gav[i]);
    __syncthreads();
    flush_y();
    if (tile + 2 < 33) prefetch(tile + 2, xin, gav);
    {
      f32x4 ga_[2][2];
#pragma unroll
      for (int a = 0; a < 2; ++a)
#pragma unroll
        for (int bb = 0; bb < 2; ++bb) ga_[a][bb] = (f32x4){0.f, 0.f, 0.f, 0.f};
#pragma unroll
      for (int ks = 0; ks < 4; ++ks) {
        const bf16x8 xf = *(const bf16x8*)(XC + (16 * w + lr) * 136 + 32 * ks + 8 * lq);
#pragma unroll
        for (int gate = 0; gate < 2; ++gate)
#pragma unroll
          for (int mt = 0; mt < 2; ++mt) {
            const bf16x8 wf = *(const bf16x8*)(WG + (gate * 32 + 16 * mt + lr) * 136 + 32 * ks + 8 * lq);
            ga_[gate][mt] = MFMA16(wf, xf, ga_[gate][mt]);
          }
      }
      const int tok = 16 * w + lr;
#pragma unroll
      for (int mt = 0; mt < 2; ++mt)
#pragma unroll
        for (int jj = 0; jj < 4; ++jj) {
          const int n = 16 * mt + 4 * lq + jj;
          const float xcv = bf2f(XC[tok * 136 + 32 * jq + n]);
          const float r = sigmoidf_(ga_[0][mt][jj] + ba[mt][jj]);
          const float ig = sigmoidf_(ga_[1][mt][jj] + bx[mt][jj]);
          const float la = -r * sp[mt][jj];
          const float a = __expf(la);
          const float x2 = 2.f * la;
          const float om = x2 > -0.02f ? -x2 * (1.f + 0.5f * x2 * (1.f + x2 * (1.f / 3.f))) : 1.f - a * a;
          const float mult = __builtin_amdgcn_sqrtf(fmaxf(om, 0.f));
          AUa[tok * 33 + n] = a;
          AUu[tok * 33 + n] = mult * ig * xcv;
        }
    }
    __syncthreads();
    {
      float A = 1.f, Hh = 0.f;
#pragma unroll
      for (int i = 0; i < 8; ++i) {
        const float a = AUa[(8 * ssg + i) * 33 + sc], uu = AUu[(8 * ssg + i) * 33 + sc];
        Hh = a * Hh + uu; A *= a;
      }
      SEGA[ssg * 32 + sc] = A; SEGH[ssg * 32 + sc] = Hh;
    }
    __syncthreads();
    float hin = CARRY[sc];
#pragma unroll
    for (int s2 = 0; s2 < 7; ++s2)
      if (s2 < ssg) hin = SEGA[s2 * 32 + sc] * hin + SEGH[s2 * 32 + sc];
    __syncthreads();
    {
      float h = hin;
#pragma unroll
      for (int i = 0; i < 8; ++i) {
        const float a = AUa[(8 * ssg + i) * 33 + sc], uu = AUu[(8 * ssg + i) * 33 + sc];
        h = a * h + uu;
        const int t = t0 + 8 * ssg + i;
        ypend[i] = f2bf(h * siluf_(gcur[i]));
      }
      if (ssg == 7) CARRY[sc] = h;
      ypend_t0 = t0;
    }
  };
#pragma unroll 1
  for (int tile = 0; tile < 33; tile += 2) {
    body(tile, xinA, gavA);
    if (tile + 1 < 33) body(tile + 1, xinB, gavB);
  }
  flush_y();
  __syncthreads();
}

__device__ __forceinline__ void phase_gla_norm(const Params& p, const WS& ws, int j) {
  const size_t gtid = (size_t)opaque_bid() * 256 + opaque_tid(), gsz = (size_t)NVB * 256;
  const float* gn = p.ab_gla_norm + j * 256;
#pragma unroll 4
  for (size_t idx = gtid; idx < (size_t)M_ * 128; idx += gsz) {
    const size_t row = idx >> 7; const int c8 = (int)(idx & 127); const int hd = c8 >> 5; const int dv = (c8 & 31) * 8;
    const float4 s0 = *(const float4*)(ws.SSQ + row * 32 + hd * 8), s1 = *(const float4*)(ws.SSQ + row * 32 + hd * 8 + 4);
    const float ssum = (s0.x + s0.y + s0.z + s0.w) + (s1.x + s1.y + s1.z + s1.w);
    const float rstd = rsqrtf(ssum * (1.f / 256.f) + EPS_);
    const u32x4 ov = *(const u32x4*)(ws.V + row * 1024 + c8 * 8);
    const u32x4 gv = *(const u32x4*)(ws.GB + row * 1024 + c8 * 8);
    const float4 g0 = *(const float4*)(gn + dv), g1 = *(const float4*)(gn + dv + 4);
    float o[8] = {bflo(ov.x), bfhi(ov.x), bflo(ov.y), bfhi(ov.y), bflo(ov.z), bfhi(ov.z), bflo(ov.w), bfhi(ov.w)};
    const float gg[8] = {bflo(gv.x), bfhi(gv.x), bflo(gv.y), bfhi(gv.y), bflo(gv.z), bfhi(gv.z), bflo(gv.w), bfhi(gv.w)};
    const float nn[8] = {g0.x, g0.y, g0.z, g0.w, g1.x, g1.y, g1.z, g1.w};
#pragma unroll
    for (int e = 0; e < 8; ++e) o[e] = o[e] * rstd * nn[e] * siluf_(gg[e]);
    u32x4 pk; pk.x = cvt_pk_bf16(o[0], o[1]); pk.y = cvt_pk_bf16(o[2], o[3]); pk.z = cvt_pk_bf16(o[4], o[5]); pk.w = cvt_pk_bf16(o[6], o[7]);
    *(u32x4*)(ws.V + row * 1024 + c8 * 8) = pk;
  }
}

__device__ __forceinline__ void attn_unit(const WS& ws, int u, bool dry = false) {
  const int qb = 16 - (u >> 7); const int bh = u & 127; const int hd = bh & 15, b = bh >> 4;
  bf16_t* Kt = (bf16_t*)smem;
  bf16_t* Vl = Kt + 2 * 64 * 104;
  const int tid = opaque_tid(), lane = tid & 63, w = tid >> 6, lr = lane & 15, lq = lane >> 4;
  const int q0 = 128 * qb;
  int nkt = 2 * qb + 2; if (nkt > 33) nkt = 33;
  bf16x8 xq[2][3];
  int qi[2];
#pragma unroll
  for (int nt = 0; nt < 2; ++nt) {
    qi[nt] = q0 + 32 * w + 16 * nt + lr;
    const int qc = qi[nt] < T_ ? qi[nt] : T_ - 1;
#pragma unroll
    for (int ks = 0; ks < 2; ++ks)
      xq[nt][ks] = *(const bf16x8*)(ws.QB + (size_t)(b * T_ + qc) * 1536 + hd * 96 + 32 * ks + 8 * lq);
    {
      const u32x4 raw = *(const u32x4*)(ws.QB + (size_t)(b * T_ + qc) * 1536 + hd * 96 + 64 + 8 * lq);
      u32x4 oth;
      oth.x = __shfl_xor(raw.x, 32); oth.y = __shfl_xor(raw.y, 32); oth.z = __shfl_xor(raw.z, 32); oth.w = __shfl_xor(raw.w, 32);
      const float sgn = lq < 2 ? -1.f : 1.f;
      const float2* rp = ws.ROPE + (size_t)(b * T_ + qc) * 16 + 8 * (lq & 1);
      const unsigned rw[4] = {raw.x, raw.y, raw.z, raw.w}, ow[4] = {oth.x, oth.y, oth.z, oth.w};
      unsigned res[4];
#pragma unroll
      for (int e = 0; e < 4; ++e) {
        const float2 c0 = rp[2 * e], c1 = rp[2 * e + 1];
        const float r0 = bflo(rw[e]) * c0.x + sgn * bflo(ow[e]) * c0.y;
        const float r1 = bfhi(rw[e]) * c1.x + sgn * bfhi(ow[e]) * c1.y;
        res[e] = cvt_pk_bf16(r0, r1);
      }
      xq[nt][2] = as_bf16x8((u32x4){res[0], res[1], res[2], res[3]});
    }
  }
  float mrun[2] = {-INFINITY, -INFINITY}, lsum[2] = {0.f, 0.f};
  f32x4 oacc[4][2];
#pragma unroll
  for (int a = 0; a < 4; ++a)
#pragma unroll
    for (int bb = 0; bb < 2; ++bb) oacc[a][bb] = (f32x4){0.f, 0.f, 0.f, 0.f};
  u32x4 kregA[3], vregA[2], kregB[3], vregB[2];
  const bf16_t* vbase = ws.VT + ((size_t)(b * 16 + hd) * 64) * TP_;
  auto loadg = [&](int kt, u32x4 (&kreg)[3], u32x4 (&vreg)[2]) {
#pragma unroll
    for (int i = 0; i < 3; ++i) {
      const int ci = tid + 256 * i; const int key = ci / 12, ch = ci - key * 12;
      int gk = 64 * kt + key; if (gk > T_ - 1) gk = T_ - 1;
      const bf16_t* src = ch < 8 ? ws.KN + (size_t)(b * T_ + gk) * 1024 + hd * 64 + ch * 8
                                 : ws.KR + (size_t)(b * T_ + gk) * 32 + (ch - 8) * 8;
      kreg[i] = *(const u32x4*)src;
    }
#pragma unroll
    for (int i = 0; i < 2; ++i) {
      const int ci = tid + 256 * i; const int dv = ci >> 3, ch = ci & 7;
      vreg[i] = *(const u32x4*)(vbase + (size_t)dv * TP_ + 64 * kt + ch * 8);
      if (64 * kt + ch * 8 >= T_) vreg[i] = (u32x4){0u, 0u, 0u, 0u};
    }
  };
  auto stores = [&](int buf, const u32x4 (&kreg)[3], const u32x4 (&vreg)[2]) {
#pragma unroll
    for (int i = 0; i < 3; ++i) {
      const int ci = tid + 256 * i; const int key = ci / 12, ch = ci - key * 12;
      *(u32x4*)(Kt + buf * 64 * 104 + key * 104 + ch * 8) = kreg[i];
    }
#pragma unroll
    for (int i = 0; i < 2; ++i) {
      const int ci = tid + 256 * i; const int dv = ci >> 3, ch = ci & 7;
      *(u32x4*)(Vl + buf * 64 * 72 + dv * 72 + ch * 8) = vreg[i];
    }
  };
  const int nkt2 = (nkt + 1) & ~1;
  loadg(0, kregA, vregA);
  loadg(1, kregB, vregB);
  stores(0, kregA, vregA);
  __syncthreads();
  auto body = [&](int kt, int buf, u32x4 (&kreg)[3], u32x4 (&vreg)[2], const u32x4 (&kregn)[3], const u32x4 (&vregn)[2]) {
    { const int kn = kt + 2 < nkt2 ? kt + 2 : nkt2 - 1; loadg(kn, kreg, vreg); }
    const bf16_t* Kb = Kt + buf * 64 * 104;
    const bf16_t* Vb = Vl + buf * 64 * 72;
    f32x4 s[4][2];
#pragma unroll
    for (int mt = 0; mt < 4; ++mt) {
      s[mt][0] = (f32x4){0.f, 0.f, 0.f, 0.f}; s[mt][1] = (f32x4){0.f, 0.f, 0.f, 0.f};
#pragma unroll
      for (int ks = 0; ks < 3; ++ks) {
        const bf16x8 kf = *(const bf16x8*)(Kb + (16 * mt + lr) * 104 + 32 * ks + 8 * lq);
        s[mt][0] = MFMA16(kf, xq[0][ks], s[mt][0]);
        s[mt][1] = MFMA16(kf, xq[1][ks], s[mt][1]);
      }
    }
    if (kt >= 2 * qb) {
#pragma unroll
      for (int mt = 0; mt < 4; ++mt)
#pragma unroll
        for (int nt = 0; nt < 2; ++nt)
#pragma unroll
          for (int jj = 0; jj < 4; ++jj) {
            const int key = 64 * kt + 16 * mt + 4 * lq + jj;
            if (key > qi[nt]) s[mt][nt][jj] = -INFINITY;
          }
    }
    bf16x8 pf[2][2];
#pragma unroll
    for (int nt = 0; nt < 2; ++nt) {
      float mx = -INFINITY;
#pragma unroll
      for (int mt = 0; mt < 4; ++mt) mx = fmaxf(mx, fmaxf(fmaxf(s[mt][nt][0], s[mt][nt][1]), fmaxf(s[mt][nt][2], s[mt][nt][3])));
      mx = fmaxf(mx, __shfl_xor(mx, 16)); mx = fmaxf(mx, __shfl_xor(mx, 32));
      if (__builtin_amdgcn_ballot_w64(mx > mrun[nt]) != 0ull) {
        const float mnew = fmaxf(mrun[nt], mx);
        const float alpha = __builtin_amdgcn_exp2f(mrun[nt] - mnew);
        mrun[nt] = mnew;
        lsum[nt] *= alpha;
#pragma unroll
        for (int mt = 0; mt < 4; ++mt) oacc[mt][nt] = scale4(oacc[mt][nt], alpha);
      }
      const float mnew = mrun[nt];
      float ps = 0.f;
#pragma unroll
      for (int mt = 0; mt < 4; ++mt)
#pragma unroll
        for (int jj = 0; jj < 4; ++jj) { const float pv = __builtin_amdgcn_exp2f(s[mt][nt][jj] - mnew); s[mt][nt][jj] = pv; ps += pv; }
      lsum[nt] += ps;
#pragma unroll
      for (int ks = 0; ks < 2; ++ks) {
        u32x4 pk;
        pk.x = cvt_pk_bf16(s[2 * ks][nt][0], s[2 * ks][nt][1]); pk.y = cvt_pk_bf16(s[2 * ks][nt][2], s[2 * ks][nt][3]);
        pk.z = cvt_pk_bf16(s[2 * ks + 1][nt][0], s[2 * ks + 1][nt][1]); pk.w = cvt_pk_bf16(s[2 * ks + 1][nt][2], s[2 * ks + 1][nt][3]);
        pf[nt][ks] = as_bf16x8(pk);
      }
    }
#pragma unroll
    for (int mt = 0; mt < 4; ++mt)
#pragma unroll
      for (int ks = 0; ks < 2; ++ks) {
        const u32x2 lo = *(const u32x2*)(Vb + (16 * mt + lr) * 72 + 32 * ks + 4 * lq);
        const u32x2 hi = *(const u32x2*)(Vb + (16 * mt + lr) * 72 + 32 * ks + 16 + 4 * lq);
        const bf16x8 vf = as_bf16x8((u32x4){lo.x, lo.y, hi.x, hi.y});
        oacc[mt][0] = MFMA16(vf, pf[0][ks], oacc[mt][0]);
        oacc[mt][1] = MFMA16(vf, pf[1][ks], oacc[mt][1]);
      }
    stores(buf ^ 1, kregn, vregn);
    __syncthreads();
  };
#pragma unroll 1
  for (int kt = 0; kt < nkt2; kt += 2) {
    body(kt, 0, kregA, vregA, kregB, vregB);
    body(kt + 1, 1, kregB, vregB, kregA, vregA);
  }
#pragma unroll
  for (int nt = 0; nt < 2; ++nt) {
    float l = lsum[nt];
    l += __shfl_xor(l, 16); l += __shfl_xor(l, 32);
    const float inv = 1.f / l;
    if (qi[nt] < T_) {
      const size_t row = (size_t)(b * T_ + qi[nt]);
#pragma unroll
      for (int mt = 0; mt < 4; ++mt) {
        const u32x2 gv = *(const u32x2*)(ws.GATE + row * 1024 + hd * 64 + 16 * mt + 4 * lq);
        const float o0 = oacc[mt][nt][0] * inv * siluf_(bflo(gv.x)), o1 = oacc[mt][nt][1] * inv * siluf_(bfhi(gv.x));
        const float o2 = oacc[mt][nt][2] * inv * siluf_(bflo(gv.y)), o3 = oacc[mt][nt][3] * inv * siluf_(bfhi(gv.y));
        u32x2 pk; pk.x = cvt_pk_bf16(o0, o1); pk.y = cvt_pk_bf16(o2, o3);
        if (!dry) *(u32x2*)(ws.QB + row * 1536 + hd * 96 + 16 * mt + 4 * lq) = pk;
      }
    }
  }
}

__device__ __forceinline__ void phase_final(const Params& p, const WS& ws) {
  const int tidf = opaque_tid();
  const int lane = tidf & 63;
  const int gw = opaque_bid() * 4 + (tidf >> 6), nw = NVB * 4;
#pragma unroll 2
  for (int r = gw; r < 8 * 2048; r += nw) {
    const int b = r >> 11, s = r & 2047;
    const size_t hoff = (size_t)(b * T_ + 16 + s) * 1024;
    float4 v[4];
    float ssum = 0.f;
#pragma unroll
    for (int i = 0; i < 4; ++i) {
      const u32x2 hi = *(const u32x2*)(ws.HHI + hoff + i * 256 + lane * 4), lo = *(const u32x2*)(ws.HLO + hoff + i * 256 + lane * 4);
      v[i] = make_float4(bflo(hi.x) + bflo(lo.x), bfhi(hi.x) + bfhi(lo.x), bflo(hi.y) + bflo(lo.y), bfhi(hi.y) + bfhi(lo.y));
      ssum += v[i].x * v[i].x + v[i].y * v[i].y + v[i].z * v[i].z + v[i].w * v[i].w;
    }
#pragma unroll
    for (int o = 1; o < 64; o <<= 1) ssum += __shfl_xor(ssum, o);
    const float rstd = rsqrtf(ssum * (1.f / 1024.f) + EPS_);
#pragma unroll
    for (int i = 0; i < 4; ++i) {
      const float4 g = *(const float4*)(p.final_norm + i * 256 + lane * 4);
      float4 o; o.x = v[i].x * rstd * g.x; o.y = v[i].y * rstd * g.y; o.z = v[i].z * rstd * g.z; o.w = v[i].w * rstd * g.w;
      *(float4*)(p.out + (size_t)r * 1024 + i * 256 + lane * 4) = o;
    }
  }
}

__global__ void __launch_bounds__(512, 2) fwd_megakernel(Params p) {
  cg::grid_group grid = cg::this_grid();
  if (p.inv_freq[0] < 0.f) grid.sync();
  volatile LAS unsigned* xst = (volatile LAS unsigned*)(smem_all + 2 * SMEM_BYTES);
  if (threadIdx.x == 0) { xst[0] = 0u; xst[1] = 0u; xst[2] = 0u; xst[3] = 0u; }
  __syncthreads();
  const XcdBarrier xb = xcd_barrier_post((unsigned*)(p.ws + BAR_OFF), xst);
  {
    const WS ws = make_ws(p);
    phase_prologue(p, ws);
  }
  xcd_barrier(xb);
#pragma unroll 1
  for (int layer = 0; layer < 4; ++layer) {
    const int j = layer >> 1;
    if ((layer & 1) == 0) {
      {
        const WS ws = make_ws(p);
        const bf16_t* wb = ws.W + (size_t)j * W_PER_J;
#pragma unroll 1
        for (int rep = 0; rep < REP_GEMM; ++rep)
          { gemm_wide<EPI_E1>(ws, ws.HHI, 1024, wb + W_IN_E, 1024, 1.f / 1024.f, 20, 64 * 20, xcd_bid(opaque_rbid()));
            gemm_rem_splitk(ws, ws.HHI, wb + W_IN_E, opaque_rbid()); }
      }
      xcd_barrier(xb);
      {
        const WS ws = make_ws(p);
#pragma unroll 1
        for (int u = opaque_bid(); u < 8 * 4 * 33 + 64; u += NVB) {
          if (u < 448) gla_decay_unit(p, ws, j, u); else if (u < 512) conv_unit(p, ws, j, u - 448); else gla_decay_unit(p, ws, j, u - 64);
        }
      }
      xcd_barrier(xb);
      {
#pragma unroll 1
        for (int rep = 0; rep < REP_E2; ++rep)
#pragma unroll 1
        for (int u = opaque_bid(); u < 512; u += NVB) {
          if (u & 1) { const WS ws = make_ws(p); rglru_unit(p, ws, j, u >> 1, rep < REP_E2 - 1); }
          else { const WS ws = make_ws(p); gla_unit(p, ws, u >> 1, rep < REP_E2 - 1); }
        }
      }
      xcd_barrier(xb);
      {
        const WS ws = make_ws(p);
        phase_gla_norm(p, ws, j);
      }
      xcd_barrier(xb);
      {
        const WS ws = make_ws(p);
        const bf16_t* wb = ws.W + (size_t)j * W_PER_J;
#pragma unroll 1
        for (int rep = 0; rep < REP_GEMM; ++rep)
          gemm_stream<false, EPI_RES, 5>(ws, ws.GA, ws.V, 1024, 16, 64, wb + W_OUT_E, 2048, 0.f, 8, 64 * 8, xcd_bid(opaque_rbid()), rep < REP_GEMM - 1);
      }
      xcd_barrier(xb);
    } else {
      {
        const WS ws = make_ws(p);
        const bf16_t* wb = ws.W + (size_t)j * W_PER_J;
#pragma unroll 1
        for (int rep = 0; rep < REP_GEMM; ++rep)
          gemm_stream<true, EPI_O1, 4>(ws, ws.HHI, nullptr, 1024, 1 << 30, 64, wb + W_IN_O, 1024, 1.f / 1024.f, 15, 65 * 15, xcd_bid(opaque_rbid()), false);
      }
      xcd_barrier(xb);
      {
        const WS ws = make_ws(p);
        const bf16_t* wb = ws.W + (size_t)j * W_PER_J;
#pragma unroll 1
        for (int rep = 0; rep < REP_GEMM; ++rep) {
          gemm_stream<true, EPI_Q, 4>(ws, ws.CQ, nullptr, 512, 1 << 30, 64, wb + W_Q, 512, 1.f / 512.f, 12, 65 * 12, xcd_bid(opaque_rbid()), false);
          gemm_stream<true, EPI_KV, 4>(ws, ws.CKV, nullptr, 256, 1 << 30, 64, wb + W_KV, 256, 1.f / 256.f, 16, 65 * 16, xcd_bid((opaque_rbid() + (int)(gridDim.x >> 1)) % (int)gridDim.x), false);
        }
      }
      xcd_barrier(xb);
      {
        const WS ws = make_ws(p);
#pragma unroll 1
        for (int rep = 0; rep < REP_ATTN; ++rep)
#pragma unroll 1
        for (int r = 0, b0 = opaque_bid(); r * NVB < 17 * 128; ++r) {
          const int u = r * NVB + ((r & 1) ? NVB - 1 - b0 : b0);
          if (u < 17 * 128) attn_unit(ws, u, rep < REP_ATTN - 1);
          __syncthreads();
        }
      }
      xcd_barrier(xb);
      {
        const WS ws = make_ws(p);
        const bf16_t* wb = ws.W + (size_t)j * W_PER_J;
#pragma unroll 1
        for (int rep = 0; rep < REP_GEMM; ++rep)
          gemm_stream<false, EPI_RES, 5>(ws, ws.QB, nullptr, 1536, 1 << 30, 96, wb + W_O, 1024, 0.f, 8, 64 * 8, xcd_bid(opaque_rbid()), rep < REP_GEMM - 1);
      }
      xcd_barrier(xb);
    }
  }
  {
    const WS ws = make_ws(p);
    phase_final(p, ws);
  }
}

extern "C" void kernel_launch(void* const* d_in, const int* in_sizes, int n_in, void* d_out, int out_size, void* d_ws,
                              size_t ws_size, hipStream_t stream) {
  static int grid_blocks = 0;
  if (!grid_blocks) {
    int dev = 0, cus = 0, per_cu = 0;
    hipGetDevice(&dev);
    hipDeviceGetAttribute(&cus, hipDeviceAttributeMultiprocessorCount, dev);
    hipOccupancyMaxActiveBlocksPerMultiprocessor(&per_cu, fwd_megakernel, 512, 0);
    per_cu = 1;
    grid_blocks = cus * per_cu;
  }
  Params p{};
  p.x = (const float*)d_in[0]; p.positions = (const int*)d_in[1]; p.meta = (const float*)d_in[2];
  p.ab_norm = (const float*)d_in[3]; p.ab_w_in = (const float*)d_in[4]; p.ab_conv_w = (const float*)d_in[5];
  p.ab_conv_b = (const float*)d_in[6]; p.ab_gate_a_w = (const float*)d_in[7]; p.ab_gate_a_b = (const float*)d_in[8];
  p.ab_gate_x_w = (const float*)d_in[9]; p.ab_gate_x_b = (const float*)d_in[10]; p.ab_lam = (const float*)d_in[11];
  p.ab_alpha_w = (const float*)d_in[12]; p.ab_alpha_b = (const float*)d_in[13]; p.ab_gla_norm = (const float*)d_in[14];
  p.ab_w_out = (const float*)d_in[15]; p.c_norm = (const float*)d_in[16]; p.c_w_in = (const float*)d_in[17];
  p.c_q_norm = (const float*)d_in[18]; p.c_w_q_up = (const float*)d_in[19]; p.c_kv_norm = (const float*)d_in[20];
  p.c_w_kv_up = (const float*)d_in[21]; p.c_w_out = (const float*)d_in[22]; p.final_norm = (const float*)d_in[23];
  p.out = (float*)d_out;
  p.ws = (unsigned char*)d_ws;
  for (int i = 0; i < 16; ++i) p.inv_freq[i] = (float)pow(10000.0, -(double)i / 16.0);
  hipMemsetAsync((unsigned char*)d_ws + BAR_OFF, 0, XCD_BAR_WORDS * 4, stream);
  void* args[] = {&p};
  hipError_t e = hipLaunchCooperativeKernel((void*)fwd_megakernel, dim3(grid_blocks), dim3(512), args, 0, stream);
  if (e != hipSuccess) fprintf(stderr, "cooperative launch failed: %s (grid %d)\n", hipGetErrorString(e), grid_blocks);
}
```

```cpp
#include <hip/hip_runtime.h>
#include <hip/hip_cooperative_groups.h>
#include <cstdio>
#include <cmath>
namespace cg = cooperative_groups;

typedef unsigned short bf16_t;
typedef short bf16x8 __attribute__((ext_vector_type(8)));
typedef float f32x4 __attribute__((ext_vector_type(4)));
typedef unsigned u32x4 __attribute__((ext_vector_type(4)));
typedef unsigned u32x2 __attribute__((ext_vector_type(2)));

constexpr int T_ = 2064;
constexpr int M_ = 8 * T_;
constexpr int TP_ = 2112;
constexpr float EPS_ = 1e-6f;
constexpr int SMEM_BYTES = 75776;
constexpr float QSCALE_MLA = 0.10206207261596575f * 1.4426950408889634f;

constexpr size_t W_PER_J = 11796480;
constexpr size_t W_IN_E = 0, W_OUT_E = 5373952, W_IN_O = 7471104, W_Q = 9437184, W_KV = 10223616, W_O = 10747904;

struct Params {
  const float* x; const int* positions; const float* meta;
  const float *ab_norm, *ab_w_in, *ab_conv_w, *ab_conv_b, *ab_gate_a_w, *ab_gate_a_b, *ab_gate_x_w, *ab_gate_x_b,
      *ab_lam, *ab_alpha_w, *ab_alpha_b, *ab_gla_norm, *ab_w_out;
  const float *c_norm, *c_w_in, *c_q_norm, *c_w_q_up, *c_kv_norm, *c_w_kv_up, *c_w_out, *final_norm;
  float* out;
  unsigned char* ws;
  float inv_freq[16];
};

struct WS {
  bf16_t *HHI, *HLO; float2* ROPE;
  bf16_t *XA, *GA, *Q, *K, *V, *GB, *AD; float* SSQ; float* BL;
  bf16_t *CQ, *CKV, *GATE, *KR, *QB, *KN, *VT;
  bf16_t* W;
};

__device__ __forceinline__ unsigned char* opaque_ptr(unsigned char* q) {
  unsigned lo = (unsigned)(unsigned long long)q, hi = (unsigned)((unsigned long long)q >> 32);
  asm volatile("" : "+v"(lo), "+v"(hi));
  lo = __builtin_amdgcn_readfirstlane(lo); hi = __builtin_amdgcn_readfirstlane(hi);
  typedef __attribute__((address_space(1))) unsigned char gu8;
  return (unsigned char*)(gu8*)(((unsigned long long)hi << 32) | lo);
}
__device__ __forceinline__ WS make_ws(const Params& p) {
  WS w;
  unsigned char* b = opaque_ptr(p.ws);
  w.HHI = (bf16_t*)b; b += (size_t)M_ * 2048;
  w.HLO = (bf16_t*)b; b += (size_t)M_ * 2048;
  w.ROPE = (float2*)b; b += (size_t)M_ * 128;
  unsigned char* r = b;
  w.XA = (bf16_t*)r; r += (size_t)M_ * 2048;
  w.GA = (bf16_t*)r; r += (size_t)M_ * 2048;
  w.Q = (bf16_t*)r; r += (size_t)M_ * 1024;
  w.K = (bf16_t*)r; r += (size_t)M_ * 1024;
  w.V = (bf16_t*)r; r += (size_t)M_ * 2048;
  w.GB = (bf16_t*)r; r += (size_t)M_ * 2048;
  w.AD = (bf16_t*)r; r += (size_t)M_ * 32;
  w.SSQ = (float*)r; r += (size_t)M_ * 128;
  w.BL = (float*)r; r += (size_t)8 * 4 * 33 * 128 * 4;
  r = b;
  w.CQ = (bf16_t*)r; r += (size_t)M_ * 1024;
  w.CKV = (bf16_t*)r; r += (size_t)M_ * 512;
  w.GATE = (bf16_t*)r; r += (size_t)M_ * 2048;
  w.KR = (bf16_t*)r; r += (size_t)M_ * 64;
  w.QB = (bf16_t*)r; r += (size_t)M_ * 3072;
  w.KN = (bf16_t*)r; r += (size_t)M_ * 2048;
  w.VT = (bf16_t*)r; r += (size_t)128 * 64 * TP_ * 2;
  w.W = (bf16_t*)opaque_ptr((unsigned char*)p.out);
  return w;
}

__device__ __forceinline__ unsigned cvt_pk_bf16(float lo, float hi) {
  typedef float f32x2_t __attribute__((ext_vector_type(2)));
  typedef __bf16 bf16x2_t __attribute__((ext_vector_type(2)));
  const f32x2_t v = {lo, hi};
  const bf16x2_t r = __builtin_convertvector(v, bf16x2_t);
  return __builtin_bit_cast(unsigned, r);
}
__device__ __forceinline__ f32x4 scale4(f32x4 a, float r) {
  asm volatile("" : "+v"(r));
  float x0 = a[0] * r, x1 = a[1] * r, x2 = a[2] * r, x3 = a[3] * r;
  asm volatile("" : "+v"(x0), "+v"(x1), "+v"(x2), "+v"(x3));
  return (f32x4){x0, x1, x2, x3};
}
__device__ __forceinline__ float bf2f(bf16_t v) { return __uint_as_float(((unsigned)v) << 16); }
__device__ __forceinline__ float bflo(unsigned v) { return __uint_as_float(v << 16); }
__device__ __forceinline__ float bfhi(unsigned v) { return __uint_as_float(v & 0xffff0000u); }
__device__ __forceinline__ bf16_t f2bf(float f) { return (bf16_t)(cvt_pk_bf16(f, 0.f) & 0xffffu); }
__device__ __forceinline__ float sigmoidf_(float x) { return __builtin_amdgcn_rcpf(1.f + __expf(-x)); }
__device__ __forceinline__ float siluf_(float x) { return x * __builtin_amdgcn_rcpf(1.f + __expf(-x)); }
__device__ __forceinline__ bf16x8 as_bf16x8(u32x4 v) { return __builtin_bit_cast(bf16x8, v); }
__device__ __forceinline__ int half_id() { return __builtin_amdgcn_readfirstlane((int)(threadIdx.x >> 8)); }
__device__ __forceinline__ int opaque_tid() { int t = threadIdx.x & 255; asm volatile("" : "+v"(t)); return t; }
__device__ __forceinline__ int opaque_tid512() { int t = threadIdx.x; asm volatile("" : "+v"(t)); return t; }
__device__ __forceinline__ int xcd_bid(int bid) { const int gpx = gridDim.x >> 3; return (bid & 7) * gpx + (bid >> 3); }
__device__ __forceinline__ int opaque_bid() { int t = blockIdx.x * 2 + half_id(); asm volatile("" : "+s"(t)); return t; }
__device__ __forceinline__ int opaque_rbid() { int t = blockIdx.x; asm volatile("" : "+s"(t)); return t; }
#define NVB ((int)gridDim.x * 2)
#define MFMA16(a, b, c) __builtin_amdgcn_mfma_f32_16x16x32_bf16((a), (b), (c), 0, 0, 0)

__shared__ __attribute__((aligned(16))) unsigned char smem_all[2 * SMEM_BYTES + 16];
#define smem (smem_all + half_id() * SMEM_BYTES)

#define XB_TMO      128
#define XB_XCNT(j)  (256  + 64 * (j))
#define XB_XSUB(j)  (1280 + 64 * (j))
#define XB_XGEN(j)  (2304 + 64 * (j))
#define XB_TOP      3328
#define XB_TOPGEN   3392
#define XCD_BAR_WORDS 3456
#define XB_SPIN_CAP (1u << 18)
#define LAS __attribute__((address_space(3)))
constexpr size_t BAR_OFF = 260046848;

__device__ __forceinline__ unsigned xb_ld(unsigned* p)              { return __hip_atomic_load(p, __ATOMIC_RELAXED, __HIP_MEMORY_SCOPE_AGENT); }
__device__ __forceinline__ unsigned xb_add(unsigned* p, unsigned v) { return __hip_atomic_fetch_add(p, v, __ATOMIC_RELAXED, __HIP_MEMORY_SCOPE_AGENT); }
__device__ __forceinline__ unsigned xb_xcc_id() { return (unsigned)__builtin_amdgcn_s_getreg((3 << 11) | 20) & 0xFu; }
#define XB_SPIN(cond, bar) do { unsigned _sp = 0; while (cond) { __builtin_amdgcn_s_sleep(1); \
    if ((++_sp & 255u) == 0u) { if (xb_ld(&(bar)[XB_TMO])) break; if (_sp > XB_SPIN_CAP) { atomicAdd(&(bar)[XB_TMO], 1u); break; } } } } while (0)

struct XcdBarrier { unsigned* bar; unsigned x; volatile LAS unsigned* st; };

__device__ __forceinline__ XcdBarrier xcd_barrier_post(unsigned* bar, volatile LAS unsigned* st) {
    XcdBarrier b; b.bar = bar; b.x = xb_xcc_id(); b.st = st;
    if (threadIdx.x == 0) (void)xb_add(&bar[XB_XCNT(b.x)], 1u);
    return b;
}
__device__ __forceinline__ void xcd_barrier_complete(unsigned* bar, unsigned x, unsigned& nloc, unsigned& nx) {
    const unsigned G = gridDim.x * gridDim.y * gridDim.z;
    unsigned sum, cnt, mine, sp = 0u;
    for (;;) {
        sum = 0u; cnt = 0u; mine = 0u;
#pragma unroll
        for (unsigned j = 0; j < 16; ++j) { const unsigned c = xb_ld(&bar[XB_XCNT(j)]); sum += c; cnt += (c > 0u) ? 1u : 0u; mine = (j == x) ? c : mine; }
        if (sum == G) break;
        __builtin_amdgcn_s_sleep(1);
        if ((++sp & 255u) == 0u) { if (xb_ld(&bar[XB_TMO])) break; if (sp > XB_SPIN_CAP) { atomicAdd(&bar[XB_TMO], 1u); break; } }
    }
    nloc = mine > 0u ? mine : 1u; nx = cnt > 0u ? cnt : 1u;
}
__device__ __forceinline__ void xcd_barrier(const XcdBarrier& b) {
    asm volatile("s_waitcnt vmcnt(0)" ::: "memory");
    __syncthreads();
    if (threadIdx.x == 0) {
        unsigned* bar = b.bar;
        __builtin_amdgcn_s_waitcnt(0);
        unsigned nloc = b.st[0], nx = b.st[1];
        if (nloc == 0u) { xcd_barrier_complete(bar, b.x, nloc, nx); b.st[0] = nloc; b.st[1] = nx; }
        const unsigned old = xb_add(&bar[XB_XSUB(b.x)], 1u);
        const unsigned gen = old / nloc;
        if (old + 1u == (gen + 1u) * nloc) {
            __builtin_amdgcn_fence(__ATOMIC_RELEASE, "agent");
            asm volatile("s_waitcnt vmcnt(0)" ::: "memory");
            const unsigned og = xb_add(&bar[XB_TOP], 1u);
            const unsigned tg = og / nx;
            if (og + 1u == (tg + 1u) * nx) xb_add(&bar[XB_TOPGEN], 1u);
            else XB_SPIN(xb_ld(&bar[XB_TOPGEN]) == tg, bar);
            __builtin_amdgcn_fence(__ATOMIC_ACQUIRE, "agent");
            xb_add(&bar[XB_XGEN(b.x)], 1u);
            asm volatile("s_waitcnt vmcnt(0)" ::: "memory");
        } else {
            XB_SPIN(xb_ld(&bar[XB_XGEN(b.x)]) == gen, bar);
            __builtin_amdgcn_fence(__ATOMIC_ACQUIRE, "agent");
            asm volatile("s_waitcnt vmcnt(0)" ::: "memory");
        }
    }
    __syncthreads();
}


__device__ __forceinline__ int map_even_in(int n) { return n < 4096 ? n : (n < 5120 ? n + 16 : (n < 5136 ? n - 1024 : -1)); }
__device__ __forceinline__ int map_odd_in(int n) { return n < 768 ? n : (n < 1792 ? n + 32 : (n < 1824 ? n - 1024 : -1)); }

__device__ __forceinline__ void convert_tile(const float* __restrict__ src, int K, int Nsrc, bf16_t* __restrict__ dst,
                                             int kind, const float* __restrict__ g, int tile) {
  float* tl = (float*)smem;
  const int nkt = K >> 7;
  const int ntile = tile / nkt, ktile = tile - ntile * nkt;
  const int n0 = ntile * 64, k0 = ktile * 128;
  const int tid = opaque_tid();
  const int nl = tid & 63, kq = tid >> 6;
  const int n = n0 + nl;
  const int sc = kind == 0 ? map_even_in(n) : (kind == 1 ? map_odd_in(n) : n);
  float cs = 1.f;
  if (kind == 0 && n >= 2048 && n < 2560) cs = 0.08838834764831845f;
  if (kind == 2) cs = QSCALE_MLA;
  float v[32];
#pragma unroll
  for (int i = 0; i < 32; ++i) {
    const int kl = kq + 4 * i;
    v[i] = 0.f;
    if (sc >= 0) v[i] = src[(size_t)(k0 + kl) * Nsrc + sc];
  }
#pragma unroll
  for (int i = 0; i < 32; ++i) {
    const int kl = kq + 4 * i;
    float t = v[i] * cs;
    if (g) t *= g[k0 + kl];
    tl[kl * 65 + nl] = t;
  }
  __syncthreads();
#pragma unroll
  for (int i = 0; i < 4; ++i) {
    const int c = tid + 256 * i;
    const int nl2 = c >> 4, kc = c & 15;
    float t[8];
#pragma unroll
    for (int jj = 0; jj < 8; ++jj) t[jj] = tl[(kc * 8 + jj) * 65 + nl2];
    u32x4 pk;
    pk.x = cvt_pk_bf16(t[0], t[1]); pk.y = cvt_pk_bf16(t[2], t[3]); pk.z = cvt_pk_bf16(t[4], t[5]); pk.w = cvt_pk_bf16(t[6], t[7]);
    *(u32x4*)(dst + (size_t)(n0 + nl2) * K + k0 + kc * 8) = pk;
  }
  __syncthreads();
}

__device__ __forceinline__ void phase_prologue(const Params& p, const WS& ws) {
  for (int id = opaque_bid(); id < 2880; id += NVB) {
    const int j = id / 1440; int r = id - j * 1440;
    bf16_t* wb = ws.W + (size_t)j * W_PER_J;
    if (r < 656) convert_tile(p.ab_w_in + (size_t)j * 1024 * 5136, 1024, 5136, wb + W_IN_E, 0, p.ab_norm + j * 1024, r);
    else if ((r -= 656) < 256) convert_tile(p.ab_w_out + (size_t)j * 2048 * 1024, 2048, 1024, wb + W_OUT_E, 3, nullptr, r);
    else if ((r -= 256) < 240) convert_tile(p.c_w_in + (size_t)j * 1024 * 1824, 1024, 1824, wb + W_IN_O, 1, p.c_norm + j * 1024, r);
    else if ((r -= 240) < 96) convert_tile(p.c_w_q_up + (size_t)j * 512 * 1536, 512, 1536, wb + W_Q, 2, p.c_q_norm + j * 512, r);
    else if ((r -= 96) < 64) convert_tile(p.c_w_kv_up + (size_t)j * 256 * 2048, 256, 2048, wb + W_KV, 3, p.c_kv_norm + j * 256, r);
    else { r -= 64; convert_tile(p.c_w_out + (size_t)j * 1024 * 1024, 1024, 1024, wb + W_O, 3, nullptr, r); }
  }
  const size_t gtid = (size_t)opaque_bid() * 256 + opaque_tid(), gsz = (size_t)NVB * 256;
  for (size_t idx0 = gtid; idx0 < (size_t)M_ * 256; idx0 += 8 * gsz) {
    float4 v4[8];
#pragma unroll
    for (int q = 0; q < 8; ++q) {
      const size_t idx = idx0 + q * gsz;
      v4[q] = make_float4(0.f, 0.f, 0.f, 0.f);
      if (idx < (size_t)M_ * 256) {
        const int row = (int)(idx >> 8), c4 = (int)(idx & 255);
        const int b = row / T_, t = row - b * T_;
        const float* src = t < 16 ? p.meta + (size_t)t * 1024 : p.x + ((size_t)b * 2048 + (t - 16)) * 1024;
        v4[q] = *(const float4*)(src + c4 * 4);
      }
    }
#pragma unroll
    for (int q = 0; q < 8; ++q) {
      const size_t idx = idx0 + q * gsz;
      if (idx < (size_t)M_ * 256) {
        const float4 v = v4[q];
        u32x2 hi; hi.x = cvt_pk_bf16(v.x, v.y); hi.y = cvt_pk_bf16(v.z, v.w);
        u32x2 lo; lo.x = cvt_pk_bf16(v.x - bflo(hi.x), v.y - bfhi(hi.x)); lo.y = cvt_pk_bf16(v.z - bflo(hi.y), v.w - bfhi(hi.y));
        *(u32x2*)(ws.HHI + idx * 4) = hi;
        *(u32x2*)(ws.HLO + idx * 4) = lo;
      }
    }
  }
  for (size_t idx = gtid; idx < (size_t)M_ * 16; idx += gsz) {
    const int row = (int)(idx >> 4), i = (int)(idx & 15);
    const int b = row / T_, t = row - b * T_;
    const int pos = t < 16 ? t : p.positions[b * 2048 + (t - 16)] + 16;
    const float angf = (float)pos * p.inv_freq[i];
    const double rev = (double)angf * 0.15915494309189533577;
    const float fr = (float)(rev - rint(rev));
    ws.ROPE[idx] = make_float2(__builtin_amdgcn_cosf(fr), __builtin_amdgcn_sinf(fr));
  }
}

#ifndef REP_GEMM
#define REP_GEMM 1
#endif
#ifndef REP_ATTN
#define REP_ATTN 1
#endif
#ifndef REP_E2
#define REP_E2 1
#endif
enum { EPI_E1 = 0, EPI_O1 = 1, EPI_Q = 2, EPI_KV = 3, EPI_RES = 4 };

template <int EPI, int TI>
__device__ __forceinline__ void gemm_epilogue(const WS& ws, const f32x4 (&acc)[4][TI], const float (&rs)[TI], int tok0, int n0,
                                              int wm, int wn, int lr, int lq, bool dry) {
  auto tokr = [&](int ti) { return tok0 + (ti < 4 ? wn * 64 + ti * 16 : 128 + wn * 16) + lr; };
  auto okr = [&](int ti) { return ti < 4 || (wn == 0 && lr == 0); };
  const int nw = n0 + wm * 64;
  if (EPI == EPI_E1) {
    bf16_t* dst; int ld, c;
    if (n0 < 1024) { dst = ws.XA; ld = 1024; c = n0; }
    else if (n0 < 2048) { dst = ws.GA; ld = 1024; c = n0 - 1024; }
    else if (n0 < 2560) { dst = ws.Q; ld = 512; c = n0 - 2048; }
    else if (n0 < 3072) { dst = ws.K; ld = 512; c = n0 - 2560; }
    else if (n0 < 4096) { dst = ws.V; ld = 1024; c = n0 - 3072; }
    else if (n0 < 5120) { dst = ws.GB; ld = 1024; c = n0 - 4096; }
    else { dst = ws.AD; ld = 16; c = 0; }
    const bool isad = n0 >= 5120;
#pragma unroll
    for (int ni = 0; ni < 4; ++ni) {
      if (isad && (wm != 0 || ni != 0)) continue;
#pragma unroll
      for (int ti = 0; ti < TI; ++ti) {
        const f32x4 v = scale4(acc[ni][ti], rs[ti]);
        u32x2 pk; pk.x = cvt_pk_bf16(v[0], v[1]); pk.y = cvt_pk_bf16(v[2], v[3]);
        if (okr(ti)) *(u32x2*)(dst + (size_t)tokr(ti) * ld + c + wm * 64 + ni * 16 + 4 * lq) = pk;
      }
    }
  } else if (EPI == EPI_O1) {
    if (n0 < 1792) {
      bf16_t* dst; int ld, c;
      if (n0 < 512) { dst = ws.CQ; ld = 512; c = n0; }
      else if (n0 < 768) { dst = ws.CKV; ld = 256; c = n0 - 512; }
      else { dst = ws.GATE; ld = 1024; c = n0 - 768; }
#pragma unroll
      for (int ni = 0; ni < 4; ++ni)
#pragma unroll
        for (int ti = 0; ti < TI; ++ti) {
          const f32x4 v = scale4(acc[ni][ti], rs[ti]);
          u32x2 pk; pk.x = cvt_pk_bf16(v[0], v[1]); pk.y = cvt_pk_bf16(v[2], v[3]);
          if (okr(ti)) *(u32x2*)(dst + (size_t)tokr(ti) * ld + c + wm * 64 + ni * 16 + 4 * lq) = pk;
        }
    } else if (wm == 0) {
#pragma unroll
      for (int ti = 0; ti < TI; ++ti) {
        const int tok = tokr(ti);
        const f32x4 x1 = scale4(acc[0][ti], rs[ti]), x2 = scale4(acc[1][ti], rs[ti]);
        float o1[4], o2[4];
#pragma unroll
        for (int jj = 0; jj < 4; ++jj) {
          const float2 cs = ws.ROPE[(size_t)tok * 16 + 4 * lq + jj];
          o1[jj] = x1[jj] * cs.x - x2[jj] * cs.y;
          o2[jj] = x2[jj] * cs.x + x1[jj] * cs.y;
        }
        u32x2 pk; pk.x = cvt_pk_bf16(o1[0], o1[1]); pk.y = cvt_pk_bf16(o1[2], o1[3]);
        *(u32x2*)(ws.KR + (size_t)tok * 32 + 4 * lq) = pk;
        pk.x = cvt_pk_bf16(o2[0], o2[1]); pk.y = cvt_pk_bf16(o2[2], o2[3]);
        *(u32x2*)(ws.KR + (size_t)tok * 32 + 16 + 4 * lq) = pk;
      }
    }
  } else if (EPI == EPI_Q) {
#pragma unroll
    for (int ni = 0; ni < 4; ++ni)
#pragma unroll
      for (int ti = 0; ti < TI; ++ti) {
        const f32x4 v = scale4(acc[ni][ti], rs[ti]);
        u32x2 pk; pk.x = cvt_pk_bf16(v[0], v[1]); pk.y = cvt_pk_bf16(v[2], v[3]);
        if (okr(ti)) *(u32x2*)(ws.QB + (size_t)tokr(ti) * 1536 + nw + ni * 16 + 4 * lq) = pk;
      }
  } else if (EPI == EPI_KV) {
    const int hd = nw >> 7;
    const bool isv = (nw & 127) >= 64;
    if (!isv) {
#pragma unroll
      for (int ni = 0; ni < 4; ++ni)
#pragma unroll
        for (int ti = 0; ti < TI; ++ti) {
          const f32x4 v = scale4(acc[ni][ti], rs[ti]);
          u32x2 pk; pk.x = cvt_pk_bf16(v[0], v[1]); pk.y = cvt_pk_bf16(v[2], v[3]);
          if (okr(ti)) *(u32x2*)(ws.KN + (size_t)tokr(ti) * 1024 + hd * 64 + ni * 16 + 4 * lq) = pk;
        }
    } else {
#pragma unroll
      for (int ti = 0; ti < TI; ++ti) {
        const int tok = tokr(ti);
        const int b = tok / T_, t = tok - b * T_;
        bf16_t* vb = ws.VT + ((size_t)(b * 16 + hd) * 64) * TP_ + t;
#pragma unroll
        for (int ni = 0; ni < 4; ++ni) {
          const f32x4 v = scale4(acc[ni][ti], rs[ti]);
#pragma unroll
          for (int jj = 0; jj < 4; ++jj) if (okr(ti)) vb[(size_t)(ni * 16 + 4 * lq + jj) * TP_] = f2bf(v[jj]);
        }
      }
    }
  } else {
#pragma unroll
    for (int ni = 0; ni < 4; ++ni)
#pragma unroll
      for (int ti = 0; ti < TI; ++ti) {
        if (!(ti < 4 || (lr == 0 && (ni >> 1) == wn))) continue;
        const size_t off = (size_t)(ti < 4 ? tokr(ti) : tok0 + 128) * 1024 + nw + ni * 16 + 4 * lq;
        const u32x2 hi = *(const u32x2*)(ws.HHI + off), lo = *(const u32x2*)(ws.HLO + off);
        const float h0 = bflo(hi.x) + bflo(lo.x) + acc[ni][ti][0], h1 = bfhi(hi.x) + bfhi(lo.x) + acc[ni][ti][1];
        const float h2 = bflo(hi.y) + bflo(lo.y) + acc[ni][ti][2], h3 = bfhi(hi.y) + bfhi(lo.y) + acc[ni][ti][3];
        u32x2 nh; nh.x = cvt_pk_bf16(h0, h1); nh.y = cvt_pk_bf16(h2, h3);
        u32x2 nl; nl.x = cvt_pk_bf16(h0 - bflo(nh.x), h1 - bfhi(nh.x)); nl.y = cvt_pk_bf16(h2 - bflo(nh.y), h3 - bfhi(nh.y));
        if (!dry) { *(u32x2*)(ws.HHI + off) = nh; *(u32x2*)(ws.HLO + off) = nl; }
      }
  }
}

__device__ __forceinline__ float sumsq8(bf16x8 v) {
  const u32x4 u = __builtin_bit_cast(u32x4, v);
  float s = 0.f, t;
  t = bflo(u.x); s += t * t; t = bfhi(u.x); s += t * t; t = bflo(u.y); s += t * t; t = bfhi(u.y); s += t * t;
  t = bflo(u.z); s += t * t; t = bfhi(u.z); s += t * t; t = bflo(u.w); s += t * t; t = bfhi(u.w); s += t * t;
  return s;
}
__device__ __forceinline__ void tile_of(int pos, int ntn, int& mt, int& nt) {
  const int full = 64 * ntn;
  if (pos < full) { const int panel = pos / (8 * ntn); const int rem = pos - panel * 8 * ntn; nt = rem >> 3; mt = panel * 8 + (rem & 7); }
  else { mt = 64; nt = pos - full; }
}
template <int EPI>
__device__ __forceinline__ void gemm_wide(const WS& ws, const bf16_t* A, int lda, const bf16_t* __restrict__ W, int K, float invK,
                                          int ntn, int ntiles, int bid) {
  unsigned char* As = smem_all + half_id() * 32768;
  unsigned char* Bs = smem_all + 65536;
  float* rsl = (float*)(smem_all + 131072 + half_id() * 1024);
  const int tid = opaque_tid(), lane = tid & 63, w = tid >> 6, wm = w >> 1, wn = w & 1, lr = lane & 15, lq = lane >> 4;
  const int tid5 = opaque_tid512(), hh = half_id();
  const int G = gridDim.x;
  const int nk = K >> 6;
  if (bid < ntiles) {
    const int my_tiles = (ntiles - 1 - bid) / G + 1;
    const int last_id = bid + (my_tiles - 1) * G;
    const int S = my_tiles * nk;
    f32x4 accA[4][4], accB[4][4];
#pragma unroll
    for (int a = 0; a < 4; ++a)
#pragma unroll
      for (int b = 0; b < 4; ++b) { accA[a][b] = (f32x4){0.f, 0.f, 0.f, 0.f}; accB[a][b] = (f32x4){0.f, 0.f, 0.f, 0.f}; }
    u32x4 ra[4], rb[4];
    float ss[4] = {0.f, 0.f, 0.f, 0.f};
    int l_id = bid, l_kt = 0, c_id = bid, c_kt = 0, st_kt = 0;
    const int srow = tid >> 3;
    const int soff = srow * 128 + (((tid & 7) ^ (srow & 7)) << 4);
    const int wrow = tid5 >> 3;
    const int woff = wrow * 128 + (((tid5 & 7) ^ (wrow & 7)) << 4);
    auto issue = [&]() {
      const int idc = l_id < last_id ? l_id : last_id;
      int mt, nt; tile_of(idc, ntn, mt, nt);
      const int arow = mt * 256 + hh * 128 + srow;
      const bf16_t* akb = A + l_kt * 64 + (tid & 7) * 8;
      const bf16_t* wp = W + (size_t)(nt * 256 + wrow) * K + l_kt * 64 + (tid5 & 7) * 8;
#pragma unroll
      for (int i = 0; i < 4; ++i) {
        int r = arow + 32 * i; r = r < M_ ? r : M_ - 1;
        ra[i] = *(const u32x4*)(akb + (size_t)r * lda);
        rb[i] = *(const u32x4*)(wp + (size_t)i * 64 * K);
      }
      if (++l_kt == nk) { l_kt = 0; l_id += G; }
    };
    auto store = [&](int buf) {
#pragma unroll
      for (int i = 0; i < 4; ++i) {
        ss[i] += sumsq8(__builtin_bit_cast(bf16x8, ra[i]));
        *(u32x4*)(As + buf * 16384 + i * 4096 + soff) = ra[i];
        *(u32x4*)(Bs + buf * 32768 + i * 8192 + woff) = rb[i];
      }
      if (++st_kt == nk) {
        st_kt = 0;
#pragma unroll
        for (int i = 0; i < 4; ++i) {
          float t = ss[i];
          t += __shfl_xor(t, 1); t += __shfl_xor(t, 2); t += __shfl_xor(t, 4);
          if ((tid & 7) == 0) rsl[srow + 32 * i] = rsqrtf(t * invK + EPS_);
          ss[i] = 0.f;
        }
      }
    };
    auto compute = [&](int buf) {
      const unsigned char* Ab = As + buf * 16384 + (wn * 64 + lr) * 128;
      const unsigned char* Bb = Bs + buf * 32768 + (wm * 64 + lr) * 128;
#pragma unroll
      for (int ks = 0; ks < 2; ++ks) {
        const int sw = ((ks * 4 + lq) ^ (lr & 7)) << 4;
        bf16x8 xf[4], wf[4];
#pragma unroll
        for (int i = 0; i < 4; ++i) { xf[i] = *(const bf16x8*)(Ab + i * 2048 + sw); wf[i] = *(const bf16x8*)(Bb + i * 2048 + sw); }
#pragma unroll
        for (int ni = 0; ni < 4; ++ni)
#pragma unroll
          for (int ti = 0; ti < 4; ++ti) accA[ni][ti] = MFMA16(wf[ni], xf[ti], accA[ni][ti]);
#pragma unroll
        for (int i = 0; i < 4; ++i) wf[i] = *(const bf16x8*)(Bb + 16384 + i * 2048 + sw);
#pragma unroll
        for (int ni = 0; ni < 4; ++ni)
#pragma unroll
          for (int ti = 0; ti < 4; ++ti) accB[ni][ti] = MFMA16(wf[ni], xf[ti], accB[ni][ti]);
      }
    };
    auto tile_end = [&]() {
      float rs[4];
#pragma unroll
      for (int ti = 0; ti < 4; ++ti) rs[ti] = rsl[wn * 64 + ti * 16 + lr];
      int mt, nt; tile_of(c_id, ntn, mt, nt);
      const int tokb = mt * 256 + hh * 128;
      if (tokb < M_) {
        gemm_epilogue<EPI, 4>(ws, accA, rs, tokb, nt * 256, wm, wn, lr, lq, false);
        if (nt * 256 + 128 < 5248) gemm_epilogue<EPI, 4>(ws, accB, rs, tokb, nt * 256 + 128, wm, wn, lr, lq, false);
      }
#pragma unroll
      for (int a = 0; a < 4; ++a)
#pragma unroll
        for (int b = 0; b < 4; ++b) { accA[a][b] = (f32x4){0.f, 0.f, 0.f, 0.f}; accB[a][b] = (f32x4){0.f, 0.f, 0.f, 0.f}; }
      c_id += G;
    };
    issue();
    store(0);
    __syncthreads();
#pragma unroll 1
    for (int s = 0; s < S; ++s) {
      issue();
      compute(s & 1);
      if (++c_kt == nk) { c_kt = 0; tile_end(); }
      store((s + 1) & 1);
      __syncthreads();
    }
  }
  __syncthreads();
}

__device__ __forceinline__ void gemm_rem_splitk(const WS& ws, const bf16_t* A, const bf16_t* __restrict__ W, int bid) {
  unsigned char* As = smem;
  unsigned char* Bs = smem + 32768;
  float* xacc = (float*)(smem_all + SMEM_BYTES);
  float* xss = (float*)(smem_all + SMEM_BYTES + 65536);
  float* rsl = (float*)(smem_all + 65536);
  const int tid = opaque_tid(), lane = tid & 63, w = tid >> 6, wm = w >> 1, wn = w & 1, lr = lane & 15, lq = lane >> 4;
  const int hh = half_id();
  if (bid < 169) {
    int rt, nt;
    if (bid < 129) { rt = bid; nt = 40; } else { rt = 128; nt = bid - 129; }
    f32x4 acc[4][4];
#pragma unroll
    for (int a = 0; a < 4; ++a)
#pragma unroll
      for (int b = 0; b < 4; ++b) acc[a][b] = (f32x4){0.f, 0.f, 0.f, 0.f};
    u32x4 ra[4], rb[4];
    float ss[4] = {0.f, 0.f, 0.f, 0.f};
    const int srow = tid >> 3;
    const int soff = srow * 128 + (((tid & 7) ^ (srow & 7)) << 4);
    const bf16_t* ap = A + (size_t)(rt * 128 + srow) * 1024 + hh * 512 + (tid & 7) * 8;
    const bf16_t* wp = W + (size_t)(nt * 128 + srow) * 1024 + hh * 512 + (tid & 7) * 8;
    auto issue = [&](int kt) {
#pragma unroll
      for (int i = 0; i < 4; ++i) {
        ra[i] = *(const u32x4*)(ap + (size_t)i * 32 * 1024 + kt * 64);
        rb[i] = *(const u32x4*)(wp + (size_t)i * 32 * 1024 + kt * 64);
      }
    };
    auto store = [&](int buf) {
#pragma unroll
      for (int i = 0; i < 4; ++i) {
        ss[i] += sumsq8(__builtin_bit_cast(bf16x8, ra[i]));
        *(u32x4*)(As + buf * 16384 + i * 4096 + soff) = ra[i];
        *(u32x4*)(Bs + buf * 16384 + i * 4096 + soff) = rb[i];
      }
    };
    issue(0);
    store(0);
    __syncthreads();
#pragma unroll 1
    for (int kt = 0; kt < 8; ++kt) {
      const int buf = kt & 1;
      if (kt + 1 < 8) issue(kt + 1);
      const unsigned char* Ab = As + buf * 16384 + (wn * 64 + lr) * 128;
      const unsigned char* Bb = Bs + buf * 16384 + (wm * 64 + lr) * 128;
#pragma unroll
      for (int ks = 0; ks < 2; ++ks) {
        const int sw = ((ks * 4 + lq) ^ (lr & 7)) << 4;
        bf16x8 wf[4], xf[4];
#pragma unroll
        for (int i = 0; i < 4; ++i) { wf[i] = *(const bf16x8*)(Bb + i * 2048 + sw); xf[i] = *(const bf16x8*)(Ab + i * 2048 + sw); }
#pragma unroll
        for (int ni = 0; ni < 4; ++ni)
#pragma unroll
          for (int ti = 0; ti < 4; ++ti) acc[ni][ti] = MFMA16(wf[ni], xf[ti], acc[ni][ti]);
      }
      if (kt + 1 < 8) store(buf ^ 1);
      __syncthreads();
    }
#pragma unroll
    for (int i = 0; i < 4; ++i) {
      float t = ss[i];
      t += __shfl_xor(t, 1); t += __shfl_xor(t, 2); t += __shfl_xor(t, 4);
      if ((tid & 7) == 0) { if (hh) xss[srow + 32 * i] = t; else rsl[srow + 32 * i] = t; }
    }
    if (hh) {
#pragma unroll
      for (int a = 0; a < 4; ++a)
#pragma unroll
        for (int b = 0; b < 4; ++b)
#pragma unroll
          for (int e = 0; e < 4; ++e) xacc[((a * 4 + b) * 4 + e) * 256 + tid] = acc[a][b][e];
    }
    __syncthreads();
    if (!hh) {
#pragma unroll
      for (int a = 0; a < 4; ++a)
#pragma unroll
        for (int b = 0; b < 4; ++b)
#pragma unroll
          for (int e = 0; e < 4; ++e) acc[a][b][e] += xacc[((a * 4 + b) * 4 + e) * 256 + tid];
      float rs[4];
#pragma unroll
      for (int ti = 0; ti < 4; ++ti) {
        const int r = wn * 64 + ti * 16 + lr;
        rs[ti] = rsqrtf((rsl[r] + xss[r]) * (1.f / 1024.f) + EPS_);
      }
      gemm_epilogue<EPI_E1, 4>(ws, acc, rs, rt * 128, nt * 128, wm, wn, lr, lq, false);
    }
  }
  __syncthreads();
}

__device__ __forceinline__ void rem_tile(int pos, int& mt, int& nt) { if (pos < 65) { mt = pos; nt = 40; } else { mt = 64; nt = pos - 65; } }
template <bool RS, int EPI, int TI, int TMAP = 0>
__device__ __forceinline__ void gemm_stream(const WS& ws, const bf16_t* A0, const bf16_t* A1, int lda, int ktsplit, int kstride,
                                            const bf16_t* __restrict__ W, int K, float invK, int ntn, int ntiles, int bid, bool dry) {
  constexpr int BMH = (TI == 5) ? 129 : 128;
  constexpr int ASTG = 16384;
  unsigned char* As = smem;
  unsigned char* Bs = smem_all + 2 * ASTG;
  float* rsl = (float*)(smem + 65536);
  int xbase = 66048;
  asm volatile("" : "+v"(xbase));
  unsigned char* Ax0 = smem + xbase;
  const int tid = opaque_tid(), lane = tid & 63, w = tid >> 6, wm = w >> 1, wn = w & 1, lr = lane & 15, lq = lane >> 4;
  const int tid5 = opaque_tid512(), hh = half_id();
  const int G = gridDim.x;
  const int nk = K >> 6;
  if (bid < ntiles) {
    const int my_tiles = (ntiles - 1 - bid) / G + 1;
    const int last_id = bid + (my_tiles - 1) * G;
    const int S = my_tiles * nk;
    f32x4 acc[4][TI];
#pragma unroll
    for (int a = 0; a < 4; ++a)
#pragma unroll
      for (int b = 0; b < TI; ++b) acc[a][b] = (f32x4){0.f, 0.f, 0.f, 0.f};
    u32x4 ra0[4], rb0[2], ra1[4], rb1[2];
    u32x4 rx0 = (u32x4){0u, 0u, 0u, 0u}, rx1 = (u32x4){0u, 0u, 0u, 0u};
    float ss[5] = {0.f, 0.f, 0.f, 0.f, 0.f};
    int l_id = bid, l_kt = 0, c_id = bid, c_kt = 0, st_kt = 0;
    const int srow = tid >> 3;
    const int soff = srow * 128 + (((tid & 7) ^ (srow & 7)) << 4);

    const int wrow = tid5 >> 3;
    const int woff = wrow * 128 + (((tid5 & 7) ^ (wrow & 7)) << 4);
    auto issue = [&](u32x4 (&ra)[4], u32x4 (&rb)[2], u32x4& rx) {
      const int idc = l_id < last_id ? l_id : last_id;
      int mt, nt; if (TMAP == 1) rem_tile(idc, mt, nt); else tile_of(idc, ntn, mt, nt);
      const bf16_t* A = (l_kt < ktsplit) ? A0 : A1;
      const int kk = (l_kt < ktsplit) ? l_kt : l_kt - ktsplit;
      const int arow = mt * 2 * BMH + hh * BMH + srow;
      const bf16_t* akb = A + kk * kstride + (tid & 7) * 8;
      const bf16_t* wp = W + (size_t)(nt * 128 + wrow) * K + l_kt * 64 + (tid5 & 7) * 8;
#pragma unroll
      for (int i = 0; i < 4; ++i) {
        int r = arow + 32 * i; r = r < M_ ? r : M_ - 1;
        ra[i] = *(const u32x4*)(akb + (size_t)r * lda);
      }
#pragma unroll
      for (int i = 0; i < 2; ++i) rb[i] = *(const u32x4*)(wp + (size_t)i * 64 * K);
      if (TI == 5) { if (srow == 0) rx = *(const u32x4*)(akb + (size_t)(arow + 128) * lda); }
      if (++l_kt == nk) { l_kt = 0; l_id += G; }
    };
    auto store = [&](const u32x4 (&ra)[4], const u32x4 (&rb)[2], const u32x4& rx, int buf) {
#pragma unroll
      for (int i = 0; i < 4; ++i) {
        if (RS) ss[i] += sumsq8(__builtin_bit_cast(bf16x8, ra[i]));
        *(u32x4*)(As + buf * ASTG + i * 4096 + soff) = ra[i];
      }
#pragma unroll
      for (int i = 0; i < 2; ++i) *(u32x4*)(Bs + buf * 16384 + i * 8192 + woff) = rb[i];
      if (TI == 5) {
        if (RS) ss[4] += sumsq8(__builtin_bit_cast(bf16x8, rx));
        if (srow == 0) *(u32x4*)(Ax0 + buf * 128 + ((tid & 7) << 4)) = rx;
      }
      if (RS) {
        if (++st_kt == nk) {
          st_kt = 0;
#pragma unroll
          for (int i = 0; i < TI; ++i) {
            float t = ss[i];
            t += __shfl_xor(t, 1); t += __shfl_xor(t, 2); t += __shfl_xor(t, 4);
            if ((tid & 7) == 0 && i < 4) rsl[srow + 32 * i] = rsqrtf(t * invK + EPS_);
            ss[i] = 0.f;
          }
        }
      }
    };
    auto compute = [&](int buf) {
      const unsigned char* Ab = As + buf * ASTG + (wn * 64 + lr) * 128;
      const unsigned char* Ax = Ax0 + buf * 128;
      const unsigned char* Bb = Bs + buf * 16384 + (wm * 64 + lr) * 128;
#pragma unroll
      for (int ks = 0; ks < 2; ++ks) {
        if (TI == 5 && ks == 1) __builtin_amdgcn_sched_barrier(0);
        const int sw = ((ks * 4 + lq) ^ (lr & 7)) << 4;
        bf16x8 wf[4], xf[TI];
#pragma unroll
        for (int i = 0; i < 4; ++i) {
          wf[i] = *(const bf16x8*)(Bb + i * 2048 + sw);
          xf[i] = *(const bf16x8*)(Ab + i * 2048 + sw);
        }
        if (TI == 5) xf[TI - 1] = *(const bf16x8*)(Ax + ((ks * 4 + lq) << 4));
#pragma unroll
        for (int ni = 0; ni < 4; ++ni)
#pragma unroll
          for (int ti = 0; ti < 4; ++ti) acc[ni][ti] = MFMA16(wf[ni], xf[ti], acc[ni][ti]);
        if (TI == 5) {
          if (wn == 0) { acc[0][TI - 1] = MFMA16(wf[0], xf[TI - 1], acc[0][TI - 1]); acc[1][TI - 1] = MFMA16(wf[1], xf[TI - 1], acc[1][TI - 1]); }
          else { acc[2][TI - 1] = MFMA16(wf[2], xf[TI - 1], acc[2][TI - 1]); acc[3][TI - 1] = MFMA16(wf[3], xf[TI - 1], acc[3][TI - 1]); }
        }
      }
    };
    auto tile_end = [&]() {
      float rs[TI];
#pragma unroll
      for (int ti = 0; ti < TI; ++ti) rs[ti] = 1.f;
      if (RS) {
#pragma unroll
        for (int ti = 0; ti < TI; ++ti) rs[ti] = rsl[(ti < 4 ? wn * 64 + ti * 16 : 0) + lr];
      }
      int mt, nt; if (TMAP == 1) rem_tile(c_id, mt, nt); else tile_of(c_id, ntn, mt, nt);
      const int tokb = mt * 2 * BMH + hh * BMH;
      if (tokb < M_) gemm_epilogue<EPI, TI>(ws, acc, rs, tokb, nt * 128, wm, wn, lr, lq, dry);
#pragma unroll
      for (int a = 0; a < 4; ++a)
#pragma unroll
        for (int b = 0; b < TI; ++b) acc[a][b] = (f32x4){0.f, 0.f, 0.f, 0.f};
      c_id += G;
    };

    issue(ra0, rb0, rx0);
    issue(ra1, rb1, rx1);
    store(ra0, rb0, rx0, 0);
    __syncthreads();
#pragma unroll 1
    for (int s = 0; s < S; s += 2) {
      issue(ra0, rb0, rx0);
      compute(0);
      store(ra1, rb1, rx1, 1);
      __syncthreads();
      issue(ra1, rb1, rx1);
      compute(1);
      c_kt += 2;
      if (c_kt == nk) { c_kt = 0; tile_end(); }
      store(ra0, rb0, rx0, 0);
      __syncthreads();
    }
  }
  __syncthreads();
}

__device__ __forceinline__ void gla_decay_unit(const Params& p, const WS& ws, int j, int u) {
  const int c = u % 33; const int bh = u / 33; const int hd = bh & 3, b = bh >> 2;
  bf16_t* Qs = (bf16_t*)smem;
  bf16_t* Ks = Qs + 64 * 136;
  float* ADs = (float*)(smem + 2 * 64 * 136 * 2);
  float* HT = ADs + 64 * 16;
  const int tid = opaque_tid();
  const int tbase = 64 * c - 48;
#pragma unroll
  for (int i = 0; i < 4; ++i) {
    const int ci = tid + 256 * i; const int row = ci >> 4, ch = ci & 15; const int t = tbase + row;
    u32x4 qv = (u32x4){0, 0, 0, 0}, kv = (u32x4){0, 0, 0, 0};
    if (t >= 0) {
      qv = *(const u32x4*)(ws.Q + (size_t)(b * T_ + t) * 512 + hd * 128 + ch * 8);
      kv = *(const u32x4*)(ws.K + (size_t)(b * T_ + t) * 512 + hd * 128 + ch * 8);
    }
    *(u32x4*)(Qs + row * 136 + ch * 8) = qv;
    *(u32x4*)(Ks + row * 136 + ch * 8) = kv;
    const int t2 = tbase + (ci >> 4);
    ADs[ci] = t2 >= 0 ? bf2f(ws.AD[(size_t)(b * T_ + t2) * 16 + (ci & 15)]) : 0.f;
  }
  const int d = tid & 127, half = tid >> 7;
  float aw[16];
#pragma unroll
  for (int r = 0; r < 16; ++r) aw[r] = p.ab_alpha_w[(size_t)(j * 16 + r) * 512 + hd * 128 + d];
  const float abias = p.ab_alpha_b[j * 512 + hd * 128 + d];
  __syncthreads();
  float cs[32];
  float run = 0.f;
#pragma unroll
  for (int ii = 0; ii < 32; ++ii) {
    const int row = half * 32 + ii;
    float xv = abias;
#pragma unroll
    for (int r4 = 0; r4 < 4; ++r4) {
      const float4 a4 = *(const float4*)(ADs + row * 16 + r4 * 4);
      xv += a4.x * aw[r4 * 4] + a4.y * aw[r4 * 4 + 1] + a4.z * aw[r4 * 4 + 2] + a4.w * aw[r4 * 4 + 3];
    }
    float la = (fminf(xv, 0.f) - __logf(1.f + __expf(-fabsf(xv)))) * 0.0625f;
    if (tbase + row < 0) la = 0.f;
    run += la;
    cs[ii] = run;
  }
  HT[half * 128 + d] = run;
  __syncthreads();
  const float off = half ? HT[d] : 0.f;
  const float blast = HT[d] + HT[128 + d];
#pragma unroll
  for (int ii = 0; ii < 32; ++ii) {
    const int row = half * 32 + ii;
    const float bb = cs[ii] + off;
    const float eb = __expf(bb), ebi = __expf(-bb);
    Qs[row * 136 + d] = f2bf(bf2f(Qs[row * 136 + d]) * eb);
    Ks[row * 136 + d] = f2bf(bf2f(Ks[row * 136 + d]) * ebi);
  }
  if (half == 0) ws.BL[(size_t)((b * 4 + hd) * 33 + c) * 128 + d] = __expf(blast);
  __syncthreads();
#pragma unroll
  for (int i = 0; i < 4; ++i) {
    const int ci = tid + 256 * i; const int row = ci >> 4, ch = ci & 15; const int t = tbase + row;
    if (t >= 0) {
      *(u32x4*)(ws.Q + (size_t)(b * T_ + t) * 512 + hd * 128 + ch * 8) = *(const u32x4*)(Qs + row * 136 + ch * 8);
      *(u32x4*)(ws.K + (size_t)(b * T_ + t) * 512 + hd * 128 + ch * 8) = *(const u32x4*)(Ks + row * 136 + ch * 8);
    }
  }
  __syncthreads();
}

__device__ __forceinline__ void conv_unit(const Params& p, const WS& ws, int j, int u) {
  const int g = u & 7, b = u >> 3;
  const int tid = opaque_tid();
  const int c8 = tid & 15, seg = tid >> 4;
  const int t0 = seg * 129;
  const int cbase = 128 * g + 8 * c8;
  float cw[4][8], cb[8];
#pragma unroll
  for (int e = 0; e < 8; ++e) {
    cb[e] = p.ab_conv_b[j * 1024 + cbase + e];
#pragma unroll
    for (int k = 0; k < 4; ++k) cw[k][e] = p.ab_conv_w[(size_t)(j * 4 + k) * 1024 + cbase + e];
  }
  bf16_t* xp = ws.XA + (size_t)(b * T_) * 1024 + cbase;
  float x0[8], x1[8], x2[8];
  {
    u32x4 h[3];
#pragma unroll
    for (int m = 0; m < 3; ++m) {
      const int t = t0 - 3 + m;
      h[m] = (u32x4){0, 0, 0, 0};
      if (t >= 0) h[m] = *(const u32x4*)(xp + (size_t)t * 1024);
    }
    const u32x4 a = h[0], bq = h[1], c = h[2];
    x0[0] = bflo(a.x); x0[1] = bfhi(a.x); x0[2] = bflo(a.y); x0[3] = bfhi(a.y); x0[4] = bflo(a.z); x0[5] = bfhi(a.z); x0[6] = bflo(a.w); x0[7] = bfhi(a.w);
    x1[0] = bflo(bq.x); x1[1] = bfhi(bq.x); x1[2] = bflo(bq.y); x1[3] = bfhi(bq.y); x1[4] = bflo(bq.z); x1[5] = bfhi(bq.z); x1[6] = bflo(bq.w); x1[7] = bfhi(bq.w);
    x2[0] = bflo(c.x); x2[1] = bfhi(c.x); x2[2] = bflo(c.y); x2[3] = bfhi(c.y); x2[4] = bflo(c.z); x2[5] = bfhi(c.z); x2[6] = bflo(c.w); x2[7] = bfhi(c.w);
  }
  __syncthreads();
#pragma unroll 1
  for (int tt = 0; tt < 129; tt += 3) {
    u32x4 r[3];
#pragma unroll
    for (int m = 0; m < 3; ++m) r[m] = *(const u32x4*)(xp + (size_t)(t0 + tt + m) * 1024);
#pragma unroll
    for (int m = 0; m < 3; ++m) {
      float x3[8];
      x3[0] = bflo(r[m].x); x3[1] = bfhi(r[m].x); x3[2] = bflo(r[m].y); x3[3] = bfhi(r[m].y);
      x3[4] = bflo(r[m].z); x3[5] = bfhi(r[m].z); x3[6] = bflo(r[m].w); x3[7] = bfhi(r[m].w);
      float y[8];
#pragma unroll
      for (int e = 0; e < 8; ++e) y[e] = cb[e] + cw[0][e] * x0[e] + cw[1][e] * x1[e] + cw[2][e] * x2[e] + cw[3][e] * x3[e];
      u32x4 pk; pk.x = cvt_pk_bf16(y[0], y[1]); pk.y = cvt_pk_bf16(y[2], y[3]); pk.z = cvt_pk_bf16(y[4], y[5]); pk.w = cvt_pk_bf16(y[6], y[7]);
      *(u32x4*)(xp + (size_t)(t0 + tt + m) * 1024) = pk;
#pragma unroll
      for (int e = 0; e < 8; ++e) { x0[e] = x1[e]; x1[e] = x2[e]; x2[e] = x3[e]; }
    }
  }
  __syncthreads();
}

__device__ __forceinline__ void gla_unit(const Params& p, const WS& ws, int u, bool dry = false) {
  const int sl = u & 7; const int bh = u >> 3; const int hd = bh & 3, b = bh >> 2;
  bf16_t* QDs = (bf16_t*)smem;
  bf16_t* KIs = QDs + 64 * 136;
  bf16_t* KIT = KIs + 64 * 136;
  bf16_t* VTs = KIT + 128 * 72;
  bf16_t* STs = VTs + 32 * 72;
  bf16_t* Ps = STs + 32 * 136;
  const int tid = opaque_tid(), lane = tid & 63, w = tid >> 6, lr = lane & 15, lq = lane >> 4;
  for (int i = tid; i < 32 * 136 / 2; i += 256) ((unsigned*)STs)[i] = 0u;
  f32x4 sacc[2][2];
#pragma unroll
  for (int a = 0; a < 2; ++a)
#pragma unroll
    for (int bb = 0; bb < 2; ++bb) sacc[a][bb] = (f32x4){0.f, 0.f, 0.f, 0.f};
  u32x4 qrA[4], krA[4], vrA, qrB[4], krB[4], vrB;
  float eblA[2], eblB[2];
  const float* BLp = ws.BL + (size_t)((b * 4 + hd) * 33) * 128;
  auto prefetch = [&](int c, u32x4 (&qr)[4], u32x4 (&kr)[4], u32x4& vr, float (&ebl)[2]) {
    const int tbase = 64 * c - 48;
#pragma unroll
    for (int i = 0; i < 4; ++i) {
      const int ci = tid + 256 * i; const int row = ci >> 4, ch = ci & 15; const int t = tbase + row;
      qr[i] = (u32x4){0, 0, 0, 0}; kr[i] = (u32x4){0, 0, 0, 0};
      if (t >= 0) {
        qr[i] = *(const u32x4*)(ws.Q + (size_t)(b * T_ + t) * 512 + hd * 128 + ch * 8);
        kr[i] = *(const u32x4*)(ws.K + (size_t)(b * T_ + t) * 512 + hd * 128 + ch * 8);
      }
    }
    {
      const int row = tid >> 2, ch = tid & 3; const int t = tbase + row;
      vr = (u32x4){0, 0, 0, 0};
      if (t >= 0) vr = *(const u32x4*)(ws.V + (size_t)(b * T_ + t) * 1024 + hd * 256 + sl * 32 + ch * 8);
    }
    ebl[0] = BLp[c * 128 + 16 * (2 * w) + lr];
    ebl[1] = BLp[c * 128 + 16 * (2 * w + 1) + lr];
  };
  prefetch(0, qrA, krA, vrA, eblA);
  prefetch(1, qrB, krB, vrB, eblB);
  __syncthreads();
  u32x2 opend[2]; float sqpend = 0.f; int tpend = -1;
  opend[0] = (u32x2){0u, 0u}; opend[1] = (u32x2){0u, 0u};
  auto flush_o = [&]() {
    if (tpend >= 0 && !dry) {
      const size_t row = (size_t)(b * T_ + tpend);
#pragma unroll
      for (int mt = 0; mt < 2; ++mt) *(u32x2*)(ws.V + row * 1024 + hd * 256 + sl * 32 + 16 * mt + 4 * lq) = opend[mt];
      if (lq == 0) ws.SSQ[row * 32 + hd * 8 + sl] = sqpend;
    }
  };
  auto body = [&](int c, u32x4 (&qr)[4], u32x4 (&kr)[4], u32x4& vr, float (&ebl)[2]) {
#pragma unroll
    for (int i = 0; i < 4; ++i) {
      const int ci = tid + 256 * i; const int row = ci >> 4, ch = ci & 15;
      *(u32x4*)(QDs + row * 136 + ch * 8) = qr[i];
      *(u32x4*)(KIs + row * 136 + ch * 8) = kr[i];
      const unsigned kk[4] = {kr[i].x, kr[i].y, kr[i].z, kr[i].w};
#pragma unroll
      for (int e = 0; e < 4; ++e) {
        KIT[(ch * 8 + 2 * e) * 72 + (row ^ ((ch & 7) << 3))] = (bf16_t)(kk[e] & 0xffffu);
        KIT[(ch * 8 + 2 * e + 1) * 72 + (row ^ ((ch & 7) << 3))] = (bf16_t)(kk[e] >> 16);
      }
    }
    {
      const int row = tid >> 2, ch = tid & 3;
      const unsigned vv[4] = {vr.x, vr.y, vr.z, vr.w};
#pragma unroll
      for (int e = 0; e < 4; ++e) {
        VTs[(ch * 8 + 2 * e) * 72 + (row ^ (ch << 3))] = (bf16_t)(vv[e] & 0xffffu);
        VTs[(ch * 8 + 2 * e + 1) * 72 + (row ^ (ch << 3))] = (bf16_t)(vv[e] >> 16);
      }
    }
    const float eb0 = ebl[0], eb1 = ebl[1];
    __syncthreads();
    flush_o();
    if (c + 2 < 33) prefetch(c + 2, qr, kr, vr, ebl);
    bf16x8 xq[4];
#pragma unroll
    for (int ks = 0; ks < 4; ++ks) xq[ks] = *(const bf16x8*)(QDs + (16 * w + lr) * 136 + 32 * ks + 8 * lq);
    const int irow = 16 * w + lr;
#pragma unroll
    for (int mt = 0; mt < 4; ++mt) {
      u32x2 pk = (u32x2){0u, 0u};
      if (mt <= w) {
        f32x4 a = (f32x4){0.f, 0.f, 0.f, 0.f};
#pragma unroll
        for (int ks = 0; ks < 4; ++ks) {
          const bf16x8 kf = *(const bf16x8*)(KIs + (16 * mt + lr) * 136 + 32 * ks + 8 * lq);
          a = MFMA16(kf, xq[ks], a);
        }
        const int ip = 16 * mt + 4 * lq;
        const float v0 = (ip + 0 <= irow) ? a[0] : 0.f, v1 = (ip + 1 <= irow) ? a[1] : 0.f;
        const float v2 = (ip + 2 <= irow) ? a[2] : 0.f, v3 = (ip + 3 <= irow) ? a[3] : 0.f;
        pk.x = cvt_pk_bf16(v0, v1); pk.y = cvt_pk_bf16(v2, v3);
      }
      *(u32x2*)(Ps + irow * 72 + 16 * mt + 4 * lq) = pk;
    }
    __syncthreads();
    f32x4 oacc[2];
    oacc[0] = (f32x4){0.f, 0.f, 0.f, 0.f}; oacc[1] = (f32x4){0.f, 0.f, 0.f, 0.f};
#pragma unroll
    for (int ks = 0; ks < 2; ++ks) {
      if (2 * ks <= w) {
        const bf16x8 pb = *(const bf16x8*)(Ps + irow * 72 + 32 * ks + 8 * lq);
#pragma unroll
        for (int mt = 0; mt < 2; ++mt) {
          const bf16x8 vf = *(const bf16x8*)(VTs + (16 * mt + lr) * 72 + (((4 * ks + lq) ^ (((16 * mt + lr) >> 3) & 3)) << 3));
          oacc[mt] = MFMA16(vf, pb, oacc[mt]);
        }
      }
    }
#pragma unroll
    for (int ks = 0; ks < 4; ++ks)
#pragma unroll
      for (int mt = 0; mt < 2; ++mt) {
        const bf16x8 sf = *(const bf16x8*)(STs + (16 * mt + lr) * 136 + 32 * ks + 8 * lq);
        oacc[mt] = MFMA16(sf, xq[ks], oacc[mt]);
      }
    {
      const int t = 64 * c - 48 + irow;
      float sq = 0.f;
#pragma unroll
      for (int mt = 0; mt < 2; ++mt) sq += oacc[mt][0] * oacc[mt][0] + oacc[mt][1] * oacc[mt][1] + oacc[mt][2] * oacc[mt][2] + oacc[mt][3] * oacc[mt][3];
      sq += __shfl_xor(sq, 16); sq += __shfl_xor(sq, 32);
      tpend = t;
      sqpend = sq;
#pragma unroll
      for (int mt = 0; mt < 2; ++mt) { opend[mt].x = cvt_pk_bf16(oacc[mt][0], oacc[mt][1]); opend[mt].y = cvt_pk_bf16(oacc[mt][2], oacc[mt][3]); }
    }
    __syncthreads();
#pragma unroll
    for (int ntl = 0; ntl < 2; ++ntl) {
#pragma unroll
      for (int ks = 0; ks < 2; ++ks) {
        const bf16x8 kf = *(const bf16x8*)(KIT + (16 * (2 * w + ntl) + lr) * 72 + (((4 * ks + lq) ^ (((16 * (2 * w + ntl) + lr) >> 3) & 7)) << 3));
#pragma unroll
        for (int mt = 0; mt < 2; ++mt) {
          const bf16x8 vf = *(const bf16x8*)(VTs + (16 * mt + lr) * 72 + (((4 * ks + lq) ^ (((16 * mt + lr) >> 3) & 3)) << 3));
          sacc[mt][ntl] = MFMA16(vf, kf, sacc[mt][ntl]);
        }
      }
      const float e = ntl ? eb1 : eb0;
#pragma unroll
      for (int mt = 0; mt < 2; ++mt) {
        sacc[mt][ntl] = scale4(sacc[mt][ntl], e);
#pragma unroll
        for (int jj = 0; jj < 4; ++jj) STs[(16 * mt + 4 * lq + jj) * 136 + 16 * (2 * w + ntl) + lr] = f2bf(sacc[mt][ntl][jj]);
      }
    }
    __syncthreads();
  };
#pragma unroll 1
  for (int c = 0; c < 33; c += 2) {
    body(c, qrA, krA, vrA, eblA);
    if (c + 1 < 33) body(c + 1, qrB, krB, vrB, eblB);
  }
  flush_o();
  __syncthreads();
}

__device__ __forceinline__ void rglru_unit(const Params& p, const WS& ws, int j, int u, bool dry = false) {
  const int jq = u & 3, g = (u >> 2) & 7, b = u >> 5;
  bf16_t* XC = (bf16_t*)smem;
  bf16_t* WG = XC + 64 * 136;
  float* AUa = (float*)(smem + 34816);
  float* AUu = AUa + 64 * 33;
  float* SEGA = AUu + 64 * 33;
  float* SEGH = SEGA + 256;
  float* CARRY = SEGH + 256;
  const int tid = opaque_tid(), lane = tid & 63, w = tid >> 6, lr = lane & 15, lq = lane >> 4;
#pragma unroll 4
  for (int i = 0; i < 32; ++i) {
    const int e = tid + 256 * i;
    const int gate = e >> 12, k = (e >> 5) & 127, n = e & 31;
    const float* gw = gate ? p.ab_gate_x_w : p.ab_gate_a_w;
    WG[(gate * 32 + n) * 136 + k] = f2bf(gw[((size_t)(j * 8 + g) * 128 + k) * 128 + 32 * jq + n]);
  }
  if (tid < 32) CARRY[tid] = 0.f;
  float ba[2][4], bx[2][4], sp[2][4];
#pragma unroll
  for (int mt = 0; mt < 2; ++mt)
#pragma unroll
    for (int jj = 0; jj < 4; ++jj) {
      const int ch = j * 1024 + 128 * g + 32 * jq + 16 * mt + 4 * lq + jj;
      ba[mt][jj] = p.ab_gate_a_b[ch]; bx[mt][jj] = p.ab_gate_x_b[ch];
      sp[mt][jj] = 8.f * log1pf(__expf(-p.ab_lam[ch]));
    }
  const int sc = tid & 31, ssg = tid >> 5;
  u32x4 xinA[4], xinB[4];
  bf16_t gavA[8], gavB[8];
  auto prefetch = [&](int tile, u32x4 (&xin)[4], bf16_t (&gav)[8]) {
    const int t0 = 64 * tile;
#pragma unroll
    for (int i = 0; i < 4; ++i) {
      const int ci = tid + 256 * i; const int row = ci >> 4, ch = ci & 15; const int t = t0 + row;
      xin[i] = (u32x4){0, 0, 0, 0};
      if (t < T_) xin[i] = *(const u32x4*)(ws.XA + (size_t)(b * T_ + t) * 1024 + 128 * g + 8 * ch);
    }
#pragma unroll
    for (int i = 0; i < 8; ++i) {
      const int t = t0 + 8 * ssg + i;
      gav[i] = 0;
      if (t < T_) gav[i] = ws.GA[(size_t)(b * T_ + t) * 1024 + 128 * g + 32 * jq + sc];
    }
  };
  prefetch(0, xinA, gavA);
  prefetch(1, xinB, gavB);
  __syncthreads();
  bf16_t ypend[8];
  int ypend_t0 = -1;
  auto flush_y = [&]() {
    if (ypend_t0 >= 0) {
#pragma unroll
      for (int i = 0; i < 8; ++i) {
        const int t = ypend_t0 + 8 * ssg + i;
        if (t < T_ && !dry) ws.GA[(size_t)(b * T_ + t) * 1024 + 128 * g + 32 * jq + sc] = ypend[i];
      }
    }
  };
  auto body = [&](int tile, u32x4 (&xin)[4], bf16_t (&gav)[8]) {
    const int t0 = 64 * tile;
#pragma unroll
    for (int i = 0; i < 4; ++i) {
      const int ci = tid + 256 * i; const int row = ci >> 4, ch = ci & 15;
      *(u32x4*)(XC + row * 136 + 8 * ch) = xin[i];
    }
    float gcur[8];
#pragma unroll
    for (int i = 0; i < 8; ++i) gcur[i] = bf2f(gav[i]);
    __syncthreads();
    flush_y();
    if (tile + 2 < 33) prefetch(tile + 2, xin, gav);
    {
      f32x4 ga_[2][2];
#pragma unroll
      for (int a = 0; a < 2; ++a)
#pragma unroll
        for (int bb = 0; bb < 2; ++bb) ga_[a][bb] = (f32x4){0.f, 0.f, 0.f, 0.f};
#pragma unroll
      for (int ks = 0; ks < 4; ++ks) {
        const bf16x8 xf = *(const bf16x8*)(XC + (16 * w + lr) * 136 + 32 * ks + 8 * lq);
#pragma unroll
        for (int gate = 0; gate < 2; ++gate)
#pragma unroll
          for (int mt = 0; mt < 2; ++mt) {
            const bf16x8 wf = *(const bf16x8*)(WG + (gate * 32 + 16 * mt + lr) * 136 + 32 * ks + 8 * lq);
            ga_[gate][mt] = MFMA16(wf, xf, ga_[gate][mt]);
          }
      }
      const int tok = 16 * w + lr;
#pragma unroll
      for (int mt = 0; mt < 2; ++mt)
#pragma unroll
        for (int jj = 0; jj < 4; ++jj) {
          const int n = 16 * mt + 4 * lq + jj;
          const float xcv = bf2f(XC[tok * 136 + 32 * jq + n]);
          const float r = sigmoidf_(ga_[0][mt][jj] + ba[mt][jj]);
          const float ig = sigmoidf_(ga_[1][mt][jj] + bx[mt][jj]);
          const float la = -r * sp[mt][jj];
          const float a = __expf(la);
          const float x2 = 2.f * la;
          const float om = x2 > -0.02f ? -x2 * (1.f + 0.5f * x2 * (1.f + x2 * (1.f / 3.f))) : 1.f - a * a;
          const float mult = __builtin_amdgcn_sqrtf(fmaxf(om, 0.f));
          AUa[tok * 33 + n] = a;
          AUu[tok * 33 + n] = mult * ig * xcv;
        }
    }
    __syncthreads();
    {
      float A = 1.f, Hh = 0.f;
#pragma unroll
      for (int i = 0; i < 8; ++i) {
        const float a = AUa[(8 * ssg + i) * 33 + sc], uu = AUu[(8 * ssg + i) * 33 + sc];
        Hh = a * Hh + uu; A *= a;
      }
      SEGA[ssg * 32 + sc] = A; SEGH[ssg * 32 + sc] = Hh;
    }
    __syncthreads();
    float hin = CARRY[sc];
#pragma unroll
    for (int s2 = 0; s2 < 7; ++s2)
      if (s2 < ssg) hin = SEGA[s2 * 32 + sc] * hin + SEGH[s2 * 32 + sc];
    __syncthreads();
    {
      float h = hin;
#pragma unroll
      for (int i = 0; i < 8; ++i) {
        const float a = AUa[(8 * ssg + i) * 33 + sc], uu = AUu[(8 * ssg + i) * 33 + sc];
        h = a * h + uu;
        const int t = t0 + 8 * ssg + i;
        ypend[i] = f2bf(h * siluf_(gcur[i]));
      }
      if (ssg == 7) CARRY[sc] = h;
      ypend_t0 = t0;
    }
  };
#pragma unroll 1
  for (int tile = 0; tile < 33; tile += 2) {
    body(tile, xinA, gavA);
    if (tile + 1 < 33) body(tile + 1, xinB, gavB);
  }
  flush_y();
  __syncthreads();
}

__device__ __forceinline__ void phase_gla_norm(const Params& p, const WS& ws, int j) {
  const size_t gtid = (size_t)opaque_bid() * 256 + opaque_tid(), gsz = (size_t)NVB * 256;
  const float* gn = p.ab_gla_norm + j * 256;
#pragma unroll 4
  for (size_t idx = gtid; idx < (size_t)M_ * 128; idx += gsz) {
    const size_t row = idx >> 7; const int c8 = (int)(idx & 127); const int hd = c8 >> 5; const int dv = (c8 & 31) * 8;
    const float4 s0 = *(const float4*)(ws.SSQ + row * 32 + hd * 8), s1 = *(const float4*)(ws.SSQ + row * 32 + hd * 8 + 4);
    const float ssum = (s0.x + s0.y + s0.z + s0.w) + (s1.x + s1.y + s1.z + s1.w);
    const float rstd = rsqrtf(ssum * (1.f / 256.f) + EPS_);
    const u32x4 ov = *(const u32x4*)(ws.V + row * 1024 + c8 * 8);
    const u32x4 gv = *(const u32x4*)(ws.GB + row * 1024 + c8 * 8);
    const float4 g0 = *(const float4*)(gn + dv), g1 = *(const float4*)(gn + dv + 4);
    float o[8] = {bflo(ov.x), bfhi(ov.x), bflo(ov.y), bfhi(ov.y), bflo(ov.z), bfhi(ov.z), bflo(ov.w), bfhi(ov.w)};
    const float gg[8] = {bflo(gv.x), bfhi(gv.x), bflo(gv.y), bfhi(gv.y), bflo(gv.z), bfhi(gv.z), bflo(gv.w), bfhi(gv.w)};
    const float nn[8] = {g0.x, g0.y, g0.z, g0.w, g1.x, g1.y, g1.z, g1.w};
#pragma unroll
    for (int e = 0; e < 8; ++e) o[e] = o[e] * rstd * nn[e] * siluf_(gg[e]);
    u32x4 pk; pk.x = cvt_pk_bf16(o[0], o[1]); pk.y = cvt_pk_bf16(o[2], o[3]); pk.z = cvt_pk_bf16(o[4], o[5]); pk.w = cvt_pk_bf16(o[6], o[7]);
    *(u32x4*)(ws.V + row * 1024 + c8 * 8) = pk;
  }
}

__device__ __forceinline__ void attn_unit(const WS& ws, int u, bool dry = false) {
  const int qb = 16 - (u >> 7); const int bh = u & 127; const int hd = bh & 15, b = bh >> 4;
  bf16_t* Kt = (bf16_t*)smem;
  bf16_t* Vl = Kt + 2 * 64 * 104;
  const int tid = opaque_tid(), lane = tid & 63, w = tid >> 6, lr = lane & 15, lq = lane >> 4;
  const int q0 = 128 * qb;
  int nkt = 2 * qb + 2; if (nkt > 33) nkt = 33;
  bf16x8 xq[2][3];
  int qi[2];
#pragma unroll
  for (int nt = 0; nt < 2; ++nt) {
    qi[nt] = q0 + 32 * w + 16 * nt + lr;
    const int qc = qi[nt] < T_ ? qi[nt] : T_ - 1;
#pragma unroll
    for (int ks = 0; ks < 2; ++ks)
      xq[nt][ks] = *(const bf16x8*)(ws.QB + (size_t)(b * T_ + qc) * 1536 + hd * 96 + 32 * ks + 8 * lq);
    {
      const u32x4 raw = *(const u32x4*)(ws.QB + (size_t)(b * T_ + qc) * 1536 + hd * 96 + 64 + 8 * lq);
      u32x4 oth;
      oth.x = __shfl_xor(raw.x, 32); oth.y = __shfl_xor(raw.y, 32); oth.z = __shfl_xor(raw.z, 32); oth.w = __shfl_xor(raw.w, 32);
      const float sgn = lq < 2 ? -1.f : 1.f;
      const float2* rp = ws.ROPE + (size_t)(b * T_ + qc) * 16 + 8 * (lq & 1);
      const unsigned rw[4] = {raw.x, raw.y, raw.z, raw.w}, ow[4] = {oth.x, oth.y, oth.z, oth.w};
      unsigned res[4];
#pragma unroll
      for (int e = 0; e < 4; ++e) {
        const float2 c0 = rp[2 * e], c1 = rp[2 * e + 1];
        const float r0 = bflo(rw[e]) * c0.x + sgn * bflo(ow[e]) * c0.y;
        const float r1 = bfhi(rw[e]) * c1.x + sgn * bfhi(ow[e]) * c1.y;
        res[e] = cvt_pk_bf16(r0, r1);
      }
      xq[nt][2] = as_bf16x8((u32x4){res[0], res[1], res[2], res[3]});
    }
  }
  float mrun[2] = {-INFINITY, -INFINITY}, lsum[2] = {0.f, 0.f};
  f32x4 oacc[4][2];
#pragma unroll
  for (int a = 0; a < 4; ++a)
#pragma unroll
    for (int bb = 0; bb < 2; ++bb) oacc[a][bb] = (f32x4){0.f, 0.f, 0.f, 0.f};
  u32x4 kregA[3], vregA[2], kregB[3], vregB[2];
  const bf16_t* vbase = ws.VT + ((size_t)(b * 16 + hd) * 64) * TP_;
  auto loadg = [&](int kt, u32x4 (&kreg)[3], u32x4 (&vreg)[2]) {
#pragma unroll
    for (int i = 0; i < 3; ++i) {
      const int ci = tid + 256 * i; const int key = ci / 12, ch = ci - key * 12;
      int gk = 64 * kt + key; if (gk > T_ - 1) gk = T_ - 1;
      const bf16_t* src = ch < 8 ? ws.KN + (size_t)(b * T_ + gk) * 1024 + hd * 64 + ch * 8
                                 : ws.KR + (size_t)(b * T_ + gk) * 32 + (ch - 8) * 8;
      kreg[i] = *(const u32x4*)src;
    }
#pragma unroll
    for (int i = 0; i < 2; ++i) {
      const int ci = tid + 256 * i; const int dv = ci >> 3, ch = ci & 7;
      vreg[i] = *(const u32x4*)(vbase + (size_t)dv * TP_ + 64 * kt + ch * 8);
      if (64 * kt + ch * 8 >= T_) vreg[i] = (u32x4){0u, 0u, 0u, 0u};
    }
  };
  auto stores = [&](int buf, const u32x4 (&kreg)[3], const u32x4 (&vreg)[2]) {
#pragma unroll
    for (int i = 0; i < 3; ++i) {
      const int ci = tid + 256 * i; const int key = ci / 12, ch = ci - key * 12;
      *(u32x4*)(Kt + buf * 64 * 104 + key * 104 + ch * 8) = kreg[i];
    }
#pragma unroll
    for (int i = 0; i < 2; ++i) {
      const int ci = tid + 256 * i; const int dv = ci >> 3, ch = ci & 7;
      *(u32x4*)(Vl + buf * 64 * 72 + dv * 72 + ch * 8) = vreg[i];
    }
  };
  const int nkt2 = (nkt + 1) & ~1;
  loadg(0, kregA, vregA);
  loadg(1, kregB, vregB);
  stores(0, kregA, vregA);
  __syncthreads();
  auto body = [&](int kt, int buf, u32x4 (&kreg)[3], u32x4 (&vreg)[2], const u32x4 (&kregn)[3], const u32x4 (&vregn)[2]) {
    { const int kn = kt + 2 < nkt2 ? kt + 2 : nkt2 - 1; loadg(kn, kreg, vreg); }
    const bf16_t* Kb = Kt + buf * 64 * 104;
    const bf16_t* Vb = Vl + buf * 64 * 72;
    f32x4 s[4][2];
#pragma unroll
    for (int mt = 0; mt < 4; ++mt) {
      s[mt][0] = (f32x4){0.f, 0.f, 0.f, 0.f}; s[mt][1] = (f32x4){0.f, 0.f, 0.f, 0.f};
#pragma unroll
      for (int ks = 0; ks < 3; ++ks) {
        const bf16x8 kf = *(const bf16x8*)(Kb + (16 * mt + lr) * 104 + 32 * ks + 8 * lq);
        s[mt][0] = MFMA16(kf, xq[0][ks], s[mt][0]);
        s[mt][1] = MFMA16(kf, xq[1][ks], s[mt][1]);
      }
    }
    if (kt >= 2 * qb) {
#pragma unroll
      for (int mt = 0; mt < 4; ++mt)
#pragma unroll
        for (int nt = 0; nt < 2; ++nt)
#pragma unroll
          for (int jj = 0; jj < 4; ++jj) {
            const int key = 64 * kt + 16 * mt + 4 * lq + jj;
            if (key > qi[nt]) s[mt][nt][jj] = -INFINITY;
          }
    }
    bf16x8 pf[2][2];
#pragma unroll
    for (int nt = 0; nt < 2; ++nt) {
      float mx = -INFINITY;
#pragma unroll
      for (int mt = 0; mt < 4; ++mt) mx = fmaxf(mx, fmaxf(fmaxf(s[mt][nt][0], s[mt][nt][1]), fmaxf(s[mt][nt][2], s[mt][nt][3])));
      mx = fmaxf(mx, __shfl_xor(mx, 16)); mx = fmaxf(mx, __shfl_xor(mx, 32));
      if (__builtin_amdgcn_ballot_w64(mx > mrun[nt]) != 0ull) {
        const float mnew = fmaxf(mrun[nt], mx);
        const float alpha = __builtin_amdgcn_exp2f(mrun[nt] - mnew);
        mrun[nt] = mnew;
        lsum[nt] *= alpha;
#pragma unroll
        for (int mt = 0; mt < 4; ++mt) oacc[mt][nt] = scale4(oacc[mt][nt], alpha);
      }
      const float mnew = mrun[nt];
      float ps = 0.f;
#pragma unroll
      for (int mt = 0; mt < 4; ++mt)
#pragma unroll
        for (int jj = 0; jj < 4; ++jj) { const float pv = __builtin_amdgcn_exp2f(s[mt][nt][jj] - mnew); s[mt][nt][jj] = pv; ps += pv; }
      lsum[nt] += ps;
#pragma unroll
      for (int ks = 0; ks < 2; ++ks) {
        u32x4 pk;
        pk.x = cvt_pk_bf16(s[2 * ks][nt][0], s[2 * ks][nt][1]); pk.y = cvt_pk_bf16(s[2 * ks][nt][2], s[2 * ks][nt][3]);
        pk.z = cvt_pk_bf16(s[2 * ks + 1][nt][0], s[2 * ks + 1][nt][1]); pk.w = cvt_pk_bf16(s[2 * ks + 1][nt][2], s[2 * ks + 1][nt][3]);
        pf[nt][ks] = as_bf16x8(pk);
      }
    }
#pragma unroll
    for (int mt = 0; mt < 4; ++mt)
#pragma unroll
      for (int ks = 0; ks < 2; ++ks) {
        const u32x2 lo = *(const u32x2*)(Vb + (16 * mt + lr) * 72 + 32 * ks + 4 * lq);
        const u32x2 hi = *(const u32x2*)(Vb + (16 * mt + lr) * 72 + 32 * ks + 16 + 4 * lq);
        const bf16x8 vf = as_bf16x8((u32x4){lo.x, lo.y, hi.x, hi.y});
        oacc[mt][0] = MFMA16(vf, pf[0][ks], oacc[mt][0]);
        oacc[mt][1] = MFMA16(vf, pf[1][ks], oacc[mt][1]);
      }
    stores(buf ^ 1, kregn, vregn);
    __syncthreads();
  };
#pragma unroll 1
  for (int kt = 0; kt < nkt2; kt += 2) {
    body(kt, 0, kregA, vregA, kregB, vregB);
    body(kt + 1, 1, kregB, vregB, kregA, vregA);
  }
#pragma unroll
  for (int nt = 0; nt < 2; ++nt) {
    float l = lsum[nt];
    l += __shfl_xor(l, 16); l += __shfl_xor(l, 32);
    const float inv = 1.f / l;
    if (qi[nt] < T_) {
      const size_t row = (size_t)(b * T_ + qi[nt]);
#pragma unroll
      for (int mt = 0; mt < 4; ++mt) {
        const u32x2 gv = *(const u32x2*)(ws.GATE + row * 1024 + hd * 64 + 16 * mt + 4 * lq);
        const float o0 = oacc[mt][nt][0] * inv * siluf_(bflo(gv.x)), o1 = oacc[mt][nt][1] * inv * siluf_(bfhi(gv.x));
        const float o2 = oacc[mt][nt][2] * inv * siluf_(bflo(gv.y)), o3 = oacc[mt][nt][3] * inv * siluf_(bfhi(gv.y));
        u32x2 pk; pk.x = cvt_pk_bf16(o0, o1); pk.y = cvt_pk_bf16(o2, o3);
        if (!dry) *(u32x2*)(ws.QB + row * 1536 + hd * 96 + 16 * mt + 4 * lq) = pk;
      }
    }
  }
}

__device__ __forceinline__ void phase_final(const Params& p, const WS& ws) {
  const int tidf = opaque_tid();
  const int lane = tidf & 63;
  const int gw = opaque_bid() * 4 + (tidf >> 6), nw = NVB * 4;
#pragma unroll 2
  for (int r = gw; r < 8 * 2048; r += nw) {
    const int b = r >> 11, s = r & 2047;
    const size_t hoff = (size_t)(b * T_ + 16 + s) * 1024;
    float4 v[4];
    float ssum = 0.f;
#pragma unroll
    for (int i = 0; i < 4; ++i) {
      const u32x2 hi = *(const u32x2*)(ws.HHI + hoff + i * 256 + lane * 4), lo = *(const u32x2*)(ws.HLO + hoff + i * 256 + lane * 4);
      v[i] = make_float4(bflo(hi.x) + bflo(lo.x), bfhi(hi.x) + bfhi(lo.x), bflo(hi.y) + bflo(lo.y), bfhi(hi.y) + bfhi(lo.y));
      ssum += v[i].x * v[i].x + v[i].y * v[i].y + v[i].z * v[i].z + v[i].w * v[i].w;
    }
#pragma unroll
    for (int o = 1; o < 64; o <<= 1) ssum += __shfl_xor(ssum, o);
    const float rstd = rsqrtf(ssum * (1.f / 1024.f) + EPS_);
#pragma unroll
    for (int i = 0; i < 4; ++i) {
      const float4 g = *(const float4*)(p.final_norm + i * 256 + lane * 4);
      float4 o; o.x = v[i].x * rstd * g.x; o.y = v[i].y * rstd * g.y; o.z = v[i].z * rstd * g.z; o.w = v[i].w * rstd * g.w;
      *(float4*)(p.out + (size_t)r * 1024 + i * 256 + lane * 4) = o;
    }
  }
}

__global__ void __launch_bounds__(512, 2) fwd_megakernel(Params p) {
  cg::grid_group grid = cg::this_grid();
  if (p.inv_freq[0] < 0.f) grid.sync();
  volatile LAS unsigned* xst = (volatile LAS unsigned*)(smem_all + 2 * SMEM_BYTES);
  if (threadIdx.x == 0) { xst[0] = 0u; xst[1] = 0u; xst[2] = 0u; xst[3] = 0u; }
  __syncthreads();
  const XcdBarrier xb = xcd_barrier_post((unsigned*)(p.ws + BAR_OFF), xst);
  {
    const WS ws = make_ws(p);
    phase_prologue(p, ws);
  }
  xcd_barrier(xb);
#pragma unroll 1
  for (int layer = 0; layer < 4; ++layer) {
    const int j = layer >> 1;
    if ((layer & 1) == 0) {
      {
        const WS ws = make_ws(p);
        const bf16_t* wb = ws.W + (size_t)j * W_PER_J;
#pragma unroll 1
        for (int rep = 0; rep < REP_GEMM; ++rep)
          { gemm_wide<EPI_E1>(ws, ws.HHI, 1024, wb + W_IN_E, 1024, 1.f / 1024.f, 20, 64 * 20, xcd_bid(opaque_rbid()));
            gemm_rem_splitk(ws, ws.HHI, wb + W_IN_E, opaque_rbid()); }
      }
      xcd_barrier(xb);
      {
        const WS ws = make_ws(p);
#pragma unroll 1
        for (int u = opaque_bid(); u < 8 * 4 * 33 + 64; u += NVB) {
          if (u < 448) gla_decay_unit(p, ws, j, u); else if (u < 512) conv_unit(p, ws, j, u - 448); else gla_decay_unit(p, ws, j, u - 64);
        }
      }
      xcd_barrier(xb);
      {
#pragma unroll 1
        for (int rep = 0; rep < REP_E2; ++rep)
#pragma unroll 1
        for (int u = opaque_bid(); u < 512; u += NVB) {
          if (u & 1) { const WS ws = make_ws(p); rglru_unit(p, ws, j, u >> 1, rep < REP_E2 - 1); }
          else { const WS ws = make_ws(p); gla_unit(p, ws, u >> 1, rep < REP_E2 - 1); }
        }
      }
      xcd_barrier(xb);
      {
        const WS ws = make_ws(p);
        phase_gla_norm(p, ws, j);
      }
      xcd_barrier(xb);
      {
        const WS ws = make_ws(p);
        const bf16_t* wb = ws.W + (size_t)j * W_PER_J;
#pragma unroll 1
        for (int rep = 0; rep < REP_GEMM; ++rep)
          gemm_stream<false, EPI_RES, 5>(ws, ws.GA, ws.V, 1024, 16, 64, wb + W_OUT_E, 2048, 0.f, 8, 64 * 8, xcd_bid(opaque_rbid()), rep < REP_GEMM - 1);
      }
      xcd_barrier(xb);
    } else {
      {
        const WS ws = make_ws(p);
        const bf16_t* wb = ws.W + (size_t)j * W_PER_J;
#pragma unroll 1
        for (int rep = 0; rep < REP_GEMM; ++rep)
          gemm_stream<true, EPI_O1, 4>(ws, ws.HHI, nullptr, 1024, 1 << 30, 64, wb + W_IN_O, 1024, 1.f / 1024.f, 15, 65 * 15, xcd_bid(opaque_rbid()), false);
      }
      xcd_barrier(xb);
      {
        const WS ws = make_ws(p);
        const bf16_t* wb = ws.W + (size_t)j * W_PER_J;
#pragma unroll 1
        for (int rep = 0; rep < REP_GEMM; ++rep) {
          gemm_stream<true, EPI_Q, 4>(ws, ws.CQ, nullptr, 512, 1 << 30, 64, wb + W_Q, 512, 1.f / 512.f, 12, 65 * 12, xcd_bid(opaque_rbid()), false);
          gemm_stream<true, EPI_KV, 4>(ws, ws.CKV, nullptr, 256, 1 << 30, 64, wb + W_KV, 256, 1.f / 256.f, 16, 65 * 16, xcd_bid((opaque_rbid() + (int)(gridDim.x >> 1)) % (int)gridDim.x), false);
        }
      }
      xcd_barrier(xb);
      {
        const WS ws = make_ws(p);
#pragma unroll 1
        for (int rep = 0; rep < REP_ATTN; ++rep)
#pragma unroll 1
        for (int r = 0, b0 = opaque_bid(); r * NVB < 17 * 128; ++r) {
          const int u = r * NVB + ((r & 1) ? NVB - 1 - b0 : b0);
          if (u < 17 * 128) attn_unit(ws, u, rep < REP_ATTN - 1);
          __syncthreads();
        }
      }
      xcd_barrier(xb);
      {
        const WS ws = make_ws(p);
        const bf16_t* wb = ws.W + (size_t)j * W_PER_J;
#pragma unroll 1
        for (int rep = 0; rep < REP_GEMM; ++rep)
          gemm_stream<false, EPI_RES, 5>(ws, ws.QB, nullptr, 1536, 1 << 30, 96, wb + W_O, 1024, 0.f, 8, 64 * 8, xcd_bid(opaque_rbid()), rep < REP_GEMM - 1);
      }
      xcd_barrier(xb);
    }
  }
  {
    const WS ws = make_ws(p);
    phase_final(p, ws);
  }
}

extern "C" void kernel_launch(void* const* d_in, const int* in_sizes, int n_in, void* d_out, int out_size, void* d_ws,
                              size_t ws_size, hipStream_t stream) {
  static int grid_blocks = 0;
  if (!grid_blocks) {
    int dev = 0, cus = 0, per_cu = 0;
    hipGetDevice(&dev);
    hipDeviceGetAttribute(&cus, hipDeviceAttributeMultiprocessorCount, dev);
    hipOccupancyMaxActiveBlocksPerMultiprocessor(&per_cu, fwd_megakernel, 512, 0);
    per_cu = 1;
    grid_blocks = cus * per_cu;
  }
  Params p{};
  p.x = (const float*)d_in[0]; p.positions = (const int*)d_in[1]; p.meta = (const float*)d_in[2];
  p.ab_norm = (const float*)d_in[3]; p.ab_w_in = (const float*)d_in[4]; p.ab_conv_w = (const float*)d_in[5];
  p.ab_conv_b = (const float*)d_in[6]; p.ab_gate_a_w = (const float*)d_in[7]; p.ab_gate_a_b = (const float*)d_in[8];
  p.ab_gate_x_w = (const float*)d_in[9]; p.ab_gate_x_b = (const float*)d_in[10]; p.ab_lam = (const float*)d_in[11];
  p.ab_alpha_w = (const float*)d_in[12]; p.ab_alpha_b = (const float*)d_in[13]; p.ab_gla_norm = (const float*)d_in[14];
  p.ab_w_out = (const float*)d_in[15]; p.c_norm = (const float*)d_in[16]; p.c_w_in = (const float*)d_in[17];
  p.c_q_norm = (const float*)d_in[18]; p.c_w_q_up = (const float*)d_in[19]; p.c_kv_norm = (const float*)d_in[20];
  p.c_w_kv_up = (const float*)d_in[21]; p.c_w_out = (const float*)d_in[22]; p.final_norm = (const float*)d_in[23];
  p.out = (float*)d_out;
  p.ws = (unsigned char*)d_ws;
  for (int i = 0; i < 16; ++i) p.inv_freq[i] = (float)pow(10000.0, -(double)i / 16.0);
  hipMemsetAsync((unsigned char*)d_ws + BAR_OFF, 0, XCD_BAR_WORDS * 4, stream);
  void* args[] = {&p};
  hipError_t e = hipLaunchCooperativeKernel((void*)fwd_megakernel, dim3(grid_blocks), dim3(512), args, 0, stream);
  if (e != hipSuccess) fprintf(stderr, "cooperative launch failed: %s (grid %d)\n", hipGetErrorString(e), grid_blocks);
}
```

```cpp
#include <hip/hip_runtime.h>
#include <hip/hip_cooperative_groups.h>
#include <cstdio>
#include <cmath>
namespace cg = cooperative_groups;

typedef unsigned short bf16_t;
typedef short bf16x8 __attribute__((ext_vector_type(8)));
typedef float f32x4 __attribute__((ext_vector_type(4)));
typedef unsigned u32x4 __attribute__((ext_vector_type(4)));
typedef unsigned u32x2 __attribute__((ext_vector_type(2)));

constexpr int T_ = 2064;
constexpr int M_ = 8 * T_;
constexpr int TP_ = 2112;
constexpr float EPS_ = 1e-6f;
constexpr int SMEM_BYTES = 75776;
constexpr float QSCALE_MLA = 0.10206207261596575f * 1.4426950408889634f;

constexpr size_t W_PER_J = 11796480;
constexpr size_t W_IN_E = 0, W_OUT_E = 5373952, W_IN_O = 7471104, W_Q = 9437184, W_KV = 10223616, W_O = 10747904;

struct Params {
  const float* x; const int* positions; const float* meta;
  const float *ab_norm, *ab_w_in, *ab_conv_w, *ab_conv_b, *ab_gate_a_w, *ab_gate_a_b, *ab_gate_x_w, *ab_gate_x_b,
      *ab_lam, *ab_alpha_w, *ab_alpha_b, *ab_gla_norm, *ab_w_out;
  const float *c_norm, *c_w_in, *c_q_norm, *c_w_q_up, *c_kv_norm, *c_w_kv_up, *c_w_out, *final_norm;
  float* out;
  unsigned char* ws;
  float inv_freq[16];
};

struct WS {
  bf16_t *HHI, *HLO; float2* ROPE;
  bf16_t *XA, *GA, *Q, *K, *V, *GB, *AD; float* SSQ; float* BL;
  bf16_t *CQ, *CKV, *GATE, *KR, *QB, *KN, *VT;
  bf16_t* W;
};

__device__ __forceinline__ unsigned char* opaque_ptr(unsigned char* q) {
  unsigned lo = (unsigned)(unsigned long long)q, hi = (unsigned)((unsigned long long)q >> 32);
  asm volatile("" : "+v"(lo), "+v"(hi));
  lo = __builtin_amdgcn_readfirstlane(lo); hi = __builtin_amdgcn_readfirstlane(hi);
  typedef __attribute__((address_space(1))) unsigned char gu8;
  return (unsigned char*)(gu8*)(((unsigned long long)hi << 32) | lo);
}
__device__ __forceinline__ WS make_ws(const Params& p) {
  WS w;
  unsigned char* b = opaque_ptr(p.ws);
  w.HHI = (bf16_t*)b; b += (size_t)M_ * 2048;
  w.HLO = (bf16_t*)b; b += (size_t)M_ * 2048;
  w.ROPE = (float2*)b; b += (size_t)M_ * 128;
  unsigned char* r = b;
  w.XA = (bf16_t*)r; r += (size_t)M_ * 2048;
  w.GA = (bf16_t*)r; r += (size_t)M_ * 2048;
  w.Q = (bf16_t*)r; r += (size_t)M_ * 1024;
  w.K = (bf16_t*)r; r += (size_t)M_ * 1024;
  w.V = (bf16_t*)r; r += (size_t)M_ * 2048;
  w.GB = (bf16_t*)r; r += (size_t)M_ * 2048;
  w.AD = (bf16_t*)r; r += (size_t)M_ * 32;
  w.SSQ = (float*)r; r += (size_t)M_ * 128;
  w.BL = (float*)r; r += (size_t)8 * 4 * 33 * 128 * 4;
  r = b;
  w.CQ = (bf16_t*)r; r += (size_t)M_ * 1024;
  w.CKV = (bf16_t*)r; r += (size_t)M_ * 512;
  w.GATE = (bf16_t*)r; r += (size_t)M_ * 2048;
  w.KR = (bf16_t*)r; r += (size_t)M_ * 64;
  w.QB = (bf16_t*)r; r += (size_t)M_ * 3072;
  w.KN = (bf16_t*)r; r += (size_t)M_ * 2048;
  w.VT = (bf16_t*)r; r += (size_t)128 * 64 * TP_ * 2;
  w.W = (bf16_t*)opaque_ptr((unsigned char*)p.out);
  return w;
}

__device__ __forceinline__ unsigned cvt_pk_bf16(float lo, float hi) {
  typedef float f32x2_t __attribute__((ext_vector_type(2)));
  typedef __bf16 bf16x2_t __attribute__((ext_vector_type(2)));
  const f32x2_t v = {lo, hi};
  const bf16x2_t r = __builtin_convertvector(v, bf16x2_t);
  return __builtin_bit_cast(unsigned, r);
}
__device__ __forceinline__ f32x4 scale4(f32x4 a, float r) {
  asm volatile("" : "+v"(r));
  float x0 = a[0] * r, x1 = a[1] * r, x2 = a[2] * r, x3 = a[3] * r;
  asm volatile("" : "+v"(x0), "+v"(x1), "+v"(x2), "+v"(x3));
  return (f32x4){x0, x1, x2, x3};
}
__device__ __forceinline__ float bf2f(bf16_t v) { return __uint_as_float(((unsigned)v) << 16); }
__device__ __forceinline__ float bflo(unsigned v) { return __uint_as_float(v << 16); }
__device__ __forceinline__ float bfhi(unsigned v) { return __uint_as_float(v & 0xffff0000u); }
__device__ __forceinline__ bf16_t f2bf(float f) { return (bf16_t)(cvt_pk_bf16(f, 0.f) & 0xffffu); }
__device__ __forceinline__ float sigmoidf_(float x) { return __builtin_amdgcn_rcpf(1.f + __expf(-x)); }
__device__ __forceinline__ float siluf_(float x) { return x * __builtin_amdgcn_rcpf(1.f + __expf(-x)); }
__device__ __forceinline__ bf16x8 as_bf16x8(u32x4 v) { return __builtin_bit_cast(bf16x8, v); }
__device__ __forceinline__ int half_id() { return __builtin_amdgcn_readfirstlane((int)(threadIdx.x >> 8)); }
__device__ __forceinline__ int opaque_tid() { int t = threadIdx.x & 255; asm volatile("" : "+v"(t)); return t; }
__device__ __forceinline__ int opaque_tid512() { int t = threadIdx.x; asm volatile("" : "+v"(t)); return t; }
__device__ __forceinline__ int xcd_bid(int bid) { const int gpx = gridDim.x >> 3; return (bid & 7) * gpx + (bid >> 3); }
__device__ __forceinline__ int opaque_bid() { int t = blockIdx.x * 2 + half_id(); asm volatile("" : "+s"(t)); return t; }
__device__ __forceinline__ int opaque_rbid() { int t = blockIdx.x; asm volatile("" : "+s"(t)); return t; }
#define NVB ((int)gridDim.x * 2)
#define MFMA16(a, b, c) __builtin_amdgcn_mfma_f32_16x16x32_bf16((a), (b), (c), 0, 0, 0)

__shared__ __attribute__((aligned(16))) unsigned char smem_all[2 * SMEM_BYTES + 16];
#define smem (smem_all + half_id() * SMEM_BYTES)

#define XB_TMO      128
#define XB_XCNT(j)  (256  + 64 * (j))
#define XB_XSUB(j)  (1280 + 64 * (j))
#define XB_XGEN(j)  (2304 + 64 * (j))
#define XB_TOP      3328
#define XB_TOPGEN   3392
#define XCD_BAR_WORDS 3456
#define XB_SPIN_CAP (1u << 18)
#define LAS __attribute__((address_space(3)))
constexpr size_t BAR_OFF = 260046848;

__device__ __forceinline__ unsigned xb_ld(unsigned* p)              { return __hip_atomic_load(p, __ATOMIC_RELAXED, __HIP_MEMORY_SCOPE_AGENT); }
__device__ __forceinline__ unsigned xb_add(unsigned* p, unsigned v) { return __hip_atomic_fetch_add(p, v, __ATOMIC_RELAXED, __HIP_MEMORY_SCOPE_AGENT); }
__device__ __forceinline__ unsigned xb_xcc_id() { return (unsigned)__builtin_amdgcn_s_getreg((3 << 11) | 20) & 0xFu; }
#define XB_SPIN(cond, bar) do { unsigned _sp = 0; while (cond) { __builtin_amdgcn_s_sleep(1); \
    if ((++_sp & 255u) == 0u) { if (xb_ld(&(bar)[XB_TMO])) break; if (_sp > XB_SPIN_CAP) { atomicAdd(&(bar)[XB_TMO], 1u); break; } } } } while (0)

struct XcdBarrier { unsigned* bar; unsigned x; volatile LAS unsigned* st; };

__device__ __forceinline__ XcdBarrier xcd_barrier_post(unsigned* bar, volatile LAS unsigned* st) {
    XcdBarrier b; b.bar = bar; b.x = xb_xcc_id(); b.st = st;
    if (threadIdx.x == 0) (void)xb_add(&bar[XB_XCNT(b.x)], 1u);
    return b;
}
__device__ __forceinline__ void xcd_barrier_complete(unsigned* bar, unsigned x, unsigned& nloc, unsigned& nx) {
    const unsigned G = gridDim.x * gridDim.y * gridDim.z;
    unsigned sum, cnt, mine, sp = 0u;
    for (;;) {
        sum = 0u; cnt = 0u; mine = 0u;
#pragma unroll
        for (unsigned j = 0; j < 16; ++j) { const unsigned c = xb_ld(&bar[XB_XCNT(j)]); sum += c; cnt += (c > 0u) ? 1u : 0u; mine = (j == x) ? c : mine; }
        if (sum == G) break;
        __builtin_amdgcn_s_sleep(1);
        if ((++sp & 255u) == 0u) { if (xb_ld(&bar[XB_TMO])) break; if (sp > XB_SPIN_CAP) { atomicAdd(&bar[XB_TMO], 1u); break; } }
    }
    nloc = mine > 0u ? mine : 1u; nx = cnt > 0u ? cnt : 1u;
}
__device__ __forceinline__ void xcd_barrier(const XcdBarrier& b) {
    asm volatile("s_waitcnt vmcnt(0)" ::: "memory");
    __syncthreads();
    if (threadIdx.x == 0) {
        unsigned* bar = b.bar;
        __builtin_amdgcn_s_waitcnt(0);
        unsigned nloc = b.st[0], nx = b.st[1];
        if (nloc == 0u) { xcd_barrier_complete(bar, b.x, nloc, nx); b.st[0] = nloc; b.st[1] = nx; }
        const unsigned old = xb_add(&bar[XB_XSUB(b.x)], 1u);
        const unsigned gen = old / nloc;
        if (old + 1u == (gen + 1u) * nloc) {
            __builtin_amdgcn_fence(__ATOMIC_RELEASE, "agent");
            asm volatile("s_waitcnt vmcnt(0)" ::: "memory");
            const unsigned og = xb_add(&bar[XB_TOP], 1u);
            const unsigned tg = og / nx;
            if (og + 1u == (tg + 1u) * nx) xb_add(&bar[XB_TOPGEN], 1u);
            else XB_SPIN(xb_ld(&bar[XB_TOPGEN]) == tg, bar);
            __builtin_amdgcn_fence(__ATOMIC_ACQUIRE, "agent");
            xb_add(&bar[XB_XGEN(b.x)], 1u);
            asm volatile("s_waitcnt vmcnt(0)" ::: "memory");
        } else {
            XB_SPIN(xb_ld(&bar[XB_XGEN(b.x)]) == gen, bar);
            __builtin_amdgcn_fence(__ATOMIC_ACQUIRE, "agent");
            asm volatile("s_waitcnt vmcnt(0)" ::: "memory");
        }
    }
    __syncthreads();
}


__device__ __forceinline__ int map_even_in(int n) { return n < 4096 ? n : (n < 5120 ? n + 16 : (n < 5136 ? n - 1024 : -1)); }
__device__ __forceinline__ int map_odd_in(int n) { return n < 768 ? n : (n < 1792 ? n + 32 : (n < 1824 ? n - 1024 : -1)); }

__device__ __forceinline__ void convert_tile(const float* __restrict__ src, int K, int Nsrc, bf16_t* __restrict__ dst,
                                             int kind, const float* __restrict__ g, int tile) {
  float* tl = (float*)smem;
  const int nkt = K >> 7;
  const int ntile = tile / nkt, ktile = tile - ntile * nkt;
  const int n0 = ntile * 64, k0 = ktile * 128;
  const int tid = opaque_tid();
  const int nl = tid & 63, kq = tid >> 6;
  const int n = n0 + nl;
  const int sc = kind == 0 ? map_even_in(n) : (kind == 1 ? map_odd_in(n) : n);
  float cs = 1.f;
  if (kind == 0 && n >= 2048 && n < 2560) cs = 0.08838834764831845f;
  if (kind == 2) cs = QSCALE_MLA;
  float v[32];
#pragma unroll
  for (int i = 0; i < 32; ++i) {
    const int kl = kq + 4 * i;
    v[i] = 0.f;
    if (sc >= 0) v[i] = src[(size_t)(k0 + kl) * Nsrc + sc];
  }
#pragma unroll
  for (int i = 0; i < 32; ++i) {
    const int kl = kq + 4 * i;
    float t = v[i] * cs;
    if (g) t *= g[k0 + kl];
    tl[kl * 65 + nl] = t;
  }
  __syncthreads();
#pragma unroll
  for (int i = 0; i < 4; ++i) {
    const int c = tid + 256 * i;
    const int nl2 = c >> 4, kc = c & 15;
    float t[8];
#pragma unroll
    for (int jj = 0; jj < 8; ++jj) t[jj] = tl[(kc * 8 + jj) * 65 + nl2];
    u32x4 pk;
    pk.x = cvt_pk_bf16(t[0], t[1]); pk.y = cvt_pk_bf16(t[2], t[3]); pk.z = cvt_pk_bf16(t[4], t[5]); pk.w = cvt_pk_bf16(t[6], t[7]);
    *(u32x4*)(dst + (size_t)(n0 + nl2) * K + k0 + kc * 8) = pk;
  }
  __syncthreads();
}

__device__ __forceinline__ void phase_prologue(const Params& p, const WS& ws) {
  for (int id = opaque_bid(); id < 2880; id += NVB) {
    const int j = id / 1440; int r = id - j * 1440;
    bf16_t* wb = ws.W + (size_t)j * W_PER_J;
    if (r < 656) convert_tile(p.ab_w_in + (size_t)j * 1024 * 5136, 1024, 5136, wb + W_IN_E, 0, p.ab_norm + j * 1024, r);
    else if ((r -= 656) < 256) convert_tile(p.ab_w_out + (size_t)j * 2048 * 1024, 2048, 1024, wb + W_OUT_E, 3, nullptr, r);
    else if ((r -= 256) < 240) convert_tile(p.c_w_in + (size_t)j * 1024 * 1824, 1024, 1824, wb + W_IN_O, 1, p.c_norm + j * 1024, r);
    else if ((r -= 240) < 96) convert_tile(p.c_w_q_up + (size_t)j * 512 * 1536, 512, 1536, wb + W_Q, 2, p.c_q_norm + j * 512, r);
    else if ((r -= 96) < 64) convert_tile(p.c_w_kv_up + (size_t)j * 256 * 2048, 256, 2048, wb + W_KV, 3, p.c_kv_norm + j * 256, r);
    else { r -= 64; convert_tile(p.c_w_out + (size_t)j * 1024 * 1024, 1024, 1024, wb + W_O, 3, nullptr, r); }
  }
  const size_t gtid = (size_t)opaque_bid() * 256 + opaque_tid(), gsz = (size_t)NVB * 256;
  for (size_t idx0 = gtid; idx0 < (size_t)M_ * 256; idx0 += 8 * gsz) {
    float4 v4[8];
#pragma unroll
    for (int q = 0; q < 8; ++q) {
      const size_t idx = idx0 + q * gsz;
      v4[q] = make_float4(0.f, 0.f, 0.f, 0.f);
      if (idx < (size_t)M_ * 256) {
        const int row = (int)(idx >> 8), c4 = (int)(idx & 255);
        const int b = row / T_, t = row - b * T_;
        const float* src = t < 16 ? p.meta + (size_t)t * 1024 : p.x + ((size_t)b * 2048 + (t - 16)) * 1024;
        v4[q] = *(const float4*)(src + c4 * 4);
      }
    }
#pragma unroll
    for (int q = 0; q < 8; ++q) {
      const size_t idx = idx0 + q * gsz;
      if (idx < (size_t)M_ * 256) {
        const float4 v = v4[q];
        u32x2 hi; hi.x = cvt_pk_bf16(v.x, v.y); hi.y = cvt_pk_bf16(v.z, v.w);
        u32x2 lo; lo.x = cvt_pk_bf16(v.x - bflo(hi.x), v.y - bfhi(hi.x)); lo.y = cvt_pk_bf16(v.z - bflo(hi.y), v.w - bfhi(hi.y));
        *(u32x2*)(ws.HHI + idx * 4) = hi;
        *(u32x2*)(ws.HLO + idx * 4) = lo;
      }
    }
  }
  for (size_t idx = gtid; idx < (size_t)M_ * 16; idx += gsz) {
    const int row = (int)(idx >> 4), i = (int)(idx & 15);
    const int b = row / T_, t = row - b * T_;
    const int pos = t < 16 ? t : p.positions[b * 2048 + (t - 16)] + 16;
    const float angf = (float)pos * p.inv_freq[i];
    const double rev = (double)angf * 0.15915494309189533577;
    const float fr = (float)(rev - rint(rev));
    ws.ROPE[idx] = make_float2(__builtin_amdgcn_cosf(fr), __builtin_amdgcn_sinf(fr));
  }
}

#ifndef REP_GEMM
#define REP_GEMM 1
#endif
#ifndef REP_ATTN
#define REP_ATTN 1
#endif
#ifndef REP_E2
#define REP_E2 1
#endif
enum { EPI_E1 = 0, EPI_O1 = 1, EPI_Q = 2, EPI_KV = 3, EPI_RES = 4 };

template <int EPI, int TI>
__device__ __forceinline__ void gemm_epilogue(const WS& ws, const f32x4 (&acc)[4][TI], const float (&rs)[TI], int tok0, int n0,
                                              int wm, int wn, int lr, int lq, bool dry) {
  auto tokr = [&](int ti) { return tok0 + (ti < 4 ? wn * 64 + ti * 16 : 128 + wn * 16) + lr; };
  auto okr = [&](int ti) { return ti < 4 || (wn == 0 && lr == 0); };
  const int nw = n0 + wm * 64;
  if (EPI == EPI_E1) {
    bf16_t* dst; int ld, c;
    if (n0 < 1024) { dst = ws.XA; ld = 1024; c = n0; }
    else if (n0 < 2048) { dst = ws.GA; ld = 1024; c = n0 - 1024; }
    else if (n0 < 2560) { dst = ws.Q; ld = 512; c = n0 - 2048; }
    else if (n0 < 3072) { dst = ws.K; ld = 512; c = n0 - 2560; }
    else if (n0 < 4096) { dst = ws.V; ld = 1024; c = n0 - 3072; }
    else if (n0 < 5120) { dst = ws.GB; ld = 1024; c = n0 - 4096; }
    else { dst = ws.AD; ld = 16; c = 0; }
    const bool isad = n0 >= 5120;
#pragma unroll
    for (int ni = 0; ni < 4; ++ni) {
      if (isad && (wm != 0 || ni != 0)) continue;
#pragma unroll
      for (int ti = 0; ti < TI; ++ti) {
        const f32x4 v = scale4(acc[ni][ti], rs[ti]);
        u32x2 pk; pk.x = cvt_pk_bf16(v[0], v[1]); pk.y = cvt_pk_bf16(v[2], v[3]);
        if (okr(ti)) *(u32x2*)(dst + (size_t)tokr(ti) * ld + c + wm * 64 + ni * 16 + 4 * lq) = pk;
      }
    }
  } else if (EPI == EPI_O1) {
    if (n0 < 1792) {
      bf16_t* dst; int ld, c;
      if (n0 < 512) { dst = ws.CQ; ld = 512; c = n0; }
      else if (n0 < 768) { dst = ws.CKV; ld = 256; c = n0 - 512; }
      else { dst = ws.GATE; ld = 1024; c = n0 - 768; }
#pragma unroll
      for (int ni = 0; ni < 4; ++ni)
#pragma unroll
        for (int ti = 0; ti < TI; ++ti) {
          const f32x4 v = scale4(acc[ni][ti], rs[ti]);
          u32x2 pk; pk.x = cvt_pk_bf16(v[0], v[1]); pk.y = cvt_pk_bf16(v[2], v[3]);
          if (okr(ti)) *(u32x2*)(dst + (size_t)tokr(ti) * ld + c + wm * 64 + ni * 16 + 4 * lq) = pk;
        }
    } else if (wm == 0) {
#pragma unroll
      for (int ti = 0; ti < TI; ++ti) {
        const int tok = tokr(ti);
        const f32x4 x1 = scale4(acc[0][ti], rs[ti]), x2 = scale4(acc[1][ti], rs[ti]);
        float o1[4], o2[4];
#pragma unroll
        for (int jj = 0; jj < 4; ++jj) {
          const float2 cs = ws.ROPE[(size_t)tok * 16 + 4 * lq + jj];
          o1[jj] = x1[jj] * cs.x - x2[jj] * cs.y;
          o2[jj] = x2[jj] * cs.x + x1[jj] * cs.y;
        }
        u32x2 pk; pk.x = cvt_pk_bf16(o1[0], o1[1]); pk.y = cvt_pk_bf16(o1[2], o1[3]);
        *(u32x2*)(ws.KR + (size_t)tok * 32 + 4 * lq) = pk;
        pk.x = cvt_pk_bf16(o2[0], o2[1]); pk.y = cvt_pk_bf16(o2[2], o2[3]);
        *(u32x2*)(ws.KR + (size_t)tok * 32 + 16 + 4 * lq) = pk;
      }
    }
  } else if (EPI == EPI_Q) {
#pragma unroll
    for (int ni = 0; ni < 4; ++ni)
#pragma unroll
      for (int ti = 0; ti < TI; ++ti) {
        const f32x4 v = scale4(acc[ni][ti], rs[ti]);
        u32x2 pk; pk.x = cvt_pk_bf16(v[0], v[1]); pk.y = cvt_pk_bf16(v[2], v[3]);
        if (okr(ti)) *(u32x2*)(ws.QB + (size_t)tokr(ti) * 1536 + nw + ni * 16 + 4 * lq) = pk;
      }
  } else if (EPI == EPI_KV) {
    const int hd = nw >> 7;
    const bool isv = (nw & 127) >= 64;
    if (!isv) {
#pragma unroll
      for (int ni = 0; ni < 4; ++ni)
#pragma unroll
        for (int ti = 0; ti < TI; ++ti) {
          const f32x4 v = scale4(acc[ni][ti], rs[ti]);
          u32x2 pk; pk.x = cvt_pk_bf16(v[0], v[1]); pk.y = cvt_pk_bf16(v[2], v[3]);
          if (okr(ti)) *(u32x2*)(ws.KN + (size_t)tokr(ti) * 1024 + hd * 64 + ni * 16 + 4 * lq) = pk;
        }
    } else {
#pragma unroll
      for (int ti = 0; ti < TI; ++ti) {
        const int tok = tokr(ti);
        const int b = tok / T_, t = tok - b * T_;
        bf16_t* vb = ws.VT + ((size_t)(b * 16 + hd) * 64) * TP_ + t;
#pragma unroll
        for (int ni = 0; ni < 4; ++ni) {
          const f32x4 v = scale4(acc[ni][ti], rs[ti]);
#pragma unroll
          for (int jj = 0; jj < 4; ++jj) if (okr(ti)) vb[(size_t)(ni * 16 + 4 * lq + jj) * TP_] = f2bf(v[jj]);
        }
      }
    }
  } else {
#pragma unroll
    for (int ni = 0; ni < 4; ++ni)
#pragma unroll
      for (int ti = 0; ti < TI; ++ti) {
        if (!(ti < 4 || (lr == 0 && (ni >> 1) == wn))) continue;
        const size_t off = (size_t)(ti < 4 ? tokr(ti) : tok0 + 128) * 1024 + nw + ni * 16 + 4 * lq;
        const u32x2 hi = *(const u32x2*)(ws.HHI + off), lo = *(const u32x2*)(ws.HLO + off);
        const float h0 = bflo(hi.x) + bflo(lo.x) + acc[ni][ti][0], h1 = bfhi(hi.x) + bfhi(lo.x) + acc[ni][ti][1];
        const float h2 = bflo(hi.y) + bflo(lo.y) + acc[ni][ti][2], h3 = bfhi(hi.y) + bfhi(lo.y) + acc[ni][ti][3];
        u32x2 nh; nh.x = cvt_pk_bf16(h0, h1); nh.y = cvt_pk_bf16(h2, h3);
        u32x2 nl; nl.x = cvt_pk_bf16(h0 - bflo(nh.x), h1 - bfhi(nh.x)); nl.y = cvt_pk_bf16(h2 - bflo(nh.y), h3 - bfhi(nh.y));
        if (!dry) { *(u32x2*)(ws.HHI + off) = nh; *(u32x2*)(ws.HLO + off) = nl; }
      }
  }
}

__device__ __forceinline__ float sumsq8(bf16x8 v) {
  const u32x4 u = __builtin_bit_cast(u32x4, v);
  float s = 0.f, t;
  t = bflo(u.x); s += t * t; t = bfhi(u.x); s += t * t; t = bflo(u.y); s += t * t; t = bfhi(u.y); s += t * t;
  t = bflo(u.z); s += t * t; t = bfhi(u.z); s += t * t; t = bflo(u.w); s += t * t; t = bfhi(u.w); s += t * t;
  return s;
}
__device__ __forceinline__ void tile_of(int pos, int ntn, int& mt, int& nt) {
  const int full = 64 * ntn;
  if (pos < full) { const int panel = pos / (8 * ntn); const int rem = pos - panel * 8 * ntn; nt = rem >> 3; mt = panel * 8 + (rem & 7); }
  else { mt = 64; nt = pos - full; }
}
template <int EPI>
__device__ __forceinline__ void gemm_wide(const WS& ws, const bf16_t* A, int lda, const bf16_t* __restrict__ W, int K, float invK,
                                          int ntn, int ntiles, int bid) {
  unsigned char* As = smem_all + half_id() * 32768;
  unsigned char* Bs = smem_all + 65536;
  float* rsl = (float*)(smem_all + 131072 + half_id() * 1024);
  const int tid = opaque_tid(), lane = tid & 63, w = tid >> 6, wm = w >> 1, wn = w & 1, lr = lane & 15, lq = lane >> 4;
  const int tid5 = opaque_tid512(), hh = half_id();
  const int G = gridDim.x;
  const int nk = K >> 6;
  if (bid < ntiles) {
    const int my_tiles = (ntiles - 1 - bid) / G + 1;
    const int last_id = bid + (my_tiles - 1) * G;
    const int S = my_tiles * nk;
    f32x4 accA[4][4], accB[4][4];
#pragma unroll
    for (int a = 0; a < 4; ++a)
#pragma unroll
      for (int b = 0; b < 4; ++b) { accA[a][b] = (f32x4){0.f, 0.f, 0.f, 0.f}; accB[a][b] = (f32x4){0.f, 0.f, 0.f, 0.f}; }
    u32x4 ra[4], rb[4];
    float ss[4] = {0.f, 0.f, 0.f, 0.f};
    int l_id = bid, l_kt = 0, c_id = bid, c_kt = 0, st_kt = 0;
    const int srow = tid >> 3;
    const int soff = srow * 128 + (((tid & 7) ^ (srow & 7)) << 4);
    const int wrow = tid5 >> 3;
    const int woff = wrow * 128 + (((tid5 & 7) ^ (wrow & 7)) << 4);
    auto issue = [&]() {
      const int idc = l_id < last_id ? l_id : last_id;
      int mt, nt; tile_of(idc, ntn, mt, nt);
      const int arow = mt * 256 + hh * 128 + srow;
      const bf16_t* akb = A + l_kt * 64 + (tid & 7) * 8;
      const bf16_t* wp = W + (size_t)(nt * 256 + wrow) * K + l_kt * 64 + (tid5 & 7) * 8;
#pragma unroll
      for (int i = 0; i < 4; ++i) {
        int r = arow + 32 * i; r = r < M_ ? r : M_ - 1;
        ra[i] = *(const u32x4*)(akb + (size_t)r * lda);
        rb[i] = *(const u32x4*)(wp + (size_t)i * 64 * K);
      }
      if (++l_kt == nk) { l_kt = 0; l_id += G; }
    };
    auto store = [&](int buf) {
#pragma unroll
      for (int i = 0; i < 4; ++i) {
        ss[i] += sumsq8(__builtin_bit_cast(bf16x8, ra[i]));
        *(u32x4*)(As + buf * 16384 + i * 4096 + soff) = ra[i];
        *(u32x4*)(Bs + buf * 32768 + i * 8192 + woff) = rb[i];
      }
      if (++st_kt == nk) {
        st_kt = 0;
#pragma unroll
        for (int i = 0; i < 4; ++i) {
          float t = ss[i];
          t += __shfl_xor(t, 1); t += __shfl_xor(t, 2); t += __shfl_xor(t, 4);
          if ((tid & 7) == 0) rsl[srow + 32 * i] = rsqrtf(t * invK + EPS_);
          ss[i] = 0.f;
        }
      }
    };
    auto compute = [&](int buf) {
      const unsigned char* Ab = As + buf * 16384 + (wn * 64 + lr) * 128;
      const unsigned char* Bb = Bs + buf * 32768 + (wm * 64 + lr) * 128;
#pragma unroll
      for (int ks = 0; ks < 2; ++ks) {
        if (ks == 1) __builtin_amdgcn_sched_barrier(0);
        const int sw = ((ks * 4 + lq) ^ (lr & 7)) << 4;
        bf16x8 xf[4], wf[4];
#pragma unroll
        for (int i = 0; i < 4; ++i) { xf[i] = *(const bf16x8*)(Ab + i * 2048 + sw); wf[i] = *(const bf16x8*)(Bb + i * 2048 + sw); }
#pragma unroll
        for (int ni = 0; ni < 4; ++ni)
#pragma unroll
          for (int ti = 0; ti < 4; ++ti) accA[ni][ti] = MFMA16(wf[ni], xf[ti], accA[ni][ti]);
#pragma unroll
        for (int i = 0; i < 4; ++i) wf[i] = *(const bf16x8*)(Bb + 16384 + i * 2048 + sw);
#pragma unroll
        for (int ni = 0; ni < 4; ++ni)
#pragma unroll
          for (int ti = 0; ti < 4; ++ti) accB[ni][ti] = MFMA16(wf[ni], xf[ti], accB[ni][ti]);
      }
    };
    auto tile_end = [&]() {
      float rs[4];
#pragma unroll
      for (int ti = 0; ti < 4; ++ti) rs[ti] = rsl[wn * 64 + ti * 16 + lr];
      int mt, nt; tile_of(c_id, ntn, mt, nt);
      const int tokb = mt * 256 + hh * 128;
      if (tokb < M_) {
        gemm_epilogue<EPI, 4>(ws, accA, rs, tokb, nt * 256, wm, wn, lr, lq, false);
        if (nt * 256 + 128 < 5248) gemm_epilogue<EPI, 4>(ws, accB, rs, tokb, nt * 256 + 128, wm, wn, lr, lq, false);
      }
#pragma unroll
      for (int a = 0; a < 4; ++a)
#pragma unroll
        for (int b = 0; b < 4; ++b) { accA[a][b] = (f32x4){0.f, 0.f, 0.f, 0.f}; accB[a][b] = (f32x4){0.f, 0.f, 0.f, 0.f}; }
      c_id += G;
    };
    issue();
    store(0);
    __syncthreads();
#pragma unroll 1
    for (int s = 0; s < S; ++s) {
      issue();
      compute(s & 1);
      if (++c_kt == nk) { c_kt = 0; tile_end(); }
      store((s + 1) & 1);
      __syncthreads();
    }
  }
  __syncthreads();
}

__device__ __forceinline__ void gemm_rem_splitk(const WS& ws, const bf16_t* A, const bf16_t* __restrict__ W, int bid) {
  unsigned char* As = smem;
  unsigned char* Bs = smem + 32768;
  float* xacc = (float*)(smem_all + SMEM_BYTES);
  float* xss = (float*)(smem_all + SMEM_BYTES + 65536);
  float* rsl = (float*)(smem_all + 65536);
  const int tid = opaque_tid(), lane = tid & 63, w = tid >> 6, wm = w >> 1, wn = w & 1, lr = lane & 15, lq = lane >> 4;
  const int hh = half_id();
  if (bid < 169) {
    int rt, nt;
    if (bid < 129) { rt = bid; nt = 40; } else { rt = 128; nt = bid - 129; }
    f32x4 acc[4][4];
#pragma unroll
    for (int a = 0; a < 4; ++a)
#pragma unroll
      for (int b = 0; b < 4; ++b) acc[a][b] = (f32x4){0.f, 0.f, 0.f, 0.f};
    u32x4 ra[4], rb[4];
    float ss[4] = {0.f, 0.f, 0.f, 0.f};
    const int srow = tid >> 3;
    const int soff = srow * 128 + (((tid & 7) ^ (srow & 7)) << 4);
    const bf16_t* ap = A + (size_t)(rt * 128 + srow) * 1024 + hh * 512 + (tid & 7) * 8;
    const bf16_t* wp = W + (size_t)(nt * 128 + srow) * 1024 + hh * 512 + (tid & 7) * 8;
    auto issue = [&](int kt) {
#pragma unroll
      for (int i = 0; i < 4; ++i) {
        ra[i] = *(const u32x4*)(ap + (size_t)i * 32 * 1024 + kt * 64);
        rb[i] = *(const u32x4*)(wp + (size_t)i * 32 * 1024 + kt * 64);
      }
    };
    auto store = [&](int buf) {
#pragma unroll
      for (int i = 0; i < 4; ++i) {
        ss[i] += sumsq8(__builtin_bit_cast(bf16x8, ra[i]));
        *(u32x4*)(As + buf * 16384 + i * 4096 + soff) = ra[i];
        *(u32x4*)(Bs + buf * 16384 + i * 4096 + soff) = rb[i];
      }
    };
    issue(0);
    store(0);
    __syncthreads();
#pragma unroll 1
    for (int kt = 0; kt < 8; ++kt) {
      const int buf = kt & 1;
      if (kt + 1 < 8) issue(kt + 1);
      const unsigned char* Ab = As + buf * 16384 + (wn * 64 + lr) * 128;
      const unsigned char* Bb = Bs + buf * 16384 + (wm * 64 + lr) * 128;
#pragma unroll
      for (int ks = 0; ks < 2; ++ks) {
        const int sw = ((ks * 4 + lq) ^ (lr & 7)) << 4;
        bf16x8 wf[4], xf[4];
#pragma unroll
        for (int i = 0; i < 4; ++i) { wf[i] = *(const bf16x8*)(Bb + i * 2048 + sw); xf[i] = *(const bf16x8*)(Ab + i * 2048 + sw); }
#pragma unroll
        for (int ni = 0; ni < 4; ++ni)
#pragma unroll
          for (int ti = 0; ti < 4; ++ti) acc[ni][ti] = MFMA16(wf[ni], xf[ti], acc[ni][ti]);
      }
      if (kt + 1 < 8) store(buf ^ 1);
      __syncthreads();
    }
#pragma unroll
    for (int i = 0; i < 4; ++i) {
      float t = ss[i];
      t += __shfl_xor(t, 1); t += __shfl_xor(t, 2); t += __shfl_xor(t, 4);
      if ((tid & 7) == 0) { if (hh) xss[srow + 32 * i] = t; else rsl[srow + 32 * i] = t; }
    }
    if (hh) {
#pragma unroll
      for (int a = 0; a < 4; ++a)
#pragma unroll
        for (int b = 0; b < 4; ++b)
#pragma unroll
          for (int e = 0; e < 4; ++e) xacc[((a * 4 + b) * 4 + e) * 256 + tid] = acc[a][b][e];
    }
    __syncthreads();
    if (!hh) {
#pragma unroll
      for (int a = 0; a < 4; ++a)
#pragma unroll
        for (int b = 0; b < 4; ++b)
#pragma unroll
          for (int e = 0; e < 4; ++e) acc[a][b][e] += xacc[((a * 4 + b) * 4 + e) * 256 + tid];
      float rs[4];
#pragma unroll
      for (int ti = 0; ti < 4; ++ti) {
        const int r = wn * 64 + ti * 16 + lr;
        rs[ti] = rsqrtf((rsl[r] + xss[r]) * (1.f / 1024.f) + EPS_);
      }
      gemm_epilogue<EPI_E1, 4>(ws, acc, rs, rt * 128, nt * 128, wm, wn, lr, lq, false);
    }
  }
  __syncthreads();
}

__device__ __forceinline__ void rem_tile(int pos, int& mt, int& nt) { if (pos < 65) { mt = pos; nt = 40; } else { mt = 64; nt = pos - 65; } }
template <bool RS, int EPI, int TI, int TMAP = 0>
__device__ __forceinline__ void gemm_stream(const WS& ws, const bf16_t* A0, const bf16_t* A1, int lda, int ktsplit, int kstride,
                                            const bf16_t* __restrict__ W, int K, float invK, int ntn, int ntiles, int bid, bool dry) {
  constexpr int BMH = (TI == 5) ? 129 : 128;
  constexpr int ASTG = 16384;
  unsigned char* As = smem;
  unsigned char* Bs = smem_all + 2 * ASTG;
  float* rsl = (float*)(smem + 65536);
  int xbase = 66048;
  asm volatile("" : "+v"(xbase));
  unsigned char* Ax0 = smem + xbase;
  const int tid = opaque_tid(), lane = tid & 63, w = tid >> 6, wm = w >> 1, wn = w & 1, lr = lane & 15, lq = lane >> 4;
  const int tid5 = opaque_tid512(), hh = half_id();
  const int G = gridDim.x;
  const int nk = K >> 6;
  if (bid < ntiles) {
    const int my_tiles = (ntiles - 1 - bid) / G + 1;
    const int last_id = bid + (my_tiles - 1) * G;
    const int S = my_tiles * nk;
    f32x4 acc[4][TI];
#pragma unroll
    for (int a = 0; a < 4; ++a)
#pragma unroll
      for (int b = 0; b < TI; ++b) acc[a][b] = (f32x4){0.f, 0.f, 0.f, 0.f};
    u32x4 ra0[4], rb0[2], ra1[4], rb1[2];
    u32x4 rx0 = (u32x4){0u, 0u, 0u, 0u}, rx1 = (u32x4){0u, 0u, 0u, 0u};
    float ss[5] = {0.f, 0.f, 0.f, 0.f, 0.f};
    int l_id = bid, l_kt = 0, c_id = bid, c_kt = 0, st_kt = 0;
    const int srow = tid >> 3;
    const int soff = srow * 128 + (((tid & 7) ^ (srow & 7)) << 4);

    const int wrow = tid5 >> 3;
    const int woff = wrow * 128 + (((tid5 & 7) ^ (wrow & 7)) << 4);
    auto issue = [&](u32x4 (&ra)[4], u32x4 (&rb)[2], u32x4& rx) {
      const int idc = l_id < last_id ? l_id : last_id;
      int mt, nt; if (TMAP == 1) rem_tile(idc, mt, nt); else tile_of(idc, ntn, mt, nt);
      const bf16_t* A = (l_kt < ktsplit) ? A0 : A1;
      const int kk = (l_kt < ktsplit) ? l_kt : l_kt - ktsplit;
      const int arow = mt * 2 * BMH + hh * BMH + srow;
      const bf16_t* akb = A + kk * kstride + (tid & 7) * 8;
      const bf16_t* wp = W + (size_t)(nt * 128 + wrow) * K + l_kt * 64 + (tid5 & 7) * 8;
#pragma unroll
      for (int i = 0; i < 4; ++i) {
        int r = arow + 32 * i; r = r < M_ ? r : M_ - 1;
        ra[i] = *(const u32x4*)(akb + (size_t)r * lda);
      }
#pragma unroll
      for (int i = 0; i < 2; ++i) rb[i] = *(const u32x4*)(wp + (size_t)i * 64 * K);
      if (TI == 5) { if (srow == 0) rx = *(const u32x4*)(akb + (size_t)(arow + 128) * lda); }
      if (++l_kt == nk) { l_kt = 0; l_id += G; }
    };
    auto store = [&](const u32x4 (&ra)[4], const u32x4 (&rb)[2], const u32x4& rx, int buf) {
#pragma unroll
      for (int i = 0; i < 4; ++i) {
        if (RS) ss[i] += sumsq8(__builtin_bit_cast(bf16x8, ra[i]));
        *(u32x4*)(As + buf * ASTG + i * 4096 + soff) = ra[i];
      }
#pragma unroll
      for (int i = 0; i < 2; ++i) *(u32x4*)(Bs + buf * 16384 + i * 8192 + woff) = rb[i];
      if (TI == 5) {
        if (RS) ss[4] += sumsq8(__builtin_bit_cast(bf16x8, rx));
        if (srow == 0) *(u32x4*)(Ax0 + buf * 128 + ((tid & 7) << 4)) = rx;
      }
      if (RS) {
        if (++st_kt == nk) {
          st_kt = 0;
#pragma unroll
          for (int i = 0; i < TI; ++i) {
            float t = ss[i];
            t += __shfl_xor(t, 1); t += __shfl_xor(t, 2); t += __shfl_xor(t, 4);
            if ((tid & 7) == 0 && i < 4) rsl[srow + 32 * i] = rsqrtf(t * invK + EPS_);
            ss[i] = 0.f;
          }
        }
      }
    };
    auto compute = [&](int buf) {
      const unsigned char* Ab = As + buf * ASTG + (wn * 64 + lr) * 128;
      const unsigned char* Ax = Ax0 + buf * 128;
      const unsigned char* Bb = Bs + buf * 16384 + (wm * 64 + lr) * 128;
#pragma unroll
      for (int ks = 0; ks < 2; ++ks) {
        if (TI == 5 && ks == 1) __builtin_amdgcn_sched_barrier(0);
        const int sw = ((ks * 4 + lq) ^ (lr & 7)) << 4;
        bf16x8 wf[4], xf[TI];
#pragma unroll
        for (int i = 0; i < 4; ++i) {
          wf[i] = *(const bf16x8*)(Bb + i * 2048 + sw);
          xf[i] = *(const bf16x8*)(Ab + i * 2048 + sw);
        }
        if (TI == 5) xf[TI - 1] = *(const bf16x8*)(Ax + ((ks * 4 + lq) << 4));
#pragma unroll
        for (int ni = 0; ni < 4; ++ni)
#pragma unroll
          for (int ti = 0; ti < 4; ++ti) acc[ni][ti] = MFMA16(wf[ni], xf[ti], acc[ni][ti]);
        if (TI == 5) {
          if (wn == 0) { acc[0][TI - 1] = MFMA16(wf[0], xf[TI - 1], acc[0][TI - 1]); acc[1][TI - 1] = MFMA16(wf[1], xf[TI - 1], acc[1][TI - 1]); }
          else { acc[2][TI - 1] = MFMA16(wf[2], xf[TI - 1], acc[2][TI - 1]); acc[3][TI - 1] = MFMA16(wf[3], xf[TI - 1], acc[3][TI - 1]); }
        }
      }
    };
    auto tile_end = [&]() {
      float rs[TI];
#pragma unroll
      for (int ti = 0; ti < TI; ++ti) rs[ti] = 1.f;
      if (RS) {
#pragma unroll
        for (int ti = 0; ti < TI; ++ti) rs[ti] = rsl[(ti < 4 ? wn * 64 + ti * 16 : 0) + lr];
      }
      int mt, nt; if (TMAP == 1) rem_tile(c_id, mt, nt); else tile_of(c_id, ntn, mt, nt);
      const int tokb = mt * 2 * BMH + hh * BMH;
      if (tokb < M_) gemm_epilogue<EPI, TI>(ws, acc, rs, tokb, nt * 128, wm, wn, lr, lq, dry);
#pragma unroll
      for (int a = 0; a < 4; ++a)
#pragma unroll
        for (int b = 0; b < TI; ++b) acc[a][b] = (f32x4){0.f, 0.f, 0.f, 0.f};
      c_id += G;
    };

    issue(ra0, rb0, rx0);
    issue(ra1, rb1, rx1);
    store(ra0, rb0, rx0, 0);
    __syncthreads();
#pragma unroll 1
    for (int s = 0; s < S; s += 2) {
      issue(ra0, rb0, rx0);
      compute(0);
      store(ra1, rb1, rx1, 1);
      __syncthreads();
      issue(ra1, rb1, rx1);
      compute(1);
      c_kt += 2;
      if (c_kt == nk) { c_kt = 0; tile_end(); }
      store(ra0, rb0, rx0, 0);
      __syncthreads();
    }
  }
  __syncthreads();
}

__device__ __forceinline__ void gla_decay_unit(const Params& p, const WS& ws, int j, int u) {
  const int c = u % 33; const int bh = u / 33; const int hd = bh & 3, b = bh >> 2;
  bf16_t* Qs = (bf16_t*)smem;
  bf16_t* Ks = Qs + 64 * 136;
  float* ADs = (float*)(smem + 2 * 64 * 136 * 2);
  float* HT = ADs + 64 * 16;
  const int tid = opaque_tid();
  const int tbase = 64 * c - 48;
#pragma unroll
  for (int i = 0; i < 4; ++i) {
    const int ci = tid + 256 * i; const int row = ci >> 4, ch = ci & 15; const int t = tbase + row;
    u32x4 qv = (u32x4){0, 0, 0, 0}, kv = (u32x4){0, 0, 0, 0};
    if (t >= 0) {
      qv = *(const u32x4*)(ws.Q + (size_t)(b * T_ + t) * 512 + hd * 128 + ch * 8);
      kv = *(const u32x4*)(ws.K + (size_t)(b * T_ + t) * 512 + hd * 128 + ch * 8);
    }
    *(u32x4*)(Qs + row * 136 + ch * 8) = qv;
    *(u32x4*)(Ks + row * 136 + ch * 8) = kv;
    const int t2 = tbase + (ci >> 4);
    ADs[ci] = t2 >= 0 ? bf2f(ws.AD[(size_t)(b * T_ + t2) * 16 + (ci & 15)]) : 0.f;
  }
  const int d = tid & 127, half = tid >> 7;
  float aw[16];
#pragma unroll
  for (int r = 0; r < 16; ++r) aw[r] = p.ab_alpha_w[(size_t)(j * 16 + r) * 512 + hd * 128 + d];
  const float abias = p.ab_alpha_b[j * 512 + hd * 128 + d];
  __syncthreads();
  float cs[32];
  float run = 0.f;
#pragma unroll
  for (int ii = 0; ii < 32; ++ii) {
    const int row = half * 32 + ii;
    float xv = abias;
#pragma unroll
    for (int r4 = 0; r4 < 4; ++r4) {
      const float4 a4 = *(const float4*)(ADs + row * 16 + r4 * 4);
      xv += a4.x * aw[r4 * 4] + a4.y * aw[r4 * 4 + 1] + a4.z * aw[r4 * 4 + 2] + a4.w * aw[r4 * 4 + 3];
    }
    float la = (fminf(xv, 0.f) - __logf(1.f + __expf(-fabsf(xv)))) * 0.0625f;
    if (tbase + row < 0) la = 0.f;
    run += la;
    cs[ii] = run;
  }
  HT[half * 128 + d] = run;
  __syncthreads();
  const float off = half ? HT[d] : 0.f;
  const float blast = HT[d] + HT[128 + d];
#pragma unroll
  for (int ii = 0; ii < 32; ++ii) {
    const int row = half * 32 + ii;
    const float bb = cs[ii] + off;
    const float eb = __expf(bb), ebi = __expf(-bb);
    Qs[row * 136 + d] = f2bf(bf2f(Qs[row * 136 + d]) * eb);
    Ks[row * 136 + d] = f2bf(bf2f(Ks[row * 136 + d]) * ebi);
  }
  if (half == 0) ws.BL[(size_t)((b * 4 + hd) * 33 + c) * 128 + d] = __expf(blast);
  __syncthreads();
#pragma unroll
  for (int i = 0; i < 4; ++i) {
    const int ci = tid + 256 * i; const int row = ci >> 4, ch = ci & 15; const int t = tbase + row;
    if (t >= 0) {
      *(u32x4*)(ws.Q + (size_t)(b * T_ + t) * 512 + hd * 128 + ch * 8) = *(const u32x4*)(Qs + row * 136 + ch * 8);
      *(u32x4*)(ws.K + (size_t)(b * T_ + t) * 512 + hd * 128 + ch * 8) = *(const u32x4*)(Ks + row * 136 + ch * 8);
    }
  }
  __syncthreads();
}

__device__ __forceinline__ void conv_unit(const Params& p, const WS& ws, int j, int u) {
  const int g = u & 7, b = u >> 3;
  const int tid = opaque_tid();
  const int c8 = tid & 15, seg = tid >> 4;
  const int t0 = seg * 129;
  const int cbase = 128 * g + 8 * c8;
  float cw[4][8], cb[8];
#pragma unroll
  for (int e = 0; e < 8; ++e) {
    cb[e] = p.ab_conv_b[j * 1024 + cbase + e];
#pragma unroll
    for (int k = 0; k < 4; ++k) cw[k][e] = p.ab_conv_w[(size_t)(j * 4 + k) * 1024 + cbase + e];
  }
  bf16_t* xp = ws.XA + (size_t)(b * T_) * 1024 + cbase;
  float x0[8], x1[8], x2[8];
  {
    u32x4 h[3];
#pragma unroll
    for (int m = 0; m < 3; ++m) {
      const int t = t0 - 3 + m;
      h[m] = (u32x4){0, 0, 0, 0};
      if (t >= 0) h[m] = *(const u32x4*)(xp + (size_t)t * 1024);
    }
    const u32x4 a = h[0], bq = h[1], c = h[2];
    x0[0] = bflo(a.x); x0[1] = bfhi(a.x); x0[2] = bflo(a.y); x0[3] = bfhi(a.y); x0[4] = bflo(a.z); x0[5] = bfhi(a.z); x0[6] = bflo(a.w); x0[7] = bfhi(a.w);
    x1[0] = bflo(bq.x); x1[1] = bfhi(bq.x); x1[2] = bflo(bq.y); x1[3] = bfhi(bq.y); x1[4] = bflo(bq.z); x1[5] = bfhi(bq.z); x1[6] = bflo(bq.w); x1[7] = bfhi(bq.w);
    x2[0] = bflo(c.x); x2[1] = bfhi(c.x); x2[2] = bflo(c.y); x2[3] = bfhi(c.y); x2[4] = bflo(c.z); x2[5] = bfhi(c.z); x2[6] = bflo(c.w); x2[7] = bfhi(c.w);
  }
  __syncthreads();
#pragma unroll 1
  for (int tt = 0; tt < 129; tt += 3) {
    u32x4 r[3];
#pragma unroll
    for (int m = 0; m < 3; ++m) r[m] = *(const u32x4*)(xp + (size_t)(t0 + tt + m) * 1024);
#pragma unroll
    for (int m = 0; m < 3; ++m) {
      float x3[8];
      x3[0] = bflo(r[m].x); x3[1] = bfhi(r[m].x); x3[2] = bflo(r[m].y); x3[3] = bfhi(r[m].y);
      x3[4] = bflo(r[m].z); x3[5] = bfhi(r[m].z); x3[6] = bflo(r[m].w); x3[7] = bfhi(r[m].w);
      float y[8];
#pragma unroll
      for (int e = 0; e < 8; ++e) y[e] = cb[e] + cw[0][e] * x0[e] + cw[1][e] * x1[e] + cw[2][e] * x2[e] + cw[3][e] * x3[e];
      u32x4 pk; pk.x = cvt_pk_bf16(y[0], y[1]); pk.y = cvt_pk_bf16(y[2], y[3]); pk.z = cvt_pk_bf16(y[4], y[5]); pk.w = cvt_pk_bf16(y[6], y[7]);
      *(u32x4*)(xp + (size_t)(t0 + tt + m) * 1024) = pk;
#pragma unroll
      for (int e = 0; e < 8; ++e) { x0[e] = x1[e]; x1[e] = x2[e]; x2[e] = x3[e]; }
    }
  }
  __syncthreads();
}

__device__ __forceinline__ void gla_unit(const Params& p, const WS& ws, int u, bool dry = false) {
  const int sl = u & 7; const int bh = u >> 3; const int hd = bh & 3, b = bh >> 2;
  bf16_t* QDs = (bf16_t*)smem;
  bf16_t* KIs = QDs + 64 * 136;
  bf16_t* KIT = KIs + 64 * 136;
  bf16_t* VTs = KIT + 128 * 72;
  bf16_t* STs = VTs + 32 * 72;
  bf16_t* Ps = STs + 32 * 136;
  const int tid = opaque_tid(), lane = tid & 63, w = tid >> 6, lr = lane & 15, lq = lane >> 4;
  for (int i = tid; i < 32 * 136 / 2; i += 256) ((unsigned*)STs)[i] = 0u;
  f32x4 sacc[2][2];
#pragma unroll
  for (int a = 0; a < 2; ++a)
#pragma unroll
    for (int bb = 0; bb < 2; ++bb) sacc[a][bb] = (f32x4){0.f, 0.f, 0.f, 0.f};
  u32x4 qrA[4], krA[4], vrA, qrB[4], krB[4], vrB;
  float eblA[2], eblB[2];
  const float* BLp = ws.BL + (size_t)((b * 4 + hd) * 33) * 128;
  auto prefetch = [&](int c, u32x4 (&qr)[4], u32x4 (&kr)[4], u32x4& vr, float (&ebl)[2]) {
    const int tbase = 64 * c - 48;
#pragma unroll
    for (int i = 0; i < 4; ++i) {
      const int ci = tid + 256 * i; const int row = ci >> 4, ch = ci & 15; const int t = tbase + row;
      qr[i] = (u32x4){0, 0, 0, 0}; kr[i] = (u32x4){0, 0, 0, 0};
      if (t >= 0) {
        qr[i] = *(const u32x4*)(ws.Q + (size_t)(b * T_ + t) * 512 + hd * 128 + ch * 8);
        kr[i] = *(const u32x4*)(ws.K + (size_t)(b * T_ + t) * 512 + hd * 128 + ch * 8);
      }
    }
    {
      const int row = tid >> 2, ch = tid & 3; const int t = tbase + row;
      vr = (u32x4){0, 0, 0, 0};
      if (t >= 0) vr = *(const u32x4*)(ws.V + (size_t)(b * T_ + t) * 1024 + hd * 256 + sl * 32 + ch * 8);
    }
    ebl[0] = BLp[c * 128 + 16 * (2 * w) + lr];
    ebl[1] = BLp[c * 128 + 16 * (2 * w + 1) + lr];
  };
  prefetch(0, qrA, krA, vrA, eblA);
  prefetch(1, qrB, krB, vrB, eblB);
  __syncthreads();
  u32x2 opend[2]; float sqpend = 0.f; int tpend = -1;
  opend[0] = (u32x2){0u, 0u}; opend[1] = (u32x2){0u, 0u};
  auto flush_o = [&]() {
    if (tpend >= 0 && !dry) {
      const size_t row = (size_t)(b * T_ + tpend);
#pragma unroll
      for (int mt = 0; mt < 2; ++mt) *(u32x2*)(ws.V + row * 1024 + hd * 256 + sl * 32 + 16 * mt + 4 * lq) = opend[mt];
      if (lq == 0) ws.SSQ[row * 32 + hd * 8 + sl] = sqpend;
    }
  };
  auto body = [&](int c, u32x4 (&qr)[4], u32x4 (&kr)[4], u32x4& vr, float (&ebl)[2]) {
#pragma unroll
    for (int i = 0; i < 4; ++i) {
      const int ci = tid + 256 * i; const int row = ci >> 4, ch = ci & 15;
      *(u32x4*)(QDs + row * 136 + ch * 8) = qr[i];
      *(u32x4*)(KIs + row * 136 + ch * 8) = kr[i];
      const unsigned kk[4] = {kr[i].x, kr[i].y, kr[i].z, kr[i].w};
#pragma unroll
      for (int e = 0; e < 4; ++e) {
        KIT[(ch * 8 + 2 * e) * 72 + (row ^ ((ch & 7) << 3))] = (bf16_t)(kk[e] & 0xffffu);
        KIT[(ch * 8 + 2 * e + 1) * 72 + (row ^ ((ch & 7) << 3))] = (bf16_t)(kk[e] >> 16);
      }
    }
    {
      const int row = tid >> 2, ch = tid & 3;
      const unsigned vv[4] = {vr.x, vr.y, vr.z, vr.w};
#pragma unroll
      for (int e = 0; e < 4; ++e) {
        VTs[(ch * 8 + 2 * e) * 72 + (row ^ (ch << 3))] = (bf16_t)(vv[e] & 0xffffu);
        VTs[(ch * 8 + 2 * e + 1) * 72 + (row ^ (ch << 3))] = (bf16_t)(vv[e] >> 16);
      }
    }
    const float eb0 = ebl[0], eb1 = ebl[1];
    __syncthreads();
    flush_o();
    if (c + 2 < 33) prefetch(c + 2, qr, kr, vr, ebl);
    bf16x8 xq[4];
#pragma unroll
    for (int ks = 0; ks < 4; ++ks) xq[ks] = *(const bf16x8*)(QDs + (16 * w + lr) * 136 + 32 * ks + 8 * lq);
    const int irow = 16 * w + lr;
#pragma unroll
    for (int mt = 0; mt < 4; ++mt) {
      u32x2 pk = (u32x2){0u, 0u};
      if (mt <= w) {
        f32x4 a = (f32x4){0.f, 0.f, 0.f, 0.f};
#pragma unroll
        for (int ks = 0; ks < 4; ++ks) {
          const bf16x8 kf = *(const bf16x8*)(KIs + (16 * mt + lr) * 136 + 32 * ks + 8 * lq);
          a = MFMA16(kf, xq[ks], a);
        }
        const int ip = 16 * mt + 4 * lq;
        const float v0 = (ip + 0 <= irow) ? a[0] : 0.f, v1 = (ip + 1 <= irow) ? a[1] : 0.f;
        const float v2 = (ip + 2 <= irow) ? a[2] : 0.f, v3 = (ip + 3 <= irow) ? a[3] : 0.f;
        pk.x = cvt_pk_bf16(v0, v1); pk.y = cvt_pk_bf16(v2, v3);
      }
      *(u32x2*)(Ps + irow * 72 + 16 * mt + 4 * lq) = pk;
    }
    __syncthreads();
    f32x4 oacc[2];
    oacc[0] = (f32x4){0.f, 0.f, 0.f, 0.f}; oacc[1] = (f32x4){0.f, 0.f, 0.f, 0.f};
#pragma unroll
    for (int ks = 0; ks < 2; ++ks) {
      if (2 * ks <= w) {
        const bf16x8 pb = *(const bf16x8*)(Ps + irow * 72 + 32 * ks + 8 * lq);
#pragma unroll
        for (int mt = 0; mt < 2; ++mt) {
          const bf16x8 vf = *(const bf16x8*)(VTs + (16 * mt + lr) * 72 + (((4 * ks + lq) ^ (((16 * mt + lr) >> 3) & 3)) << 3));
          oacc[mt] = MFMA16(vf, pb, oacc[mt]);
        }
      }
    }
#pragma unroll
    for (int ks = 0; ks < 4; ++ks)
#pragma unroll
      for (int mt = 0; mt < 2; ++mt) {
        const bf16x8 sf = *(const bf16x8*)(STs + (16 * mt + lr) * 136 + 32 * ks + 8 * lq);
        oacc[mt] = MFMA16(sf, xq[ks], oacc[mt]);
      }
    {
      const int t = 64 * c - 48 + irow;
      float sq = 0.f;
#pragma unroll
      for (int mt = 0; mt < 2; ++mt) sq += oacc[mt][0] * oacc[mt][0] + oacc[mt][1] * oacc[mt][1] + oacc[mt][2] * oacc[mt][2] + oacc[mt][3] * oacc[mt][3];
      sq += __shfl_xor(sq, 16); sq += __shfl_xor(sq, 32);
      tpend = t;
      sqpend = sq;
#pragma unroll
      for (int mt = 0; mt < 2; ++mt) { opend[mt].x = cvt_pk_bf16(oacc[mt][0], oacc[mt][1]); opend[mt].y = cvt_pk_bf16(oacc[mt][2], oacc[mt][3]); }
    }
    __syncthreads();
#pragma unroll
    for (int ntl = 0; ntl < 2; ++ntl) {
#pragma unroll
      for (int ks = 0; ks < 2; ++ks) {
        const bf16x8 kf = *(const bf16x8*)(KIT + (16 * (2 * w + ntl) + lr) * 72 + (((4 * ks + lq) ^ (((16 * (2 * w + ntl) + lr) >> 3) & 7)) << 3));
#pragma unroll
        for (int mt = 0; mt < 2; ++mt) {
          const bf16x8 vf = *(const bf16x8*)(VTs + (16 * mt + lr) * 72 + (((4 * ks + lq) ^ (((16 * mt + lr) >> 3) & 3)) << 3));
          sacc[mt][ntl] = MFMA16(vf, kf, sacc[mt][ntl]);
        }
      }
      const float e = ntl ? eb1 : eb0;
#pragma unroll
      for (int mt = 0; mt < 2; ++mt) {
        sacc[mt][ntl] = scale4(sacc[mt][ntl], e);
#pragma unroll
        for (int jj = 0; jj < 4; ++jj) STs[(16 * mt + 4 * lq + jj) * 136 + 16 * (2 * w + ntl) + lr] = f2bf(sacc[mt][ntl][jj]);
      }
    }
    __syncthreads();
  };
#pragma unroll 1
  for (int c = 0; c < 33; c += 2) {
    body(c, qrA, krA, vrA, eblA);
    if (c + 1 < 33) body(c + 1, qrB, krB, vrB, eblB);
  }
  flush_o();
  __syncthreads();
}

__device__ __forceinline__ void rglru_unit(const Params& p, const WS& ws, int j, int u, bool dry = false) {
  const int jq = u & 3, g = (u >> 2) & 7, b = u >> 5;
  bf16_t* XC = (bf16_t*)smem;
  bf16_t* WG = XC + 64 * 136;
  float* AUa = (float*)(smem + 34816);
  float* AUu = AUa + 64 * 33;
  float* SEGA = AUu + 64 * 33;
  float* SEGH = SEGA + 256;
  float* CARRY = SEGH + 256;
  const int tid = opaque_tid(), lane = tid & 63, w = tid >> 6, lr = lane & 15, lq = lane >> 4;
#pragma unroll 4
  for (int i = 0; i < 32; ++i) {
    const int e = tid + 256 * i;
    const int gate = e >> 12, k = (e >> 5) & 127, n = e & 31;
    const float* gw = gate ? p.ab_gate_x_w : p.ab_gate_a_w;
    WG[(gate * 32 + n) * 136 + k] = f2bf(gw[((size_t)(j * 8 + g) * 128 + k) * 128 + 32 * jq + n]);
  }
  if (tid < 32) CARRY[tid] = 0.f;
  float ba[2][4], bx[2][4], sp[2][4];
#pragma unroll
  for (int mt = 0; mt < 2; ++mt)
#pragma unroll
    for (int jj = 0; jj < 4; ++jj) {
      const int ch = j * 1024 + 128 * g + 32 * jq + 16 * mt + 4 * lq + jj;
      ba[mt][jj] = p.ab_gate_a_b[ch]; bx[mt][jj] = p.ab_gate_x_b[ch];
      sp[mt][jj] = 8.f * log1pf(__expf(-p.ab_lam[ch]));
    }
  const int sc = tid & 31, ssg = tid >> 5;
  u32x4 xinA[4], xinB[4];
  bf16_t gavA[8], gavB[8];
  auto prefetch = [&](int tile, u32x4 (&xin)[4], bf16_t (&gav)[8]) {
    const int t0 = 64 * tile;
#pragma unroll
    for (int i = 0; i < 4; ++i) {
      const int ci = tid + 256 * i; const int row = ci >> 4, ch = ci & 15; const int t = t0 + row;
      xin[i] = (u32x4){0, 0, 0, 0};
      if (t < T_) xin[i] = *(const u32x4*)(ws.XA + (size_t)(b * T_ + t) * 1024 + 128 * g + 8 * ch);
    }
#pragma unroll
    for (int i = 0; i < 8; ++i) {
      const int t = t0 + 8 * ssg + i;
      gav[i] = 0;
      if (t < T_) gav[i] = ws.GA[(size_t)(b * T_ + t) * 1024 + 128 * g + 32 * jq + sc];
    }
  };
  prefetch(0, xinA, gavA);
  prefetch(1, xinB, gavB);
  __syncthreads();
  bf16_t ypend[8];
  int ypend_t0 = -1;
  auto flush_y = [&]() {
    if (ypend_t0 >= 0) {
#pragma unroll
      for (int i = 0; i < 8; ++i) {
        const int t = ypend_t0 + 8 * ssg + i;
        if (t < T_ && !dry) ws.GA[(size_t)(b * T_ + t) * 1024 + 128 * g + 32 * jq + sc] = ypend[i];
      }
    }
  };
  auto body = [&](int tile, u32x4 (&xin)[4], bf16_t (&gav)[8]) {
    const int t0 = 64 * tile;
#pragma unroll
    for (int i = 0; i < 4; ++i) {
      const int ci = tid + 256 * i; const int row = ci >> 4, ch = ci & 15;
      *(u32x4*)(XC + row * 136 + 8 * ch) = xin[i];
    }
    float gcur[8];
#pragma unroll
    for (int i = 0; i < 8; ++i) gcur[i] = bf2f(gav[i]);
    __syncthreads();
    flush_y();
    if (tile + 2 < 33) prefetch(tile + 2, xin, gav);
    {
      f32x4 ga_[2][2];
#pragma unroll
      for (int a = 0; a < 2; ++a)
#pragma unroll
        for (int bb = 0; bb < 2; ++bb) ga_[a][bb] = (f32x4){0.f, 0.f, 0.f, 0.f};
#pragma unroll
      for (int ks = 0; ks < 4; ++ks) {
        const bf16x8 xf = *(const bf16x8*)(XC + (16 * w + lr) * 136 + 32 * ks + 8 * lq);
#pragma unroll
        for (int gate = 0; gate < 2; ++gate)
#pragma unroll
          for (int mt = 0; mt < 2; ++mt) {
            const bf16x8 wf = *(const bf16x8*)(WG + (gate * 32 + 16 * mt + lr) * 136 + 32 * ks + 8 * lq);
            ga_[gate][mt] = MFMA16(wf, xf, ga_[gate][mt]);
          }
      }
      const int tok = 16 * w + lr;
#pragma unroll
      for (int mt = 0; mt < 2; ++mt)
#pragma unroll
        for (int jj = 0; jj < 4; ++jj) {
          const int n = 16 * mt + 4 * lq + jj;
          const float xcv = bf2f(XC[tok * 136 + 32 * jq + n]);
          const float r = sigmoidf_(ga_[0][mt][jj] + ba[mt][jj]);
          const float ig = sigmoidf_(ga_[1][mt][jj] + bx[mt][jj]);
          const float la = -r * sp[mt][jj];
          const float a = __expf(la);
          const float x2 = 2.f * la;
          const float om = x2 > -0.02f ? -x2 * (1.f + 0.5f * x2 * (1.f + x2 * (1.f / 3.f))) : 1.f - a * a;
          const float mult = __builtin_amdgcn_sqrtf(fmaxf(om, 0.f));
          AUa[tok * 33 + n] = a;
          AUu[tok * 33 + n] = mult * ig * xcv;
        }
    }
    __syncthreads();
    {
      float A = 1.f, Hh = 0.f;
#pragma unroll
      for (int i = 0; i < 8; ++i) {
        const float a = AUa[(8 * ssg + i) * 33 + sc], uu = AUu[(8 * ssg + i) * 33 + sc];
        Hh = a * Hh + uu; A *= a;
      }
      SEGA[ssg * 32 + sc] = A; SEGH[ssg * 32 + sc] = Hh;
    }
    __syncthreads();
    float hin = CARRY[sc];
#pragma unroll
    for (int s2 = 0; s2 < 7; ++s2)
      if (s2 < ssg) hin = SEGA[s2 * 32 + sc] * hin + SEGH[s2 * 32 + sc];
    __syncthreads();
    {
      float h = hin;
#pragma unroll
      for (int i = 0; i < 8; ++i) {
        const float a = AUa[(8 * ssg + i) * 33 + sc], uu = AUu[(8 * ssg + i) * 33 + sc];
        h = a * h + uu;
        const int t = t0 + 8 * ssg + i;
        ypend[i] = f2bf(h * siluf_(gcur[i]));
      }
      if (ssg == 7) CARRY[sc] = h;
      ypend_t0 = t0;
    }
  };
#pragma unroll 1
  for (int tile = 0; tile < 33; tile += 2) {
    body(tile, xinA, gavA);
    if (tile + 1 < 33) body(tile + 1, xinB, gavB);
  }
  flush_y();
  __syncthreads();
}

__device__ __forceinline__ void phase_gla_norm(const Params& p, const WS& ws, int j) {
  const size_t gtid = (size_t)opaque_bid() * 256 + opaque_tid(), gsz = (size_t)NVB * 256;
  const float* gn = p.ab_gla_norm + j * 256;
#pragma unroll 4
  for (size_t idx = gtid; idx < (size_t)M_ * 128; idx += gsz) {
    const size_t row = idx >> 7; const int c8 = (int)(idx & 127); const int hd = c8 >> 5; const int dv = (c8 & 31) * 8;
    const float4 s0 = *(const float4*)(ws.SSQ + row * 32 + hd * 8), s1 = *(const float4*)(ws.SSQ + row * 32 + hd * 8 + 4);
    const float ssum = (s0.x + s0.y + s0.z + s0.w) + (s1.x + s1.y + s1.z + s1.w);
    const float rstd = rsqrtf(ssum * (1.f / 256.f) + EPS_);
    const u32x4 ov = *(const u32x4*)(ws.V + row * 1024 + c8 * 8);
    const u32x4 gv = *(const u32x4*)(ws.GB + row * 1024 + c8 * 8);
    const float4 g0 = *(const float4*)(gn + dv), g1 = *(const float4*)(gn + dv + 4);
    float o[8] = {bflo(ov.x), bfhi(ov.x), bflo(ov.y), bfhi(ov.y), bflo(ov.z), bfhi(ov.z), bflo(ov.w), bfhi(ov.w)};
    const float gg[8] = {bflo(gv.x), bfhi(gv.x), bflo(gv.y), bfhi(gv.y), bflo(gv.z), bfhi(gv.z), bflo(gv.w), bfhi(gv.w)};
    const float nn[8] = {g0.x, g0.y, g0.z, g0.w, g1.x, g1.y, g1.z, g1.w};
#pragma unroll
    for (int e = 0; e < 8; ++e) o[e] = o[e] * rstd * nn[e] * siluf_(gg[e]);
    u32x4 pk; pk.x = cvt_pk_bf16(o[0], o[1]); pk.y = cvt_pk_bf16(o[2], o[3]); pk.z = cvt_pk_bf16(o[4], o[5]); pk.w = cvt_pk_bf16(o[6], o[7]);
    *(u32x4*)(ws.V + row * 1024 + c8 * 8) = pk;
  }
}

__device__ __forceinline__ void attn_unit(const WS& ws, int u, bool dry = false) {
  const int qb = 16 - (u >> 7); const int bh = u & 127; const int hd = bh & 15, b = bh >> 4;
  bf16_t* Kt = (bf16_t*)smem;
  bf16_t* Vl = Kt + 2 * 64 * 104;
  const int tid = opaque_tid(), lane = tid & 63, w = tid >> 6, lr = lane & 15, lq = lane >> 4;
  const int q0 = 128 * qb;
  int nkt = 2 * qb + 2; if (nkt > 33) nkt = 33;
  bf16x8 xq[2][3];
  int qi[2];
#pragma unroll
  for (int nt = 0; nt < 2; ++nt) {
    qi[nt] = q0 + 32 * w + 16 * nt + lr;
    const int qc = qi[nt] < T_ ? qi[nt] : T_ - 1;
#pragma unroll
    for (int ks = 0; ks < 2; ++ks)
      xq[nt][ks] = *(const bf16x8*)(ws.QB + (size_t)(b * T_ + qc) * 1536 + hd * 96 + 32 * ks + 8 * lq);
    {
      const u32x4 raw = *(const u32x4*)(ws.QB + (size_t)(b * T_ + qc) * 1536 + hd * 96 + 64 + 8 * lq);
      u32x4 oth;
      oth.x = __shfl_xor(raw.x, 32); oth.y = __shfl_xor(raw.y, 32); oth.z = __shfl_xor(raw.z, 32); oth.w = __shfl_xor(raw.w, 32);
      const float sgn = lq < 2 ? -1.f : 1.f;
      const float2* rp = ws.ROPE + (size_t)(b * T_ + qc) * 16 + 8 * (lq & 1);
      const unsigned rw[4] = {raw.x, raw.y, raw.z, raw.w}, ow[4] = {oth.x, oth.y, oth.z, oth.w};
      unsigned res[4];
#pragma unroll
      for (int e = 0; e < 4; ++e) {
        const float2 c0 = rp[2 * e], c1 = rp[2 * e + 1];
        const float r0 = bflo(rw[e]) * c0.x + sgn * bflo(ow[e]) * c0.y;
        const float r1 = bfhi(rw[e]) * c1.x + sgn * bfhi(ow[e]) * c1.y;
        res[e] = cvt_pk_bf16(r0, r1);
      }
      xq[nt][2] = as_bf16x8((u32x4){res[0], res[1], res[2], res[3]});
    }
  }
  float mrun[2] = {-INFINITY, -INFINITY}, lsum[2] = {0.f, 0.f};
  f32x4 oacc[4][2];
#pragma unroll
  for (int a = 0; a < 4; ++a)
#pragma unroll
    for (int bb = 0; bb < 2; ++bb) oacc[a][bb] = (f32x4){0.f, 0.f, 0.f, 0.f};
  u32x4 kregA[3], vregA[2], kregB[3], vregB[2];
  const bf16_t* vbase = ws.VT + ((size_t)(b * 16 + hd) * 64) * TP_;
  auto loadg = [&](int kt, u32x4 (&kreg)[3], u32x4 (&vreg)[2]) {
#pragma unroll
    for (int i = 0; i < 3; ++i) {
      const int ci = tid + 256 * i; const int key = ci / 12, ch = ci - key * 12;
      int gk = 64 * kt + key; if (gk > T_ - 1) gk = T_ - 1;
      const bf16_t* src = ch < 8 ? ws.KN + (size_t)(b * T_ + gk) * 1024 + hd * 64 + ch * 8
                                 : ws.KR + (size_t)(b * T_ + gk) * 32 + (ch - 8) * 8;
      kreg[i] = *(const u32x4*)src;
    }
#pragma unroll
    for (int i = 0; i < 2; ++i) {
      const int ci = tid + 256 * i; const int dv = ci >> 3, ch = ci & 7;
      vreg[i] = *(const u32x4*)(vbase + (size_t)dv * TP_ + 64 * kt + ch * 8);
      if (64 * kt + ch * 8 >= T_) vreg[i] = (u32x4){0u, 0u, 0u, 0u};
    }
  };
  auto stores = [&](int buf, const u32x4 (&kreg)[3], const u32x4 (&vreg)[2]) {
#pragma unroll
    for (int i = 0; i < 3; ++i) {
      const int ci = tid + 256 * i; const int key = ci / 12, ch = ci - key * 12;
      *(u32x4*)(Kt + buf * 64 * 104 + key * 104 + ch * 8) = kreg[i];
    }
#pragma unroll
    for (int i = 0; i < 2; ++i) {
      const int ci = tid + 256 * i; const int dv = ci >> 3, ch = ci & 7;
      *(u32x4*)(Vl + buf * 64 * 72 + dv * 72 + ch * 8) = vreg[i];
    }
  };
  const int nkt2 = (nkt + 1) & ~1;
  loadg(0, kregA, vregA);
  loadg(1, kregB, vregB);
  stores(0, kregA, vregA);
  __syncthreads();
  auto body = [&](int kt, int buf, u32x4 (&kreg)[3], u32x4 (&vreg)[2], const u32x4 (&kregn)[3], const u32x4 (&vregn)[2]) {
    { const int kn = kt + 2 < nkt2 ? kt + 2 : nkt2 - 1; loadg(kn, kreg, vreg); }
    const bf16_t* Kb = Kt + buf * 64 * 104;
    const bf16_t* Vb = Vl + buf * 64 * 72;
    f32x4 s[4][2];
#pragma unroll
    for (int mt = 0; mt < 4; ++mt) {
      s[mt][0] = (f32x4){0.f, 0.f, 0.f, 0.f}; s[mt][1] = (f32x4){0.f, 0.f, 0.f, 0.f};
#pragma unroll
      for (int ks = 0; ks < 3; ++ks) {
        const bf16x8 kf = *(const bf16x8*)(Kb + (16 * mt + lr) * 104 + 32 * ks + 8 * lq);
        s[mt][0] = MFMA16(kf, xq[0][ks], s[mt][0]);
        s[mt][1] = MFMA16(kf, xq[1][ks], s[mt][1]);
      }
    }
    if (kt >= 2 * qb) {
#pragma unroll
      for (int mt = 0; mt < 4; ++mt)
#pragma unroll
        for (int nt = 0; nt < 2; ++nt)
#pragma unroll
          for (int jj = 0; jj < 4; ++jj) {
            const int key = 64 * kt + 16 * mt + 4 * lq + jj;
            if (key > qi[nt]) s[mt][nt][jj] = -INFINITY;
          }
    }
    bf16x8 pf[2][2];
#pragma unroll
    for (int nt = 0; nt < 2; ++nt) {
      float mx = -INFINITY;
#pragma unroll
      for (int mt = 0; mt < 4; ++mt) mx = fmaxf(mx, fmaxf(fmaxf(s[mt][nt][0], s[mt][nt][1]), fmaxf(s[mt][nt][2], s[mt][nt][3])));
      mx = fmaxf(mx, __shfl_xor(mx, 16)); mx = fmaxf(mx, __shfl_xor(mx, 32));
      if (__builtin_amdgcn_ballot_w64(mx > mrun[nt]) != 0ull) {
        const float mnew = fmaxf(mrun[nt], mx);
        const float alpha = __builtin_amdgcn_exp2f(mrun[nt] - mnew);
        mrun[nt] = mnew;
        lsum[nt] *= alpha;
#pragma unroll
        for (int mt = 0; mt < 4; ++mt) oacc[mt][nt] = scale4(oacc[mt][nt], alpha);
      }
      const float mnew = mrun[nt];
      float ps = 0.f;
#pragma unroll
      for (int mt = 0; mt < 4; ++mt)
#pragma unroll
        for (int jj = 0; jj < 4; ++jj) { const float pv = __builtin_amdgcn_exp2f(s[mt][nt][jj] - mnew); s[mt][nt][jj] = pv; ps += pv; }
      lsum[nt] += ps;
#pragma unroll
      for (int ks = 0; ks < 2; ++ks) {
        u32x4 pk;
        pk.x = cvt_pk_bf16(s[2 * ks][nt][0], s[2 * ks][nt][1]); pk.y = cvt_pk_bf16(s[2 * ks][nt][2], s[2 * ks][nt][3]);
        pk.z = cvt_pk_bf16(s[2 * ks + 1][nt][0], s[2 * ks + 1][nt][1]); pk.w = cvt_pk_bf16(s[2 * ks + 1][nt][2], s[2 * ks + 1][nt][3]);
        pf[nt][ks] = as_bf16x8(pk);
      }
    }
#pragma unroll
    for (int mt = 0; mt < 4; ++mt)
#pragma unroll
      for (int ks = 0; ks < 2; ++ks) {
        const u32x2 lo = *(const u32x2*)(Vb + (16 * mt + lr) * 72 + 32 * ks + 4 * lq);
        const u32x2 hi = *(const u32x2*)(Vb + (16 * mt + lr) * 72 + 32 * ks + 16 + 4 * lq);
        const bf16x8 vf = as_bf16x8((u32x4){lo.x, lo.y, hi.x, hi.y});
        oacc[mt][0] = MFMA16(vf, pf[0][ks], oacc[mt][0]);
        oacc[mt][1] = MFMA16(vf, pf[1][ks], oacc[mt][1]);
      }
    stores(buf ^ 1, kregn, vregn);
    __syncthreads();
  };
#pragma unroll 1
  for (int kt = 0; kt < nkt2; kt += 2) {
    body(kt, 0, kregA, vregA, kregB, vregB);
    body(kt + 1, 1, kregB, vregB, kregA, vregA);
  }
#pragma unroll
  for (int nt = 0; nt < 2; ++nt) {
    float l = lsum[nt];
    l += __shfl_xor(l, 16); l += __shfl_xor(l, 32);
    const float inv = 1.f / l;
    if (qi[nt] < T_) {
      const size_t row = (size_t)(b * T_ + qi[nt]);
#pragma unroll
      for (int mt = 0; mt < 4; ++mt) {
        const u32x2 gv = *(const u32x2*)(ws.GATE + row * 1024 + hd * 64 + 16 * mt + 4 * lq);
        const float o0 = oacc[mt][nt][0] * inv * siluf_(bflo(gv.x)), o1 = oacc[mt][nt][1] * inv * siluf_(bfhi(gv.x));
        const float o2 = oacc[mt][nt][2] * inv * siluf_(bflo(gv.y)), o3 = oacc[mt][nt][3] * inv * siluf_(bfhi(gv.y));
        u32x2 pk; pk.x = cvt_pk_bf16(o0, o1); pk.y = cvt_pk_bf16(o2, o3);
        if (!dry) *(u32x2*)(ws.QB + row * 1536 + hd * 96 + 16 * mt + 4 * lq) = pk;
      }
    }
  }
}

__device__ __forceinline__ void phase_final(const Params& p, const WS& ws) {
  const int tidf = opaque_tid();
  const int lane = tidf & 63;
  const int gw = opaque_bid() * 4 + (tidf >> 6), nw = NVB * 4;
#pragma unroll 2
  for (int r = gw; r < 8 * 2048; r += nw) {
    const int b = r >> 11, s = r & 2047;
    const size_t hoff = (size_t)(b * T_ + 16 + s) * 1024;
    float4 v[4];
    float ssum = 0.f;
#pragma unroll
    for (int i = 0; i < 4; ++i) {
      const u32x2 hi = *(const u32x2*)(ws.HHI + hoff + i * 256 + lane * 4), lo = *(const u32x2*)(ws.HLO + hoff + i * 256 + lane * 4);
      v[i] = make_float4(bflo(hi.x) + bflo(lo.x), bfhi(hi.x) + bfhi(lo.x), bflo(hi.y) + bflo(lo.y), bfhi(hi.y) + bfhi(lo.y));
      ssum += v[i].x * v[i].x + v[i].y * v[i].y + v[i].z * v[i].z + v[i].w * v[i].w;
    }
#pragma unroll
    for (int o = 1; o < 64; o <<= 1) ssum += __shfl_xor(ssum, o);
    const float rstd = rsqrtf(ssum * (1.f / 1024.f) + EPS_);
#pragma unroll
    for (int i = 0; i < 4; ++i) {
      const float4 g = *(const float4*)(p.final_norm + i * 256 + lane * 4);
      float4 o; o.x = v[i].x * rstd * g.x; o.y = v[i].y * rstd * g.y; o.z = v[i].z * rstd * g.z; o.w = v[i].w * rstd * g.w;
      *(float4*)(p.out + (size_t)r * 1024 + i * 256 + lane * 4) = o;
    }
  }
}

__global__ void __launch_bounds__(512, 2) fwd_megakernel(Params p) {
  cg::grid_group grid = cg::this_grid();
  if (p.inv_freq[0] < 0.f) grid.sync();
  volatile LAS unsigned* xst = (volatile LAS unsigned*)(smem_all + 2 * SMEM_BYTES);
  if (threadIdx.x == 0) { xst[0] = 0u; xst[1] = 0u; xst[2] = 0u; xst[3] = 0u; }
  __syncthreads();
  const XcdBarrier xb = xcd_barrier_post((unsigned*)(p.ws + BAR_OFF), xst);
  {
    const WS ws = make_ws(p);
    phase_prologue(p, ws);
  }
  xcd_barrier(xb);
#pragma unroll 1
  for (int layer = 0; layer < 4; ++layer) {
    const int j = layer >> 1;
    if ((layer & 1) == 0) {
      {
        const WS ws = make_ws(p);
        const bf16_t* wb = ws.W + (size_t)j * W_PER_J;
#pragma unroll 1
        for (int rep = 0; rep < REP_GEMM; ++rep)
          { gemm_wide<EPI_E1>(ws, ws.HHI, 1024, wb + W_IN_E, 1024, 1.f / 1024.f, 20, 64 * 20, xcd_bid(opaque_rbid()));
            gemm_rem_splitk(ws, ws.HHI, wb + W_IN_E, opaque_rbid()); }
      }
      xcd_barrier(xb);
      {
        const WS ws = make_ws(p);
#pragma unroll 1
        for (int u = opaque_bid(); u < 8 * 4 * 33 + 64; u += NVB) {
          if (u < 448) gla_decay_unit(p, ws, j, u); else if (u < 512) conv_unit(p, ws, j, u - 448); else gla_decay_unit(p, ws, j, u - 64);
        }
      }
      xcd_barrier(xb);
      {
#pragma unroll 1
        for (int rep = 0; rep < REP_E2; ++rep)
#pragma unroll 1
        for (int u = opaque_bid(); u < 512; u += NVB) {
          if (u & 1) { const WS ws = make_ws(p); rglru_unit(p, ws, j, u >> 1, rep < REP_E2 - 1); }
          else { const WS ws = make_ws(p); gla_unit(p, ws, u >> 1, rep < REP_E2 - 1); }
        }
      }
      xcd_barrier(xb);
      {
        const WS ws = make_ws(p);
        phase_gla_norm(p, ws, j);
      }
      xcd_barrier(xb);
      {
        const WS ws = make_ws(p);
        const bf16_t* wb = ws.W + (size_t)j * W_PER_J;
#pragma unroll 1
        for (int rep = 0; rep < REP_GEMM; ++rep)
          gemm_stream<false, EPI_RES, 5>(ws, ws.GA, ws.V, 1024, 16, 64, wb + W_OUT_E, 2048, 0.f, 8, 64 * 8, xcd_bid(opaque_rbid()), rep < REP_GEMM - 1);
      }
      xcd_barrier(xb);
    } else {
      {
        const WS ws = make_ws(p);
        const bf16_t* wb = ws.W + (size_t)j * W_PER_J;
#pragma unroll 1
        for (int rep = 0; rep < REP_GEMM; ++rep)
          gemm_stream<true, EPI_O1, 4>(ws, ws.HHI, nullptr, 1024, 1 << 30, 64, wb + W_IN_O, 1024, 1.f / 1024.f, 15, 65 * 15, xcd_bid(opaque_rbid()), false);
      }
      xcd_barrier(xb);
      {
        const WS ws = make_ws(p);
        const bf16_t* wb = ws.W + (size_t)j * W_PER_J;
#pragma unroll 1
        for (int rep = 0; rep < REP_GEMM; ++rep) {
          gemm_stream<true, EPI_Q, 4>(ws, ws.CQ, nullptr, 512, 1 << 30, 64, wb + W_Q, 512, 1.f / 512.f, 12, 65 * 12, xcd_bid(opaque_rbid()), false);
          gemm_stream<true, EPI_KV, 4>(ws, ws.CKV, nullptr, 256, 1 << 30, 64, wb + W_KV, 256, 1.f / 256.f, 16, 65 * 16, xcd_bid((opaque_rbid() + (int)(gridDim.x >> 1)) % (int)gridDim.x), false);
        }
      }
      xcd_barrier(xb);
      {
        const WS ws = make_ws(p);
#pragma unroll 1
        for (int rep = 0; rep < REP_ATTN; ++rep)
#pragma unroll 1
        for (int r = 0, b0 = opaque_bid(); r * NVB < 17 * 128; ++r) {
          const int u = r * NVB + ((r & 1) ? NVB - 1 - b0 : b0);
          if (u < 17 * 128) attn_unit(ws, u, rep < REP_ATTN - 1);
          __syncthreads();
        }
      }
      xcd_barrier(xb);
      {
        const WS ws = make_ws(p);
        const bf16_t* wb = ws.W + (size_t)j * W_PER_J;
#pragma unroll 1
        for (int rep = 0; rep < REP_GEMM; ++rep)
          gemm_stream<false, EPI_RES, 5>(ws, ws.QB, nullptr, 1536, 1 << 30, 96, wb + W_O, 1024, 0.f, 8, 64 * 8, xcd_bid(opaque_rbid()), rep < REP_GEMM - 1);
      }
      xcd_barrier(xb);
    }
  }
  {
    const WS ws = make_ws(p);
    phase_final(p, ws);
  }
}

extern "C" void kernel_launch(void* const* d_in, const int* in_sizes, int n_in, void* d_out, int out_size, void* d_ws,
                              size_t ws_size, hipStream_t stream) {
  static int grid_blocks = 0;
  if (!grid_blocks) {
    int dev = 0, cus = 0, per_cu = 0;
    hipGetDevice(&dev);
    hipDeviceGetAttribute(&cus, hipDeviceAttributeMultiprocessorCount, dev);
    hipOccupancyMaxActiveBlocksPerMultiprocessor(&per_cu, fwd_megakernel, 512, 0);
    per_cu = 1;
    grid_blocks = cus * per_cu;
  }
  Params p{};
  p.x = (const float*)d_in[0]; p.positions = (const int*)d_in[1]; p.meta = (const float*)d_in[2];
  p.ab_norm = (const float*)d_in[3]; p.ab_w_in = (const float*)d_in[4]; p.ab_conv_w = (const float*)d_in[5];
  p.ab_conv_b = (const float*)d_in[6]; p.ab_gate_a_w = (const float*)d_in[7]; p.ab_gate_a_b = (const float*)d_in[8];
  p.ab_gate_x_w = (const float*)d_in[9]; p.ab_gate_x_b = (const float*)d_in[10]; p.ab_lam = (const float*)d_in[11];
  p.ab_alpha_w = (const float*)d_in[12]; p.ab_alpha_b = (const float*)d_in[13]; p.ab_gla_norm = (const float*)d_in[14];
  p.ab_w_out = (const float*)d_in[15]; p.c_norm = (const float*)d_in[16]; p.c_w_in = (const float*)d_in[17];
  p.c_q_norm = (const float*)d_in[18]; p.c_w_q_up = (const float*)d_in[19]; p.c_kv_norm = (const float*)d_in[20];
  p.c_w_kv_up = (const float*)d_in[21]; p.c_w_out = (const float*)d_in[22]; p.final_norm = (const float*)d_in[23];
  p.out = (float*)d_out;
  p.ws = (unsigned char*)d_ws;
  for (int i = 0; i < 16; ++i) p.inv_freq[i] = (float)pow(10000.0, -(double)i / 16.0);
  hipMemsetAsync((unsigned char*)d_ws + BAR_OFF, 0, XCD_BAR_WORDS * 4, stream);
  void* args[] = {&p};
  hipError_t e = hipLaunchCooperativeKernel((void*)fwd_megakernel, dim3(grid_blocks), dim3(512), args, 0, stream);
  if (e != hipSuccess) fprintf(stderr, "cooperative launch failed: %s (grid %d)\n", hipGetErrorString(e), grid_blocks);
}
```
